# Optimizing an MI355X kernel written in HIP

```python
import math
import jax, jax.numpy as jnp
from jax import lax
import numpy as np

D_MODEL = 1024
BATCH = 32
SEQ = 2048
DEPTH = 1

MEM_LEN = 256
SSM_WIDTH = 512
SSM_GROUP = 16
SSM_GROUPS = SSM_WIDTH // SSM_GROUP
SSM_STATE = 64
DSA_HEADS = 8
DSA_HEAD_DIM = 64
IDX_HEADS = 4
IDX_DIM = 64
IDX_TOPK_MAX = 256
Q_BLOCK = 128
MEM_HEADS = 4
MEM_HEAD_DIM = 128
N_BRANCHES = 3
ROPE_THETA = 10000.0
N_GROUPS = 4
EXPERTS_PER_GROUP = 8
N_EXPERTS = N_GROUPS * EXPERTS_PER_GROUP
TOP_K_EXPERTS = 2
EXPERT_FF = 512
EPS = 1e-6
IN_SPLITS = (SSM_WIDTH, DSA_HEADS * DSA_HEAD_DIM, DSA_HEAD_DIM, DSA_HEAD_DIM, IDX_HEADS * IDX_DIM, IDX_DIM, IDX_HEADS, MEM_HEADS * MEM_HEAD_DIM, N_BRANCHES * D_MODEL)
IN_COLS = sum(IN_SPLITS)

kernel_name = 'hybrid_s5_dsa_memxattn_hmoe'

F32 = jnp.float32


def rms_norm(x, g):
    xf = x.astype(F32)
    y = xf * lax.rsqrt(jnp.mean(xf * xf, axis=-1, keepdims=True) + EPS)
    return (y * g.astype(F32)).astype(x.dtype)


def rope_tables(positions, dim):
    inv = 1.0 / (ROPE_THETA ** (jnp.arange(0, dim, 2, dtype=F32) / dim))
    ang = positions.astype(F32)[..., None] * inv
    return jnp.cos(ang), jnp.sin(ang)


def apply_rope(x, cos, sin):
    extra = x.ndim - cos.ndim
    cos = cos.reshape(cos.shape[:2] + (1,) * extra + cos.shape[2:])
    sin = sin.reshape(sin.shape[:2] + (1,) * extra + sin.shape[2:])
    x1, x2 = jnp.split(x.astype(F32), 2, axis=-1)
    out = jnp.concatenate([x1 * cos - x2 * sin, x2 * cos + x1 * sin], axis=-1)
    return out.astype(x.dtype)


def _ssm_combine(e1, e2):
    a1, b1 = e1
    a2, b2 = e2
    return a1 * a2, a2 * b1 + b2


def s5_branch(u, lam_re, lam_im, log_dt, b_re, b_im, c_re, c_im, d_skip, w_glu):
    bsz, seq, _ = u.shape
    uf = u.astype(F32).reshape(bsz, seq, SSM_GROUPS, SSM_GROUP)
    lam = lax.complex(lam_re.astype(F32), lam_im.astype(F32))
    dt = jnp.exp(log_dt.astype(F32))[:, None]
    lam_bar = jnp.exp(lam * dt)
    b = lax.complex(b_re.astype(F32), b_im.astype(F32))
    b_bar = ((lam_bar - 1.0) / lam)[..., None] * b
    bu = jnp.einsum('bsgh,gph->bsgp', uf.astype(jnp.complex64), b_bar)
    a = jnp.broadcast_to(lam_bar, (1, seq) + lam_bar.shape)
    _, states = lax.associative_scan(_ssm_combine, (a, bu), axis=1)
    c = lax.complex(c_re.astype(F32), c_im.astype(F32))
    y = jnp.real(jnp.einsum('bsgp,ghp->bsgh', states, c))
    y = y + d_skip.astype(F32).reshape(SSM_GROUPS, SSM_GROUP) * uf
    y = jax.nn.gelu(y.reshape(bsz, seq, SSM_WIDTH))
    y = y * jax.nn.sigmoid(y @ w_glu.astype(F32))
    return y.astype(u.dtype)


def dsa_branch(q, k, v, qi, ki, wi, pos):
    bsz, seq = pos.shape
    topk = min(IDX_TOPK_MAX, seq // 4)
    nb = seq // Q_BLOCK
    kif = ki.astype(F32)
    gather = jax.vmap(lambda src, idx: src[idx])

    def to_blocks(t):
        t = t.reshape((bsz, nb, Q_BLOCK) + t.shape[2:])
        return jnp.moveaxis(t, 1, 0)

    def block_fn(args):
        qb, qib, wib, posb = args
        sc = jnp.einsum('bqhd,bsd->bqhs', qib.astype(F32), kif) * (IDX_DIM ** -0.5)
        iscore = jnp.einsum('bqh,bqhs->bqs', wib.astype(F32), jax.nn.relu(sc))
        causal = pos[:, None, :] <= posb[:, :, None]
        iscore = jnp.where(causal, iscore, -jnp.inf)
        _, idx = lax.top_k(iscore, topk)
        ks = gather(k, idx).astype(F32)
        vs = gather(v, idx).astype(F32)
        ps = gather(pos, idx)
        s = jnp.einsum('bqhd,bqkd->bqhk', qb.astype(F32), ks) * (DSA_HEAD_DIM ** -0.5)
        valid = (ps <= posb[..., None])[:, :, None, :]
        p = jax.nn.softmax(jnp.where(valid, s, -jnp.inf), axis=-1)
        o = jnp.einsum('bqhk,bqkd->bqhd', p, vs)
        return o.astype(qb.dtype)

    out = lax.map(block_fn, (to_blocks(q), to_blocks(qi), to_blocks(wi), to_blocks(pos)))
    out = jnp.moveaxis(out, 0, 1).reshape(bsz, seq, DSA_HEADS * DSA_HEAD_DIM)
    return out


def memory_branch(qm, km, vm):
    bsz, seq = qm.shape[:2]
    s = jnp.einsum('bshd,bmhd->bhsm', qm.astype(F32), km.astype(F32)) * (MEM_HEAD_DIM ** -0.5)
    p = jax.nn.softmax(s, axis=-1)
    o = jnp.einsum('bhsm,bmhd->bshd', p, vm.astype(F32))
    return o.reshape(bsz, seq, MEM_HEADS * MEM_HEAD_DIM).astype(qm.dtype)


def hier_moe(h, w_group, b_group, w_expert, b_expert, w_gate, w_up, w_down):
    bsz, seq, d = h.shape
    t = h.reshape(-1, d)
    hf = t.astype(F32)
    g_prob = jax.nn.softmax(hf @ w_group.astype(F32) + b_group.astype(F32), axis=-1)
    g_idx = jnp.argmax(g_prob, axis=-1)
    g_gate = jnp.take_along_axis(g_prob, g_idx[:, None], axis=-1)[:, 0]
    e_logits = (hf @ w_expert.astype(F32)).reshape(-1, N_GROUPS, EXPERTS_PER_GROUP) + b_expert.astype(F32)
    e_logits = jnp.take_along_axis(e_logits, g_idx[:, None, None], axis=1)[:, 0]
    e_prob = jax.nn.softmax(e_logits, axis=-1)
    top_p, top_i = lax.top_k(e_prob, TOP_K_EXPERTS)
    top_w = g_gate[:, None] * top_p / jnp.sum(top_p, axis=-1, keepdims=True)
    global_i = g_idx[:, None] * EXPERTS_PER_GROUP + top_i
    combine = jnp.sum(jax.nn.one_hot(global_i, N_EXPERTS, dtype=F32) * top_w[..., None], axis=1)
    out = jnp.zeros(hf.shape, F32)
    for e in range(N_EXPERTS):
        hid = jax.nn.silu(t @ w_gate[e]) * (t @ w_up[e])
        out = out + combine[:, e:e + 1] * (hid @ w_down[e]).astype(F32)
    return out.reshape(bsz, seq, d).astype(h.dtype)


def hybrid_layer(x, mem, positions, g_mix, g_mem, w_in, lam_re, lam_im, log_dt, b_re, b_im, c_re, c_im, d_skip, w_glu, g_q, g_k, g_qm, g_km, w_mem_kv, w_up_ssm, w_up_dsa, w_up_mem, w_out, g_ffn, w_group, b_group, w_expert, b_expert, w_gate, w_up, w_down):
    bsz, seq, _ = x.shape
    mlen = mem.shape[1]
    h = rms_norm(x, g_mix)
    proj = h @ w_in
    offs = [int(o) for o in np.cumsum(IN_SPLITS)[:-1]]
    u_ssm, q, k, v, qi, ki, wi, qm, gates = jnp.split(proj, offs, axis=-1)
    cos_a, sin_a = rope_tables(positions, DSA_HEAD_DIM)
    cos_i, sin_i = rope_tables(positions, IDX_DIM)
    q = apply_rope(rms_norm(q.reshape(bsz, seq, DSA_HEADS, DSA_HEAD_DIM), g_q), cos_a, sin_a)
    k = apply_rope(rms_norm(k, g_k), cos_a, sin_a)
    qi = apply_rope(qi.reshape(bsz, seq, IDX_HEADS, IDX_DIM), cos_i, sin_i)
    ki = apply_rope(ki, cos_i, sin_i)
    wi = wi * (IDX_HEADS ** -0.5)
    qm = rms_norm(qm.reshape(bsz, seq, MEM_HEADS, MEM_HEAD_DIM), g_qm)
    km, vm = jnp.split(rms_norm(mem, g_mem) @ w_mem_kv, 2, axis=-1)
    km = rms_norm(km.reshape(bsz, mlen, MEM_HEADS, MEM_HEAD_DIM), g_km)
    vm = vm.reshape(bsz, mlen, MEM_HEADS, MEM_HEAD_DIM)

    y_ssm = s5_branch(u_ssm, lam_re, lam_im, log_dt, b_re, b_im, c_re, c_im, d_skip, w_glu)
    y_dsa = dsa_branch(q, k, v, qi, ki, wi, positions)
    y_mem = memory_branch(qm, km, vm)

    g_s, g_d, g_m = jnp.split(jax.nn.sigmoid(gates), N_BRANCHES, axis=-1)
    merged = g_s * (y_ssm @ w_up_ssm) + g_d * (y_dsa @ w_up_dsa) + g_m * (y_mem @ w_up_mem)
    x = x + merged @ w_out
    x = x + hier_moe(rms_norm(x, g_ffn), w_group, b_group, w_expert, b_expert, w_gate, w_up, w_down)
    return x


def setup_inputs(seed: int = 0) -> dict:
    key = jax.random.key(seed)
    ks = iter(jax.random.split(key, 48))
    L = DEPTH

    def nrm(shape, scale):
        return jax.random.normal(next(ks), shape, F32) * scale

    def gain(shape):
        return 1.0 + 0.02 * jax.random.normal(next(ks), shape, F32)

    x = nrm((BATCH, SEQ, D_MODEL), 1.0)
    mem = nrm((BATCH, MEM_LEN, D_MODEL), 1.0)
    offset = jax.random.randint(next(ks), (BATCH, 1), 0, 1024, dtype=jnp.int32)
    positions = offset + jnp.arange(SEQ, dtype=jnp.int32)[None, :]
    n = jnp.arange(SSM_STATE, dtype=F32)
    lam_re = -0.5 + nrm((L, SSM_GROUPS, SSM_STATE), 0.01)
    lam_im = jnp.pi * n + nrm((L, SSM_GROUPS, SSM_STATE), 0.01)
    log_dt = jax.random.uniform(next(ks), (L, SSM_GROUPS), F32, math.log(1e-3), math.log(1e-1))
    return {
        'x': x,
        'mem': mem,
        'positions': positions,
        'g_mix': gain((L, D_MODEL)),
        'g_mem': gain((L, D_MODEL)),
        'w_in': nrm((L, D_MODEL, IN_COLS), D_MODEL ** -0.5),
        'lam_re': lam_re,
        'lam_im': lam_im,
        'log_dt': log_dt,
        'b_re': nrm((L, SSM_GROUPS, SSM_STATE, SSM_GROUP), (2 * SSM_GROUP) ** -0.5),
        'b_im': nrm((L, SSM_GROUPS, SSM_STATE, SSM_GROUP), (2 * SSM_GROUP) ** -0.5),
        'c_re': nrm((L, SSM_GROUPS, SSM_GROUP, SSM_STATE), SSM_STATE ** -0.5),
        'c_im': nrm((L, SSM_GROUPS, SSM_GROUP, SSM_STATE), SSM_STATE ** -0.5),
        'd_skip': nrm((L, SSM_WIDTH), 1.0),
        'w_glu': nrm((L, SSM_WIDTH, SSM_WIDTH), SSM_WIDTH ** -0.5),
        'g_q': gain((L, DSA_HEAD_DIM)),
        'g_k': gain((L, DSA_HEAD_DIM)),
        'g_qm': gain((L, MEM_HEAD_DIM)),
        'g_km': gain((L, MEM_HEAD_DIM)),
        'w_mem_kv': nrm((L, D_MODEL, 2 * MEM_HEADS * MEM_HEAD_DIM), D_MODEL ** -0.5),
        'w_up_ssm': nrm((L, SSM_WIDTH, D_MODEL), SSM_WIDTH ** -0.5),
        'w_up_dsa': nrm((L, DSA_HEADS * DSA_HEAD_DIM, D_MODEL), (DSA_HEADS * DSA_HEAD_DIM) ** -0.5),
        'w_up_mem': nrm((L, MEM_HEADS * MEM_HEAD_DIM, D_MODEL), (MEM_HEADS * MEM_HEAD_DIM) ** -0.5),
        'w_out': nrm((L, D_MODEL, D_MODEL), D_MODEL ** -0.5),
        'g_ffn': gain((L, D_MODEL)),
        'w_group': nrm((L, D_MODEL, N_GROUPS), D_MODEL ** -0.5),
        'b_group': nrm((L, N_GROUPS), 0.01),
        'w_expert': nrm((L, D_MODEL, N_EXPERTS), D_MODEL ** -0.5),
        'b_expert': nrm((L, N_GROUPS, EXPERTS_PER_GROUP), 0.01),
        'w_gate': nrm((L, N_EXPERTS, D_MODEL, EXPERT_FF), D_MODEL ** -0.5),
        'w_up': nrm((L, N_EXPERTS, D_MODEL, EXPERT_FF), D_MODEL ** -0.5),
        'w_down': nrm((L, N_EXPERTS, EXPERT_FF, D_MODEL), EXPERT_FF ** -0.5),
    }


def reference(x, mem, positions, g_mix, g_mem, w_in, lam_re, lam_im, log_dt, b_re, b_im, c_re, c_im, d_skip, w_glu, g_q, g_k, g_qm, g_km, w_mem_kv, w_up_ssm, w_up_dsa, w_up_mem, w_out, g_ffn, w_group, b_group, w_expert, b_expert, w_gate, w_up, w_down):
    for l in range(DEPTH):
        x = hybrid_layer(x, mem, positions, g_mix[l], g_mem[l], w_in[l], lam_re[l], lam_im[l], log_dt[l], b_re[l], b_im[l], c_re[l], c_im[l], d_skip[l], w_glu[l], g_q[l], g_k[l], g_qm[l], g_km[l], w_mem_kv[l], w_up_ssm[l], w_up_dsa[l], w_up_mem[l], w_out[l], g_ffn[l], w_group[l], b_group[l], w_expert[l], b_expert[l], w_gate[l], w_up[l], w_down[l])
    return x
```

```cpp
#include <hip/hip_runtime.h>
#include <stdio.h>
#include <stdint.h>

#ifndef MK_PER_PHASE
#define MK_PER_PHASE 0
#endif

#define LAS __attribute__((address_space(3)))
typedef unsigned short bf16_t;
typedef short bf16x8 __attribute__((ext_vector_type(8)));
typedef float f32x4 __attribute__((ext_vector_type(4)));
typedef float f32x16 __attribute__((ext_vector_type(16)));
typedef unsigned u32x4 __attribute__((ext_vector_type(4)));
typedef unsigned u32x2 __attribute__((ext_vector_type(2)));

constexpr int T = 65536, NB = 32, SEQ = 2048, D = 1024;
constexpr int NTHR = 512;
constexpr int LDS_BYTES = 151552, MISC_OFF = LDS_BYTES - 4096;
constexpr int NPHASE = 11;

constexpr size_t WS_CTL = 0, CTL_BYTES = 65536;
constexpr size_t CTL_GCNT = 16384;
constexpr size_t WS_WIN = WS_CTL + CTL_BYTES;
constexpr size_t WS_WMEM = WS_WIN + (size_t)5120 * 1024 * 2;
constexpr size_t WS_WGLU = WS_WMEM + (size_t)1024 * 1024 * 2;
constexpr size_t WS_WUP = WS_WGLU + (size_t)512 * 512 * 2;
constexpr size_t WS_WOUT = WS_WUP + (size_t)3 * 1024 * 512 * 2;
constexpr size_t WS_WGU = WS_WOUT + (size_t)1024 * 1024 * 2;
constexpr size_t WS_WD = WS_WGU + (size_t)32 * 1024 * 1024 * 2;
constexpr size_t WS_TW = WS_WD + (size_t)32 * 1024 * 512 * 2;
constexpr size_t WS_SIN = WS_TW + (size_t)32 * 512 * 640 * 2;
constexpr size_t WS_LAM32 = WS_SIN + (size_t)32 * 256 * 512 * 2;
constexpr size_t WS_WR = WS_LAM32 + 16384;
constexpr size_t WS_HB = WS_WR + 98304;
constexpr size_t WS_UA = WS_HB + (size_t)T * 1024 * 2;
constexpr size_t WS_KVX = WS_UA + (size_t)32 * 2048 * 640 * 2;
constexpr size_t WS_KVP = WS_KVX + (size_t)T * 256 * 2;
constexpr size_t WS_KIP = WS_KVP + (size_t)T * 128 * 2;
constexpr size_t WS_WIF = WS_KIP + (size_t)T * 64 * 2;
constexpr size_t WS_QI = WS_WIF + (size_t)T * 4 * 4;
constexpr size_t WS_SG = WS_QI + (size_t)T * 256 * 2;
constexpr size_t WS_X1B = WS_SG;
constexpr size_t WS_HID = WS_SG + (size_t)T * 3072;
constexpr size_t WS_X1B8 = WS_HID + (size_t)T * 1024;
constexpr size_t WS_SC = WS_HID + (size_t)T * 1024 * 2;
constexpr size_t WS_IDX = WS_SC + (size_t)32 * 2048 * 128 * 4;
constexpr size_t WS_MEMN = WS_IDX + (size_t)T * 256 * 2;
constexpr size_t WS_KMVM = WS_MEMN + (size_t)8192 * 1024 * 2;
constexpr size_t WS_KM = WS_KMVM + (size_t)8192 * 1024 * 2;
constexpr size_t WS_VMT = WS_KM + (size_t)128 * 256 * 128 * 2;
constexpr size_t WS_TOK = WS_VMT + (size_t)128 * 128 * 256 * 2;
constexpr size_t WS_RW = WS_TOK + (size_t)32 * 65536 * 4;
constexpr size_t WS_TOK2 = WS_RW + (size_t)32 * 65536 * 8;
constexpr size_t WS_LP = WS_TOK2 + (size_t)112 * 65536 * 4;
constexpr size_t WS_BB = WS_LP + (size_t)32 * 64 * 33 * 8;
constexpr size_t WS_HB8 = WS_BB + (size_t)32 * 64 * 16 * 8;
constexpr size_t WS_WG8 = WS_HB8 + (size_t)T * 1024;
constexpr size_t WS_CS = WS_WG8 + (size_t)5120 * 1024;
constexpr size_t WS_END = WS_CS + (size_t)T * 32 * 8;
constexpr size_t DO_Y3 = 0, DO_Y8 = (size_t)T * 1024 * 2, DO_YS8 = DO_Y8, DO_YD8 = DO_Y8 + (size_t)T * 512, DO_YM8 = DO_Y8 + (size_t)2 * T * 512;
constexpr int Y3LD = 1024;
constexpr size_t WS_YG = WS_HID;

__device__ __forceinline__ float bf2f(unsigned b) { return __uint_as_float(b << 16); }
__device__ __forceinline__ unsigned cvt_pk_bf16(float lo, float hi) { unsigned r; asm("v_cvt_pk_bf16_f32 %0, %1, %2" : "=v"(r) : "v"(lo), "v"(hi)); return r; }
__device__ __forceinline__ bf16_t f2bf(float f) { return (bf16_t)(cvt_pk_bf16(f, 0.f) & 0xffffu); }
__device__ __forceinline__ float wave_sum(float v) { v += __shfl_xor(v, 32); v += __shfl_xor(v, 16); v += __shfl_xor(v, 8); v += __shfl_xor(v, 4); v += __shfl_xor(v, 2); v += __shfl_xor(v, 1); return v; }
__device__ __forceinline__ float sum32(float v) { v += __shfl_xor(v, 16); v += __shfl_xor(v, 8); v += __shfl_xor(v, 4); v += __shfl_xor(v, 2); v += __shfl_xor(v, 1); return v; }
__device__ __forceinline__ float sigm(float x) { return __builtin_amdgcn_rcpf(1.0f + __expf(-x)); }
__device__ __forceinline__ float gelu_tanh(float x) { const float u = 1.5957691216057308f * (x + 0.044715f * x * x * x); return x * sigm(u); }
__device__ __forceinline__ u32x4 pack8(const f32x4 a, const f32x4 b) { u32x4 w; w.x = cvt_pk_bf16(a[0], a[1]); w.y = cvt_pk_bf16(a[2], a[3]); w.z = cvt_pk_bf16(b[0], b[1]); w.w = cvt_pk_bf16(b[2], b[3]); return w; }
__device__ __forceinline__ void unpack8(const u32x4 w, f32x4& a, f32x4& b) {
    a[0] = bf2f(w.x & 0xffffu); a[1] = bf2f(w.x >> 16); a[2] = bf2f(w.y & 0xffffu); a[3] = bf2f(w.y >> 16);
    b[0] = bf2f(w.z & 0xffffu); b[1] = bf2f(w.z >> 16); b[2] = bf2f(w.w & 0xffffu); b[3] = bf2f(w.w >> 16); }

__device__ __forceinline__ unsigned pack_fp8x4(float a, float b, float c, float d) {
    a = fminf(fmaxf(a, -448.f), 448.f); b = fminf(fmaxf(b, -448.f), 448.f); c = fminf(fmaxf(c, -448.f), 448.f); d = fminf(fmaxf(d, -448.f), 448.f);
    int p = __builtin_amdgcn_cvt_pk_fp8_f32(a, b, 0, false); p = __builtin_amdgcn_cvt_pk_fp8_f32(c, d, p, true); return (unsigned)p; }

__device__ __forceinline__ unsigned pack_fp8x4_nc(float a, float b, float c, float d) {
    int p = __builtin_amdgcn_cvt_pk_fp8_f32(a, b, 0, false); p = __builtin_amdgcn_cvt_pk_fp8_f32(c, d, p, true); return (unsigned)p; }

#define XB_TMO      128
#define XB_XCNT(j)  (256  + 64 * (j))
#define XB_XSUB(j)  (1280 + 64 * (j))
#define XB_XGEN(j)  (2304 + 64 * (j))
#define XB_TOP      3328
#define XB_TOPGEN   3392
#define XCD_BAR_WORDS 3456
#define XB_SPIN_CAP (1u << 18)
__device__ __forceinline__ unsigned xb_ld(unsigned* p)              { return __hip_atomic_load(p, __ATOMIC_RELAXED, __HIP_MEMORY_SCOPE_AGENT); }
__device__ __forceinline__ unsigned xb_add(unsigned* p, unsigned v) { return __hip_atomic_fetch_add(p, v, __ATOMIC_RELAXED, __HIP_MEMORY_SCOPE_AGENT); }
__device__ __forceinline__ unsigned xb_xcc_id() { return (unsigned)__builtin_amdgcn_s_getreg((3 << 11) | 20) & 0xFu; }
#define XB_SPIN(cond, bar) do { unsigned _sp = 0; while (cond) { __builtin_amdgcn_s_sleep(1); \
    if ((++_sp & 255u) == 0u) { if (xb_ld(&(bar)[XB_TMO])) break; if (_sp > XB_SPIN_CAP) { atomicAdd(&(bar)[XB_TMO], 1u); break; } } } } while (0)
struct XcdBarrier { unsigned* bar; unsigned x; volatile LAS unsigned* st; };
__device__ __forceinline__ XcdBarrier xcd_barrier_post(unsigned* bar, volatile LAS unsigned* st) {
    XcdBarrier b; b.bar = bar; b.x = xb_xcc_id(); b.st = st;
    if (threadIdx.x == 0) st[2] = xb_add(&bar[XB_XCNT(b.x)], 1u);
    return b;
}
__device__ __forceinline__ void xcd_barrier_complete(unsigned* bar, unsigned x, unsigned& nloc, unsigned& nx) {
    const unsigned G = gridDim.x * gridDim.y * gridDim.z;
    unsigned sum, cnt, mine, sp = 0u;
    for (;;) {
        sum = 0u; cnt = 0u; mine = 0u;
#pragma unroll
        for (unsigned j = 0; j < 16; ++j) { const unsigned c = xb_ld(&bar[XB_XCNT(j)]); sum += c; cnt += (c > 0u) ? 1u : 0u; mine = (j == x) ? c : mine; }
        if (sum == G) break;
        __builtin_amdgcn_s_sleep(1);
        if ((++sp & 255u) == 0u) { if (xb_ld(&bar[XB_TMO])) break; if (sp > XB_SPIN_CAP) { atomicAdd(&bar[XB_TMO], 1u); break; } }
    }
    nloc = mine > 0u ? mine : 1u; nx = cnt > 0u ? cnt : 1u;
}
__device__ __forceinline__ void xcd_barrier(const XcdBarrier& b) {
    asm volatile("s_waitcnt vmcnt(0)" ::: "memory");
    __syncthreads();
    if (threadIdx.x == 0) {
        unsigned* bar = b.bar;
        __builtin_amdgcn_s_waitcnt(0);
        unsigned nloc = b.st[0], nx = b.st[1];
        if (nloc == 0u) { xcd_barrier_complete(bar, b.x, nloc, nx); b.st[0] = nloc; b.st[1] = nx; }
        const unsigned old = xb_add(&bar[XB_XSUB(b.x)], 1u);
        const unsigned gen = old / nloc;
        if (old + 1u == (gen + 1u) * nloc) {
            __builtin_amdgcn_fence(__ATOMIC_RELEASE, "agent");
            asm volatile("s_waitcnt vmcnt(0)" ::: "memory");
            const unsigned og = xb_add(&bar[XB_TOP], 1u);
            const unsigned tg = og / nx;
            if (og + 1u == (tg + 1u) * nx) xb_add(&bar[XB_TOPGEN], 1u);
            else XB_SPIN(xb_ld(&bar[XB_TOPGEN]) == tg, bar);
            __builtin_amdgcn_fence(__ATOMIC_ACQUIRE, "agent");
            xb_add(&bar[XB_XGEN(b.x)], 1u);
            asm volatile("s_waitcnt vmcnt(0)" ::: "memory");
        } else {
            XB_SPIN(xb_ld(&bar[XB_XGEN(b.x)]) == gen, bar);
            __builtin_amdgcn_fence(__ATOMIC_ACQUIRE, "agent");
            asm volatile("s_waitcnt vmcnt(0)" ::: "memory");
        }
    }
    __syncthreads();
}

namespace pg8 {
constexpr int BM = 256, BK = 64, HALF = 128, HTB = HALF * BK * 2, STAGE_BYTES = 8 * HTB;
__device__ __forceinline__ int lds_byte(int r, int c) { const int st = (r >> 4) * 2 + (c >> 5), rr = r & 15, cc = c & 31, ob = rr * 64 + cc * 2; return st * 1024 + (ob ^ (((ob >> 9) & 1) << 5)); }
__device__ __forceinline__ void stage_rc(int b, int& R, int& C) { const int st = b / 1024, sb = b % 1024, swz = sb ^ (((sb >> 9) & 1) << 5); R = (st >> 1) * 16 + swz / 64; C = (st & 1) * 32 + (swz % 64) / 2; }
__device__ __forceinline__ int perm32(int rho) { const int n = rho >> 4, i = rho & 15; return 8 * (i >> 2) + 4 * n + (i & 3); }
struct Unit { int pm, pn, z; };
struct Gemm { int lda, ldb, K; int sa = 0x7f, sb = 0x7f; };
typedef int v8i32 __attribute__((ext_vector_type(8)));
typedef int v4i32 __attribute__((ext_vector_type(4)));

#ifndef PG8_SP2
#define PG8_SP2 true
#endif
template <class Epi, class Sched, bool GATHER, bool SP2 = PG8_SP2, bool F8 = false>
__device__ __forceinline__ void gemm_phase(LAS unsigned char* lds, const Gemm g, const Sched& S, const Epi& E) {
    const int tid = threadIdx.x, wid = __builtin_amdgcn_readfirstlane(tid >> 6), lane = tid & 63, wr = wid >> 2, wc = wid & 3, fr = lane & 15, fq = lane >> 4;
    const int K = g.K, nt = K / BK;
    unsigned voffA[2], voffB[2]; int Rr[2], Cc[2];
#pragma unroll
    for (int i = 0; i < 2; ++i) { int R, C; stage_rc(tid * 16 + i * 8192, R, C); const int Rb = Epi::PERM ? ((R & ~31) + perm32(R & 31)) : R;
        Rr[i] = R; Cc[i] = C; voffA[i] = (unsigned)(R * g.lda + C) * 2u; voffB[i] = (unsigned)(Rb * g.ldb + C) * 2u; }
    const size_t hstepA = (size_t)HALF * g.lda * 2, hstepB = (size_t)HALF * g.ldb * 2;
    const unsigned ldsw = (unsigned)wid * 1024u;
    const int aoff = lds_byte(wr * 64 + fr, fq * 8), boff = lds_byte(wc * 32 + fr, fq * 8);
#define PG8_SA(b, h) (((b) * 2 + (h)) * HTB)
#define PG8_SB(b, h) ((4 + (b) * 2 + (h)) * HTB)
#define PG8_GLDS(gp, lo) __builtin_amdgcn_global_load_lds((const unsigned*)(gp), (LAS unsigned*)(lds + (lo)), 16, 0, 0)
#define PG8_STAGE_B(bufoff, gbase, h) do { const char* _b = (const char*)(gbase) + (h) * hstepB; PG8_GLDS(_b + voffB[0], (bufoff) + ldsw); PG8_GLDS(_b + voffB[1], (bufoff) + ldsw + 8192); } while (0)
#define PG8_STAGE_A(bufoff, gbase, h, OFF) do { if constexpr (GATHER) { PG8_GLDS((const char*)(gbase) + OFF##h##0, (bufoff) + ldsw); PG8_GLDS((const char*)(gbase) + OFF##h##1, (bufoff) + ldsw + 8192); } \
        else { const char* _a = (const char*)(gbase) + (h) * hstepA; PG8_GLDS(_a + voffA[0], (bufoff) + ldsw); PG8_GLDS(_a + voffA[1], (bufoff) + ldsw + 8192); } } while (0)
#define PG8_LDA(dst, b, h) do { if constexpr (F8) { _Pragma("unroll") for (int m = 0; m < 4; ++m) { const v4i32 _lo = *(const LAS v4i32*)(lds + PG8_SA(b, h) + aoff + m * 2048), _hi = *(const LAS v4i32*)(lds + PG8_SA(b, h) + aoff + m * 2048 + 1024); \
            dst##8[m] = __builtin_shufflevector(_lo, _hi, 0, 1, 2, 3, 4, 5, 6, 7); } } \
        else { _Pragma("unroll") for (int m = 0; m < 4; ++m) _Pragma("unroll") for (int k = 0; k < 2; ++k) dst[m][k] = *(const LAS bf16x8*)(lds + PG8_SA(b, h) + aoff + m * 2048 + k * 1024); } } while (0)
#define PG8_LDB(dst, b, h) do { if constexpr (F8) { _Pragma("unroll") for (int n = 0; n < 2; ++n) { const v4i32 _lo = *(const LAS v4i32*)(lds + PG8_SB(b, h) + boff + n * 2048), _hi = *(const LAS v4i32*)(lds + PG8_SB(b, h) + boff + n * 2048 + 1024); \
            dst##8[n] = __builtin_shufflevector(_lo, _hi, 0, 1, 2, 3, 4, 5, 6, 7); } } \
        else { _Pragma("unroll") for (int n = 0; n < 2; ++n) _Pragma("unroll") for (int k = 0; k < 2; ++k) dst[n][k] = *(const LAS bf16x8*)(lds + PG8_SB(b, h) + boff + n * 2048 + k * 1024); } } while (0)
#define PG8_MMA(ai, bj, At, Bt) do { __builtin_amdgcn_s_setprio(1); \
        if constexpr (F8) { _Pragma("unroll") for (int m = 0; m < 4; ++m) _Pragma("unroll") for (int n = 0; n < 2; ++n) \
            asm volatile("v_mfma_scale_f32_16x16x128_f8f6f4 %0, %1, %2, %0, %3, %4 op_sel_hi:[0,0,0]" : "+v"(acc[ai][bj][m][n]) : "v"(Bt##8[n]), "v"(At##8[m]), "v"(f8sb), "v"(f8sa)); } \
        else { _Pragma("unroll") for (int m = 0; m < 4; ++m) _Pragma("unroll") for (int n = 0; n < 2; ++n) _Pragma("unroll") for (int k = 0; k < 2; ++k) \
            acc[ai][bj][m][n] = __builtin_amdgcn_mfma_f32_16x16x32_bf16(Bt[n][k], At[m][k], acc[ai][bj][m][n], 0, 0, 0); } \
        __builtin_amdgcn_s_setprio(0); } while (0)
#define PG8_WAIT_V(n) asm volatile("s_waitcnt vmcnt(" #n ")" ::: "memory")
#define PG8_WAIT_L(n) asm volatile("s_waitcnt lgkmcnt(" #n ")" ::: "memory")
#define PG8_BAR __builtin_amdgcn_s_barrier()
#define PG8_SCHED __builtin_amdgcn_sched_barrier(0)
    Unit cur, nxt; int ui = 0;
    if (!S.next(0, cur)) return;
    f32x4 acc[2][2][4][2];
#pragma unroll
    for (int a = 0; a < 2; ++a)
#pragma unroll
        for (int b = 0; b < 2; ++b)
#pragma unroll
            for (int m = 0; m < 4; ++m)
#pragma unroll
                for (int n = 0; n < 2; ++n) acc[a][b][m][n] = (f32x4){0.f, 0.f, 0.f, 0.f};
    bf16x8 At[4][2], B0[2][2], B1[2][2]; v8i32 At8[4], B08[2], B18[2];
    const int f8sa = g.sa, f8sb = g.sb;
    unsigned coff00 = 0u, coff01 = 0u, coff10 = 0u, coff11 = 0u, noff00 = 0u, noff01 = 0u, noff10 = 0u, noff11 = 0u;
    if constexpr (GATHER) {
        coff00 = S.a_off(cur, Rr[0]) + (unsigned)Cc[0] * 2u; coff01 = S.a_off(cur, Rr[1]) + (unsigned)Cc[1] * 2u;
        coff10 = S.a_off(cur, HALF + Rr[0]) + (unsigned)Cc[0] * 2u; coff11 = S.a_off(cur, HALF + Rr[1]) + (unsigned)Cc[1] * 2u;
    }
    { const char* cA = S.a_ptr(cur, 0); const char* cB = S.b_ptr(cur, 0); const char* cA1 = S.a_ptr(cur, 1); const char* cB1 = S.b_ptr(cur, 1);
    if constexpr (SP2) {
    PG8_STAGE_B(PG8_SB(0, 0), cB, 0); PG8_STAGE_B(PG8_SB(0, 1), cB, 1); PG8_STAGE_A(PG8_SA(0, 0), cA, 0, coff); PG8_STAGE_A(PG8_SA(0, 1), cA, 1, coff);
    if (wr == 1) PG8_BAR;
    PG8_WAIT_V(2); PG8_BAR;
    PG8_STAGE_B(PG8_SB(1, 0), cB1, 0); PG8_STAGE_A(PG8_SA(1, 0), cA1, 0, coff); PG8_STAGE_B(PG8_SB(1, 1), cB1, 1);
    PG8_WAIT_V(6); PG8_BAR;
    } else {
    PG8_STAGE_B(PG8_SB(0, 0), cB, 0); PG8_STAGE_A(PG8_SA(0, 0), cA, 0, coff); PG8_STAGE_B(PG8_SB(0, 1), cB, 1); PG8_STAGE_A(PG8_SA(0, 1), cA, 1, coff);
    if (wr == 1) PG8_BAR;
    PG8_WAIT_V(4); PG8_BAR;
    PG8_STAGE_B(PG8_SB(1, 0), cB1, 0); PG8_STAGE_A(PG8_SA(1, 0), cA1, 0, coff); PG8_STAGE_B(PG8_SB(1, 1), cB1, 1);
    PG8_WAIT_V(6); PG8_BAR; } }
    for (;;) {
        const bool has_next = S.next(ui + 1, nxt);
        Unit un; un.pm = has_next ? nxt.pm : cur.pm; un.pn = has_next ? nxt.pn : cur.pn; un.z = has_next ? nxt.z : cur.z;
        if constexpr (GATHER) {
            noff00 = has_next ? (S.a_off(nxt, Rr[0]) + (unsigned)Cc[0] * 2u) : coff00; noff01 = has_next ? (S.a_off(nxt, Rr[1]) + (unsigned)Cc[1] * 2u) : coff01;
            noff10 = has_next ? (S.a_off(nxt, HALF + Rr[0]) + (unsigned)Cc[0] * 2u) : coff10; noff11 = has_next ? (S.a_off(nxt, HALF + Rr[1]) + (unsigned)Cc[1] * 2u) : coff11;
        }
        for (int t = 0; t < nt; t += 2) {
            const bool last = (t == nt - 2);
            if constexpr (Epi::HOOK) { if (t == Epi::H1 || t == Epi::H2) { if constexpr (F8) asm volatile("s_nop 15\n\ts_nop 15\n\ts_nop 7" ::: "memory"); if (wr == 0) PG8_BAR; E.hook(acc, cur, t, wr, wc, fr, fq); if (wr == 1) PG8_BAR; } }
            const char* a1 = S.a_ptr(cur, t + 1);
            const char* a2 = last ? S.a_ptr(un, 0) : S.a_ptr(cur, t + 2); const char* b2 = last ? S.b_ptr(un, 0) : S.b_ptr(cur, t + 2);
            const char* a3 = last ? S.a_ptr(un, 1) : S.a_ptr(cur, t + 3); const char* b3 = last ? S.b_ptr(un, 1) : S.b_ptr(cur, t + 3);
            const unsigned o200 = last ? noff00 : coff00, o201 = last ? noff01 : coff01, o210 = last ? noff10 : coff10, o211 = last ? noff11 : coff11;
            if constexpr (SP2) {
            PG8_LDB(B0, 0, 0); PG8_LDB(B1, 0, 1); PG8_SCHED; PG8_LDA(At, 0, 0); PG8_STAGE_A(PG8_SA(1, 1), a1, 1, coff);
            PG8_WAIT_V(8); PG8_WAIT_L(0); PG8_BAR; PG8_MMA(0, 0, At, B0); PG8_MMA(0, 1, At, B1); PG8_BAR; PG8_SCHED;
            PG8_LDA(At, 0, 1); PG8_STAGE_B(PG8_SB(0, 0), b2, 0); PG8_STAGE_B(PG8_SB(0, 1), b2, 1); PG8_STAGE_A(PG8_SA(0, 0), a2, 0, o2);
            PG8_WAIT_V(8); PG8_WAIT_L(0); PG8_BAR; PG8_MMA(1, 0, At, B0); PG8_MMA(1, 1, At, B1); PG8_BAR; PG8_SCHED;
            PG8_LDB(B0, 1, 0); PG8_LDB(B1, 1, 1); PG8_SCHED; PG8_LDA(At, 1, 0); PG8_STAGE_A(PG8_SA(0, 1), a2, 1, o2);
            PG8_WAIT_V(8); PG8_WAIT_L(0); PG8_BAR; PG8_MMA(0, 0, At, B0); PG8_MMA(0, 1, At, B1); PG8_BAR; PG8_SCHED;
            PG8_LDA(At, 1, 1); PG8_STAGE_B(PG8_SB(1, 0), b3, 0); PG8_STAGE_B(PG8_SB(1, 1), b3, 1); PG8_STAGE_A(PG8_SA(1, 0), a3, 0, o2);
            PG8_WAIT_V(8); PG8_WAIT_L(0); PG8_BAR; PG8_MMA(1, 0, At, B0); PG8_MMA(1, 1, At, B1); PG8_BAR; PG8_SCHED;
            } else {
            PG8_LDB(B0, 0, 0); PG8_SCHED; PG8_LDA(At, 0, 0); PG8_STAGE_A(PG8_SA(1, 1), a1, 1, coff);
            PG8_WAIT_L(8); PG8_BAR; PG8_WAIT_L(0); PG8_MMA(0, 0, At, B0); PG8_BAR; PG8_SCHED;
            PG8_LDB(B1, 0, 1); PG8_STAGE_B(PG8_SB(0, 0), b2, 0);
            PG8_BAR; PG8_WAIT_L(0); PG8_MMA(0, 1, At, B1); PG8_BAR;
            PG8_LDA(At, 0, 1); PG8_STAGE_A(PG8_SA(0, 0), a2, 0, o2);
            PG8_BAR; PG8_WAIT_L(0); PG8_MMA(1, 0, At, B0); PG8_BAR; PG8_SCHED;
            PG8_STAGE_B(PG8_SB(0, 1), b2, 1);
            PG8_WAIT_V(6); PG8_BAR; PG8_MMA(1, 1, At, B1); PG8_BAR;
            PG8_LDB(B0, 1, 0); PG8_SCHED; PG8_LDA(At, 1, 0); PG8_STAGE_A(PG8_SA(0, 1), a2, 1, o2);
            PG8_WAIT_L(8); PG8_BAR; PG8_WAIT_L(0); PG8_MMA(0, 0, At, B0); PG8_BAR; PG8_SCHED;
            PG8_LDB(B1, 1, 1); PG8_STAGE_B(PG8_SB(1, 0), b3, 0);
            PG8_BAR; PG8_WAIT_L(0); PG8_MMA(0, 1, At, B1); PG8_BAR;
            PG8_LDA(At, 1, 1); PG8_STAGE_A(PG8_SA(1, 0), a3, 0, o2);
            PG8_BAR; PG8_WAIT_L(0); PG8_MMA(1, 0, At, B0); PG8_BAR; PG8_SCHED;
            PG8_STAGE_B(PG8_SB(1, 1), b3, 1);
            PG8_WAIT_V(6); PG8_BAR; PG8_MMA(1, 1, At, B1); PG8_BAR;
            }
        }
        if constexpr (F8) asm volatile("s_nop 15\n\ts_nop 15\n\ts_nop 7" ::: "memory");
        if (wr == 0) PG8_BAR;
        E(acc, cur, wr, wc, fr, fq);
        if (!has_next) break;
#pragma unroll
        for (int a = 0; a < 2; ++a)
#pragma unroll
            for (int b = 0; b < 2; ++b)
#pragma unroll
                for (int m = 0; m < 4; ++m)
#pragma unroll
                    for (int n = 0; n < 2; ++n) acc[a][b][m][n] = (f32x4){0.f, 0.f, 0.f, 0.f};
        cur = nxt; ++ui;
        if constexpr (GATHER) { coff00 = noff00; coff01 = noff01; coff10 = noff10; coff11 = noff11; }
        if (wr == 1) PG8_BAR;
    }
    PG8_WAIT_V(0);
    PG8_BAR;
#undef PG8_SA
#undef PG8_SB
#undef PG8_GLDS
#undef PG8_STAGE_A
#undef PG8_STAGE_B
#undef PG8_LDA
#undef PG8_LDB
#undef PG8_MMA
#undef PG8_WAIT_V
#undef PG8_WAIT_L
#undef PG8_BAR
#undef PG8_SCHED
}

struct SchedGrid {
    const char* A; const char* B; size_t zA, zB, tA, tB; int nM, nN, nz, G, c, rep;
    __device__ __forceinline__ bool next(int i, Unit& u) const {
        const int nwg = nz * nM * nN; const long L = (long)i * G + c; if (L >= (long)nwg * rep) return false;
        int w = (int)(L % nwg); { const int q = nwg / 8, r = nwg % 8, x = w % 8, off = w / 8; w = (x < r ? x * (q + 1) : r * (q + 1) + (x - r) * q) + off; }
        const int per = nM * nN; u.z = w / per; w -= u.z * per;
#ifdef PROBE_NOEPI
        if (L >= nwg) u.z |= 0x4000;
#endif
        const int nig = 8 * nN, gid = w / nig, fm = gid * 8, gsz = (nM - fm) < 8 ? (nM - fm) : 8;
        u.pm = fm + ((w % nig) % gsz); u.pn = (w % nig) / gsz; return true; }
    __device__ __forceinline__ const char* a_ptr(const Unit& u, int t) const { return A + (size_t)u.z * zA + (size_t)u.pm * tA + (size_t)t * 128; }
    __device__ __forceinline__ const char* b_ptr(const Unit& u, int t) const { return B + (size_t)u.z * zB + (size_t)u.pn * tB + (size_t)t * 128; }
    __device__ __forceinline__ unsigned a_off(const Unit&, int) const { return 0u; }
};
}

struct Args { const void* in[32]; float* out; unsigned char* ws; int ph_lo, ph_hi; };
struct Frame {
    LAS unsigned char* lds; int tid, lane, wave, G, c;
    unsigned char* ws; unsigned char* dout;
};
enum { I_X = 0, I_MEM, I_POS, I_GMIX, I_GMEM, I_WIN, I_LRE, I_LIM, I_LDT, I_BRE, I_BIM, I_CRE, I_CIM, I_DSKIP, I_WGLU, I_GQ, I_GK, I_GQM, I_GKM, I_WMEMKV,
       I_WUPS, I_WUPD, I_WUPM, I_WOUT, I_GFFN, I_WGROUP, I_BGROUP, I_WEXP, I_BEXP, I_WGATE, I_WUP, I_WDOWN };
#define INP(i) ((const float*)a.in[i])
#define WSP(T_, off) ((T_*)(F.ws + (off)))
#define DOP(T_, off) ((T_*)(F.dout + (off)))

using pg8::Unit;
__device__ __forceinline__ unsigned gpack4(const f32x4 v) {
    unsigned w = 0u;
#pragma unroll
    for (int j = 0; j < 4; ++j) { const float sg = __builtin_amdgcn_rcpf(1.0f + __builtin_amdgcn_exp2f(v[j])); w = __builtin_amdgcn_cvt_pk_u8_f32(sg * 255.0f, j, w); }
    return w; }
__device__ __forceinline__ void gdecode(const u32x2 w, float (&g)[8]) {
#pragma unroll
    for (int j = 0; j < 4; ++j) { g[j] = fmaxf((float)((w.x >> (8 * j)) & 255u), 0.5f); g[4 + j] = fmaxf((float)((w.y >> (8 * j)) & 255u), 0.5f); } }
struct EpiInProj {
    static constexpr bool PERM = true, HOOK = false;
    bf16_t *UA, *Y3; unsigned char* SG;
    __device__ __forceinline__ void operator()(const f32x4 (&acc)[2][2][4][2], const Unit& u, int wr, int wc, int fr, int fq) const {
        const int pn = u.pn, row0 = u.pm * 256 + wr * 64 + fr, cw = wc * 32 + 8 * fq;
#pragma unroll
        for (int ai = 0; ai < 2; ++ai)
#pragma unroll
            for (int m = 0; m < 4; ++m) {
                const int r = row0 + ai * 128 + m * 16;
#pragma unroll
                for (int bj = 0; bj < 2; ++bj) {
                    const int c = bj * 128 + cw;
                    if (pn >= 6) {
                        u32x2 w; w.x = gpack4(acc[ai][bj][m][0]); w.y = gpack4(acc[ai][bj][m][1]);
                        *(u32x2*)(SG + (size_t)r * 3072 + (pn - 6) * 256 + c) = w;
                    } else {
                        bf16_t* p;
                        if (pn < 2) { const int cc = pn * 256 + c, gI = cc >> 4, h0 = cc & 15, b = r >> 11, s = r & 2047;
                            p = UA + ((size_t)(gI * 2048 + b * 64 + (s >> 5)) * 640 + (s & 31) * 16 + h0); }
                        else p = Y3 + (size_t)r * Y3LD + (pn - 2) * 256 + c;
                        *(u32x4*)p = pack8(acc[ai][bj][m][0], acc[ai][bj][m][1]);
                    }
                }
            }
    }
};
struct EpiInProjB {
    static constexpr bool PERM = true, HOOK = false;
    bf16_t *KVX, *QI;
    __device__ __forceinline__ void operator()(const f32x4 (&acc)[2][2][4][2], const Unit& u, int wr, int wc, int fr, int fq) const {
        const int row0 = u.pm * 256 + wr * 64 + fr, cw = wc * 32 + 8 * fq; bf16_t* base = u.pn == 0 ? KVX : QI;
#pragma unroll
        for (int ai = 0; ai < 2; ++ai)
#pragma unroll
            for (int m = 0; m < 4; ++m)
#pragma unroll
                for (int bj = 0; bj < 2; ++bj)
                    *(u32x4*)(base + (size_t)(row0 + ai * 128 + m * 16) * 256 + bj * 128 + cw) = pack8(acc[ai][bj][m][0], acc[ai][bj][m][1]);
    }
};
struct EpiBf16 {
    static constexpr bool PERM = true, HOOK = false;
    bf16_t* O; int ld;
    __device__ __forceinline__ void operator()(const f32x4 (&acc)[2][2][4][2], const Unit& u, int wr, int wc, int fr, int fq) const {
        const int row0 = u.pm * 256 + wr * 64 + fr, col0 = u.pn * 256 + wc * 32 + 8 * fq;
#pragma unroll
        for (int ai = 0; ai < 2; ++ai)
#pragma unroll
            for (int m = 0; m < 4; ++m)
#pragma unroll
                for (int bj = 0; bj < 2; ++bj)
                    *(u32x4*)(O + (size_t)(row0 + ai * 128 + m * 16) * ld + col0 + bj * 128) = pack8(acc[ai][bj][m][0], acc[ai][bj][m][1]);
    }
};
struct EpiSc {
    static constexpr bool PERM = false, HOOK = false;
    float* SC;
    __device__ __forceinline__ void operator()(const f32x4 (&acc)[2][2][4][2], const Unit& u, int wr, int wc, int fr, int fq) const {
        const int row0 = u.pm * 256 + wr * 64 + fr, col0 = wc * 32 + 4 * fq;
#pragma unroll
        for (int ai = 0; ai < 2; ++ai)
#pragma unroll
            for (int m = 0; m < 4; ++m)
#pragma unroll
                for (int n = 0; n < 2; ++n)
                    *(f32x4*)(SC + ((size_t)u.z * 2048 + row0 + ai * 128 + m * 16) * 128 + col0 + n * 16) = acc[ai][0][m][n];
    }
};
struct EpiGelu {
    static constexpr bool PERM = true, HOOK = false;
    bf16_t* YG;
    __device__ __forceinline__ void operator()(const f32x4 (&acc)[2][2][4][2], const Unit& u, int wr, int wc, int fr, int fq) const {
        const int row0 = u.pm * 256 + wr * 64 + fr, col0 = u.pn * 256 + wc * 32 + 8 * fq;
#pragma unroll
        for (int ai = 0; ai < 2; ++ai)
#pragma unroll
            for (int m = 0; m < 4; ++m) {
                const int row = row0 + ai * 128 + m * 16;
#pragma unroll
                for (int bj = 0; bj < 2; ++bj) {
                    const int n8 = col0 + bj * 128, i = n8 >> 4, ho = n8 & 15;
                    f32x4 v0 = acc[ai][bj][m][0], v1 = acc[ai][bj][m][1];
#pragma unroll
                    for (int j = 0; j < 4; ++j) { v0[j] = gelu_tanh(v0[j]); v1[j] = gelu_tanh(v1[j]); }
                    *(u32x4*)(YG + ((size_t)row * 32 + i) * 512 + u.z * 16 + ho) = pack8(v0, v1);
                }
            }
    }
};
struct EpiGlu {
    static constexpr bool PERM = true, HOOK = false;
    const bf16_t* YG; unsigned char* YS8;
    __device__ __forceinline__ void operator()(const f32x4 (&acc)[2][2][4][2], const Unit& u, int wr, int wc, int fr, int fq) const {
        const int row0 = u.pm * 256 + wr * 64 + fr, col0 = u.pn * 256 + wc * 32 + 8 * fq;
        u32x4 yv[2][4][2];
#pragma unroll
        for (int ai = 0; ai < 2; ++ai)
#pragma unroll
            for (int m = 0; m < 4; ++m)
#pragma unroll
                for (int bj = 0; bj < 2; ++bj) yv[ai][m][bj] = *(const u32x4*)(YG + (size_t)(row0 + ai * 128 + m * 16) * 512 + col0 + bj * 128);
#pragma unroll
        for (int ai = 0; ai < 2; ++ai)
#pragma unroll
            for (int m = 0; m < 4; ++m)
#pragma unroll
                for (int bj = 0; bj < 2; ++bj) {
                    const int r = row0 + ai * 128 + m * 16, c = col0 + bj * 128;
                    f32x4 y0, y1; unpack8(yv[ai][m][bj], y0, y1);
                    f32x4 v0 = acc[ai][bj][m][0], v1 = acc[ai][bj][m][1];
#pragma unroll
                    for (int j = 0; j < 4; ++j) { v0[j] = y0[j] * sigm(v0[j]) * 16.0f; v1[j] = y1[j] * sigm(v1[j]) * 16.0f; }
                    u32x2 w8; w8.x = pack_fp8x4(v0[0], v0[1], v0[2], v0[3]); w8.y = pack_fp8x4(v1[0], v1[1], v1[2], v1[3]);
                    *(u32x2*)(YS8 + (size_t)r * 512 + c) = w8;
                }
    }
};
struct EpiMerge {
    static constexpr bool PERM = true, HOOK = true; static constexpr int H1 = 4, H2 = 8;
    const unsigned char* SG; unsigned char* MG;
    __device__ __forceinline__ void hook(f32x4 (&acc)[2][2][4][2], const Unit& u, int t, int wr, int wc, int fr, int fq) const {
        int row0 = u.pm * 256 + wr * 64 + fr, col0 = u.pn * 256 + wc * 32 + 8 * fq; const int br = (t >> 2) - 1;
        asm volatile("" : "+v"(row0), "+v"(col0));
        u32x2 wa[2][4][2], wb[2][4][2];
#pragma unroll
        for (int ai = 0; ai < 2; ++ai)
#pragma unroll
            for (int m = 0; m < 4; ++m)
#pragma unroll
                for (int bj = 0; bj < 2; ++bj) { const unsigned char* gp = SG + (size_t)(row0 + ai * 128 + m * 16) * 3072 + br * 1024 + col0 + bj * 128;
                    wa[ai][m][bj] = *(const u32x2*)gp; wb[ai][m][bj] = *(const u32x2*)(gp + 1024); }
#pragma unroll
        for (int ai = 0; ai < 2; ++ai)
#pragma unroll
            for (int m = 0; m < 4; ++m)
#pragma unroll
                for (int bj = 0; bj < 2; ++bj) {
                    float ga[8], gb[8]; gdecode(wa[ai][m][bj], ga); gdecode(wb[ai][m][bj], gb);
#pragma unroll
                    for (int j = 0; j < 4; ++j) { acc[ai][bj][m][0][j] *= ga[j] * __builtin_amdgcn_rcpf(gb[j]); acc[ai][bj][m][1][j] *= ga[4 + j] * __builtin_amdgcn_rcpf(gb[4 + j]); }
                }
    }
    __device__ __forceinline__ void operator()(const f32x4 (&acc)[2][2][4][2], const Unit& u, int wr, int wc, int fr, int fq) const {
        const int row0 = u.pm * 256 + wr * 64 + fr, col0 = u.pn * 256 + wc * 32 + 8 * fq;
        u32x2 wg[2][4][2];
#pragma unroll
        for (int ai = 0; ai < 2; ++ai)
#pragma unroll
            for (int m = 0; m < 4; ++m)
#pragma unroll
                for (int bj = 0; bj < 2; ++bj) wg[ai][m][bj] = *(const u32x2*)(SG + (size_t)(row0 + ai * 128 + m * 16) * 3072 + 2048 + col0 + bj * 128);
#pragma unroll
        for (int ai = 0; ai < 2; ++ai)
#pragma unroll
            for (int m = 0; m < 4; ++m)
#pragma unroll
                for (int bj = 0; bj < 2; ++bj) {
                    const int r = row0 + ai * 128 + m * 16, c = col0 + bj * 128;
                    float g2[8]; gdecode(wg[ai][m][bj], g2);
                    f32x4 v0 = acc[ai][bj][m][0], v1 = acc[ai][bj][m][1];
#pragma unroll
                    for (int j = 0; j < 4; ++j) { v0[j] *= g2[j] * (8.0f / 255.0f); v1[j] *= g2[4 + j] * (8.0f / 255.0f); }
                    u32x2 w8; w8.x = pack_fp8x4(v0[0], v0[1], v0[2], v0[3]); w8.y = pack_fp8x4(v1[0], v1[1], v1[2], v1[3]);
                    *(u32x2*)(MG + (size_t)r * 1024 + c) = w8;
                }
    }
};
struct EpiOut {
    static constexpr bool PERM = true, HOOK = false;
    const float* X; bf16_t* X1B; unsigned char* X1B8;
    __device__ __forceinline__ void operator()(const f32x4 (&acc)[2][2][4][2], const Unit& u, int wr, int wc, int fr, int fq) const {
        const int row0 = u.pm * 256 + wr * 64 + fr, col0 = u.pn * 256 + wc * 32 + 8 * fq;
#pragma unroll
        for (int ai = 0; ai < 2; ++ai) {
            f32x4 xv[4][2][2];
#pragma unroll
            for (int m = 0; m < 4; ++m)
#pragma unroll
                for (int bj = 0; bj < 2; ++bj) { const float* xp = X + (size_t)(row0 + ai * 128 + m * 16) * 1024 + col0 + bj * 128; xv[m][bj][0] = __builtin_nontemporal_load((const f32x4*)xp); xv[m][bj][1] = __builtin_nontemporal_load((const f32x4*)(xp + 4)); }
#pragma unroll
            for (int m = 0; m < 4; ++m)
#pragma unroll
                for (int bj = 0; bj < 2; ++bj)
                { const f32x4 v0 = xv[m][bj][0] + acc[ai][bj][m][0], v1 = xv[m][bj][1] + acc[ai][bj][m][1]; const size_t o = (size_t)(row0 + ai * 128 + m * 16) * 1024 + col0 + bj * 128;
                    *(u32x4*)(X1B + o) = pack8(v0, v1);
                    u32x2 w8; w8.x = pack_fp8x4(v0[0], v0[1], v0[2], v0[3]); w8.y = pack_fp8x4(v1[0], v1[1], v1[2], v1[3]); *(u32x2*)(X1B8 + o) = w8; }
        }
    }
};

constexpr int MI_CNT = 16, MI_PRE = 160, MI_TILE = 320, MI_PT = 960;
struct SchedMoE1 {
    const char* A; const char* W; LAS const int* misc; const int* tok; int ntile4, G, c, rep;
    __device__ __forceinline__ bool next(int i, Unit& u) const {
        long L = (long)i * G + c; if (L >= (long)ntile4 * rep) return false; L %= ntile4;
        const int e = misc[MI_TILE + (int)(L >> 2)]; u.z = e & 255; u.pm = e >> 8; u.pn = (int)(L & 3); return true; }
    __device__ __forceinline__ const char* a_ptr(const Unit&, int t) const { return A + (size_t)t * 128; }
    __device__ __forceinline__ const char* b_ptr(const Unit& u, int t) const { return W + (size_t)u.z * (1024 * 1024) + (size_t)u.pn * (256 * 1024) + (size_t)t * 128; }
    __device__ __forceinline__ unsigned a_off(const Unit& u, int r) const {
        int pos = u.pm * 256 + r; const int n = misc[MI_CNT + u.z]; pos = pos < n ? pos : 0;
        return (unsigned)(tok[(size_t)u.z * 65536 + pos] & 0x7fffffff) * 1024u; }
};
struct EpiMoe1 {
    static constexpr bool PERM = true, HOOK = false;
    LAS const int* misc; const int* tok; const float2* rw; unsigned char* HID;
    __device__ __forceinline__ void operator()(const f32x4 (&acc)[2][2][4][2], const Unit& u, int wr, int wc, int fr, int fq) const {
        const int l = u.z, n = misc[MI_CNT + l], col = u.pn * 128 + wc * 32 + 8 * fq;
        unsigned tk[2][4]; float2 qv[2][4];
#pragma unroll
        for (int ai = 0; ai < 2; ++ai)
#pragma unroll
            for (int m = 0; m < 4; ++m) { int pos = u.pm * 256 + ai * 128 + wr * 64 + m * 16 + fr; pos = pos < n ? pos : 0;
                tk[ai][m] = (unsigned)tok[(size_t)l * 65536 + pos]; qv[ai][m] = rw[(size_t)l * 65536 + pos]; }
#pragma unroll
        for (int ai = 0; ai < 2; ++ai)
#pragma unroll
            for (int m = 0; m < 4; ++m) {
                const int pos = u.pm * 256 + ai * 128 + wr * 64 + m * 16 + fr;
                if (pos < n) {
                    const float2 q = qv[ai][m];
                    f32x4 v0, v1;
#pragma unroll
                    for (int j = 0; j < 4; ++j) {
                        const float g0 = acc[ai][0][m][0][j] * q.x, u0 = acc[ai][1][m][0][j] * q.x, g1 = acc[ai][0][m][1][j] * q.x, u1 = acc[ai][1][m][1][j] * q.x;
                        v0[j] = g0 * sigm(g0) * u0 * (q.y * 16.0f); v1[j] = g1 * sigm(g1) * u1 * (q.y * 16.0f); }
                    u32x2 w8; w8.x = pack_fp8x4(v0[0], v0[1], v0[2], v0[3]); w8.y = pack_fp8x4(v1[0], v1[1], v1[2], v1[3]);
                    *(u32x2*)(HID + ((size_t)(tk[ai][m] & 0x7fffffffu) * 2 + (tk[ai][m] >> 31)) * 512 + col) = w8;
                }
            }
    }
};
struct SchedMoE2 {
    const char* A; const char* W; LAS const int* misc; const int* tok; int ntile4, G, c, rep;
    __device__ __forceinline__ bool next(int i, Unit& u) const {
        long L = (long)i * G + c; if (L >= (long)ntile4 * rep) return false; L %= ntile4;
        const int e = misc[MI_TILE + (int)(L >> 2)], l = e & 255, gi = l / 28, pt = misc[MI_PT + (l - gi * 28)];
        u.z = l | ((gi * 8 + (pt & 15)) << 8) | ((gi * 8 + (pt >> 4)) << 16); u.pm = e >> 8; u.pn = (int)(L & 3); return true; }
    __device__ __forceinline__ const char* a_ptr(const Unit&, int t) const { return A + (size_t)t * 128; }
    __device__ __forceinline__ const char* b_ptr(const Unit& u, int t) const {
        const int e = t < 4 ? ((u.z >> 8) & 255) : (u.z >> 16), tt = t < 4 ? t : t - 4;
        return W + (size_t)e * (1024 * 512) + (size_t)u.pn * (256 * 512) + (size_t)tt * 128; }
    __device__ __forceinline__ unsigned a_off(const Unit& u, int r) const {
        const int l = u.z & 255; int pos = u.pm * 256 + r; const int n = misc[MI_CNT + l]; pos = pos < n ? pos : 0;
        return (unsigned)tok[(size_t)l * 65536 + pos] * 1024u; }
};
struct EpiMoe2 {
    static constexpr bool PERM = false, HOOK = false;
    LAS const int* misc; const int* tok; const bf16_t* X1B; float* O;
    __device__ __forceinline__ void operator()(const f32x4 (&acc)[2][2][4][2], const Unit& u, int wr, int wc, int fr, int fq) const {
        const int l = u.z & 255, n = misc[MI_CNT + l], col0 = u.pn * 256 + wc * 32 + 4 * fq;
        int tk[2][4];
#pragma unroll
        for (int ai = 0; ai < 2; ++ai)
#pragma unroll
            for (int m = 0; m < 4; ++m) { int pos = u.pm * 256 + ai * 128 + wr * 64 + m * 16 + fr; pos = pos < n ? pos : 0; tk[ai][m] = tok[(size_t)l * 65536 + pos]; }
#pragma unroll
        for (int ai = 0; ai < 2; ++ai) {
            u32x2 xb[4][2][2];
#pragma unroll
            for (int m = 0; m < 4; ++m)
#pragma unroll
                for (int bj = 0; bj < 2; ++bj)
#pragma unroll
                    for (int nn = 0; nn < 2; ++nn) xb[m][bj][nn] = *(const u32x2*)(X1B + (size_t)tk[ai][m] * 1024 + col0 + bj * 128 + nn * 16);
#pragma unroll
            for (int m = 0; m < 4; ++m) {
                const int pos = u.pm * 256 + ai * 128 + wr * 64 + m * 16 + fr;
                if (pos < n) {
#pragma unroll
                    for (int bj = 0; bj < 2; ++bj)
#pragma unroll
                        for (int nn = 0; nn < 2; ++nn) { const u32x2 x = xb[m][bj][nn];
                            const f32x4 xv = (f32x4){bf2f(x.x & 0xffffu), bf2f(x.x >> 16), bf2f(x.y & 0xffffu), bf2f(x.y >> 16)};
                            __builtin_nontemporal_store(xv + acc[ai][bj][m][nn], (f32x4*)(O + (size_t)tk[ai][m] * 1024 + col0 + bj * 128 + nn * 16)); }
                }
            }
        }
    }
};
struct SchedMerge3 {
    const char* Y; const char* W; int G, c, rep;
    __device__ __forceinline__ bool next(int i, Unit& u) const {
        const int nwg = 1024; const long L = (long)i * G + c; if (L >= (long)nwg * rep) return false;
        int w = (int)(L % nwg); { const int q = nwg / 8, x = w % 8, off = w / 8; w = x * q + off; }
        const int nig = 8 * 4, gid = w / nig, fm = gid * 8;
        u.pm = fm + ((w % nig) % 8); u.pn = (w % nig) / 8; u.z = 0; return true; }
    __device__ __forceinline__ const char* a_ptr(const Unit& u, int t) const { return Y + (size_t)(t >> 2) * ((size_t)T * 512) + (size_t)u.pm * (256 * 512) + (size_t)(t & 3) * 128; }
    __device__ __forceinline__ const char* b_ptr(const Unit& u, int t) const { return W + (size_t)u.pn * (256 * 1536) + (size_t)t * 128; }
    __device__ __forceinline__ unsigned a_off(const Unit&, int) const { return 0u; }
};

__device__ __forceinline__ void rms_rows_bf16(const float* x, const float* g, bf16_t* out, unsigned char* out8, int nrows, int gw, int nw, int lane) {
    float4 gg[4];
#pragma unroll
    for (int i = 0; i < 4; ++i) gg[i] = ((const float4*)g)[lane + 64 * i];
#pragma unroll 1
    for (int r0 = gw; r0 < nrows; r0 += 2 * nw) {
        const int r1 = r0 + nw < nrows ? r0 + nw : r0;
        const float4* xa = (const float4*)(x + (size_t)r0 * 1024); const float4* xb = (const float4*)(x + (size_t)r1 * 1024);
        float4 va[4], vb[4]; float sa = 0.f, sb = 0.f;
#pragma unroll
        for (int i = 0; i < 4; ++i) { const f32x4 ta = __builtin_nontemporal_load((const f32x4*)xa + lane + 64 * i), tb = __builtin_nontemporal_load((const f32x4*)xb + lane + 64 * i);
            va[i] = make_float4(ta[0], ta[1], ta[2], ta[3]); vb[i] = make_float4(tb[0], tb[1], tb[2], tb[3]); }
#pragma unroll
        for (int i = 0; i < 4; ++i) { sa += va[i].x * va[i].x + va[i].y * va[i].y + va[i].z * va[i].z + va[i].w * va[i].w; sb += vb[i].x * vb[i].x + vb[i].y * vb[i].y + vb[i].z * vb[i].z + vb[i].w * vb[i].w; }
        sa = wave_sum(sa); sb = wave_sum(sb);
        const float ra = rsqrtf(sa * (1.0f / 1024.0f) + 1e-6f), rb = rsqrtf(sb * (1.0f / 1024.0f) + 1e-6f);
#pragma unroll
        for (int i = 0; i < 4; ++i) {
            u32x2 w; w.x = cvt_pk_bf16(va[i].x * ra * gg[i].x, va[i].y * ra * gg[i].y); w.y = cvt_pk_bf16(va[i].z * ra * gg[i].z, va[i].w * ra * gg[i].w);
            if (out) *(u32x2*)(out + (size_t)r0 * 1024 + (lane + 64 * i) * 4) = w;
            if (out8) *(unsigned*)(out8 + (size_t)r0 * 1024 + (lane + 64 * i) * 4) = pack_fp8x4(va[i].x * ra * gg[i].x, va[i].y * ra * gg[i].y, va[i].z * ra * gg[i].z, va[i].w * ra * gg[i].w);
            if (r1 != r0) { u32x2 z; z.x = cvt_pk_bf16(vb[i].x * rb * gg[i].x, vb[i].y * rb * gg[i].y); z.y = cvt_pk_bf16(vb[i].z * rb * gg[i].z, vb[i].w * rb * gg[i].w);
                if (out) *(u32x2*)(out + (size_t)r1 * 1024 + (lane + 64 * i) * 4) = z;
                if (out8) *(unsigned*)(out8 + (size_t)r1 * 1024 + (lane + 64 * i) * 4) = pack_fp8x4(vb[i].x * rb * gg[i].x, vb[i].y * rb * gg[i].y, vb[i].z * rb * gg[i].z, vb[i].w * rb * gg[i].w); }
        }
    }
}
__device__ __forceinline__ void tr_tile(LAS float* tl, const float* src, int ldsrc, int nvalid, const float* ks, float tsc, bf16_t* dst, unsigned char* dst8, int ldd, int lane) {
    const int r = lane >> 4, c4 = (lane & 15) * 4;
    float4 v[16];
#pragma unroll
    for (int p = 0; p < 16; ++p) { const int k = r + 4 * p; v[p] = make_float4(0.f, 0.f, 0.f, 0.f); if (c4 < nvalid) { const f32x4 tv = __builtin_nontemporal_load((const f32x4*)(src + (size_t)k * ldsrc + c4)); v[p] = make_float4(tv[0], tv[1], tv[2], tv[3]); } }
#pragma unroll
    for (int p = 0; p < 16; ++p) { const int k = r + 4 * p; float4 w = v[p];
        { const float sc = ks ? ks[k] * tsc : tsc; w.x *= sc; w.y *= sc; w.z *= sc; w.w *= sc; }
        tl[k * 65 + c4] = w.x; tl[k * 65 + c4 + 1] = w.y; tl[k * 65 + c4 + 2] = w.z; tl[k * 65 + c4 + 3] = w.w; }
    const int kq = lane & 7;
#pragma unroll
    for (int p = 0; p < 8; ++p) { const int n = (lane >> 3) + 8 * p; float f[8];
#pragma unroll
        for (int j = 0; j < 8; ++j) f[j] = tl[(kq * 8 + j) * 65 + n];
        if (dst8) { u32x2 w8; w8.x = pack_fp8x4(f[0], f[1], f[2], f[3]); w8.y = pack_fp8x4(f[4], f[5], f[6], f[7]); *(u32x2*)(dst8 + (size_t)n * ldd + kq * 8) = w8; }
        else { u32x4 w; w.x = cvt_pk_bf16(f[0], f[1]); w.y = cvt_pk_bf16(f[2], f[3]); w.z = cvt_pk_bf16(f[4], f[5]); w.w = cvt_pk_bf16(f[6], f[7]);
            *(u32x4*)(dst + (size_t)n * ldd + kq * 8) = w; } }
}
struct cf { float re, im; };
__device__ __forceinline__ cf cmul(cf a, cf b) { return cf{a.re * b.re - a.im * b.im, a.re * b.im + a.im * b.re}; }
__device__ __forceinline__ cf lam_pow(const Args& a, int g, int p, float e) {
    const float lre = INP(I_LRE)[g * 64 + p], lim = INP(I_LIM)[g * 64 + p], dt = __expf(INP(I_LDT)[g]);
    const float mag = __expf(lre * dt * e);
    const double rev = (double)lim * (double)dt * (double)e * 0.15915494309189535; const float fr = (float)(rev - rint(rev));
    return cf{mag * __builtin_amdgcn_cosf(fr), mag * __builtin_amdgcn_sinf(fr)};
}
__device__ __forceinline__ cf bbar_of(const Args& a, int g, int p, int h) {
    const float lre = INP(I_LRE)[g * 64 + p], lim = INP(I_LIM)[g * 64 + p];
    const cf lb = lam_pow(a, g, p, 1.0f); const cf num = cf{lb.re - 1.0f, lb.im};
    const float inv = 1.0f / (lre * lre + lim * lim);
    const cf q = cf{(num.re * lre + num.im * lim) * inv, (num.im * lre - num.re * lim) * inv};
    return cmul(q, cf{INP(I_BRE)[(g * 64 + p) * 16 + h], INP(I_BIM)[(g * 64 + p) * 16 + h]});
}
__device__ __forceinline__ void p0_prep(const Frame& F, const Args& a) {
    const int gw = F.c * 8 + F.wave, nw = F.G * 8;
    rms_rows_bf16(INP(I_X), INP(I_GMIX), WSP(bf16_t, WS_HB), WSP(unsigned char, WS_HB8), T, gw, nw, F.lane);
    rms_rows_bf16(INP(I_MEM), INP(I_GMEM), nullptr, WSP(unsigned char, WS_MEMN), 8192, gw, nw, F.lane);
    LAS float* tl = (LAS float*)F.lds + F.wave * (64 * 65);
    constexpr int NT_WIN = 80 * 16, NT_WMEM = 256, NT_WGLU = 64, NT_WUP = 384, NT_WOUT = 256, NT_E = 4096;
    constexpr int O1 = NT_WIN, O2 = O1 + NT_WMEM, O3 = O2 + NT_WGLU, O4 = O3 + NT_WUP, O5 = O4 + NT_WOUT, O6 = O5 + NT_E, O7 = O6 + NT_E, O8 = O7 + NT_E;
    for (int ti = gw; ti < O8; ti += nw) {
        const float* src; int ldsrc, nvalid = 64, ldd; const float* ks = nullptr; bf16_t* dst = nullptr; unsigned char* dst8 = nullptr; float tsc = 1.0f;
        if (ti < O1) { const int nt = ti / 16, kt = ti % 16, n0 = nt * 64; int sc;
            if (n0 < 1152) sc = n0;
            else if (n0 == 1152) sc = 1408;
            else if (n0 == 1216) { sc = 1472; nvalid = 4; }
            else if (n0 < 1280) { sc = 0; nvalid = 0; }
            else if (n0 < 1536) sc = 1152 + (n0 - 1280);
            else if (n0 < 2048) sc = 1476 + (n0 - 1536);
            else { sc = 1988 + (n0 - 2048); tsc = -1.4426950408889634f; }
            src = INP(I_WIN) + (size_t)kt * 64 * 5060 + sc; ldsrc = 5060; ldd = 1024;
            if (n0 >= 1024 && n0 < 1536) dst = WSP(bf16_t, WS_WIN) + (size_t)(n0 - 1024) * 1024 + kt * 64;
            else { const int r8 = n0 < 1024 ? n0 : (n0 < 2048 ? n0 - 512 : n0 - 512); dst8 = WSP(unsigned char, WS_WG8) + (size_t)r8 * 1024 + kt * 64; tsc *= 32.0f; } }
        else if (ti < O2) { const int t = ti - O1, nt = t / 16, kt = t % 16; src = INP(I_WMEMKV) + (size_t)kt * 64 * 1024 + nt * 64; ldsrc = 1024; tsc = 32.0f; dst8 = WSP(unsigned char, WS_WMEM) + (size_t)nt * 64 * 1024 + kt * 64; ldd = 1024; }
        else if (ti < O3) { const int t = ti - O2, nt = t / 8, kt = t % 8; src = INP(I_WGLU) + (size_t)kt * 64 * 512 + nt * 64; ldsrc = 512; dst = WSP(bf16_t, WS_WGLU) + (size_t)nt * 64 * 512 + kt * 64; ldd = 512; }
        else if (ti < O4) { const int t = ti - O3, br = t / 128, tt = t % 128, nt = tt / 8, kt = tt % 8; const float* w = br == 0 ? INP(I_WUPS) : (br == 1 ? INP(I_WUPD) : INP(I_WUPM));
            src = w + (size_t)kt * 64 * 1024 + nt * 64; ldsrc = 1024; tsc = 32.0f; dst8 = WSP(unsigned char, WS_WUP) + (size_t)nt * 64 * 1536 + br * 512 + kt * 64; ldd = 1536; }
        else if (ti < O5) { const int t = ti - O4, nt = t / 16, kt = t % 16; src = INP(I_WOUT) + (size_t)kt * 64 * 1024 + nt * 64; ldsrc = 1024; tsc = 32.0f; dst8 = WSP(unsigned char, WS_WOUT) + (size_t)nt * 64 * 1024 + kt * 64; ldd = 1024; }
        else if (ti < O7) { const int up = ti >= O6, t = ti - (up ? O6 : O5), e = t / 128, tt = t % 128, nt = tt / 16, kt = tt % 16, j0 = nt * 64;
            src = (up ? INP(I_WUP) : INP(I_WGATE)) + (size_t)e * 1024 * 512 + (size_t)kt * 64 * 512 + j0; ldsrc = 512; ks = INP(I_GFFN) + kt * 64; tsc = 32.0f;
            dst8 = WSP(unsigned char, WS_WGU) + (size_t)e * 1024 * 1024 + (size_t)((j0 >> 7) * 256 + up * 128 + (j0 & 127)) * 1024 + kt * 64; ldd = 1024; }
        else { const int t = ti - O7, e = t / 128, tt = t % 128, nt = tt / 8, kt = tt % 8;
            src = INP(I_WDOWN) + (size_t)e * 512 * 1024 + (size_t)kt * 64 * 1024 + nt * 64; ldsrc = 1024; tsc = 32.0f;
            dst8 = WSP(unsigned char, WS_WD) + (size_t)e * 1024 * 512 + (size_t)nt * 64 * 512 + kt * 64; ldd = 512; }
        tr_tile(tl, src, ldsrc, nvalid, ks, tsc, dst, dst8, ldd, F.lane);
    }
    const int gt = F.c * NTHR + F.tid, NTT = F.G * NTHR;
    for (int id = gt; id < 2048 * 33; id += NTT) { const int gp = id / 33, e = id - gp * 33; const cf z = lam_pow(a, gp >> 6, gp & 63, (float)e); WSP(float2, WS_LP)[id] = make_float2(z.re, z.im);
        if (e == 32) { WSP(float, WS_LAM32)[gp * 2] = z.re; WSP(float, WS_LAM32)[gp * 2 + 1] = z.im; } }
    for (int id = gt; id < 2048 * 16; id += NTT) { const int gp = id >> 4, h = id & 15; const cf z = bbar_of(a, gp >> 6, gp & 63, h); WSP(float2, WS_BB)[id] = make_float2(z.re, z.im); }
    for (int id = gt; id < 48 * 1024; id += NTT) { const int n = id >> 10, k = id & 1023;
        const float v = n < 4 ? INP(I_WGROUP)[k * 4 + n] : (n < 36 ? INP(I_WEXP)[k * 32 + (n - 4)] : 0.f);
        WSP(bf16_t, WS_WR)[id] = f2bf(v * INP(I_GFFN)[k]); }
}

__device__ __forceinline__ void p1_tables(const Frame& F, const Args& a, int wgi, int wgn) {
    const int gt = wgi * NTHR + F.tid, NTT = wgn * NTHR;
    bf16_t* TW = WSP(bf16_t, WS_TW); bf16_t* SIN = WSP(bf16_t, WS_SIN); const float2* LP = WSP(float2, WS_LP); const float2* BB = WSP(float2, WS_BB);
    for (int id = gt; id < 32 * 32 * 256; id += NTT) {
        const int hi = id & 15, ho = (id >> 4) & 15, d = (id >> 8) & 31, g = id >> 13;
        float val = 0.f;
        for (int p = 0; p < 64; ++p) { const float2 ez = LP[(g * 64 + p) * 33 + d], bb = BB[(g * 64 + p) * 16 + hi];
            const float cr = INP(I_CRE)[(g * 16 + ho) * 64 + p], ci = INP(I_CIM)[(g * 16 + ho) * 64 + p];
            const float tr = cr * ez.x - ci * ez.y, ti = cr * ez.y + ci * ez.x; val += tr * bb.x - ti * bb.y; }
        if (d == 0 && ho == hi) val += INP(I_DSKIP)[g * 16 + ho];
        const bf16_t bv = f2bf(val); bf16_t* tg = TW + (size_t)g * 512 * 640;
        for (int i = d; i < 32; ++i) { tg[(size_t)(i * 16 + ho) * 640 + (i - d) * 16 + hi] = bv; if (d > 0) tg[(size_t)((i - d) * 16 + ho) * 640 + i * 16 + hi] = 0; }
    }
    for (int id = gt; id < 32 * 32 * 16 * 64; id += NTT) {
        const int p = id & 63, ho = (id >> 6) & 15, i = (id >> 10) & 31, g = id >> 15;
        const float2 ez = LP[(g * 64 + p) * 33 + i + 1]; const float cr = INP(I_CRE)[(g * 16 + ho) * 64 + p], ci = INP(I_CIM)[(g * 16 + ho) * 64 + p];
        bf16_t* row = TW + (size_t)g * 512 * 640 + (size_t)(i * 16 + ho) * 640 + 512; row[p] = f2bf(cr * ez.x - ci * ez.y); row[64 + p] = f2bf(-(cr * ez.y + ci * ez.x));
    }
    for (int id = gt; id < 32 * 64 * 32 * 16; id += NTT) {
        const int h = id & 15, j = (id >> 4) & 31, p = (id >> 9) & 63, g = id >> 15;
        const float2 ez = LP[(g * 64 + p) * 33 + 31 - j], bb = BB[(g * 64 + p) * 16 + h];
        bf16_t* sg = SIN + (size_t)g * 256 * 512; sg[(size_t)p * 512 + j * 16 + h] = f2bf(ez.x * bb.x - ez.y * bb.y); sg[(size_t)(64 + p) * 512 + j * 16 + h] = f2bf(ez.x * bb.y + ez.y * bb.x);
    }
    for (int id = gt; id < 32 * 128 * 64; id += NTT) {
        const int q = id & 63, r = (id >> 6) & 127, g = id >> 13;
        *(u32x4*)(SIN + (size_t)g * 256 * 512 + (size_t)(128 + r) * 512 + q * 8) = (u32x4){0u, 0u, 0u, 0u};
    }
}

__device__ __forceinline__ void p2_post(const Frame& F, const Args& a, bool dry) {
    const int gw = F.c * 8 + F.wave, nw = F.G * 8, lane = F.lane, j = lane & 3, hs = lane >> 5, lr = lane & 31;
    const bf16_t* KVX = WSP(bf16_t, WS_KVX); unsigned char* KVP8 = WSP(unsigned char, WS_KVP); bf16_t* KIP = WSP(bf16_t, WS_KIP); bf16_t* QI = WSP(bf16_t, WS_QI);
    const bool rqi = lr < 16, rk = lr >= 16 && lr < 20, rki = lr >= 20 && lr < 24;
    const float scl = rqi ? 0.125f : 1.0f;
    float g1[8], g2[8];
#pragma unroll
    for (int e = 0; e < 8; ++e) { g1[e] = rk ? INP(I_GK)[8 * j + e] : 1.0f; g2[e] = rk ? INP(I_GK)[32 + 8 * j + e] : 1.0f; }
    constexpr int TB = 4;
    typedef float f32x2e __attribute__((ext_vector_type(2)));
    LAS f32x2e* cst = (LAS f32x2e*)F.lds + F.wave * (TB * 64);
    const float invf1 = __expf(-(float)lr * (9.210340371976184f / 32.0f));
#pragma unroll 1
    for (int tb = gw; tb < T; tb += nw * TB * 2) {
        u32x4 lo[TB], hi[TB]; float posf[TB]; unsigned short wraw[TB];
#pragma unroll
        for (int u = 0; u < TB; ++u) {
            const int tt = tb + (u * 2 + hs) * nw, t = tt < T ? tt : T - 1;
            const bf16_t* src;
            if (rqi) src = QI + (size_t)t * 256 + (lr >> 2) * 64;
            else if (rk) src = KVX + (size_t)t * 256;
            else if (rki) src = KVX + (size_t)t * 256 + 128;
            else src = KVX + (size_t)t * 256 + 64 + (lr - 24) * 8 - 8 * j;
            lo[u] = *(const u32x4*)(src + 8 * j); hi[u] = (lr < 24) ? *(const u32x4*)(src + 32 + 8 * j) : lo[u];
            posf[u] = (float)((const int*)a.in[I_POS])[t];
            wraw[u] = KVX[(size_t)t * 256 + 192 + (lane & 3)];
            { const float ang = posf[u] * invf1; const double rev = (double)ang * 0.15915494309189535; const float fr = (float)(rev - rint(rev));
              const f32x2e cs2 = (f32x2e){__builtin_amdgcn_cosf(fr), __builtin_amdgcn_sinf(fr)}; cst[(u * 2 + hs) * 32 + lr] = cs2;
              if (tt < T) WSP(f32x2e, WS_CS)[(size_t)t * 32 + lr] = cs2; }
        }
#pragma unroll
        for (int u = 0; u < TB; ++u) {
            const int t = tb + (u * 2 + hs) * nw;
            const bool live = t < T;
            if (lr < 24) {
                bf16_t* dst;
                if (rqi) dst = dry ? WSP(bf16_t, WS_RW) + (size_t)(live ? t : 0) * 256 + (lr >> 2) * 64 : QI + (size_t)(live ? t : 0) * 256 + (lr >> 2) * 64;
                else if (rk) dst = nullptr;
                else dst = KIP + (size_t)(live ? t : 0) * 64;
                f32x4 a0, a1, b0, b1; unpack8(lo[u], a0, a1); unpack8(hi[u], b0, b1);
                float x1[8] = {a0[0], a0[1], a0[2], a0[3], a1[0], a1[1], a1[2], a1[3]}, x2[8] = {b0[0], b0[1], b0[2], b0[3], b1[0], b1[1], b1[2], b1[3]};
                float ss = 0.f;
#pragma unroll
                for (int e = 0; e < 8; ++e) ss += x1[e] * x1[e] + x2[e] * x2[e];
                ss += __shfl_xor(ss, 1); ss += __shfl_xor(ss, 2);
                const float rs = rk ? rsqrtf(ss * (1.0f / 64.0f) + 1e-6f) : 1.0f;
                float o1[8], o2[8];
#pragma unroll
                for (int e = 0; e < 8; ++e) {
                    const f32x2e csn = cst[(u * 2 + hs) * 32 + 8 * j + e]; const float cs = csn.x, sn = csn.y;
                    const float y1 = x1[e] * rs * g1[e], y2 = x2[e] * rs * g2[e];
                    o1[e] = (y1 * cs - y2 * sn) * scl; o2[e] = (y2 * cs + y1 * sn) * scl; }
                if (live) {
                    if (rk) {
                        u32x2 w0, w1; w0.x = pack_fp8x4(o1[0], o1[1], o1[2], o1[3]); w0.y = pack_fp8x4(o1[4], o1[5], o1[6], o1[7]); w1.x = pack_fp8x4(o2[0], o2[1], o2[2], o2[3]); w1.y = pack_fp8x4(o2[4], o2[5], o2[6], o2[7]);
                        *(u32x2*)(KVP8 + (size_t)t * 128 + 8 * j) = w0; *(u32x2*)(KVP8 + (size_t)t * 128 + 32 + 8 * j) = w1;
                    } else {
                        *(u32x4*)(dst + 8 * j) = pack8((f32x4){o1[0], o1[1], o1[2], o1[3]}, (f32x4){o1[4], o1[5], o1[6], o1[7]});
                        *(u32x4*)(dst + 32 + 8 * j) = pack8((f32x4){o2[0], o2[1], o2[2], o2[3]}, (f32x4){o2[4], o2[5], o2[6], o2[7]}); } }
            } else if (live) {
                f32x4 a0, a1; unpack8(lo[u], a0, a1); u32x2 w; w.x = pack_fp8x4(a0[0], a0[1], a0[2], a0[3]); w.y = pack_fp8x4(a1[0], a1[1], a1[2], a1[3]);
                *(u32x2*)(KVP8 + (size_t)t * 128 + 64 + (lr - 24) * 8) = w;
            }
            if (lr < 4 && live) WSP(float, WS_WIF)[t * 4 + lr] = bf2f(wraw[u]) * 0.5f;
        }
    }
    const bf16_t* KMVM = WSP(bf16_t, WS_KMVM); bf16_t* KM = WSP(bf16_t, WS_KM); bf16_t* VMT = WSP(bf16_t, WS_VMT);
    { float gk8[8];
#pragma unroll
        for (int e = 0; e < 8; ++e) gk8[e] = INP(I_GKM)[(lane & 15) * 8 + e] * INP(I_GQM)[(lane & 15) * 8 + e];
        for (int r = gw; r < 8192; r += nw) {
            const int h = lane >> 4, b = r >> 8, m = r & 255;
            f32x4 a0, a1; unpack8(*(const u32x4*)(KMVM + (size_t)r * 1024 + h * 128 + (lane & 15) * 8), a0, a1);
            float ss = a0[0] * a0[0] + a0[1] * a0[1] + a0[2] * a0[2] + a0[3] * a0[3] + a1[0] * a1[0] + a1[1] * a1[1] + a1[2] * a1[2] + a1[3] * a1[3];
            ss += __shfl_xor(ss, 1); ss += __shfl_xor(ss, 2); ss += __shfl_xor(ss, 4); ss += __shfl_xor(ss, 8);
            const float rs = rsqrtf(ss * (1.0f / 128.0f) + 1e-6f);
            *(u32x4*)(KM + ((size_t)(b * 4 + h) * 256 + m) * 128 + (lane & 15) * 8) = pack8((f32x4){a0[0] * rs * gk8[0], a0[1] * rs * gk8[1], a0[2] * rs * gk8[2], a0[3] * rs * gk8[3]}, (f32x4){a1[0] * rs * gk8[4], a1[1] * rs * gk8[5], a1[2] * rs * gk8[6], a1[3] * rs * gk8[7]}); } }
    const int gt = F.c * NTHR + F.tid, NTT = F.G * NTHR;
    for (int id = gt; id < 32 * 4 * 32 * 128; id += NTT) { const int d = id & 127, pg = (id >> 7) & 31, h = (id >> 12) & 3, b = id >> 14;
        unsigned short v[8];
#pragma unroll
        for (int j = 0; j < 8; ++j) { const int pp = pg * 8 + j, q = pp & 15, key = (pp & ~15) + 8 * ((q & 7) >> 2) + 4 * (q >> 3) + (q & 3);
            v[j] = KMVM[(size_t)(b * 256 + key) * 1024 + 512 + h * 128 + d]; }
        u32x4 w; w.x = v[0] | ((unsigned)v[1] << 16); w.y = v[2] | ((unsigned)v[3] << 16); w.z = v[4] | ((unsigned)v[5] << 16); w.w = v[6] | ((unsigned)v[7] << 16);
        *(u32x4*)(VMT + ((size_t)(b * 4 + h) * 128 + d) * 256 + pg * 8) = w; }
}

__device__ __forceinline__ void p3_scan(const Frame& F) {
    const int gt = F.c * NTHR + F.tid, NTT = F.G * NTHR;
    const float* SC = WSP(float, WS_SC); bf16_t* UA = WSP(bf16_t, WS_UA);
    for (int id = gt; id < 65536; id += NTT) { const int p = id & 63, b = (id >> 6) & 31, g = id >> 11;
        const float lr = WSP(float, WS_LAM32)[(g * 64 + p) * 2], li = WSP(float, WS_LAM32)[(g * 64 + p) * 2 + 1];
        float sr = 0.f, si = 0.f;
        for (int c = 0; c < 64; ++c) { const size_t row = (size_t)g * 2048 + b * 64 + c;
            UA[row * 640 + 512 + p] = f2bf(sr); UA[row * 640 + 576 + p] = f2bf(si);
            const float cr = SC[row * 128 + p], ci = SC[row * 128 + 64 + p];
            const float nr = lr * sr - li * si + cr, ni = lr * si + li * sr + ci; sr = nr; si = ni; }
    }
}

constexpr int SEL_SC = 0, SEL_HIST = 131072, SEL_END = SEL_HIST + 128 * 32 * 4;
__device__ __forceinline__ int suffix_sum64(int x, int rm1, int rm2, int rm3, int& tot) {
    int p = x;
    p += __builtin_amdgcn_update_dpp(0, p, 0x111, 0xf, 0xf, false);
    p += __builtin_amdgcn_update_dpp(0, p, 0x112, 0xf, 0xf, false);
    p += __builtin_amdgcn_update_dpp(0, p, 0x114, 0xf, 0xf, false);
    p += __builtin_amdgcn_update_dpp(0, p, 0x118, 0xf, 0xf, false);
    const int t0 = __builtin_amdgcn_readlane(p, 15), t1 = __builtin_amdgcn_readlane(p, 31), t2 = __builtin_amdgcn_readlane(p, 47), t3 = __builtin_amdgcn_readlane(p, 63);
    p += (t0 & rm1) + (t1 & rm2) + (t2 & rm3);
    tot = t0 + t1 + t2 + t3;
    return tot - p + x;
}
__device__ __forceinline__ int mbcnt64(unsigned long long m) { return (int)__builtin_amdgcn_mbcnt_hi((unsigned)(m >> 32), __builtin_amdgcn_mbcnt_lo((unsigned)m, 0u)); }
__device__ __forceinline__ void p3_select(const Frame& F, bool doB) {
    LAS unsigned short* sc = (LAS unsigned short*)(F.lds + SEL_SC);
    LAS unsigned* hist = (LAS unsigned*)(F.lds + SEL_HIST);
    const bf16_t* QI = WSP(bf16_t, WS_QI); const bf16_t* KIP = WSP(bf16_t, WS_KIP); const float* WIF = WSP(float, WS_WIF);
    unsigned short* IDX = WSP(unsigned short, WS_IDX);
    const int lane = F.lane, n = lane & 31, hf = lane >> 5, wv = F.wave;
    const int rm1 = (lane >> 4) >= 1 ? -1 : 0, rm2 = (lane >> 4) >= 2 ? -1 : 0, rm3 = (lane >> 4) >= 3 ? -1 : 0;
    for (int L = F.c; L < 2048; L += F.G) {
        int qt = 63 - (L >> 5); const int b = L & 31;
        if (F.G == 256) { const int k = F.c >> 5, i = L >> 8, pr = i >> 1;
            qt = (i & 1) ? (48 - 16 * pr + k) : (63 - 16 * pr - k); }
        const int t0 = qt * 32, nkt = qt + 1, tok0 = b * 2048 + t0;
        for (int i = F.tid; i < 128 * 32; i += NTHR) hist[i] = 0u;
        { const int nz = ((nkt * 8 + 63) & ~63) - nkt * 8;
            for (int i = F.tid; i < nz * 32; i += NTHR) { const int nn = i & 31, ch = nkt * 8 + (i >> 5); *(LAS u32x2*)(sc + nn * 2048 + ((ch ^ nn) << 2)) = (u32x2){0u, 0u}; } }
        bf16x8 bq[4][4]; float wq[4];
#pragma unroll
        for (int h = 0; h < 4; ++h) { wq[h] = WIF[(tok0 + n) * 4 + h];
#pragma unroll
            for (int ks = 0; ks < 4; ++ks) bq[h][ks] = *(const bf16x8*)(QI + (size_t)(tok0 + n) * 256 + h * 64 + ks * 16 + hf * 8); }
        __syncthreads();
        bf16x8 ka[4];
        { const int k0 = wv < nkt ? wv : 0; const bf16_t* kp = KIP + (size_t)(b * 2048 + k0 * 32 + n) * 64 + hf * 8;
#pragma unroll
            for (int ks = 0; ks < 4; ++ks) ka[ks] = *(const bf16x8*)(kp + ks * 16); }
        for (int kt = wv; kt < nkt; kt += 8) {
            f32x16 acc[4];
#pragma unroll
            for (int h = 0; h < 4; ++h)
#pragma unroll
                for (int r = 0; r < 16; ++r) acc[h][r] = 0.f;
#pragma unroll
            for (int ks = 0; ks < 4; ++ks)
#pragma unroll
                for (int h = 0; h < 4; ++h) acc[h] = __builtin_amdgcn_mfma_f32_32x32x16_bf16(ka[ks], bq[h][ks], acc[h], 0, 0, 0);
            { const int k1 = kt + 8 < nkt ? kt + 8 : kt; const bf16_t* kp = KIP + (size_t)(b * 2048 + k1 * 32 + n) * 64 + hf * 8;
#pragma unroll
                for (int ks = 0; ks < 4; ++ks) ka[ks] = *(const bf16x8*)(kp + ks * 16); }
            unsigned key[16];
#pragma unroll
            for (int r = 0; r < 16; ++r) {
                const int i0 = __float_as_int(acc[0][r]), i1 = __float_as_int(acc[1][r]), i2 = __float_as_int(acc[2][r]), i3 = __float_as_int(acc[3][r]);
                const float isc = wq[0] * __int_as_float(i0 > 0 ? i0 : 0) + wq[1] * __int_as_float(i1 > 0 ? i1 : 0) + wq[2] * __int_as_float(i2 > 0 ? i2 : 0) + wq[3] * __int_as_float(i3 > 0 ? i3 : 0);
                const float y = isc * __builtin_amdgcn_rcpf(1.0f + 0.25f * fabsf(isc));
                key[r] = (unsigned)(y * 8191.75f + 32768.0f);
            }
            if (kt < qt) {
#pragma unroll
                for (int g4 = 0; g4 < 4; ++g4) {
#pragma unroll
                    for (int j = 0; j < 4; ++j) (void)__hip_atomic_fetch_add(hist + (key[g4 * 4 + j] >> 9) * 32 + n, 1u, __ATOMIC_RELAXED, __HIP_MEMORY_SCOPE_WORKGROUP);
                    u32x2 w; w.x = key[g4 * 4] | (key[g4 * 4 + 1] << 16); w.y = key[g4 * 4 + 2] | (key[g4 * 4 + 3] << 16);
                    const int chunk = (kt * 32 + 8 * g4 + 4 * hf) >> 2;
                    *(LAS u32x2*)(sc + n * 2048 + ((chunk ^ n) << 2)) = w;
                }
            } else {
                asm volatile("" ::: "memory");
#pragma unroll
                for (int g4 = 0; g4 < 4; ++g4) {
                    unsigned kk[4];
#pragma unroll
                    for (int j = 0; j < 4; ++j) { const int s = kt * 32 + j + 8 * g4 + 4 * hf; const bool valid = s <= t0 + n;
                        kk[j] = valid ? key[g4 * 4 + j] : 0u;
                        (void)__hip_atomic_fetch_add(hist + (kk[j] >> 9) * 32 + n, valid ? 1u : 0u, __ATOMIC_RELAXED, __HIP_MEMORY_SCOPE_WORKGROUP); }
                    u32x2 w; w.x = kk[0] | (kk[1] << 16); w.y = kk[2] | (kk[3] << 16);
                    const int chunk = (kt * 32 + 8 * g4 + 4 * hf) >> 2;
                    *(LAS u32x2*)(sc + n * 2048 + ((chunk ^ n) << 2)) = w;
                }
            }
        }
        __syncthreads();
        for (int qq = 0; qq < (doB ? 4 : 0); ++qq) {
            const int nq = wv * 4 + qq, tq = t0 + nq, nvalid = tq + 1, tok = tok0 + nq;
            LAS unsigned short* lst = sc + nq * 2048; LAS unsigned* cand = (LAS unsigned*)(sc + nq * 2048 + 512);
            if (nvalid <= 256) {
#pragma unroll
                for (int e = 0; e < 4; ++e) { const int p = lane * 4 + e; lst[p] = (unsigned short)(p < nvalid ? p : 0); }
            } else {
                unsigned v[32];
                LAS const unsigned short* rowp = sc + nq * 2048 + ((((lane >> 2) ^ (nq & 15)) << 2) | (lane & 3));
#pragma unroll
                for (int r = 0; r < 32; ++r) v[r] = rowp[r * 64];
                const int hhi = (int)hist[(64 + lane) * 32 + nq], hlo = (int)hist[lane * 32 + nq];
                int tothi; const int shi = suffix_sum64(hhi, rm1, rm2, rm3, tothi);
                int b1, above;
                if (tothi >= 256) { const unsigned long long mk = __builtin_amdgcn_ballot_w64(shi >= 256); const int lb = 63 - __clzll(mk); b1 = 64 + lb; above = __builtin_amdgcn_readlane(shi - hhi, lb); }
                else { int totlo; const int slo = tothi + suffix_sum64(hlo, rm1, rm2, rm3, totlo); const unsigned long long mk = __builtin_amdgcn_ballot_w64(slo >= 256); const int lb = 63 - __clzll(mk); b1 = lb; above = __builtin_amdgcn_readlane(slo - hlo, lb); }
                const int sw64 = (nq >> 4) << 6, laneE = lane + sw64, laneO = lane - sw64;
                int base = 0, m = 0;
                const unsigned binhi = (unsigned)b1 * 512u + 511u, binlo = b1 ? (unsigned)b1 * 512u : 1u, binspan = binhi - binlo;
#pragma unroll
                for (int r4 = 0; r4 < 32; r4 += 4) {
                    if (r4 * 64 >= nvalid) break;
#pragma unroll
                    for (int rr = 0; rr < 4; ++rr) { const int r = r4 + rr; const unsigned idx = (unsigned)(r * 64 + ((r & 1) ? laneO : laneE));
                        const bool gt_ = v[r] > binhi, eq = (v[r] - binlo) <= binspan;
                        const unsigned long long mg = __builtin_amdgcn_ballot_w64(gt_), me = __builtin_amdgcn_ballot_w64(eq);
                        int pg = base + mbcnt64(mg), cp = m + mbcnt64(me);
                        asm("" : "+v"(pg), "+v"(cp));
                        lst[gt_ ? pg : 256 + lane] = (unsigned short)idx;
                        cand[(eq && cp < 128) ? cp : 128 + lane] = ((v[r] & 511u) << 11) | idx;
                        base += __popcll(mg); m += __popcll(me); }
                }
                if (m <= 128) {
                    const int need = 256 - above;
                    const unsigned c0 = lane < m ? cand[lane] : 0u, c1 = 64 + lane < m ? cand[64 + lane] : 0u;
                    const unsigned a0 = lane < m ? (c0 >> 11) + 1u : 0u, a1 = 64 + lane < m ? (c1 >> 11) + 1u : 0u;
                    unsigned lo = 0u;
                    for (int bit = 9; bit >= 0; --bit) { const unsigned cd = lo | (1u << bit); const int c = __popcll(__builtin_amdgcn_ballot_w64(a0 >= cd)) + __popcll(__builtin_amdgcn_ballot_w64(a1 >= cd)); if (c >= need) lo = cd; }
                    const unsigned long long g0 = __builtin_amdgcn_ballot_w64(a0 > lo), g1 = __builtin_amdgcn_ballot_w64(a1 > lo), e0 = __builtin_amdgcn_ballot_w64(a0 == lo), e1 = __builtin_amdgcn_ballot_w64(a1 == lo);
                    const int ties = need - (__popcll(g0) + __popcll(g1));
                    int k0 = mbcnt64(e0), k1 = __popcll(e0) + mbcnt64(e1); asm("" : "+v"(k0), "+v"(k1));
                    const bool s0 = a0 > lo || (a0 == lo && k0 < ties), s1 = a1 > lo || (a1 == lo && k1 < ties);
                    const unsigned long long m0 = __builtin_amdgcn_ballot_w64(s0), m1 = __builtin_amdgcn_ballot_w64(s1);
                    if (s0) lst[base + mbcnt64(m0)] = (unsigned short)(c0 & 2047u);
                    if (s1) lst[base + __popcll(m0) + mbcnt64(m1)] = (unsigned short)(c1 & 2047u);
                } else {
#pragma unroll
                    for (int r = 0; r < 32; ++r) v[r] = ((r * 64 + ((r & 1) ? laneO : laneE)) < nvalid) ? v[r] : 0u;
                    unsigned lo = 0u;
                    for (int bit = 15; bit >= 0; --bit) { const unsigned cd = lo | (1u << bit); int cnt = 0;
#pragma unroll
                        for (int r = 0; r < 32; ++r) cnt += __popcll(__builtin_amdgcn_ballot_w64(v[r] >= cd));
                        if (cnt >= 256) lo = cd; }
                    int cgt = 0;
#pragma unroll
                    for (int r = 0; r < 32; ++r) cgt += __popcll(__builtin_amdgcn_ballot_w64(v[r] > lo));
                    const int need = 256 - cgt; int bs = 0, eqb = 0;
#pragma unroll
                    for (int r = 0; r < 32; ++r) {
                        const bool gt_ = v[r] > lo, eq = v[r] == lo;
                        const unsigned long long me = __builtin_amdgcn_ballot_w64(eq);
                        const bool sel = gt_ || (eq && eqb + mbcnt64(me) < need);
                        const unsigned long long ms = __builtin_amdgcn_ballot_w64(sel);
                        if (sel) lst[bs + mbcnt64(ms)] = (unsigned short)(r * 64 + ((r & 1) ? laneO : laneE));
                        bs += __popcll(ms); eqb += __popcll(me);
                    }
                }
            }
            *(u32x2*)(IDX + (size_t)tok * 256 + lane * 4) = *(LAS u32x2*)(lst + lane * 4);
        }
        __syncthreads();
    }
}

__device__ __forceinline__ void p3_memattn(const Frame& F) {
    constexpr int KS = 272, VS = 528, VOFF = 256 * KS;
    const bf16_t* KM = WSP(bf16_t, WS_KM); const bf16_t* VMT = WSP(bf16_t, WS_VMT); const bf16_t* QM = DOP(bf16_t, DO_Y3) + 512; unsigned char* YM8 = DOP(unsigned char, DO_YM8);
    const int lane = F.lane, n = lane & 31, hf = lane >> 5;
    for (int u = F.c; u < 256; u += F.G) {
        const int half = u & 1, bh = u >> 1, b = bh >> 2, h = bh & 3;
#pragma unroll
        for (int i = 0; i < 8; ++i) { const int id = F.tid + 512 * i;
            { const int row = id >> 4, seg = id & 15; *(LAS u32x4*)(F.lds + row * KS + seg * 16) = *(const u32x4*)(KM + ((size_t)bh * 256 + row) * 128 + seg * 8); }
            { const int row = id >> 5, seg = id & 31; *(LAS u32x4*)(F.lds + VOFF + row * VS + seg * 16) = *(const u32x4*)(VMT + ((size_t)bh * 128 + row) * 256 + seg * 8); } }
        __syncthreads();
#pragma unroll 1
        for (int qi = 0; qi < 4; ++qi) {
            const int tok = b * 2048 + half * 1024 + F.wave * 128 + qi * 32 + n;
            const bf16_t* qp = QM + (size_t)tok * Y3LD + h * 128;
            bf16x8 bq[8];
#pragma unroll
            for (int ks = 0; ks < 8; ++ks) bq[ks] = *(const bf16x8*)(qp + ks * 16 + hf * 8);
            float qss = 0.f;
#pragma unroll
            for (int ks = 0; ks < 8; ++ks)
#pragma unroll
                for (int e = 0; e < 8; ++e) { const float f = bf2f((unsigned short)bq[ks][e]); qss += f * f; }
            qss += __shfl_xor(qss, 32);
            const float qc = rsqrtf(qss * (1.0f / 128.0f) + 1e-6f) * (0.08838834764831845f * 1.4426950408889634f);
            f32x16 o[4];
#pragma unroll
            for (int dt = 0; dt < 4; ++dt)
#pragma unroll
                for (int r = 0; r < 16; ++r) o[dt][r] = 0.f;
            float mrun = -3.0e38f, lrun = 0.f;
#pragma unroll 1
            for (int kh = 0; kh < 2; ++kh) {
                f32x16 s[4];
#pragma unroll
                for (int k4 = 0; k4 < 4; ++k4) { const int kt = kh * 4 + k4;
#pragma unroll
                    for (int r = 0; r < 16; ++r) s[k4][r] = 0.f;
#pragma unroll
                    for (int ks = 0; ks < 8; ++ks) { const bf16x8 a = *(const LAS bf16x8*)(F.lds + (kt * 32 + n) * KS + (ks * 16 + hf * 8) * 2);
                        s[k4] = __builtin_amdgcn_mfma_f32_32x32x16_bf16(a, bq[ks], s[k4], 0, 0, 0); } }
                float mx = mrun;
#pragma unroll
                for (int k4 = 0; k4 < 4; ++k4)
#pragma unroll
                    for (int r = 0; r < 16; ++r) mx = fmaxf(mx, s[k4][r]);
                mx = fmaxf(mx, __shfl_xor(mx, 32));
                const float resc = __builtin_amdgcn_exp2f((mrun - mx) * qc);
                float sum = 0.f;
#pragma unroll
                for (int k4 = 0; k4 < 4; ++k4)
#pragma unroll
                    for (int r = 0; r < 16; ++r) { const float p = __builtin_amdgcn_exp2f((s[k4][r] - mx) * qc); s[k4][r] = p; sum += p; }
                sum += __shfl_xor(sum, 32);
                lrun = lrun * resc + sum; mrun = mx;
#pragma unroll
                for (int dt = 0; dt < 4; ++dt)
#pragma unroll
                    for (int r = 0; r < 16; ++r) o[dt][r] *= resc;
#pragma unroll
                for (int k4 = 0; k4 < 4; ++k4)
#pragma unroll
                    for (int st = 0; st < 2; ++st) { const int kt = kh * 4 + k4;
                        union { u32x4 u; bf16x8 v; } pb;
                        pb.u.x = cvt_pk_bf16(s[k4][8 * st + 0], s[k4][8 * st + 1]); pb.u.y = cvt_pk_bf16(s[k4][8 * st + 2], s[k4][8 * st + 3]);
                        pb.u.z = cvt_pk_bf16(s[k4][8 * st + 4], s[k4][8 * st + 5]); pb.u.w = cvt_pk_bf16(s[k4][8 * st + 6], s[k4][8 * st + 7]);
#pragma unroll
                        for (int dt = 0; dt < 4; ++dt) { const bf16x8 a = *(const LAS bf16x8*)(F.lds + VOFF + (dt * 32 + n) * VS + (kt * 32 + 16 * st + 8 * hf) * 2);
                            o[dt] = __builtin_amdgcn_mfma_f32_32x32x16_bf16(a, pb.v, o[dt], 0, 0, 0); }
                    }
            }
            const float inv = 16.0f / lrun;
#pragma unroll
            for (int dt = 0; dt < 4; ++dt)
#pragma unroll
                for (int g4 = 0; g4 < 4; ++g4)
                    *(unsigned*)(YM8 + (size_t)tok * 512 + h * 128 + dt * 32 + 8 * g4 + 4 * hf) = pack_fp8x4(o[dt][g4 * 4] * inv, o[dt][g4 * 4 + 1] * inv, o[dt][g4 * 4 + 2] * inv, o[dt][g4 * 4 + 3] * inv);
        }
        __syncthreads();
    }
}

__device__ __forceinline__ void p4_attend(const Frame& F, const Args& a) {
    constexpr int WB = 2 * 8192 + 1024;
    LAS unsigned char* wb = F.lds + F.wave * WB;
    LAS unsigned short* lst = (LAS unsigned short*)(wb + 16384);
    const unsigned short* IDX = WSP(unsigned short, WS_IDX); const unsigned char* KVP8 = WSP(unsigned char, WS_KVP); const bf16_t* Q = DOP(bf16_t, DO_Y3); unsigned char* YD8 = DOP(unsigned char, DO_YD8);
    const int lane = F.lane, n = lane & 15, g = lane >> 4, gw = F.c * 8 + F.wave, nw = F.G * 8;
    const int ntk = (T - gw + nw - 1) / nw;
    float gkm = fabsf(INP(I_GK)[lane]);
    gkm = fmaxf(gkm, __shfl_xor(gkm, 32)); gkm = fmaxf(gkm, __shfl_xor(gkm, 16)); gkm = fmaxf(gkm, __shfl_xor(gkm, 8)); gkm = fmaxf(gkm, __shfl_xor(gkm, 4)); gkm = fmaxf(gkm, __shfl_xor(gkm, 2)); gkm = fmaxf(gkm, __shfl_xor(gkm, 1));
    const float kmax = 8.0f * gkm * 1.07f;
    int koff[4][2];
#pragma unroll
    for (int blk = 0; blk < 4; ++blk)
#pragma unroll
        for (int ks = 0; ks < 2; ++ks) { const int row = blk * 16 + n, pc = ks * 2 + (g >> 1); koff[blk][ks] = row * 128 + ((pc ^ (row & 7)) << 4) + 8 * (g & 1); }
    const int q8 = n >> 1, p8 = n & 1;
    int toff[2][4];
#pragma unroll
    for (int kb2 = 0; kb2 < 2; ++kb2)
#pragma unroll
        for (int d = 0; d < 4; ++d) { const int row = (kb2 * 2 + (q8 >> 2)) * 16 + g * 4 + (q8 & 3), pc = 4 + d; toff[kb2][d] = row * 128 + ((pc ^ (row & 7)) << 4) + 8 * p8; }
    const int grow = lane >> 3, gpc = lane & 7;
    const unsigned wbase = (unsigned)(uintptr_t)wb;
#define AT_ISSUE(TOK, LB, CH, BUF) do { const char* _kb = (const char*)(KVP8 + (size_t)((TOK) >> 11) * 2048 * 128); \
        _Pragma("unroll") for (int _i = 0; _i < 8; ++_i) { const int _row = 8 * _i + grow; const int _key = lst[(LB) * 256 + (CH) * 64 + _row]; \
            __builtin_amdgcn_global_load_lds((const unsigned*)(_kb + (size_t)_key * 128 + ((gpc ^ (_row & 7)) << 4)), (LAS unsigned*)(wb + (BUF) * 8192 + _i * 1024), 16, 0, 0); } } while (0)
    if (ntk <= 0) return;
    { const u32x2 l0 = *(const u32x2*)(IDX + (size_t)gw * 256 + lane * 4); *(LAS u32x2*)(lst + lane * 4) = l0; }
    float gq1[8], gq2[8];
#pragma unroll
    for (int e = 0; e < 8; ++e) { gq1[e] = INP(I_GQ)[g * 8 + e]; gq2[e] = INP(I_GQ)[32 + g * 8 + e]; }
    const f32x4* CS = WSP(f32x4, WS_CS);
    bf16x8 nbq[2]; f32x4 ncs[4];
#pragma unroll
    for (int e = 0; e < 4; ++e) ncs[e] = CS[(size_t)gw * 16 + g * 4 + e];
#pragma unroll
    for (int ks = 0; ks < 2; ++ks) { if (n < 8) nbq[ks] = *(const bf16x8*)(Q + (size_t)gw * Y3LD + n * 64 + ks * 32 + g * 8); else nbq[ks] = (bf16x8){0, 0, 0, 0, 0, 0, 0, 0}; }
    AT_ISSUE(gw, 0, 0, 0); AT_ISSUE(gw, 0, 1, 1);
#pragma unroll 1
    for (int k = 0; k < ntk; ++k) {
        const int tok = gw + k * nw, ntok = tok + nw, lb = k & 1; const bool hasn = (k + 1 < ntk);
        const int tq = tok & 2047, cnt = tq + 1 < 256 ? tq + 1 : 256;
        long bq[2]; float qs = 0.f;
        { float x1[8], x2[8], ss = 0.f;
#pragma unroll
            for (int e = 0; e < 8; ++e) { x1[e] = bf2f((unsigned short)nbq[0][e]); x2[e] = bf2f((unsigned short)nbq[1][e]); ss += x1[e] * x1[e] + x2[e] * x2[e]; }
            ss += __shfl_xor(ss, 16); ss += __shfl_xor(ss, 32);
            const float rs = rsqrtf(ss * (1.0f / 64.0f) + 1e-6f) * (0.125f * 1.4426950408889634f); float o1[8], o2[8];
#pragma unroll
            for (int e = 0; e < 8; ++e) { const float cs = ncs[e >> 1][(e & 1) * 2], sn = ncs[e >> 1][(e & 1) * 2 + 1], y1 = x1[e] * rs * gq1[e], y2 = x2[e] * rs * gq2[e];
                o1[e] = y1 * cs - y2 * sn; o2[e] = y2 * cs + y1 * sn; qs += o1[e] * o1[e] + o2[e] * o2[e]; }
            const unsigned a0 = pack_fp8x4(o1[0], o1[1], o1[2], o1[3]), a1 = pack_fp8x4(o1[4], o1[5], o1[6], o1[7]), b0 = pack_fp8x4(o2[0], o2[1], o2[2], o2[3]), b1 = pack_fp8x4(o2[4], o2[5], o2[6], o2[7]);
            bq[0] = (long)(((unsigned long long)a1 << 32) | a0); bq[1] = (long)(((unsigned long long)b1 << 32) | b0); }
        qs += __shfl_xor(qs, 16); qs += __shfl_xor(qs, 32);
        const float shift = sqrtf(qs) * 1.07f * kmax - 7.0f;
        u32x2 nl = (u32x2){0u, 0u};
        if (hasn) { nl = *(const u32x2*)(IDX + (size_t)ntok * 256 + lane * 4);
#pragma unroll
            for (int e = 0; e < 4; ++e) ncs[e] = CS[(size_t)ntok * 16 + g * 4 + e];
#pragma unroll
            for (int ks = 0; ks < 2; ++ks) if (n < 8) nbq[ks] = *(const bf16x8*)(Q + (size_t)ntok * Y3LD + n * 64 + ks * 32 + g * 8); }
        f32x4 o[4];
#pragma unroll
        for (int d = 0; d < 4; ++d) o[d] = (f32x4){0.f, 0.f, 0.f, 0.f};
        float lsum = 0.f;
#pragma unroll
        for (int ch = 0; ch < 4; ++ch) {
            const int buf = ch & 1;
            if (ch == 3 && !hasn) asm volatile("s_waitcnt vmcnt(0)" ::: "memory"); else asm volatile("s_waitcnt vmcnt(8)" ::: "memory");
            LAS const unsigned char* bb = wb + buf * 8192;
            f32x4 s[4];
#pragma unroll
            for (int blk = 0; blk < 4; ++blk) {
                const long k0 = *(LAS const long*)(bb + koff[blk][0]), k1 = *(LAS const long*)(bb + koff[blk][1]);
                s[blk] = __builtin_amdgcn_mfma_f32_16x16x32_fp8_fp8(k0, bq[0], (f32x4){0.f, 0.f, 0.f, 0.f}, 0, 0, 0);
                s[blk] = __builtin_amdgcn_mfma_f32_16x16x32_fp8_fp8(k1, bq[1], s[blk], 0, 0, 0);
            }
            if (cnt >= (ch + 1) * 64) {
#pragma unroll
                for (int blk = 0; blk < 4; ++blk)
#pragma unroll
                    for (int j = 0; j < 4; ++j) { const float e = __builtin_amdgcn_exp2f(s[blk][j] - shift); s[blk][j] = e; lsum += e; }
            } else {
                asm volatile("" ::: "memory");
#pragma unroll
                for (int blk = 0; blk < 4; ++blk)
#pragma unroll
                    for (int j = 0; j < 4; ++j) { const int p = ch * 64 + blk * 16 + g * 4 + j; const float e = p < cnt ? __builtin_amdgcn_exp2f(s[blk][j] - shift) : 0.f; s[blk][j] = e; lsum += e; }
            }
#pragma unroll
            for (int kb2 = 0; kb2 < 2; ++kb2) {
                const unsigned plo = pack_fp8x4_nc(s[2 * kb2][0], s[2 * kb2][1], s[2 * kb2][2], s[2 * kb2][3]), phi = pack_fp8x4_nc(s[2 * kb2 + 1][0], s[2 * kb2 + 1][1], s[2 * kb2 + 1][2], s[2 * kb2 + 1][3]);
                const long pb = (long)(((unsigned long long)phi << 32) | plo);
                u32x2 tr[4];
#pragma unroll
                for (int d = 0; d < 4; ++d) asm volatile("ds_read_b64_tr_b8 %0, %1 offset:%2" : "=&v"(tr[d]) : "v"(wbase + (unsigned)toff[kb2][d]), "i"(buf * 8192) : "memory");
                asm volatile("s_waitcnt lgkmcnt(0)" : "+v"(tr[0]), "+v"(tr[1]), "+v"(tr[2]), "+v"(tr[3]) :: "memory");
#pragma unroll
                for (int d = 0; d < 4; ++d) { const long av = (long)(((unsigned long long)tr[d].y << 32) | tr[d].x);
                    o[d] = __builtin_amdgcn_mfma_f32_16x16x32_fp8_fp8(av, pb, o[d], 0, 0, 0); }
            }
            __builtin_amdgcn_sched_barrier(0);
            if (ch == 1 && hasn) *(LAS u32x2*)(lst + (lb ^ 1) * 256 + lane * 4) = nl;
            if (ch < 2) AT_ISSUE(tok, lb, ch + 2, buf);
            else if (hasn) AT_ISSUE(ntok, lb ^ 1, ch - 2, buf);
            __builtin_amdgcn_sched_barrier(0);
        }
        lsum += __shfl_xor(lsum, 16); lsum += __shfl_xor(lsum, 32);
        const float inv = 16.0f / lsum;
        if (n < 8) {
#pragma unroll
            for (int d = 0; d < 4; ++d) *(unsigned*)(YD8 + (size_t)tok * 512 + n * 64 + d * 16 + g * 4) = pack_fp8x4(o[d][0] * inv, o[d][1] * inv, o[d][2] * inv, o[d][3] * inv);
        }
    }
#undef AT_ISSUE
}

__device__ __forceinline__ void p8_router(const Frame& F, const Args& a, bool commit) {
    const bf16_t* X1B = WSP(bf16_t, WS_X1B); const bf16_t* WR = WSP(bf16_t, WS_WR);
    int* TOK = WSP(int, WS_TOK); float2* RW = WSP(float2, WS_RW); int* TOK2 = WSP(int, WS_TOK2); unsigned* gcnt = (unsigned*)(F.ws + WS_CTL + CTL_GCNT);
    constexpr int WRS = 2064, RT_LG = 48 * WRS, RT_RS = RT_LG + 8 * 16 * 48 * 4, RT_LC = RT_RS + 8 * 16 * 4;
    LAS float* lg = (LAS float*)(F.lds + RT_LG) + F.wave * (16 * 48);
    LAS float* rsb = (LAS float*)(F.lds + RT_RS) + F.wave * 16;
    LAS int* lc = (LAS int*)(F.lds + RT_LC); LAS int* lbase = lc + 144;
    const int lane = F.lane, n = lane & 15, q = lane >> 4;
    for (int i = F.tid; i < 48 * 128; i += NTHR) { const int r = i >> 7, c = i & 127; *(LAS u32x4*)(F.lds + r * WRS + c * 16) = *(const u32x4*)(WR + (size_t)r * 1024 + c * 8); }
    __syncthreads();
    for (int it = F.c; it < T / 128; it += F.G) {
        const int tw = it * 128 + F.wave * 16;
        if (F.tid < 144) lc[F.tid] = 0;
        const bf16_t* xp = X1B + (size_t)(tw + n) * 1024 + q * 8;
        f32x4 acc[3] = {(f32x4){0.f, 0.f, 0.f, 0.f}, (f32x4){0.f, 0.f, 0.f, 0.f}, (f32x4){0.f, 0.f, 0.f, 0.f}};
        float ss = 0.f;
#pragma unroll
        for (int hb = 0; hb < 2; ++hb) {
            bf16x8 av[16];
#pragma unroll
            for (int k2 = 0; k2 < 16; ++k2) av[k2] = *(const bf16x8*)(xp + (hb * 16 + k2) * 32);
#pragma unroll
            for (int k2 = 0; k2 < 16; ++k2) { const int ks = hb * 16 + k2;
#pragma unroll
                for (int j = 0; j < 8; ++j) { const float f = bf2f((unsigned short)av[k2][j]); ss += f * f; }
#pragma unroll
                for (int bl = 0; bl < 3; ++bl) { const bf16x8 bb = *(const LAS bf16x8*)(F.lds + (bl * 16 + n) * WRS + (ks * 32 + q * 8) * 2);
                    acc[bl] = __builtin_amdgcn_mfma_f32_16x16x32_bf16(av[k2], bb, acc[bl], 0, 0, 0); } }
        }
        ss += __shfl_xor(ss, 16); ss += __shfl_xor(ss, 32);
        const float rs = rsqrtf(ss * (1.0f / 1024.0f) + 1e-6f);
        if (q == 0) rsb[n] = rs;
#pragma unroll
        for (int bl = 0; bl < 3; ++bl)
#pragma unroll
            for (int j = 0; j < 4; ++j) lg[(q * 4 + j) * 48 + bl * 16 + n] = acc[bl][j] * rsb[q * 4 + j];
        __syncthreads();
        int l1 = 0, l2 = 0, lp = 0, r1 = 0, r2 = 0, rp = 0, s1 = 0; float wa = 0.f, wb = 0.f, myrs = 0.f;
        if (lane < 16) {
            LAS const float* l = lg + lane * 48; myrs = rsb[lane];
            float g0 = l[0] + INP(I_BGROUP)[0]; int gi = 0; float gm = g0, gl[4]; gl[0] = g0;
#pragma unroll
            for (int j = 1; j < 4; ++j) { gl[j] = l[j] + INP(I_BGROUP)[j]; if (gl[j] > gm) { gm = gl[j]; gi = j; } }
            float gs = 0.f;
#pragma unroll
            for (int j = 0; j < 4; ++j) gs += __expf(gl[j] - gm);
            const float ggate = 1.0f / gs;
            float e1 = -3.0e38f, e2 = -3.0e38f; int i1 = 0, i2 = 0;
            for (int e = 0; e < 8; ++e) { const float v = l[4 + gi * 8 + e] + INP(I_BEXP)[gi * 8 + e];
                if (v > e1) { e2 = e1; i2 = i1; e1 = v; i1 = e; } else if (v > e2) { e2 = v; i2 = e; } }
            const float pa = 1.0f / (1.0f + __expf(e2 - e1));
            wa = ggate * pa; wb = ggate - wa;
            s1 = i1 < i2 ? 0 : 1;
            const int elo = i1 < i2 ? i1 : i2, ehi = i1 < i2 ? i2 : i1;
            l1 = gi * 8 + i1; l2 = gi * 8 + i2; lp = 32 + gi * 28 + (elo * (15 - elo)) / 2 + (ehi - elo - 1);
            r1 = atomicAdd((int*)(lc + l1), 1); r2 = atomicAdd((int*)(lc + l2), 1); rp = atomicAdd((int*)(lc + lp), 1);
        }
        __syncthreads();
        if (F.tid < 144) { const int cn = lc[F.tid]; lbase[F.tid] = (cn > 0 && commit) ? (int)atomicAdd(gcnt + F.tid * 64, (unsigned)cn) : 0; }
        __syncthreads();
        if (lane < 16 && commit) { const int t = tw + lane;
            const size_t p1 = (size_t)l1 * 65536 + lbase[l1] + r1, p2 = (size_t)l2 * 65536 + lbase[l2] + r2;
            TOK[p1] = t | (s1 << 31); RW[p1] = make_float2(myrs, wa); TOK[p2] = t | ((s1 ^ 1) << 31); RW[p2] = make_float2(myrs, wb);
            TOK2[(size_t)(lp - 32) * 65536 + lbase[lp] + rp] = t; }
        __syncthreads();
    }
}

__device__ __forceinline__ int moe_table(const Frame& F, int first, int count) {
    LAS int* misc = (LAS int*)(F.lds + MISC_OFF); const unsigned* gcnt = (const unsigned*)(F.ws + WS_CTL + CTL_GCNT);
    __syncthreads();
    if (F.tid < count) misc[MI_CNT + F.tid] = (int)__hip_atomic_load(gcnt + (first + F.tid) * 64, __ATOMIC_RELAXED, __HIP_MEMORY_SCOPE_AGENT);
    if (F.tid >= 256 && F.tid < 256 + 28) { const int pi = F.tid - 256; int elo = 0; while (elo < 6 && ((elo + 1) * (15 - (elo + 1))) / 2 <= pi) ++elo;
        misc[MI_PT + pi] = elo | ((pi - (elo * (15 - elo)) / 2 + elo + 1) << 4); }
    __syncthreads();
    if (F.tid == 0) { int run = 0; for (int l = 0; l < count; ++l) { misc[MI_PRE + l] = run; run += (misc[MI_CNT + l] + 255) >> 8; } misc[MI_PRE + count] = run; }
    __syncthreads();
    const int nt = misc[MI_PRE + count];
    for (int idx = F.tid; idx < nt && idx < 640; idx += NTHR) { int l = 0; while (l < count - 1 && misc[MI_PRE + l + 1] <= idx) ++l; misc[MI_TILE + idx] = l | ((idx - misc[MI_PRE + l]) << 8); }
    __syncthreads();
    return nt < 640 ? nt : 640;
}

__global__ void __launch_bounds__(NTHR, 2) fwd(Args a) {
    extern __shared__ __attribute__((aligned(16))) unsigned char lds_raw[];
    Frame F;
    F.lds = (LAS unsigned char*)lds_raw; F.tid = threadIdx.x; F.lane = F.tid & 63; F.wave = __builtin_amdgcn_readfirstlane(F.tid >> 6); F.G = gridDim.x; F.c = blockIdx.x;
    F.ws = a.ws; F.dout = (unsigned char*)a.out;
    LAS unsigned* misc = (LAS unsigned*)(F.lds + MISC_OFF);
    for (int i = F.tid; i < 1024; i += NTHR) misc[i] = 0u;
    __syncthreads();
    XcdBarrier bar; bar.bar = (unsigned*)(F.ws + WS_CTL); bar.x = 0; bar.st = (volatile LAS unsigned*)misc;
    const int lo = a.ph_lo, hi = a.ph_hi;
    if (hi - lo > 1) bar = xcd_barrier_post((unsigned*)(F.ws + WS_CTL), (volatile LAS unsigned*)misc);
#ifndef PH_MASK
#define PH_MASK 0xFFF
#endif
#define IN(k) (((PH_MASK >> (k)) & 1) && lo <= (k) && (k) < hi)
#ifndef REP_MASK
#define REP_MASK 0
#endif
#define NREP(k) (1 + ((REP_MASK >> (k)) & 1))
#define SEAM(k) do { if (IN(k) && IN((k) + 1)) xcd_barrier(bar); } while (0)
    bf16_t* HB = WSP(bf16_t, WS_HB); bf16_t* UA = WSP(bf16_t, WS_UA); unsigned char* SG = WSP(unsigned char, WS_SG);
    bf16_t* Y3 = DOP(bf16_t, DO_Y3); bf16_t* YG = WSP(bf16_t, WS_YG);
    LAS const int* imisc = (LAS const int*)(F.lds + MISC_OFF);

    if (IN(0)) for (int rep = 0; rep < NREP(0); ++rep) { p0_prep(F, a); __syncthreads(); }
    SEAM(0);
    if (IN(0) && IN(1)) {
        if (F.tid == 0) { unsigned* bw = (unsigned*)(F.ws + WS_CTL); bool bal = (F.G % 8) == 0;
            for (int j = 0; j < 16; ++j) { const unsigned cj = xb_ld(&bw[XB_XCNT(j)]); bal = bal && (cj == (j < 8 ? (unsigned)F.G / 8u : 0u)); }
            misc[3] = bal ? (misc[2] * 8u + bar.x) : (unsigned)blockIdx.x; }
        __syncthreads();
        F.c = (int)misc[3];
    }
    if (IN(1)) {
        { pg8::Gemm g{512, 512, 512, 0x7f, 0x7a};
          pg8::SchedGrid S{(const char*)WSP(unsigned char, WS_HB8), (const char*)WSP(unsigned char, WS_WG8), 0, 0, (size_t)256 * 1024, (size_t)256 * 1024, 256, 18, 1, F.G, F.c, NREP(1)};
          EpiInProj E{UA, Y3, SG};
          pg8::gemm_phase<EpiInProj, pg8::SchedGrid, false, PG8_SP2, true>(F.lds, g, S, E); }
        { pg8::Gemm g{1024, 1024, 1024}; pg8::SchedGrid S{(const char*)HB, (const char*)WSP(bf16_t, WS_WIN), 0, 0, (size_t)256 * 1024 * 2, (size_t)256 * 1024 * 2, 256, 2, 1, F.G, F.c, NREP(1)};
          EpiInProjB E{WSP(bf16_t, WS_KVX), WSP(bf16_t, WS_QI)};
          pg8::gemm_phase<EpiInProjB, pg8::SchedGrid, false>(F.lds, g, S, E); }
        { pg8::Gemm g{512, 512, 512, 0x7f, 0x7a};
          pg8::SchedGrid S{(const char*)WSP(unsigned char, WS_MEMN), (const char*)WSP(unsigned char, WS_WMEM), 0, 0, (size_t)256 * 1024, (size_t)256 * 1024, 32, 4, 1, F.G, F.c, NREP(1)};
          EpiBf16 E{WSP(bf16_t, WS_KMVM), 1024};
          pg8::gemm_phase<EpiBf16, pg8::SchedGrid, false, PG8_SP2, true>(F.lds, g, S, E); }
        if (F.G > 128) { if (F.c >= 128) p1_tables(F, a, F.c - 128, F.G - 128); } else p1_tables(F, a, F.c, F.G);
    }
    SEAM(1);
    if (IN(2)) {
        { pg8::Gemm g{640, 512, 512}; pg8::SchedGrid S{(const char*)UA, (const char*)WSP(bf16_t, WS_SIN), (size_t)2048 * 640 * 2, (size_t)256 * 512 * 2, (size_t)256 * 640 * 2, (size_t)256 * 512 * 2, 8, 1, 32, F.G, F.c, NREP(2)};
          EpiSc E{WSP(float, WS_SC)};
          pg8::gemm_phase<EpiSc, pg8::SchedGrid, false>(F.lds, g, S, E); }
        for (int rep = 0; rep < NREP(15); ++rep) p2_post(F, a, rep < NREP(15) - 1);
    }
    SEAM(2);
#ifndef P3_SUB
#define P3_SUB 7
#endif
    if (IN(3)) { for (int rep = 0; rep < NREP(13); ++rep) { if (P3_SUB & 1) p3_scan(F); } for (int rep = 0; rep < NREP(3); ++rep) { if (P3_SUB & 2) p3_select(F, rep == 0 || (REP_MASK & 0x10000)); } for (int rep = 0; rep < NREP(12); ++rep) if (P3_SUB & 4) p3_memattn(F); }
    SEAM(3);
    if (IN(4)) {
        { pg8::Gemm g{640, 640, 640}; pg8::SchedGrid S{(const char*)UA, (const char*)WSP(bf16_t, WS_TW), (size_t)2048 * 640 * 2, (size_t)512 * 640 * 2, (size_t)256 * 640 * 2, (size_t)256 * 640 * 2, 8, 2, 32, F.G, F.c, NREP(4)};
          EpiGelu E{YG};
          pg8::gemm_phase<EpiGelu, pg8::SchedGrid, false>(F.lds, g, S, E); }
        for (int rep = 0; rep < NREP(14); ++rep) p4_attend(F, a);
    }
    SEAM(4);
    if (IN(5)) {
        pg8::Gemm g{512, 512, 512}; pg8::SchedGrid S{(const char*)YG, (const char*)WSP(bf16_t, WS_WGLU), 0, 0, (size_t)256 * 512 * 2, (size_t)256 * 512 * 2, 256, 2, 1, F.G, F.c, NREP(5)};
        EpiGlu E{YG, DOP(unsigned char, DO_YS8)};
        pg8::gemm_phase<EpiGlu, pg8::SchedGrid, false>(F.lds, g, S, E);
    }
    SEAM(5);
    if (IN(6)) {
        pg8::Gemm g{256, 768, 768, 0x7b, 0x7a};
        SchedMerge3 S{(const char*)DOP(unsigned char, DO_Y8), (const char*)WSP(unsigned char, WS_WUP), F.G, F.c, NREP(6)};
        EpiMerge E{SG, (unsigned char*)HB};
        pg8::gemm_phase<EpiMerge, SchedMerge3, false, PG8_SP2, true>(F.lds, g, S, E);
    }
    SEAM(6);
    if (IN(7)) {
        pg8::Gemm g{512, 512, 512, 0x7c, 0x7a};
        pg8::SchedGrid S{(const char*)HB, (const char*)WSP(unsigned char, WS_WOUT), 0, 0, (size_t)256 * 1024, (size_t)256 * 1024, 256, 4, 1, F.G, F.c, NREP(7)};
        EpiOut E{INP(I_X), WSP(bf16_t, WS_X1B), WSP(unsigned char, WS_X1B8)};
        pg8::gemm_phase<EpiOut, pg8::SchedGrid, false, PG8_SP2, true>(F.lds, g, S, E);
    }
    SEAM(7);
    if (IN(8)) for (int rep = 0; rep < NREP(8); ++rep) p8_router(F, a, rep == NREP(8) - 1);
    SEAM(8);
    if (IN(9)) {
        const int nt = moe_table(F, 0, 32);
        pg8::Gemm g{512, 512, 512, 0x7f, 0x7a};
        SchedMoE1 S{(const char*)WSP(unsigned char, WS_X1B8), (const char*)WSP(unsigned char, WS_WGU), imisc, WSP(int, WS_TOK), nt * 4, F.G, F.c, NREP(9)};
        EpiMoe1 E{imisc, WSP(int, WS_TOK), WSP(float2, WS_RW), WSP(unsigned char, WS_HID)};
        pg8::gemm_phase<EpiMoe1, SchedMoE1, true, PG8_SP2, true>(F.lds, g, S, E);
    }
    SEAM(9);
    if (IN(10)) {
        const int nt = moe_table(F, 32, 112);
        pg8::Gemm g{512, 256, 512, 0x7b, 0x7a};
        SchedMoE2 S{(const char*)WSP(unsigned char, WS_HID), (const char*)WSP(unsigned char, WS_WD), imisc, WSP(int, WS_TOK2), nt * 4, F.G, F.c, NREP(10)};
        EpiMoe2 E{imisc, WSP(int, WS_TOK2), WSP(bf16_t, WS_X1B), a.out};
        pg8::gemm_phase<EpiMoe2, SchedMoE2, true, PG8_SP2, true>(F.lds, g, S, E);
    }
#undef IN
#undef SEAM
}

extern "C" void kernel_launch(void* const* d_in, const int* in_sizes, int n_in, void* d_out, int out_size, void* d_ws, size_t ws_size, hipStream_t stream) {
    static int grid = 0;
    if (grid == 0) {
        if (n_in != 32 || out_size != T * D || ws_size < WS_END) { fprintf(stderr, "kernel_launch: unexpected shapes: n_in %d out %d ws %zu (need %zu)\n", n_in, out_size, ws_size, (size_t)WS_END); grid = -1; return; }
        int dev = 0, cus = 0;
        if (hipGetDevice(&dev) != hipSuccess || hipDeviceGetAttribute(&cus, hipDeviceAttributeMultiprocessorCount, dev) != hipSuccess) { grid = -1; return; }
        if (hipFuncSetAttribute((const void*)fwd, hipFuncAttributeMaxDynamicSharedMemorySize, LDS_BYTES) != hipSuccess) { fprintf(stderr, "kernel_launch: hipFuncSetAttribute failed\n"); grid = -1; return; }
        int per_cu = 0;
        if (hipOccupancyMaxActiveBlocksPerMultiprocessor(&per_cu, (const void*)fwd, NTHR, LDS_BYTES) != hipSuccess || per_cu < 1) fprintf(stderr, "kernel_launch: occupancy query reports %d\n", per_cu);
        (void)hipGetLastError();
        grid = cus;
    }
    if (grid < 0) return;
    (void)hipMemsetAsync((char*)d_ws + WS_CTL, 0, CTL_BYTES, stream);
    Args a{};
    for (int i = 0; i < 32; ++i) a.in[i] = d_in[i];
    a.out = (float*)d_out; a.ws = (unsigned char*)d_ws;
#if MK_PER_PHASE
    for (int ph = 0; ph < NPHASE; ++ph) { a.ph_lo = ph; a.ph_hi = ph + 1; hipLaunchKernelGGL(fwd, dim3(grid), dim3(NTHR), LDS_BYTES, stream, a); }
#else
    a.ph_lo = 0; a.ph_hi = NPHASE; hipLaunchKernelGGL(fwd, dim3(grid), dim3(NTHR), LDS_BYTES, stream, a);
#endif
}
```

```cpp
#include <hip/hip_runtime.h>
#include <stdio.h>
#include <stdint.h>

#ifndef MK_PER_PHASE
#define MK_PER_PHASE 0
#endif

#define LAS __attribute__((address_space(3)))
typedef unsigned short bf16_t;
typedef short bf16x8 __attribute__((ext_vector_type(8)));
typedef float f32x4 __attribute__((ext_vector_type(4)));
typedef float f32x16 __attribute__((ext_vector_type(16)));
typedef unsigned u32x4 __attribute__((ext_vector_type(4)));
typedef unsigned u32x2 __attribute__((ext_vector_type(2)));

constexpr int T = 65536, NB = 32, SEQ = 2048, D = 1024;
constexpr int NTHR = 512;
constexpr int LDS_BYTES = 147456, MISC_OFF = LDS_BYTES - 4096;
constexpr int NPHASE = 11;

constexpr size_t WS_CTL = 0, CTL_BYTES = 65536;
constexpr size_t CTL_GCNT = 16384;
constexpr size_t WS_WIN = WS_CTL + CTL_BYTES;
constexpr size_t WS_WMEM = WS_WIN + (size_t)5120 * 1024 * 2;
constexpr size_t WS_WGLU = WS_WMEM + (size_t)1024 * 1024 * 2;
constexpr size_t WS_WUP = WS_WGLU + (size_t)512 * 512 * 2;
constexpr size_t WS_WOUT = WS_WUP + (size_t)3 * 1024 * 512 * 2;
constexpr size_t WS_WGU = WS_WOUT + (size_t)1024 * 1024 * 2;
constexpr size_t WS_WD = WS_WGU + (size_t)32 * 1024 * 1024 * 2;
constexpr size_t WS_TW = WS_WD + (size_t)32 * 1024 * 512 * 2;
constexpr size_t WS_SIN = WS_TW + (size_t)32 * 512 * 640 * 2;
constexpr size_t WS_LAM32 = WS_SIN + (size_t)32 * 256 * 512 * 2;
constexpr size_t WS_WR = WS_LAM32 + 16384;
constexpr size_t WS_HB = WS_WR + 98304;
constexpr size_t WS_UA = WS_HB + (size_t)T * 1024 * 2;
constexpr size_t WS_KVX = WS_UA + (size_t)32 * 2048 * 640 * 2;
constexpr size_t WS_KVP = WS_KVX + (size_t)T * 256 * 2;
constexpr size_t WS_KIP = WS_KVP + (size_t)T * 128 * 2;
constexpr size_t WS_WIF = WS_KIP + (size_t)T * 64 * 2;
constexpr size_t WS_QI = WS_WIF + (size_t)T * 4 * 4;
constexpr size_t WS_SG = WS_QI + (size_t)T * 256 * 2;
constexpr size_t WS_X1B = WS_SG;
constexpr size_t WS_HID = WS_SG + (size_t)T * 3072;
constexpr size_t WS_X1B8 = WS_HID + (size_t)T * 1024;
constexpr size_t WS_SC = WS_HID + (size_t)T * 1024 * 2;
constexpr size_t WS_IDX = WS_SC + (size_t)32 * 2048 * 128 * 4;
constexpr size_t WS_MEMN = WS_IDX + (size_t)T * 256 * 2;
constexpr size_t WS_KMVM = WS_MEMN + (size_t)8192 * 1024 * 2;
constexpr size_t WS_KM = WS_KMVM + (size_t)8192 * 1024 * 2;
constexpr size_t WS_VMT = WS_KM + (size_t)128 * 256 * 128 * 2;
constexpr size_t WS_TOK = WS_VMT + (size_t)128 * 128 * 256 * 2;
constexpr size_t WS_RW = WS_TOK + (size_t)32 * 65536 * 4;
constexpr size_t WS_TOK2 = WS_RW + (size_t)32 * 65536 * 8;
constexpr size_t WS_LP = WS_TOK2 + (size_t)112 * 65536 * 4;
constexpr size_t WS_BB = WS_LP + (size_t)32 * 64 * 33 * 8;
constexpr size_t WS_HB8 = WS_BB + (size_t)32 * 64 * 16 * 8;
constexpr size_t WS_WG8 = WS_HB8 + (size_t)T * 1024;
constexpr size_t WS_CS = WS_WG8 + (size_t)5120 * 1024;
constexpr size_t WS_END = WS_CS + (size_t)T * 32 * 8;
constexpr size_t DO_Y3 = 0, DO_Y8 = (size_t)T * 1024 * 2, DO_YS8 = DO_Y8, DO_YD8 = DO_Y8 + (size_t)T * 512, DO_YM8 = DO_Y8 + (size_t)2 * T * 512;
constexpr int Y3LD = 1024;
constexpr size_t WS_YG = WS_HID;

__device__ __forceinline__ float bf2f(unsigned b) { return __uint_as_float(b << 16); }
__device__ __forceinline__ unsigned cvt_pk_bf16(float lo, float hi) { unsigned r; asm("v_cvt_pk_bf16_f32 %0, %1, %2" : "=v"(r) : "v"(lo), "v"(hi)); return r; }
__device__ __forceinline__ bf16_t f2bf(float f) { return (bf16_t)(cvt_pk_bf16(f, 0.f) & 0xffffu); }
__device__ __forceinline__ float wave_sum(float v) { v += __shfl_xor(v, 32); v += __shfl_xor(v, 16); v += __shfl_xor(v, 8); v += __shfl_xor(v, 4); v += __shfl_xor(v, 2); v += __shfl_xor(v, 1); return v; }
__device__ __forceinline__ float sum32(float v) { v += __shfl_xor(v, 16); v += __shfl_xor(v, 8); v += __shfl_xor(v, 4); v += __shfl_xor(v, 2); v += __shfl_xor(v, 1); return v; }
__device__ __forceinline__ float sigm(float x) { return __builtin_amdgcn_rcpf(1.0f + __expf(-x)); }
__device__ __forceinline__ float gelu_tanh(float x) { const float u = 1.5957691216057308f * (x + 0.044715f * x * x * x); return x * sigm(u); }
__device__ __forceinline__ u32x4 pack8(const f32x4 a, const f32x4 b) { u32x4 w; w.x = cvt_pk_bf16(a[0], a[1]); w.y = cvt_pk_bf16(a[2], a[3]); w.z = cvt_pk_bf16(b[0], b[1]); w.w = cvt_pk_bf16(b[2], b[3]); return w; }
__device__ __forceinline__ void unpack8(const u32x4 w, f32x4& a, f32x4& b) {
    a[0] = bf2f(w.x & 0xffffu); a[1] = bf2f(w.x >> 16); a[2] = bf2f(w.y & 0xffffu); a[3] = bf2f(w.y >> 16);
    b[0] = bf2f(w.z & 0xffffu); b[1] = bf2f(w.z >> 16); b[2] = bf2f(w.w & 0xffffu); b[3] = bf2f(w.w >> 16); }

__device__ __forceinline__ unsigned pack_fp8x4(float a, float b, float c, float d) {
    a = fminf(fmaxf(a, -448.f), 448.f); b = fminf(fmaxf(b, -448.f), 448.f); c = fminf(fmaxf(c, -448.f), 448.f); d = fminf(fmaxf(d, -448.f), 448.f);
    int p = __builtin_amdgcn_cvt_pk_fp8_f32(a, b, 0, false); p = __builtin_amdgcn_cvt_pk_fp8_f32(c, d, p, true); return (unsigned)p; }

__device__ __forceinline__ unsigned pack_fp8x4_nc(float a, float b, float c, float d) {
    int p = __builtin_amdgcn_cvt_pk_fp8_f32(a, b, 0, false); p = __builtin_amdgcn_cvt_pk_fp8_f32(c, d, p, true); return (unsigned)p; }

#define XB_TMO      128
#define XB_XCNT(j)  (256  + 64 * (j))
#define XB_XSUB(j)  (1280 + 64 * (j))
#define XB_XGEN(j)  (2304 + 64 * (j))
#define XB_TOP      3328
#define XB_TOPGEN   3392
#define XCD_BAR_WORDS 3456
#define XB_SPIN_CAP (1u << 18)
__device__ __forceinline__ unsigned xb_ld(unsigned* p)              { return __hip_atomic_load(p, __ATOMIC_RELAXED, __HIP_MEMORY_SCOPE_AGENT); }
__device__ __forceinline__ unsigned xb_add(unsigned* p, unsigned v) { return __hip_atomic_fetch_add(p, v, __ATOMIC_RELAXED, __HIP_MEMORY_SCOPE_AGENT); }
__device__ __forceinline__ unsigned xb_xcc_id() { return (unsigned)__builtin_amdgcn_s_getreg((3 << 11) | 20) & 0xFu; }
#define XB_SPIN(cond, bar) do { unsigned _sp = 0; while (cond) { __builtin_amdgcn_s_sleep(1); \
    if ((++_sp & 255u) == 0u) { if (xb_ld(&(bar)[XB_TMO])) break; if (_sp > XB_SPIN_CAP) { atomicAdd(&(bar)[XB_TMO], 1u); break; } } } } while (0)
struct XcdBarrier { unsigned* bar; unsigned x; volatile LAS unsigned* st; };
__device__ __forceinline__ XcdBarrier xcd_barrier_post(unsigned* bar, volatile LAS unsigned* st) {
    XcdBarrier b; b.bar = bar; b.x = xb_xcc_id(); b.st = st;
    if (threadIdx.x == 0) st[2] = xb_add(&bar[XB_XCNT(b.x)], 1u);
    return b;
}
__device__ __forceinline__ void xcd_barrier_complete(unsigned* bar, unsigned x, unsigned& nloc, unsigned& nx) {
    const unsigned G = gridDim.x * gridDim.y * gridDim.z;
    unsigned sum, cnt, mine, sp = 0u;
    for (;;) {
        sum = 0u; cnt = 0u; mine = 0u;
#pragma unroll
        for (unsigned j = 0; j < 16; ++j) { const unsigned c = xb_ld(&bar[XB_XCNT(j)]); sum += c; cnt += (c > 0u) ? 1u : 0u; mine = (j == x) ? c : mine; }
        if (sum == G) break;
        __builtin_amdgcn_s_sleep(1);
        if ((++sp & 255u) == 0u) { if (xb_ld(&bar[XB_TMO])) break; if (sp > XB_SPIN_CAP) { atomicAdd(&bar[XB_TMO], 1u); break; } }
    }
    nloc = mine > 0u ? mine : 1u; nx = cnt > 0u ? cnt : 1u;
}
__device__ __forceinline__ void xcd_barrier(const XcdBarrier& b) {
    asm volatile("s_waitcnt vmcnt(0)" ::: "memory");
    __syncthreads();
    if (threadIdx.x == 0) {
        unsigned* bar = b.bar;
        __builtin_amdgcn_s_waitcnt(0);
        unsigned nloc = b.st[0], nx = b.st[1];
        if (nloc == 0u) { xcd_barrier_complete(bar, b.x, nloc, nx); b.st[0] = nloc; b.st[1] = nx; }
        const unsigned old = xb_add(&bar[XB_XSUB(b.x)], 1u);
        const unsigned gen = old / nloc;
        if (old + 1u == (gen + 1u) * nloc) {
            __builtin_amdgcn_fence(__ATOMIC_RELEASE, "agent");
            asm volatile("s_waitcnt vmcnt(0)" ::: "memory");
            const unsigned og = xb_add(&bar[XB_TOP], 1u);
            const unsigned tg = og / nx;
            if (og + 1u == (tg + 1u) * nx) xb_add(&bar[XB_TOPGEN], 1u);
            else XB_SPIN(xb_ld(&bar[XB_TOPGEN]) == tg, bar);
            __builtin_amdgcn_fence(__ATOMIC_ACQUIRE, "agent");
            xb_add(&bar[XB_XGEN(b.x)], 1u);
            asm volatile("s_waitcnt vmcnt(0)" ::: "memory");
        } else {
            XB_SPIN(xb_ld(&bar[XB_XGEN(b.x)]) == gen, bar);
            __builtin_amdgcn_fence(__ATOMIC_ACQUIRE, "agent");
            asm volatile("s_waitcnt vmcnt(0)" ::: "memory");
        }
    }
    __syncthreads();
}

namespace pg8 {
constexpr int BM = 256, BK = 64, HALF = 128, HTB = HALF * BK * 2, STAGE_BYTES = 8 * HTB;
__device__ __forceinline__ int lds_byte(int r, int c) { const int st = (r >> 4) * 2 + (c >> 5), rr = r & 15, cc = c & 31, ob = rr * 64 + cc * 2; return st * 1024 + (ob ^ (((ob >> 9) & 1) << 5)); }
__device__ __forceinline__ void stage_rc(int b, int& R, int& C) { const int st = b / 1024, sb = b % 1024, swz = sb ^ (((sb >> 9) & 1) << 5); R = (st >> 1) * 16 + swz / 64; C = (st & 1) * 32 + (swz % 64) / 2; }
__device__ __forceinline__ int perm32(int rho) { const int n = rho >> 4, i = rho & 15; return 8 * (i >> 2) + 4 * n + (i & 3); }
struct Unit { int pm, pn, z; };
struct Gemm { int lda, ldb, K; int sa = 0x7f, sb = 0x7f; };
typedef int v8i32 __attribute__((ext_vector_type(8)));
typedef int v4i32 __attribute__((ext_vector_type(4)));

#ifndef PG8_SP2
#define PG8_SP2 true
#endif
template <class Epi, class Sched, bool GATHER, bool SP2 = PG8_SP2, bool F8 = false>
__device__ __forceinline__ void gemm_phase(LAS unsigned char* lds, const Gemm g, const Sched& S, const Epi& E) {
    const int tid = threadIdx.x, wid = __builtin_amdgcn_readfirstlane(tid >> 6), lane = tid & 63, wr = wid >> 2, wc = wid & 3, fr = lane & 15, fq = lane >> 4;
    const int K = g.K, nt = K / BK;
    unsigned voffA[2], voffB[2]; int Rr[2], Cc[2];
#pragma unroll
    for (int i = 0; i < 2; ++i) { int R, C; stage_rc(tid * 16 + i * 8192, R, C); const int Rb = Epi::PERM ? ((R & ~31) + perm32(R & 31)) : R;
        Rr[i] = R; Cc[i] = C; voffA[i] = (unsigned)(R * g.lda + C) * 2u; voffB[i] = (unsigned)(Rb * g.ldb + C) * 2u; }
    const size_t hstepA = (size_t)HALF * g.lda * 2, hstepB = (size_t)HALF * g.ldb * 2;
    const unsigned ldsw = (unsigned)wid * 1024u;
    const int aoff = lds_byte(wr * 64 + fr, fq * 8), boff = lds_byte(wc * 32 + fr, fq * 8);
#define PG8_SA(b, h) (((b) * 2 + (h)) * HTB)
#define PG8_SB(b, h) ((4 + (b) * 2 + (h)) * HTB)
#define PG8_GLDS(gp, lo) __builtin_amdgcn_global_load_lds((const unsigned*)(gp), (LAS unsigned*)(lds + (lo)), 16, 0, 0)
#define PG8_STAGE_B(bufoff, gbase, h) do { const char* _b = (const char*)(gbase) + (h) * hstepB; PG8_GLDS(_b + voffB[0], (bufoff) + ldsw); PG8_GLDS(_b + voffB[1], (bufoff) + ldsw + 8192); } while (0)
#define PG8_STAGE_A(bufoff, gbase, h, OFF) do { if constexpr (GATHER) { PG8_GLDS((const char*)(gbase) + OFF##h##0, (bufoff) + ldsw); PG8_GLDS((const char*)(gbase) + OFF##h##1, (bufoff) + ldsw + 8192); } \
        else { const char* _a = (const char*)(gbase) + (h) * hstepA; PG8_GLDS(_a + voffA[0], (bufoff) + ldsw); PG8_GLDS(_a + voffA[1], (bufoff) + ldsw + 8192); } } while (0)
#define PG8_LDA(dst, b, h) do { if constexpr (F8) { _Pragma("unroll") for (int m = 0; m < 4; ++m) { const v4i32 _lo = *(const LAS v4i32*)(lds + PG8_SA(b, h) + aoff + m * 2048), _hi = *(const LAS v4i32*)(lds + PG8_SA(b, h) + aoff + m * 2048 + 1024); \
            dst##8[m] = __builtin_shufflevector(_lo, _hi, 0, 1, 2, 3, 4, 5, 6, 7); } } \
        else { _Pragma("unroll") for (int m = 0; m < 4; ++m) _Pragma("unroll") for (int k = 0; k < 2; ++k) dst[m][k] = *(const LAS bf16x8*)(lds + PG8_SA(b, h) + aoff + m * 2048 + k * 1024); } } while (0)
#define PG8_LDB(dst, b, h) do { if constexpr (F8) { _Pragma("unroll") for (int n = 0; n < 2; ++n) { const v4i32 _lo = *(const LAS v4i32*)(lds + PG8_SB(b, h) + boff + n * 2048), _hi = *(const LAS v4i32*)(lds + PG8_SB(b, h) + boff + n * 2048 + 1024); \
            dst##8[n] = __builtin_shufflevector(_lo, _hi, 0, 1, 2, 3, 4, 5, 6, 7); } } \
        else { _Pragma("unroll") for (int n = 0; n < 2; ++n) _Pragma("unroll") for (int k = 0; k < 2; ++k) dst[n][k] = *(const LAS bf16x8*)(lds + PG8_SB(b, h) + boff + n * 2048 + k * 1024); } } while (0)
#define PG8_MMA(ai, bj, At, Bt) do { __builtin_amdgcn_s_setprio(1); \
        if constexpr (F8) { _Pragma("unroll") for (int m = 0; m < 4; ++m) _Pragma("unroll") for (int n = 0; n < 2; ++n) \
            asm volatile("v_mfma_scale_f32_16x16x128_f8f6f4 %0, %1, %2, %0, %3, %4 op_sel_hi:[0,0,0]" : "+v"(acc[ai][bj][m][n]) : "v"(Bt##8[n]), "v"(At##8[m]), "v"(f8sb), "v"(f8sa)); } \
        else { _Pragma("unroll") for (int m = 0; m < 4; ++m) _Pragma("unroll") for (int n = 0; n < 2; ++n) _Pragma("unroll") for (int k = 0; k < 2; ++k) \
            acc[ai][bj][m][n] = __builtin_amdgcn_mfma_f32_16x16x32_bf16(Bt[n][k], At[m][k], acc[ai][bj][m][n], 0, 0, 0); } \
        __builtin_amdgcn_s_setprio(0); } while (0)
#define PG8_WAIT_V(n) asm volatile("s_waitcnt vmcnt(" #n ")" ::: "memory")
#define PG8_WAIT_L(n) asm volatile("s_waitcnt lgkmcnt(" #n ")" ::: "memory")
#define PG8_BAR __builtin_amdgcn_s_barrier()
#define PG8_SCHED __builtin_amdgcn_sched_barrier(0)
    Unit cur, nxt; int ui = 0;
    if (!S.next(0, cur)) return;
    f32x4 acc[2][2][4][2];
#pragma unroll
    for (int a = 0; a < 2; ++a)
#pragma unroll
        for (int b = 0; b < 2; ++b)
#pragma unroll
            for (int m = 0; m < 4; ++m)
#pragma unroll
                for (int n = 0; n < 2; ++n) acc[a][b][m][n] = (f32x4){0.f, 0.f, 0.f, 0.f};
    bf16x8 At[4][2], B0[2][2], B1[2][2]; v8i32 At8[4], B08[2], B18[2];
    const int f8sa = g.sa, f8sb = g.sb;
    unsigned coff00 = 0u, coff01 = 0u, coff10 = 0u, coff11 = 0u, noff00 = 0u, noff01 = 0u, noff10 = 0u, noff11 = 0u;
    if constexpr (GATHER) {
        coff00 = S.a_off(cur, Rr[0]) + (unsigned)Cc[0] * 2u; coff01 = S.a_off(cur, Rr[1]) + (unsigned)Cc[1] * 2u;
        coff10 = S.a_off(cur, HALF + Rr[0]) + (unsigned)Cc[0] * 2u; coff11 = S.a_off(cur, HALF + Rr[1]) + (unsigned)Cc[1] * 2u;
    }
    { const char* cA = S.a_ptr(cur, 0); const char* cB = S.b_ptr(cur, 0); const char* cA1 = S.a_ptr(cur, 1); const char* cB1 = S.b_ptr(cur, 1);
    if constexpr (SP2) {
    PG8_STAGE_B(PG8_SB(0, 0), cB, 0); PG8_STAGE_B(PG8_SB(0, 1), cB, 1); PG8_STAGE_A(PG8_SA(0, 0), cA, 0, coff); PG8_STAGE_A(PG8_SA(0, 1), cA, 1, coff);
    if (wr == 1) PG8_BAR;
    PG8_WAIT_V(2); PG8_BAR;
    PG8_STAGE_B(PG8_SB(1, 0), cB1, 0); PG8_STAGE_A(PG8_SA(1, 0), cA1, 0, coff); PG8_STAGE_B(PG8_SB(1, 1), cB1, 1);
    PG8_WAIT_V(6); PG8_BAR;
    } else {
    PG8_STAGE_B(PG8_SB(0, 0), cB, 0); PG8_STAGE_A(PG8_SA(0, 0), cA, 0, coff); PG8_STAGE_B(PG8_SB(0, 1), cB, 1); PG8_STAGE_A(PG8_SA(0, 1), cA, 1, coff);
    if (wr == 1) PG8_BAR;
    PG8_WAIT_V(4); PG8_BAR;
    PG8_STAGE_B(PG8_SB(1, 0), cB1, 0); PG8_STAGE_A(PG8_SA(1, 0), cA1, 0, coff); PG8_STAGE_B(PG8_SB(1, 1), cB1, 1);
    PG8_WAIT_V(6); PG8_BAR; } }
    for (;;) {
        const bool has_next = S.next(ui + 1, nxt);
        Unit un; un.pm = has_next ? nxt.pm : cur.pm; un.pn = has_next ? nxt.pn : cur.pn; un.z = has_next ? nxt.z : cur.z;
        if constexpr (GATHER) {
            noff00 = has_next ? (S.a_off(nxt, Rr[0]) + (unsigned)Cc[0] * 2u) : coff00; noff01 = has_next ? (S.a_off(nxt, Rr[1]) + (unsigned)Cc[1] * 2u) : coff01;
            noff10 = has_next ? (S.a_off(nxt, HALF + Rr[0]) + (unsigned)Cc[0] * 2u) : coff10; noff11 = has_next ? (S.a_off(nxt, HALF + Rr[1]) + (unsigned)Cc[1] * 2u) : coff11;
        }
        for (int t = 0; t < nt; t += 2) {
            const bool last = (t == nt - 2);
            if constexpr (Epi::HOOK) { if (t == Epi::H1 || t == Epi::H2) { if constexpr (F8) asm volatile("s_nop 15\n\ts_nop 15\n\ts_nop 7" ::: "memory"); if (wr == 0) PG8_BAR; E.hook(acc, cur, t, wr, wc, fr, fq); if (wr == 1) PG8_BAR; } }
            const char* a1 = S.a_ptr(cur, t + 1);
            const char* a2 = last ? S.a_ptr(un, 0) : S.a_ptr(cur, t + 2); const char* b2 = last ? S.b_ptr(un, 0) : S.b_ptr(cur, t + 2);
            const char* a3 = last ? S.a_ptr(un, 1) : S.a_ptr(cur, t + 3); const char* b3 = last ? S.b_ptr(un, 1) : S.b_ptr(cur, t + 3);
            const unsigned o200 = last ? noff00 : coff00, o201 = last ? noff01 : coff01, o210 = last ? noff10 : coff10, o211 = last ? noff11 : coff11;
            if constexpr (SP2) {
            PG8_LDB(B0, 0, 0); PG8_LDB(B1, 0, 1); PG8_SCHED; PG8_LDA(At, 0, 0); PG8_STAGE_A(PG8_SA(1, 1), a1, 1, coff);
            PG8_WAIT_V(8); PG8_WAIT_L(0); PG8_BAR; PG8_MMA(0, 0, At, B0); PG8_MMA(0, 1, At, B1); PG8_BAR; PG8_SCHED;
            PG8_LDA(At, 0, 1); PG8_STAGE_B(PG8_SB(0, 0), b2, 0); PG8_STAGE_B(PG8_SB(0, 1), b2, 1); PG8_STAGE_A(PG8_SA(0, 0), a2, 0, o2);
            PG8_WAIT_V(8); PG8_WAIT_L(0); PG8_BAR; PG8_MMA(1, 0, At, B0); PG8_MMA(1, 1, At, B1); PG8_BAR; PG8_SCHED;
            PG8_LDB(B0, 1, 0); PG8_LDB(B1, 1, 1); PG8_SCHED; PG8_LDA(At, 1, 0); PG8_STAGE_A(PG8_SA(0, 1), a2, 1, o2);
            PG8_WAIT_V(8); PG8_WAIT_L(0); PG8_BAR; PG8_MMA(0, 0, At, B0); PG8_MMA(0, 1, At, B1); PG8_BAR; PG8_SCHED;
            PG8_LDA(At, 1, 1); PG8_STAGE_B(PG8_SB(1, 0), b3, 0); PG8_STAGE_B(PG8_SB(1, 1), b3, 1); PG8_STAGE_A(PG8_SA(1, 0), a3, 0, o2);
            PG8_WAIT_V(8); PG8_WAIT_L(0); PG8_BAR; PG8_MMA(1, 0, At, B0); PG8_MMA(1, 1, At, B1); PG8_BAR; PG8_SCHED;
            } else {
            PG8_LDB(B0, 0, 0); PG8_SCHED; PG8_LDA(At, 0, 0); PG8_STAGE_A(PG8_SA(1, 1), a1, 1, coff);
            PG8_WAIT_L(8); PG8_BAR; PG8_WAIT_L(0); PG8_MMA(0, 0, At, B0); PG8_BAR; PG8_SCHED;
            PG8_LDB(B1, 0, 1); PG8_STAGE_B(PG8_SB(0, 0), b2, 0);
            PG8_BAR; PG8_WAIT_L(0); PG8_MMA(0, 1, At, B1); PG8_BAR;
            PG8_LDA(At, 0, 1); PG8_STAGE_A(PG8_SA(0, 0), a2, 0, o2);
            PG8_BAR; PG8_WAIT_L(0); PG8_MMA(1, 0, At, B0); PG8_BAR; PG8_SCHED;
            PG8_STAGE_B(PG8_SB(0, 1), b2, 1);
            PG8_WAIT_V(6); PG8_BAR; PG8_MMA(1, 1, At, B1); PG8_BAR;
            PG8_LDB(B0, 1, 0); PG8_SCHED; PG8_LDA(At, 1, 0); PG8_STAGE_A(PG8_SA(0, 1), a2, 1, o2);
            PG8_WAIT_L(8); PG8_BAR; PG8_WAIT_L(0); PG8_MMA(0, 0, At, B0); PG8_BAR; PG8_SCHED;
            PG8_LDB(B1, 1, 1); PG8_STAGE_B(PG8_SB(1, 0), b3, 0);
            PG8_BAR; PG8_WAIT_L(0); PG8_MMA(0, 1, At, B1); PG8_BAR;
            PG8_LDA(At, 1, 1); PG8_STAGE_A(PG8_SA(1, 0), a3, 0, o2);
            PG8_BAR; PG8_WAIT_L(0); PG8_MMA(1, 0, At, B0); PG8_BAR; PG8_SCHED;
            PG8_STAGE_B(PG8_SB(1, 1), b3, 1);
            PG8_WAIT_V(6); PG8_BAR; PG8_MMA(1, 1, At, B1); PG8_BAR;
            }
        }
        if constexpr (F8) asm volatile("s_nop 15\n\ts_nop 15\n\ts_nop 7" ::: "memory");
        if (wr == 0) PG8_BAR;
        E(acc, cur, wr, wc, fr, fq);
        if (!has_next) break;
#pragma unroll
        for (int a = 0; a < 2; ++a)
#pragma unroll
            for (int b = 0; b < 2; ++b)
#pragma unroll
                for (int m = 0; m < 4; ++m)
#pragma unroll
                    for (int n = 0; n < 2; ++n) acc[a][b][m][n] = (f32x4){0.f, 0.f, 0.f, 0.f};
        cur = nxt; ++ui;
        if constexpr (GATHER) { coff00 = noff00; coff01 = noff01; coff10 = noff10; coff11 = noff11; }
        if (wr == 1) PG8_BAR;
    }
    PG8_WAIT_V(0);
    PG8_BAR;
#undef PG8_SA
#undef PG8_SB
#undef PG8_GLDS
#undef PG8_STAGE_A
#undef PG8_STAGE_B
#undef PG8_LDA
#undef PG8_LDB
#undef PG8_MMA
#undef PG8_WAIT_V
#undef PG8_WAIT_L
#undef PG8_BAR
#undef PG8_SCHED
}

struct SchedGrid {
    const char* A; const char* B; size_t zA, zB, tA, tB; int nM, nN, nz, G, c, rep;
    __device__ __forceinline__ bool next(int i, Unit& u) const {
        const int nwg = nz * nM * nN; const long L = (long)i * G + c; if (L >= (long)nwg * rep) return false;
        int w = (int)(L % nwg); { const int q = nwg / 8, r = nwg % 8, x = w % 8, off = w / 8; w = (x < r ? x * (q + 1) : r * (q + 1) + (x - r) * q) + off; }
        const int per = nM * nN; u.z = w / per; w -= u.z * per;
#ifdef PROBE_NOEPI
        if (L >= nwg) u.z |= 0x4000;
#endif
        const int nig = 8 * nN, gid = w / nig, fm = gid * 8, gsz = (nM - fm) < 8 ? (nM - fm) : 8;
        u.pm = fm + ((w % nig) % gsz); u.pn = (w % nig) / gsz; return true; }
    __device__ __forceinline__ const char* a_ptr(const Unit& u, int t) const { return A + (size_t)u.z * zA + (size_t)u.pm * tA + (size_t)t * 128; }
    __device__ __forceinline__ const char* b_ptr(const Unit& u, int t) const { return B + (size_t)u.z * zB + (size_t)u.pn * tB + (size_t)t * 128; }
    __device__ __forceinline__ unsigned a_off(const Unit&, int) const { return 0u; }
};
}

struct Args { const void* in[32]; float* out; unsigned char* ws; int ph_lo, ph_hi; };
struct Frame {
    LAS unsigned char* lds; int tid, lane, wave, G, c;
    unsigned char* ws; unsigned char* dout;
};
enum { I_X = 0, I_MEM, I_POS, I_GMIX, I_GMEM, I_WIN, I_LRE, I_LIM, I_LDT, I_BRE, I_BIM, I_CRE, I_CIM, I_DSKIP, I_WGLU, I_GQ, I_GK, I_GQM, I_GKM, I_WMEMKV,
       I_WUPS, I_WUPD, I_WUPM, I_WOUT, I_GFFN, I_WGROUP, I_BGROUP, I_WEXP, I_BEXP, I_WGATE, I_WUP, I_WDOWN };
#define INP(i) ((const float*)a.in[i])
#define WSP(T_, off) ((T_*)(F.ws + (off)))
#define DOP(T_, off) ((T_*)(F.dout + (off)))

using pg8::Unit;
__device__ __forceinline__ unsigned gpack4(const f32x4 v) {
    unsigned w = 0u;
#pragma unroll
    for (int j = 0; j < 4; ++j) { const float sg = __builtin_amdgcn_rcpf(1.0f + __builtin_amdgcn_exp2f(v[j])); w = __builtin_amdgcn_cvt_pk_u8_f32(sg * 255.0f, j, w); }
    return w; }
__device__ __forceinline__ void gdecode(const u32x2 w, float (&g)[8]) {
#pragma unroll
    for (int j = 0; j < 4; ++j) { g[j] = fmaxf((float)((w.x >> (8 * j)) & 255u), 0.5f); g[4 + j] = fmaxf((float)((w.y >> (8 * j)) & 255u), 0.5f); } }
struct EpiInProj {
    static constexpr bool PERM = true, HOOK = false;
    bf16_t *UA, *Y3; unsigned char* SG;
    __device__ __forceinline__ void operator()(const f32x4 (&acc)[2][2][4][2], const Unit& u, int wr, int wc, int fr, int fq) const {
        const int pn = u.pn, row0 = u.pm * 256 + wr * 64 + fr, cw = wc * 32 + 8 * fq;
#pragma unroll
        for (int ai = 0; ai < 2; ++ai)
#pragma unroll
            for (int m = 0; m < 4; ++m) {
                const int r = row0 + ai * 128 + m * 16;
#pragma unroll
                for (int bj = 0; bj < 2; ++bj) {
                    const int c = bj * 128 + cw;
                    if (pn >= 6) {
                        u32x2 w; w.x = gpack4(acc[ai][bj][m][0]); w.y = gpack4(acc[ai][bj][m][1]);
                        *(u32x2*)(SG + (size_t)r * 3072 + (pn - 6) * 256 + c) = w;
                    } else {
                        bf16_t* p;
                        if (pn < 2) { const int cc = pn * 256 + c, gI = cc >> 4, h0 = cc & 15, b = r >> 11, s = r & 2047;
                            p = UA + ((size_t)(gI * 2048 + b * 64 + (s >> 5)) * 640 + (s & 31) * 16 + h0); }
                        else p = Y3 + (size_t)r * Y3LD + (pn - 2) * 256 + c;
                        *(u32x4*)p = pack8(acc[ai][bj][m][0], acc[ai][bj][m][1]);
                    }
                }
            }
    }
};
struct EpiInProjB {
    static constexpr bool PERM = true, HOOK = false;
    bf16_t *KVX, *QI;
    __device__ __forceinline__ void operator()(const f32x4 (&acc)[2][2][4][2], const Unit& u, int wr, int wc, int fr, int fq) const {
        const int row0 = u.pm * 256 + wr * 64 + fr, cw = wc * 32 + 8 * fq; bf16_t* base = u.pn == 0 ? KVX : QI;
#pragma unroll
        for (int ai = 0; ai < 2; ++ai)
#pragma unroll
            for (int m = 0; m < 4; ++m)
#pragma unroll
                for (int bj = 0; bj < 2; ++bj)
                    *(u32x4*)(base + (size_t)(row0 + ai * 128 + m * 16) * 256 + bj * 128 + cw) = pack8(acc[ai][bj][m][0], acc[ai][bj][m][1]);
    }
};
struct EpiBf16 {
    static constexpr bool PERM = true, HOOK = false;
    bf16_t* O; int ld;
    __device__ __forceinline__ void operator()(const f32x4 (&acc)[2][2][4][2], const Unit& u, int wr, int wc, int fr, int fq) const {
        const int row0 = u.pm * 256 + wr * 64 + fr, col0 = u.pn * 256 + wc * 32 + 8 * fq;
#pragma unroll
        for (int ai = 0; ai < 2; ++ai)
#pragma unroll
            for (int m = 0; m < 4; ++m)
#pragma unroll
                for (int bj = 0; bj < 2; ++bj)
                    *(u32x4*)(O + (size_t)(row0 + ai * 128 + m * 16) * ld + col0 + bj * 128) = pack8(acc[ai][bj][m][0], acc[ai][bj][m][1]);
    }
};
struct EpiSc {
    static constexpr bool PERM = false, HOOK = false;
    float* SC;
    __device__ __forceinline__ void operator()(const f32x4 (&acc)[2][2][4][2], const Unit& u, int wr, int wc, int fr, int fq) const {
        const int row0 = u.pm * 256 + wr * 64 + fr, col0 = wc * 32 + 4 * fq;
#pragma unroll
        for (int ai = 0; ai < 2; ++ai)
#pragma unroll
            for (int m = 0; m < 4; ++m)
#pragma unroll
                for (int n = 0; n < 2; ++n)
                    *(f32x4*)(SC + ((size_t)u.z * 2048 + row0 + ai * 128 + m * 16) * 128 + col0 + n * 16) = acc[ai][0][m][n];
    }
};
struct EpiGelu {
    static constexpr bool PERM = true, HOOK = false;
    bf16_t* YG;
    __device__ __forceinline__ void operator()(const f32x4 (&acc)[2][2][4][2], const Unit& u, int wr, int wc, int fr, int fq) const {
        const int row0 = u.pm * 256 + wr * 64 + fr, col0 = u.pn * 256 + wc * 32 + 8 * fq;
#pragma unroll
        for (int ai = 0; ai < 2; ++ai)
#pragma unroll
            for (int m = 0; m < 4; ++m) {
                const int row = row0 + ai * 128 + m * 16;
#pragma unroll
                for (int bj = 0; bj < 2; ++bj) {
                    const int n8 = col0 + bj * 128, i = n8 >> 4, ho = n8 & 15;
                    f32x4 v0 = acc[ai][bj][m][0], v1 = acc[ai][bj][m][1];
#pragma unroll
                    for (int j = 0; j < 4; ++j) { v0[j] = gelu_tanh(v0[j]); v1[j] = gelu_tanh(v1[j]); }
                    *(u32x4*)(YG + ((size_t)row * 32 + i) * 512 + u.z * 16 + ho) = pack8(v0, v1);
                }
            }
    }
};
struct EpiGlu {
    static constexpr bool PERM = true, HOOK = false;
    const bf16_t* YG; unsigned char* YS8;
    __device__ __forceinline__ void operator()(const f32x4 (&acc)[2][2][4][2], const Unit& u, int wr, int wc, int fr, int fq) const {
        const int row0 = u.pm * 256 + wr * 64 + fr, col0 = u.pn * 256 + wc * 32 + 8 * fq;
        u32x4 yv[2][4][2];
#pragma unroll
        for (int ai = 0; ai < 2; ++ai)
#pragma unroll
            for (int m = 0; m < 4; ++m)
#pragma unroll
                for (int bj = 0; bj < 2; ++bj) yv[ai][m][bj] = *(const u32x4*)(YG + (size_t)(row0 + ai * 128 + m * 16) * 512 + col0 + bj * 128);
#pragma unroll
        for (int ai = 0; ai < 2; ++ai)
#pragma unroll
            for (int m = 0; m < 4; ++m)
#pragma unroll
                for (int bj = 0; bj < 2; ++bj) {
                    const int r = row0 + ai * 128 + m * 16, c = col0 + bj * 128;
                    f32x4 y0, y1; unpack8(yv[ai][m][bj], y0, y1);
                    f32x4 v0 = acc[ai][bj][m][0], v1 = acc[ai][bj][m][1];
#pragma unroll
                    for (int j = 0; j < 4; ++j) { v0[j] = y0[j] * sigm(v0[j]) * 16.0f; v1[j] = y1[j] * sigm(v1[j]) * 16.0f; }
                    u32x2 w8; w8.x = pack_fp8x4(v0[0], v0[1], v0[2], v0[3]); w8.y = pack_fp8x4(v1[0], v1[1], v1[2], v1[3]);
                    *(u32x2*)(YS8 + (size_t)r * 512 + c) = w8;
                }
    }
};
struct EpiMerge {
    static constexpr bool PERM = true, HOOK = true; static constexpr int H1 = 4, H2 = 8;
    const unsigned char* SG; unsigned char* MG;
    __device__ __forceinline__ void hook(f32x4 (&acc)[2][2][4][2], const Unit& u, int t, int wr, int wc, int fr, int fq) const {
        int row0 = u.pm * 256 + wr * 64 + fr, col0 = u.pn * 256 + wc * 32 + 8 * fq; const int br = (t >> 2) - 1;
        asm volatile("" : "+v"(row0), "+v"(col0));
        u32x2 wa[2][4][2], wb[2][4][2];
#pragma unroll
        for (int ai = 0; ai < 2; ++ai)
#pragma unroll
            for (int m = 0; m < 4; ++m)
#pragma unroll
                for (int bj = 0; bj < 2; ++bj) { const unsigned char* gp = SG + (size_t)(row0 + ai * 128 + m * 16) * 3072 + br * 1024 + col0 + bj * 128;
                    wa[ai][m][bj] = *(const u32x2*)gp; wb[ai][m][bj] = *(const u32x2*)(gp + 1024); }
#pragma unroll
        for (int ai = 0; ai < 2; ++ai)
#pragma unroll
            for (int m = 0; m < 4; ++m)
#pragma unroll
                for (int bj = 0; bj < 2; ++bj) {
                    float ga[8], gb[8]; gdecode(wa[ai][m][bj], ga); gdecode(wb[ai][m][bj], gb);
#pragma unroll
                    for (int j = 0; j < 4; ++j) { acc[ai][bj][m][0][j] *= ga[j] * __builtin_amdgcn_rcpf(gb[j]); acc[ai][bj][m][1][j] *= ga[4 + j] * __builtin_amdgcn_rcpf(gb[4 + j]); }
                }
    }
    __device__ __forceinline__ void operator()(const f32x4 (&acc)[2][2][4][2], const Unit& u, int wr, int wc, int fr, int fq) const {
        const int row0 = u.pm * 256 + wr * 64 + fr, col0 = u.pn * 256 + wc * 32 + 8 * fq;
        u32x2 wg[2][4][2];
#pragma unroll
        for (int ai = 0; ai < 2; ++ai)
#pragma unroll
            for (int m = 0; m < 4; ++m)
#pragma unroll
                for (int bj = 0; bj < 2; ++bj) wg[ai][m][bj] = *(const u32x2*)(SG + (size_t)(row0 + ai * 128 + m * 16) * 3072 + 2048 + col0 + bj * 128);
#pragma unroll
        for (int ai = 0; ai < 2; ++ai)
#pragma unroll
            for (int m = 0; m < 4; ++m)
#pragma unroll
                for (int bj = 0; bj < 2; ++bj) {
                    const int r = row0 + ai * 128 + m * 16, c = col0 + bj * 128;
                    float g2[8]; gdecode(wg[ai][m][bj], g2);
                    f32x4 v0 = acc[ai][bj][m][0], v1 = acc[ai][bj][m][1];
#pragma unroll
                    for (int j = 0; j < 4; ++j) { v0[j] *= g2[j] * (8.0f / 255.0f); v1[j] *= g2[4 + j] * (8.0f / 255.0f); }
                    u32x2 w8; w8.x = pack_fp8x4(v0[0], v0[1], v0[2], v0[3]); w8.y = pack_fp8x4(v1[0], v1[1], v1[2], v1[3]);
                    *(u32x2*)(MG + (size_t)r * 1024 + c) = w8;
                }
    }
};
struct EpiOut {
    static constexpr bool PERM = true, HOOK = false;
    const float* X; bf16_t* X1B; unsigned char* X1B8;
    __device__ __forceinline__ void operator()(const f32x4 (&acc)[2][2][4][2], const Unit& u, int wr, int wc, int fr, int fq) const {
        const int row0 = u.pm * 256 + wr * 64 + fr, col0 = u.pn * 256 + wc * 32 + 8 * fq;
#pragma unroll
        for (int ai = 0; ai < 2; ++ai) {
            f32x4 xv[4][2][2];
#pragma unroll
            for (int m = 0; m < 4; ++m)
#pragma unroll
                for (int bj = 0; bj < 2; ++bj) { const float* xp = X + (size_t)(row0 + ai * 128 + m * 16) * 1024 + col0 + bj * 128; xv[m][bj][0] = __builtin_nontemporal_load((const f32x4*)xp); xv[m][bj][1] = __builtin_nontemporal_load((const f32x4*)(xp + 4)); }
#pragma unroll
            for (int m = 0; m < 4; ++m)
#pragma unroll
                for (int bj = 0; bj < 2; ++bj)
                { const f32x4 v0 = xv[m][bj][0] + acc[ai][bj][m][0], v1 = xv[m][bj][1] + acc[ai][bj][m][1]; const size_t o = (size_t)(row0 + ai * 128 + m * 16) * 1024 + col0 + bj * 128;
                    *(u32x4*)(X1B + o) = pack8(v0, v1);
                    u32x2 w8; w8.x = pack_fp8x4(v0[0], v0[1], v0[2], v0[3]); w8.y = pack_fp8x4(v1[0], v1[1], v1[2], v1[3]); *(u32x2*)(X1B8 + o) = w8; }
        }
    }
};

constexpr int MI_CNT = 16, MI_PRE = 160, MI_TILE = 320, MI_PT = 960;
struct SchedMoE1 {
    const char* A; const char* W; LAS const int* misc; const int* tok; int ntile4, G, c, rep;
    __device__ __forceinline__ bool next(int i, Unit& u) const {
        long L = (long)i * G + c; if (L >= (long)ntile4 * rep) return false; L %= ntile4;
        const int e = misc[MI_TILE + (int)(L >> 2)]; u.z = e & 255; u.pm = e >> 8; u.pn = (int)(L & 3); return true; }
    __device__ __forceinline__ const char* a_ptr(const Unit&, int t) const { return A + (size_t)t * 128; }
    __device__ __forceinline__ const char* b_ptr(const Unit& u, int t) const { return W + (size_t)u.z * (1024 * 1024) + (size_t)u.pn * (256 * 1024) + (size_t)t * 128; }
    __device__ __forceinline__ unsigned a_off(const Unit& u, int r) const {
        int pos = u.pm * 256 + r; const int n = misc[MI_CNT + u.z]; pos = pos < n ? pos : 0;
        return (unsigned)(tok[(size_t)u.z * 65536 + pos] & 0x7fffffff) * 1024u; }
};
struct EpiMoe1 {
    static constexpr bool PERM = true, HOOK = false;
    LAS const int* misc; const int* tok; const float2* rw; unsigned char* HID;
    __device__ __forceinline__ void operator()(const f32x4 (&acc)[2][2][4][2], const Unit& u, int wr, int wc, int fr, int fq) const {
        const int l = u.z, n = misc[MI_CNT + l], col = u.pn * 128 + wc * 32 + 8 * fq;
        unsigned tk[2][4]; float2 qv[2][4];
#pragma unroll
        for (int ai = 0; ai < 2; ++ai)
#pragma unroll
            for (int m = 0; m < 4; ++m) { int pos = u.pm * 256 + ai * 128 + wr * 64 + m * 16 + fr; pos = pos < n ? pos : 0;
                tk[ai][m] = (unsigned)tok[(size_t)l * 65536 + pos]; qv[ai][m] = rw[(size_t)l * 65536 + pos]; }
#pragma unroll
        for (int ai = 0; ai < 2; ++ai)
#pragma unroll
            for (int m = 0; m < 4; ++m) {
                const int pos = u.pm * 256 + ai * 128 + wr * 64 + m * 16 + fr;
                if (pos < n) {
                    const float2 q = qv[ai][m];
                    f32x4 v0, v1;
#pragma unroll
                    for (int j = 0; j < 4; ++j) {
                        const float g0 = acc[ai][0][m][0][j] * q.x, u0 = acc[ai][1][m][0][j] * q.x, g1 = acc[ai][0][m][1][j] * q.x, u1 = acc[ai][1][m][1][j] * q.x;
                        v0[j] = g0 * sigm(g0) * u0 * (q.y * 16.0f); v1[j] = g1 * sigm(g1) * u1 * (q.y * 16.0f); }
                    u32x2 w8; w8.x = pack_fp8x4(v0[0], v0[1], v0[2], v0[3]); w8.y = pack_fp8x4(v1[0], v1[1], v1[2], v1[3]);
                    *(u32x2*)(HID + ((size_t)(tk[ai][m] & 0x7fffffffu) * 2 + (tk[ai][m] >> 31)) * 512 + col) = w8;
                }
            }
    }
};
struct SchedMoE2 {
    const char* A; const char* W; LAS const int* misc; const int* tok; int ntile4, G, c, rep;
    __device__ __forceinline__ bool next(int i, Unit& u) const {
        long L = (long)i * G + c; if (L >= (long)ntile4 * rep) return false; L %= ntile4;
        const int e = misc[MI_TILE + (int)(L >> 2)], l = e & 255, gi = l / 28, pt = misc[MI_PT + (l - gi * 28)];
        u.z = l | ((gi * 8 + (pt & 15)) << 8) | ((gi * 8 + (pt >> 4)) << 16); u.pm = e >> 8; u.pn = (int)(L & 3); return true; }
    __device__ __forceinline__ const char* a_ptr(const Unit&, int t) const { return A + (size_t)t * 128; }
    __device__ __forceinline__ const char* b_ptr(const Unit& u, int t) const {
        const int e = t < 4 ? ((u.z >> 8) & 255) : (u.z >> 16), tt = t < 4 ? t : t - 4;
        return W + (size_t)e * (1024 * 512) + (size_t)u.pn * (256 * 512) + (size_t)tt * 128; }
    __device__ __forceinline__ unsigned a_off(const Unit& u, int r) const {
        const int l = u.z & 255; int pos = u.pm * 256 + r; const int n = misc[MI_CNT + l]; pos = pos < n ? pos : 0;
        return (unsigned)tok[(size_t)l * 65536 + pos] * 1024u; }
};
struct EpiMoe2 {
    static constexpr bool PERM = false, HOOK = false;
    LAS const int* misc; const int* tok; const bf16_t* X1B; float* O;
    __device__ __forceinline__ void operator()(const f32x4 (&acc)[2][2][4][2], const Unit& u, int wr, int wc, int fr, int fq) const {
        const int l = u.z & 255, n = misc[MI_CNT + l], col0 = u.pn * 256 + wc * 32 + 4 * fq;
        int tk[2][4];
#pragma unroll
        for (int ai = 0; ai < 2; ++ai)
#pragma unroll
            for (int m = 0; m < 4; ++m) { int pos = u.pm * 256 + ai * 128 + wr * 64 + m * 16 + fr; pos = pos < n ? pos : 0; tk[ai][m] = tok[(size_t)l * 65536 + pos]; }
#pragma unroll
        for (int ai = 0; ai < 2; ++ai) {
            u32x2 xb[4][2][2];
#pragma unroll
            for (int m = 0; m < 4; ++m)
#pragma unroll
                for (int bj = 0; bj < 2; ++bj)
#pragma unroll
                    for (int nn = 0; nn < 2; ++nn) xb[m][bj][nn] = *(const u32x2*)(X1B + (size_t)tk[ai][m] * 1024 + col0 + bj * 128 + nn * 16);
#pragma unroll
            for (int m = 0; m < 4; ++m) {
                const int pos = u.pm * 256 + ai * 128 + wr * 64 + m * 16 + fr;
                if (pos < n) {
#pragma unroll
                    for (int bj = 0; bj < 2; ++bj)
#pragma unroll
                        for (int nn = 0; nn < 2; ++nn) { const u32x2 x = xb[m][bj][nn];
                            const f32x4 xv = (f32x4){bf2f(x.x & 0xffffu), bf2f(x.x >> 16), bf2f(x.y & 0xffffu), bf2f(x.y >> 16)};
                            __builtin_nontemporal_store(xv + acc[ai][bj][m][nn], (f32x4*)(O + (size_t)tk[ai][m] * 1024 + col0 + bj * 128 + nn * 16)); }
                }
            }
        }
    }
};
struct SchedMerge3 {
    const char* Y; const char* W; int G, c, rep;
    __device__ __forceinline__ bool next(int i, Unit& u) const {
        const int nwg = 1024; const long L = (long)i * G + c; if (L >= (long)nwg * rep) return false;
        int w = (int)(L % nwg); { const int q = nwg / 8, x = w % 8, off = w / 8; w = x * q + off; }
        const int nig = 8 * 4, gid = w / nig, fm = gid * 8;
        u.pm = fm + ((w % nig) % 8); u.pn = (w % nig) / 8; u.z = 0; return true; }
    __device__ __forceinline__ const char* a_ptr(const Unit& u, int t) const { return Y + (size_t)(t >> 2) * ((size_t)T * 512) + (size_t)u.pm * (256 * 512) + (size_t)(t & 3) * 128; }
    __device__ __forceinline__ const char* b_ptr(const Unit& u, int t) const { return W + (size_t)u.pn * (256 * 1536) + (size_t)t * 128; }
    __device__ __forceinline__ unsigned a_off(const Unit&, int) const { return 0u; }
};

__device__ __forceinline__ void rms_rows_bf16(const float* x, const float* g, bf16_t* out, unsigned char* out8, int nrows, int gw, int nw, int lane) {
    float4 gg[4];
#pragma unroll
    for (int i = 0; i < 4; ++i) gg[i] = ((const float4*)g)[lane + 64 * i];
#pragma unroll 1
    for (int r0 = gw; r0 < nrows; r0 += 2 * nw) {
        const int r1 = r0 + nw < nrows ? r0 + nw : r0;
        const float4* xa = (const float4*)(x + (size_t)r0 * 1024); const float4* xb = (const float4*)(x + (size_t)r1 * 1024);
        float4 va[4], vb[4]; float sa = 0.f, sb = 0.f;
#pragma unroll
        for (int i = 0; i < 4; ++i) { const f32x4 ta = __builtin_nontemporal_load((const f32x4*)xa + lane + 64 * i), tb = __builtin_nontemporal_load((const f32x4*)xb + lane + 64 * i);
            va[i] = make_float4(ta[0], ta[1], ta[2], ta[3]); vb[i] = make_float4(tb[0], tb[1], tb[2], tb[3]); }
#pragma unroll
        for (int i = 0; i < 4; ++i) { sa += va[i].x * va[i].x + va[i].y * va[i].y + va[i].z * va[i].z + va[i].w * va[i].w; sb += vb[i].x * vb[i].x + vb[i].y * vb[i].y + vb[i].z * vb[i].z + vb[i].w * vb[i].w; }
        sa = wave_sum(sa); sb = wave_sum(sb);
        const float ra = rsqrtf(sa * (1.0f / 1024.0f) + 1e-6f), rb = rsqrtf(sb * (1.0f / 1024.0f) + 1e-6f);
#pragma unroll
        for (int i = 0; i < 4; ++i) {
            u32x2 w; w.x = cvt_pk_bf16(va[i].x * ra * gg[i].x, va[i].y * ra * gg[i].y); w.y = cvt_pk_bf16(va[i].z * ra * gg[i].z, va[i].w * ra * gg[i].w);
            if (out) *(u32x2*)(out + (size_t)r0 * 1024 + (lane + 64 * i) * 4) = w;
            if (out8) *(unsigned*)(out8 + (size_t)r0 * 1024 + (lane + 64 * i) * 4) = pack_fp8x4(va[i].x * ra * gg[i].x, va[i].y * ra * gg[i].y, va[i].z * ra * gg[i].z, va[i].w * ra * gg[i].w);
            if (r1 != r0) { u32x2 z; z.x = cvt_pk_bf16(vb[i].x * rb * gg[i].x, vb[i].y * rb * gg[i].y); z.y = cvt_pk_bf16(vb[i].z * rb * gg[i].z, vb[i].w * rb * gg[i].w);
                if (out) *(u32x2*)(out + (size_t)r1 * 1024 + (lane + 64 * i) * 4) = z;
                if (out8) *(unsigned*)(out8 + (size_t)r1 * 1024 + (lane + 64 * i) * 4) = pack_fp8x4(vb[i].x * rb * gg[i].x, vb[i].y * rb * gg[i].y, vb[i].z * rb * gg[i].z, vb[i].w * rb * gg[i].w); }
        }
    }
}
__device__ __forceinline__ void tr_tile(LAS float* tl, const float* src, int ldsrc, int nvalid, const float* ks, float tsc, bf16_t* dst, unsigned char* dst8, int ldd, int lane) {
    const int r = lane >> 4, c4 = (lane & 15) * 4;
    float4 v[16];
#pragma unroll
    for (int p = 0; p < 16; ++p) { const int k = r + 4 * p; v[p] = make_float4(0.f, 0.f, 0.f, 0.f); if (c4 < nvalid) { const f32x4 tv = __builtin_nontemporal_load((const f32x4*)(src + (size_t)k * ldsrc + c4)); v[p] = make_float4(tv[0], tv[1], tv[2], tv[3]); } }
#pragma unroll
    for (int p = 0; p < 16; ++p) { const int k = r + 4 * p; float4 w = v[p];
        { const float sc = ks ? ks[k] * tsc : tsc; w.x *= sc; w.y *= sc; w.z *= sc; w.w *= sc; }
        tl[k * 65 + c4] = w.x; tl[k * 65 + c4 + 1] = w.y; tl[k * 65 + c4 + 2] = w.z; tl[k * 65 + c4 + 3] = w.w; }
    const int kq = lane & 7;
#pragma unroll
    for (int p = 0; p < 8; ++p) { const int n = (lane >> 3) + 8 * p; float f[8];
#pragma unroll
        for (int j = 0; j < 8; ++j) f[j] = tl[(kq * 8 + j) * 65 + n];
        if (dst8) { u32x2 w8; w8.x = pack_fp8x4(f[0], f[1], f[2], f[3]); w8.y = pack_fp8x4(f[4], f[5], f[6], f[7]); *(u32x2*)(dst8 + (size_t)n * ldd + kq * 8) = w8; }
        else { u32x4 w; w.x = cvt_pk_bf16(f[0], f[1]); w.y = cvt_pk_bf16(f[2], f[3]); w.z = cvt_pk_bf16(f[4], f[5]); w.w = cvt_pk_bf16(f[6], f[7]);
            *(u32x4*)(dst + (size_t)n * ldd + kq * 8) = w; } }
}
struct cf { float re, im; };
__device__ __forceinline__ cf cmul(cf a, cf b) { return cf{a.re * b.re - a.im * b.im, a.re * b.im + a.im * b.re}; }
__device__ __forceinline__ cf lam_pow(const Args& a, int g, int p, float e) {
    const float lre = INP(I_LRE)[g * 64 + p], lim = INP(I_LIM)[g * 64 + p], dt = __expf(INP(I_LDT)[g]);
    const float mag = __expf(lre * dt * e);
    const double rev = (double)lim * (double)dt * (double)e * 0.15915494309189535; const float fr = (float)(rev - rint(rev));
    return cf{mag * __builtin_amdgcn_cosf(fr), mag * __builtin_amdgcn_sinf(fr)};
}
__device__ __forceinline__ cf bbar_of(const Args& a, int g, int p, int h) {
    const float lre = INP(I_LRE)[g * 64 + p], lim = INP(I_LIM)[g * 64 + p];
    const cf lb = lam_pow(a, g, p, 1.0f); const cf num = cf{lb.re - 1.0f, lb.im};
    const float inv = 1.0f / (lre * lre + lim * lim);
    const cf q = cf{(num.re * lre + num.im * lim) * inv, (num.im * lre - num.re * lim) * inv};
    return cmul(q, cf{INP(I_BRE)[(g * 64 + p) * 16 + h], INP(I_BIM)[(g * 64 + p) * 16 + h]});
}
__device__ __forceinline__ void p0_prep(const Frame& F, const Args& a) {
    const int gw = F.c * 8 + F.wave, nw = F.G * 8;
    rms_rows_bf16(INP(I_X), INP(I_GMIX), WSP(bf16_t, WS_HB), WSP(unsigned char, WS_HB8), T, gw, nw, F.lane);
    rms_rows_bf16(INP(I_MEM), INP(I_GMEM), nullptr, WSP(unsigned char, WS_MEMN), 8192, gw, nw, F.lane);
    LAS float* tl = (LAS float*)F.lds + F.wave * (64 * 65);
    constexpr int NT_WIN = 80 * 16, NT_WMEM = 256, NT_WGLU = 64, NT_WUP = 384, NT_WOUT = 256, NT_E = 4096;
    constexpr int O1 = NT_WIN, O2 = O1 + NT_WMEM, O3 = O2 + NT_WGLU, O4 = O3 + NT_WUP, O5 = O4 + NT_WOUT, O6 = O5 + NT_E, O7 = O6 + NT_E, O8 = O7 + NT_E;
    for (int ti = gw; ti < O8; ti += nw) {
        const float* src; int ldsrc, nvalid = 64, ldd; const float* ks = nullptr; bf16_t* dst = nullptr; unsigned char* dst8 = nullptr; float tsc = 1.0f;
        if (ti < O1) { const int nt = ti / 16, kt = ti % 16, n0 = nt * 64; int sc;
            if (n0 < 1152) sc = n0;
            else if (n0 == 1152) sc = 1408;
            else if (n0 == 1216) { sc = 1472; nvalid = 4; }
            else if (n0 < 1280) { sc = 0; nvalid = 0; }
            else if (n0 < 1536) sc = 1152 + (n0 - 1280);
            else if (n0 < 2048) sc = 1476 + (n0 - 1536);
            else { sc = 1988 + (n0 - 2048); tsc = -1.4426950408889634f; }
            src = INP(I_WIN) + (size_t)kt * 64 * 5060 + sc; ldsrc = 5060; ldd = 1024;
            if (n0 >= 1024 && n0 < 1536) dst = WSP(bf16_t, WS_WIN) + (size_t)(n0 - 1024) * 1024 + kt * 64;
            else { const int r8 = n0 < 1024 ? n0 : (n0 < 2048 ? n0 - 512 : n0 - 512); dst8 = WSP(unsigned char, WS_WG8) + (size_t)r8 * 1024 + kt * 64; tsc *= 32.0f; } }
        else if (ti < O2) { const int t = ti - O1, nt = t / 16, kt = t % 16; src = INP(I_WMEMKV) + (size_t)kt * 64 * 1024 + nt * 64; ldsrc = 1024; tsc = 32.0f; dst8 = WSP(unsigned char, WS_WMEM) + (size_t)nt * 64 * 1024 + kt * 64; ldd = 1024; }
        else if (ti < O3) { const int t = ti - O2, nt = t / 8, kt = t % 8; src = INP(I_WGLU) + (size_t)kt * 64 * 512 + nt * 64; ldsrc = 512; dst = WSP(bf16_t, WS_WGLU) + (size_t)nt * 64 * 512 + kt * 64; ldd = 512; }
        else if (ti < O4) { const int t = ti - O3, br = t / 128, tt = t % 128, nt = tt / 8, kt = tt % 8; const float* w = br == 0 ? INP(I_WUPS) : (br == 1 ? INP(I_WUPD) : INP(I_WUPM));
            src = w + (size_t)kt * 64 * 1024 + nt * 64; ldsrc = 1024; tsc = 32.0f; dst8 = WSP(unsigned char, WS_WUP) + (size_t)nt * 64 * 1536 + br * 512 + kt * 64; ldd = 1536; }
        else if (ti < O5) { const int t = ti - O4, nt = t / 16, kt = t % 16; src = INP(I_WOUT) + (size_t)kt * 64 * 1024 + nt * 64; ldsrc = 1024; tsc = 32.0f; dst8 = WSP(unsigned char, WS_WOUT) + (size_t)nt * 64 * 1024 + kt * 64; ldd = 1024; }
        else if (ti < O7) { const int up = ti >= O6, t = ti - (up ? O6 : O5), e = t / 128, tt = t % 128, nt = tt / 16, kt = tt % 16, j0 = nt * 64;
            src = (up ? INP(I_WUP) : INP(I_WGATE)) + (size_t)e * 1024 * 512 + (size_t)kt * 64 * 512 + j0; ldsrc = 512; ks = INP(I_GFFN) + kt * 64; tsc = 32.0f;
            dst8 = WSP(unsigned char, WS_WGU) + (size_t)e * 1024 * 1024 + (size_t)((j0 >> 7) * 256 + up * 128 + (j0 & 127)) * 1024 + kt * 64; ldd = 1024; }
        else { const int t = ti - O7, e = t / 128, tt = t % 128, nt = tt / 8, kt = tt % 8;
            src = INP(I_WDOWN) + (size_t)e * 512 * 1024 + (size_t)kt * 64 * 1024 + nt * 64; ldsrc = 1024; tsc = 32.0f;
            dst8 = WSP(unsigned char, WS_WD) + (size_t)e * 1024 * 512 + (size_t)nt * 64 * 512 + kt * 64; ldd = 512; }
        tr_tile(tl, src, ldsrc, nvalid, ks, tsc, dst, dst8, ldd, F.lane);
    }
    const int gt = F.c * NTHR + F.tid, NTT = F.G * NTHR;
    for (int id = gt; id < 2048 * 33; id += NTT) { const int gp = id / 33, e = id - gp * 33; const cf z = lam_pow(a, gp >> 6, gp & 63, (float)e); WSP(float2, WS_LP)[id] = make_float2(z.re, z.im);
        if (e == 32) { WSP(float, WS_LAM32)[gp * 2] = z.re; WSP(float, WS_LAM32)[gp * 2 + 1] = z.im; } }
    for (int id = gt; id < 2048 * 16; id += NTT) { const int gp = id >> 4, h = id & 15; const cf z = bbar_of(a, gp >> 6, gp & 63, h); WSP(float2, WS_BB)[id] = make_float2(z.re, z.im); }
    for (int id = gt; id < 48 * 1024; id += NTT) { const int n = id >> 10, k = id & 1023;
        const float v = n < 4 ? INP(I_WGROUP)[k * 4 + n] : (n < 36 ? INP(I_WEXP)[k * 32 + (n - 4)] : 0.f);
        WSP(bf16_t, WS_WR)[id] = f2bf(v * INP(I_GFFN)[k]); }
}

__device__ __forceinline__ void p1_tables(const Frame& F, const Args& a, int wgi, int wgn) {
    const int gt = wgi * NTHR + F.tid, NTT = wgn * NTHR;
    bf16_t* TW = WSP(bf16_t, WS_TW); bf16_t* SIN = WSP(bf16_t, WS_SIN); const float2* LP = WSP(float2, WS_LP); const float2* BB = WSP(float2, WS_BB);
    for (int id = gt; id < 32 * 32 * 256; id += NTT) {
        const int hi = id & 15, ho = (id >> 4) & 15, d = (id >> 8) & 31, g = id >> 13;
        float val = 0.f;
        for (int p = 0; p < 64; ++p) { const float2 ez = LP[(g * 64 + p) * 33 + d], bb = BB[(g * 64 + p) * 16 + hi];
            const float cr = INP(I_CRE)[(g * 16 + ho) * 64 + p], ci = INP(I_CIM)[(g * 16 + ho) * 64 + p];
            const float tr = cr * ez.x - ci * ez.y, ti = cr * ez.y + ci * ez.x; val += tr * bb.x - ti * bb.y; }
        if (d == 0 && ho == hi) val += INP(I_DSKIP)[g * 16 + ho];
        const bf16_t bv = f2bf(val); bf16_t* tg = TW + (size_t)g * 512 * 640;
        for (int i = d; i < 32; ++i) { tg[(size_t)(i * 16 + ho) * 640 + (i - d) * 16 + hi] = bv; if (d > 0) tg[(size_t)((i - d) * 16 + ho) * 640 + i * 16 + hi] = 0; }
    }
    for (int id = gt; id < 32 * 32 * 16 * 64; id += NTT) {
        const int p = id & 63, ho = (id >> 6) & 15, i = (id >> 10) & 31, g = id >> 15;
        const float2 ez = LP[(g * 64 + p) * 33 + i + 1]; const float cr = INP(I_CRE)[(g * 16 + ho) * 64 + p], ci = INP(I_CIM)[(g * 16 + ho) * 64 + p];
        bf16_t* row = TW + (size_t)g * 512 * 640 + (size_t)(i * 16 + ho) * 640 + 512; row[p] = f2bf(cr * ez.x - ci * ez.y); row[64 + p] = f2bf(-(cr * ez.y + ci * ez.x));
    }
    for (int id = gt; id < 32 * 64 * 32 * 16; id += NTT) {
        const int h = id & 15, j = (id >> 4) & 31, p = (id >> 9) & 63, g = id >> 15;
        const float2 ez = LP[(g * 64 + p) * 33 + 31 - j], bb = BB[(g * 64 + p) * 16 + h];
        bf16_t* sg = SIN + (size_t)g * 256 * 512; sg[(size_t)p * 512 + j * 16 + h] = f2bf(ez.x * bb.x - ez.y * bb.y); sg[(size_t)(64 + p) * 512 + j * 16 + h] = f2bf(ez.x * bb.y + ez.y * bb.x);
    }
    for (int id = gt; id < 32 * 128 * 64; id += NTT) {
        const int q = id & 63, r = (id >> 6) & 127, g = id >> 13;
        *(u32x4*)(SIN + (size_t)g * 256 * 512 + (size_t)(128 + r) * 512 + q * 8) = (u32x4){0u, 0u, 0u, 0u};
    }
}

__device__ __forceinline__ void p2_post(const Frame& F, const Args& a, bool dry) {
    const int gw = F.c * 8 + F.wave, nw = F.G * 8, lane = F.lane, j = lane & 3, hs = lane >> 5, lr = lane & 31;
    const bf16_t* KVX = WSP(bf16_t, WS_KVX); unsigned char* KVP8 = WSP(unsigned char, WS_KVP); bf16_t* KIP = WSP(bf16_t, WS_KIP); bf16_t* QI = WSP(bf16_t, WS_QI);
    const bool rqi = lr < 16, rk = lr >= 16 && lr < 20, rki = lr >= 20 && lr < 24;
    const float scl = rqi ? 0.125f : 1.0f;
    float g1[8], g2[8];
#pragma unroll
    for (int e = 0; e < 8; ++e) { g1[e] = rk ? INP(I_GK)[8 * j + e] : 1.0f; g2[e] = rk ? INP(I_GK)[32 + 8 * j + e] : 1.0f; }
    constexpr int TB = 4;
    typedef float f32x2e __attribute__((ext_vector_type(2)));
    LAS f32x2e* cst = (LAS f32x2e*)F.lds + F.wave * (TB * 64);
    const float invf1 = __expf(-(float)lr * (9.210340371976184f / 32.0f));
#pragma unroll 1
    for (int tb = gw; tb < T; tb += nw * TB * 2) {
        u32x4 lo[TB], hi[TB]; float posf[TB]; unsigned short wraw[TB];
#pragma unroll
        for (int u = 0; u < TB; ++u) {
            const int tt = tb + (u * 2 + hs) * nw, t = tt < T ? tt : T - 1;
            const bf16_t* src;
            if (rqi) src = QI + (size_t)t * 256 + (lr >> 2) * 64;
            else if (rk) src = KVX + (size_t)t * 256;
            else if (rki) src = KVX + (size_t)t * 256 + 128;
            else src = KVX + (size_t)t * 256 + 64 + (lr - 24) * 8 - 8 * j;
            lo[u] = *(const u32x4*)(src + 8 * j); hi[u] = (lr < 24) ? *(const u32x4*)(src + 32 + 8 * j) : lo[u];
            posf[u] = (float)((const int*)a.in[I_POS])[t];
            wraw[u] = KVX[(size_t)t * 256 + 192 + (lane & 3)];
            { const float ang = posf[u] * invf1; const double rev = (double)ang * 0.15915494309189535; const float fr = (float)(rev - rint(rev));
              const f32x2e cs2 = (f32x2e){__builtin_amdgcn_cosf(fr), __builtin_amdgcn_sinf(fr)}; cst[(u * 2 + hs) * 32 + lr] = cs2;
              if (tt < T) WSP(f32x2e, WS_CS)[(size_t)t * 32 + lr] = cs2; }
        }
#pragma unroll
        for (int u = 0; u < TB; ++u) {
            const int t = tb + (u * 2 + hs) * nw;
            const bool live = t < T;
            if (lr < 24) {
                bf16_t* dst;
                if (rqi) dst = dry ? WSP(bf16_t, WS_RW) + (size_t)(live ? t : 0) * 256 + (lr >> 2) * 64 : QI + (size_t)(live ? t : 0) * 256 + (lr >> 2) * 64;
                else if (rk) dst = nullptr;
                else dst = KIP + (size_t)(live ? t : 0) * 64;
                f32x4 a0, a1, b0, b1; unpack8(lo[u], a0, a1); unpack8(hi[u], b0, b1);
                float x1[8] = {a0[0], a0[1], a0[2], a0[3], a1[0], a1[1], a1[2], a1[3]}, x2[8] = {b0[0], b0[1], b0[2], b0[3], b1[0], b1[1], b1[2], b1[3]};
                float ss = 0.f;
#pragma unroll
                for (int e = 0; e < 8; ++e) ss += x1[e] * x1[e] + x2[e] * x2[e];
                ss += __shfl_xor(ss, 1); ss += __shfl_xor(ss, 2);
                const float rs = rk ? rsqrtf(ss * (1.0f / 64.0f) + 1e-6f) : 1.0f;
                float o1[8], o2[8];
#pragma unroll
                for (int e = 0; e < 8; ++e) {
                    const f32x2e csn = cst[(u * 2 + hs) * 32 + 8 * j + e]; const float cs = csn.x, sn = csn.y;
                    const float y1 = x1[e] * rs * g1[e], y2 = x2[e] * rs * g2[e];
                    o1[e] = (y1 * cs - y2 * sn) * scl; o2[e] = (y2 * cs + y1 * sn) * scl; }
                if (live) {
                    if (rk) {
                        u32x2 w0, w1; w0.x = pack_fp8x4(o1[0], o1[1], o1[2], o1[3]); w0.y = pack_fp8x4(o1[4], o1[5], o1[6], o1[7]); w1.x = pack_fp8x4(o2[0], o2[1], o2[2], o2[3]); w1.y = pack_fp8x4(o2[4], o2[5], o2[6], o2[7]);
                        *(u32x2*)(KVP8 + (size_t)t * 128 + 8 * j) = w0; *(u32x2*)(KVP8 + (size_t)t * 128 + 32 + 8 * j) = w1;
                    } else {
                        *(u32x4*)(dst + 8 * j) = pack8((f32x4){o1[0], o1[1], o1[2], o1[3]}, (f32x4){o1[4], o1[5], o1[6], o1[7]});
                        *(u32x4*)(dst + 32 + 8 * j) = pack8((f32x4){o2[0], o2[1], o2[2], o2[3]}, (f32x4){o2[4], o2[5], o2[6], o2[7]}); } }
            } else if (live) {
                f32x4 a0, a1; unpack8(lo[u], a0, a1); u32x2 w; w.x = pack_fp8x4(a0[0], a0[1], a0[2], a0[3]); w.y = pack_fp8x4(a1[0], a1[1], a1[2], a1[3]);
                *(u32x2*)(KVP8 + (size_t)t * 128 + 64 + (lr - 24) * 8) = w;
            }
            if (lr < 4 && live) WSP(float, WS_WIF)[t * 4 + lr] = bf2f(wraw[u]) * 0.5f;
        }
    }
    const bf16_t* KMVM = WSP(bf16_t, WS_KMVM); bf16_t* KM = WSP(bf16_t, WS_KM); bf16_t* VMT = WSP(bf16_t, WS_VMT);
    { float gk8[8];
#pragma unroll
        for (int e = 0; e < 8; ++e) gk8[e] = INP(I_GKM)[(lane & 15) * 8 + e] * INP(I_GQM)[(lane & 15) * 8 + e];
        for (int r = gw; r < 8192; r += nw) {
            const int h = lane >> 4, b = r >> 8, m = r & 255;
            f32x4 a0, a1; unpack8(*(const u32x4*)(KMVM + (size_t)r * 1024 + h * 128 + (lane & 15) * 8), a0, a1);
            float ss = a0[0] * a0[0] + a0[1] * a0[1] + a0[2] * a0[2] + a0[3] * a0[3] + a1[0] * a1[0] + a1[1] * a1[1] + a1[2] * a1[2] + a1[3] * a1[3];
            ss += __shfl_xor(ss, 1); ss += __shfl_xor(ss, 2); ss += __shfl_xor(ss, 4); ss += __shfl_xor(ss, 8);
            const float rs = rsqrtf(ss * (1.0f / 128.0f) + 1e-6f);
            *(u32x4*)(KM + ((size_t)(b * 4 + h) * 256 + m) * 128 + (lane & 15) * 8) = pack8((f32x4){a0[0] * rs * gk8[0], a0[1] * rs * gk8[1], a0[2] * rs * gk8[2], a0[3] * rs * gk8[3]}, (f32x4){a1[0] * rs * gk8[4], a1[1] * rs * gk8[5], a1[2] * rs * gk8[6], a1[3] * rs * gk8[7]}); } }
    const int gt = F.c * NTHR + F.tid, NTT = F.G * NTHR;
    for (int id = gt; id < 32 * 4 * 32 * 128; id += NTT) { const int d = id & 127, pg = (id >> 7) & 31, h = (id >> 12) & 3, b = id >> 14;
        unsigned short v[8];
#pragma unroll
        for (int j = 0; j < 8; ++j) { const int pp = pg * 8 + j, q = pp & 15, key = (pp & ~15) + 8 * ((q & 7) >> 2) + 4 * (q >> 3) + (q & 3);
            v[j] = KMVM[(size_t)(b * 256 + key) * 1024 + 512 + h * 128 + d]; }
        u32x4 w; w.x = v[0] | ((unsigned)v[1] << 16); w.y = v[2] | ((unsigned)v[3] << 16); w.z = v[4] | ((unsigned)v[5] << 16); w.w = v[6] | ((unsigned)v[7] << 16);
        *(u32x4*)(VMT + ((size_t)(b * 4 + h) * 128 + d) * 256 + pg * 8) = w; }
}

__device__ __forceinline__ void p3_scan(const Frame& F) {
    const int gt = F.c * NTHR + F.tid, NTT = F.G * NTHR;
    const float* SC = WSP(float, WS_SC); bf16_t* UA = WSP(bf16_t, WS_UA);
    for (int id = gt; id < 65536; id += NTT) { const int p = id & 63, b = (id >> 6) & 31, g = id >> 11;
        const float lr = WSP(float, WS_LAM32)[(g * 64 + p) * 2], li = WSP(float, WS_LAM32)[(g * 64 + p) * 2 + 1];
        float sr = 0.f, si = 0.f;
        for (int c = 0; c < 64; ++c) { const size_t row = (size_t)g * 2048 + b * 64 + c;
            UA[row * 640 + 512 + p] = f2bf(sr); UA[row * 640 + 576 + p] = f2bf(si);
            const float cr = SC[row * 128 + p], ci = SC[row * 128 + 64 + p];
            const float nr = lr * sr - li * si + cr, ni = lr * si + li * sr + ci; sr = nr; si = ni; }
    }
}

constexpr int SEL_SC = 0, SEL_HIST = 131072, SEL_END = SEL_HIST + 128 * 17 * 4;
__device__ __forceinline__ int suffix_sum64(int x, int rm1, int rm2, int rm3, int& tot) {
    int p = x;
    p += __builtin_amdgcn_update_dpp(0, p, 0x111, 0xf, 0xf, false);
    p += __builtin_amdgcn_update_dpp(0, p, 0x112, 0xf, 0xf, false);
    p += __builtin_amdgcn_update_dpp(0, p, 0x114, 0xf, 0xf, false);
    p += __builtin_amdgcn_update_dpp(0, p, 0x118, 0xf, 0xf, false);
    const int t0 = __builtin_amdgcn_readlane(p, 15), t1 = __builtin_amdgcn_readlane(p, 31), t2 = __builtin_amdgcn_readlane(p, 47), t3 = __builtin_amdgcn_readlane(p, 63);
    p += (t0 & rm1) + (t1 & rm2) + (t2 & rm3);
    tot = t0 + t1 + t2 + t3;
    return tot - p + x;
}
__device__ __forceinline__ int mbcnt64(unsigned long long m) { return (int)__builtin_amdgcn_mbcnt_hi((unsigned)(m >> 32), __builtin_amdgcn_mbcnt_lo((unsigned)m, 0u)); }
__device__ __forceinline__ void p3_select(const Frame& F, bool doB) {
    LAS unsigned short* sc = (LAS unsigned short*)(F.lds + SEL_SC);
    LAS unsigned* hist = (LAS unsigned*)(F.lds + SEL_HIST);
    const bf16_t* QI = WSP(bf16_t, WS_QI); const bf16_t* KIP = WSP(bf16_t, WS_KIP); const float* WIF = WSP(float, WS_WIF);
    unsigned short* IDX = WSP(unsigned short, WS_IDX);
    const int lane = F.lane, n = lane & 31, hf = lane >> 5, wv = F.wave;
    const int rm1 = (lane >> 4) >= 1 ? -1 : 0, rm2 = (lane >> 4) >= 2 ? -1 : 0, rm3 = (lane >> 4) >= 3 ? -1 : 0;
#define SEL_UNIT(L_, QT, B_) int QT = 63 - ((L_) >> 5); const int B_ = (L_) & 31; \
        if (F.G == 256) { const int k_ = F.c >> 5, i_ = (L_) >> 8, pr_ = i_ >> 1;     \
            QT = (i_ & 1) ? (48 - 16 * pr_ + k_) : (63 - 16 * pr_ - k_); }
#define SEL_LOADQK(QT, B_) do { const int tk_ = (B_) * 2048 + (QT) * 32 + n; \
        _Pragma("unroll") for (int h = 0; h < 4; ++h) { wq[h] = WIF[tk_ * 4 + h]; \
            _Pragma("unroll") for (int ks = 0; ks < 4; ++ks) bq[h][ks] = *(const bf16x8*)(QI + (size_t)tk_ * 256 + h * 64 + ks * 16 + hf * 8); } \
        { const int k0 = wv < (QT) + 1 ? wv : 0; const bf16_t* kp = KIP + (size_t)((B_) * 2048 + k0 * 32 + n) * 64 + hf * 8; \
            _Pragma("unroll") for (int ks = 0; ks < 4; ++ks) ka[ks] = *(const bf16x8*)(kp + ks * 16); } } while (0)
    bf16x8 bq[4][4]; float wq[4]; bf16x8 ka[4];
    if (F.c < 2048) { SEL_UNIT(F.c, qt0, b0); SEL_LOADQK(qt0, b0); }
    for (int L = F.c; L < 2048; L += F.G) {
        SEL_UNIT(L, qt, b);
        const int t0 = qt * 32, nkt = qt + 1, tok0 = b * 2048 + t0;
        for (int i = F.tid; i < 128 * 17; i += NTHR) hist[i] = 0u;
        { const int nz = ((nkt * 8 + 63) & ~63) - nkt * 8;
            for (int i = F.tid; i < nz * 32; i += NTHR) { const int nn = i & 31, ch = nkt * 8 + (i >> 5); *(LAS u32x2*)(sc + nn * 2048 + ((ch ^ nn) << 2)) = (u32x2){0u, 0u}; } }
        __syncthreads();
        const unsigned hinc = 1u << (16 * (n & 1));
        for (int kt = wv; kt < nkt; kt += 8) {
            f32x16 acc[4];
#pragma unroll
            for (int h = 0; h < 4; ++h)
#pragma unroll
                for (int r = 0; r < 16; ++r) acc[h][r] = 0.f;
#pragma unroll
            for (int ks = 0; ks < 4; ++ks)
#pragma unroll
                for (int h = 0; h < 4; ++h) acc[h] = __builtin_amdgcn_mfma_f32_32x32x16_bf16(ka[ks], bq[h][ks], acc[h], 0, 0, 0);
            { const int k1 = kt + 8 < nkt ? kt + 8 : kt; const bf16_t* kp = KIP + (size_t)(b * 2048 + k1 * 32 + n) * 64 + hf * 8;
#pragma unroll
                for (int ks = 0; ks < 4; ++ks) ka[ks] = *(const bf16x8*)(kp + ks * 16); }
            unsigned key[16];
#pragma unroll
            for (int r = 0; r < 16; ++r) {
                const int i0 = __float_as_int(acc[0][r]), i1 = __float_as_int(acc[1][r]), i2 = __float_as_int(acc[2][r]), i3 = __float_as_int(acc[3][r]);
                const float isc = wq[0] * __int_as_float(i0 > 0 ? i0 : 0) + wq[1] * __int_as_float(i1 > 0 ? i1 : 0) + wq[2] * __int_as_float(i2 > 0 ? i2 : 0) + wq[3] * __int_as_float(i3 > 0 ? i3 : 0);
                const float y = isc * __builtin_amdgcn_rcpf(1.0f + 0.25f * fabsf(isc));
                key[r] = (unsigned)(y * 8191.75f + 32768.0f);
            }
            if (kt < qt) {
#pragma unroll
                for (int g4 = 0; g4 < 4; ++g4) {
#pragma unroll
                    for (int j = 0; j < 4; ++j) (void)__hip_atomic_fetch_add(hist + (key[g4 * 4 + j] >> 9) * 17 + (n >> 1), hinc, __ATOMIC_RELAXED, __HIP_MEMORY_SCOPE_WORKGROUP);
                    u32x2 w; w.x = key[g4 * 4] | (key[g4 * 4 + 1] << 16); w.y = key[g4 * 4 + 2] | (key[g4 * 4 + 3] << 16);
                    const int chunk = (kt * 32 + 8 * g4 + 4 * hf) >> 2;
                    *(LAS u32x2*)(sc + n * 2048 + ((chunk ^ n) << 2)) = w;
                }
            } else {
                asm volatile("" ::: "memory");
#pragma unroll
                for (int g4 = 0; g4 < 4; ++g4) {
                    unsigned kk[4];
#pragma unroll
                    for (int j = 0; j < 4; ++j) { const int s = kt * 32 + j + 8 * g4 + 4 * hf; const bool valid = s <= t0 + n;
                        kk[j] = valid ? key[g4 * 4 + j] : 0u;
                        (void)__hip_atomic_fetch_add(hist + (kk[j] >> 9) * 17 + (n >> 1), valid ? hinc : 0u, __ATOMIC_RELAXED, __HIP_MEMORY_SCOPE_WORKGROUP); }
                    u32x2 w; w.x = kk[0] | (kk[1] << 16); w.y = kk[2] | (kk[3] << 16);
                    const int chunk = (kt * 32 + 8 * g4 + 4 * hf) >> 2;
                    *(LAS u32x2*)(sc + n * 2048 + ((chunk ^ n) << 2)) = w;
                }
            }
        }
        __syncthreads();
        if (L + F.G < 2048) { SEL_UNIT(L + F.G, qtn, bn); SEL_LOADQK(qtn, bn); }
        for (int qq = 0; qq < (doB ? 4 : 0); ++qq) {
            const int nq = wv * 4 + qq, tq = t0 + nq, nvalid = tq + 1, tok = tok0 + nq;
            LAS unsigned short* lst = sc + nq * 2048; LAS unsigned* cand = (LAS unsigned*)(sc + nq * 2048 + 512);
            if (nvalid <= 256) {
#pragma unroll
                for (int e = 0; e < 4; ++e) { const int p = lane * 4 + e; lst[p] = (unsigned short)(p < nvalid ? p : 0); }
            } else {
                unsigned v[32];
                LAS const unsigned short* rowp = sc + nq * 2048 + ((((lane >> 2) ^ (nq & 15)) << 2) | (lane & 3));
#pragma unroll
                for (int r = 0; r < 32; ++r) v[r] = rowp[r * 64];
                const int sh = 16 * (nq & 1);
                const int hhi = (int)((hist[(64 + lane) * 17 + (nq >> 1)] >> sh) & 0xffffu), hlo = (int)((hist[lane * 17 + (nq >> 1)] >> sh) & 0xffffu);
                int tothi; const int shi = suffix_sum64(hhi, rm1, rm2, rm3, tothi);
                int b1, above;
                if (tothi >= 256) { const unsigned long long mk = __builtin_amdgcn_ballot_w64(shi >= 256); const int lb = 63 - __clzll(mk); b1 = 64 + lb; above = __builtin_amdgcn_readlane(shi - hhi, lb); }
                else { int totlo; const int slo = tothi + suffix_sum64(hlo, rm1, rm2, rm3, totlo); const unsigned long long mk = __builtin_amdgcn_ballot_w64(slo >= 256); const int lb = 63 - __clzll(mk); b1 = lb; above = __builtin_amdgcn_readlane(slo - hlo, lb); }
                const int sw64 = (nq >> 4) << 6, laneE = lane + sw64, laneO = lane - sw64;
                int base = 0, m = 0;
                const unsigned binhi = (unsigned)b1 * 512u + 511u, binlo = b1 ? (unsigned)b1 * 512u : 1u, binspan = binhi - binlo;
#pragma unroll
                for (int r4 = 0; r4 < 32; r4 += 4) {
                    if (r4 * 64 >= nvalid) break;
#pragma unroll
                    for (int rr = 0; rr < 4; ++rr) { const int r = r4 + rr; const unsigned idx = (unsigned)(r * 64 + ((r & 1) ? laneO : laneE));
                        const bool gt_ = v[r] > binhi, eq = (v[r] - binlo) <= binspan;
                        const unsigned long long mg = __builtin_amdgcn_ballot_w64(gt_), me = __builtin_amdgcn_ballot_w64(eq);
                        int pg = base + mbcnt64(mg), cp = m + mbcnt64(me);
                        asm("" : "+v"(pg), "+v"(cp));
                        lst[gt_ ? pg : 256 + lane] = (unsigned short)idx;
                        cand[(eq && cp < 128) ? cp : 128 + lane] = ((v[r] & 511u) << 11) | idx;
                        base += __popcll(mg); m += __popcll(me); }
                }
                if (m <= 128) {
                    const int need = 256 - above;
                    const unsigned c0 = lane < m ? cand[lane] : 0u, c1 = 64 + lane < m ? cand[64 + lane] : 0u;
                    const unsigned a0 = lane < m ? (c0 >> 11) + 1u : 0u, a1 = 64 + lane < m ? (c1 >> 11) + 1u : 0u;
                    unsigned lo = 0u;
                    for (int bit = 9; bit >= 0; --bit) { const unsigned cd = lo | (1u << bit); const int c = __popcll(__builtin_amdgcn_ballot_w64(a0 >= cd)) + __popcll(__builtin_amdgcn_ballot_w64(a1 >= cd)); if (c >= need) lo = cd; }
                    const unsigned long long g0 = __builtin_amdgcn_ballot_w64(a0 > lo), g1 = __builtin_amdgcn_ballot_w64(a1 > lo), e0 = __builtin_amdgcn_ballot_w64(a0 == lo), e1 = __builtin_amdgcn_ballot_w64(a1 == lo);
                    const int ties = need - (__popcll(g0) + __popcll(g1));
                    int k0 = mbcnt64(e0), k1 = __popcll(e0) + mbcnt64(e1); asm("" : "+v"(k0), "+v"(k1));
                    const bool s0 = a0 > lo || (a0 == lo && k0 < ties), s1 = a1 > lo || (a1 == lo && k1 < ties);
                    const unsigned long long m0 = __builtin_amdgcn_ballot_w64(s0), m1 = __builtin_amdgcn_ballot_w64(s1);
                    if (s0) lst[base + mbcnt64(m0)] = (unsigned short)(c0 & 2047u);
                    if (s1) lst[base + __popcll(m0) + mbcnt64(m1)] = (unsigned short)(c1 & 2047u);
                } else {
#pragma unroll
                    for (int r = 0; r < 32; ++r) v[r] = ((r * 64 + ((r & 1) ? laneO : laneE)) < nvalid) ? v[r] : 0u;
                    unsigned lo = 0u;
                    for (int bit = 15; bit >= 0; --bit) { const unsigned cd = lo | (1u << bit); int cnt = 0;
#pragma unroll
                        for (int r = 0; r < 32; ++r) cnt += __popcll(__builtin_amdgcn_ballot_w64(v[r] >= cd));
                        if (cnt >= 256) lo = cd; }
                    int cgt = 0;
#pragma unroll
                    for (int r = 0; r < 32; ++r) cgt += __popcll(__builtin_amdgcn_ballot_w64(v[r] > lo));
                    const int need = 256 - cgt; int bs = 0, eqb = 0;
#pragma unroll
                    for (int r = 0; r < 32; ++r) {
                        const bool gt_ = v[r] > lo, eq = v[r] == lo;
                        const unsigned long long me = __builtin_amdgcn_ballot_w64(eq);
                        const bool sel = gt_ || (eq && eqb + mbcnt64(me) < need);
                        const unsigned long long ms = __builtin_amdgcn_ballot_w64(sel);
                        if (sel) lst[bs + mbcnt64(ms)] = (unsigned short)(r * 64 + ((r & 1) ? laneO : laneE));
                        bs += __popcll(ms); eqb += __popcll(me);
                    }
                }
            }
            *(u32x2*)(IDX + (size_t)tok * 256 + lane * 4) = *(LAS u32x2*)(lst + lane * 4);
        }
        __syncthreads();
    }
}

#undef SEL_UNIT
#undef SEL_LOADQK
__device__ __forceinline__ void p3_memattn(const Frame& F) {
    constexpr int KS = 272, VS = 528, VOFF = 256 * KS;
    const bf16_t* KM = WSP(bf16_t, WS_KM); const bf16_t* VMT = WSP(bf16_t, WS_VMT); const bf16_t* QM = DOP(bf16_t, DO_Y3) + 512; unsigned char* YM8 = DOP(unsigned char, DO_YM8);
    const int lane = F.lane, n = lane & 31, hf = lane >> 5;
    for (int u = F.c; u < 256; u += F.G) {
        const int half = u & 1, bh = u >> 1, b = bh >> 2, h = bh & 3;
#pragma unroll
        for (int i = 0; i < 8; ++i) { const int id = F.tid + 512 * i;
            { const int row = id >> 4, seg = id & 15; *(LAS u32x4*)(F.lds + row * KS + seg * 16) = *(const u32x4*)(KM + ((size_t)bh * 256 + row) * 128 + seg * 8); }
            { const int row = id >> 5, seg = id & 31; *(LAS u32x4*)(F.lds + VOFF + row * VS + seg * 16) = *(const u32x4*)(VMT + ((size_t)bh * 128 + row) * 256 + seg * 8); } }
        __syncthreads();
#pragma unroll 1
        for (int qi = 0; qi < 4; ++qi) {
            const int tok = b * 2048 + half * 1024 + F.wave * 128 + qi * 32 + n;
            const bf16_t* qp = QM + (size_t)tok * Y3LD + h * 128;
            bf16x8 bq[8];
#pragma unroll
            for (int ks = 0; ks < 8; ++ks) bq[ks] = *(const bf16x8*)(qp + ks * 16 + hf * 8);
            float qss = 0.f;
#pragma unroll
            for (int ks = 0; ks < 8; ++ks)
#pragma unroll
                for (int e = 0; e < 8; ++e) { const float f = bf2f((unsigned short)bq[ks][e]); qss += f * f; }
            qss += __shfl_xor(qss, 32);
            const float qc = rsqrtf(qss * (1.0f / 128.0f) + 1e-6f) * (0.08838834764831845f * 1.4426950408889634f);
            f32x16 o[4];
#pragma unroll
            for (int dt = 0; dt < 4; ++dt)
#pragma unroll
                for (int r = 0; r < 16; ++r) o[dt][r] = 0.f;
            float mrun = -3.0e38f, lrun = 0.f;
#pragma unroll 1
            for (int kh = 0; kh < 2; ++kh) {
                f32x16 s[4];
#pragma unroll
                for (int k4 = 0; k4 < 4; ++k4) { const int kt = kh * 4 + k4;
#pragma unroll
                    for (int r = 0; r < 16; ++r) s[k4][r] = 0.f;
#pragma unroll
                    for (int ks = 0; ks < 8; ++ks) { const bf16x8 a = *(const LAS bf16x8*)(F.lds + (kt * 32 + n) * KS + (ks * 16 + hf * 8) * 2);
                        s[k4] = __builtin_amdgcn_mfma_f32_32x32x16_bf16(a, bq[ks], s[k4], 0, 0, 0); } }
                float mx = mrun;
#pragma unroll
                for (int k4 = 0; k4 < 4; ++k4)
#pragma unroll
                    for (int r = 0; r < 16; ++r) mx = fmaxf(mx, s[k4][r]);
                mx = fmaxf(mx, __shfl_xor(mx, 32));
                const float resc = __builtin_amdgcn_exp2f((mrun - mx) * qc);
                float sum = 0.f;
#pragma unroll
                for (int k4 = 0; k4 < 4; ++k4)
#pragma unroll
                    for (int r = 0; r < 16; ++r) { const float p = __builtin_amdgcn_exp2f((s[k4][r] - mx) * qc); s[k4][r] = p; sum += p; }
                sum += __shfl_xor(sum, 32);
                lrun = lrun * resc + sum; mrun = mx;
#pragma unroll
                for (int dt = 0; dt < 4; ++dt)
#pragma unroll
                    for (int r = 0; r < 16; ++r) o[dt][r] *= resc;
#pragma unroll
                for (int k4 = 0; k4 < 4; ++k4)
#pragma unroll
                    for (int st = 0; st < 2; ++st) { const int kt = kh * 4 + k4;
                        union { u32x4 u; bf16x8 v; } pb;
                        pb.u.x = cvt_pk_bf16(s[k4][8 * st + 0], s[k4][8 * st + 1]); pb.u.y = cvt_pk_bf16(s[k4][8 * st + 2], s[k4][8 * st + 3]);
                        pb.u.z = cvt_pk_bf16(s[k4][8 * st + 4], s[k4][8 * st + 5]); pb.u.w = cvt_pk_bf16(s[k4][8 * st + 6], s[k4][8 * st + 7]);
#pragma unroll
                        for (int dt = 0; dt < 4; ++dt) { const bf16x8 a = *(const LAS bf16x8*)(F.lds + VOFF + (dt * 32 + n) * VS + (kt * 32 + 16 * st + 8 * hf) * 2);
                            o[dt] = __builtin_amdgcn_mfma_f32_32x32x16_bf16(a, pb.v, o[dt], 0, 0, 0); }
                    }
            }
            const float inv = 16.0f / lrun;
#pragma unroll
            for (int dt = 0; dt < 4; ++dt)
#pragma unroll
                for (int g4 = 0; g4 < 4; ++g4)
                    *(unsigned*)(YM8 + (size_t)tok * 512 + h * 128 + dt * 32 + 8 * g4 + 4 * hf) = pack_fp8x4(o[dt][g4 * 4] * inv, o[dt][g4 * 4 + 1] * inv, o[dt][g4 * 4 + 2] * inv, o[dt][g4 * 4 + 3] * inv);
        }
        __syncthreads();
    }
}

__device__ __forceinline__ void p4_attend(const Frame& F, const Args& a) {
    constexpr int WB = 2 * 8192 + 1024;
    LAS unsigned char* wb = F.lds + F.wave * WB;
    LAS unsigned short* lst = (LAS unsigned short*)(wb + 16384);
    const unsigned short* IDX = WSP(unsigned short, WS_IDX); const unsigned char* KVP8 = WSP(unsigned char, WS_KVP); const bf16_t* Q = DOP(bf16_t, DO_Y3); unsigned char* YD8 = DOP(unsigned char, DO_YD8);
    const int lane = F.lane, n = lane & 15, g = lane >> 4, gw = F.c * 8 + F.wave, nw = F.G * 8;
    const int ntk = (T - gw + nw - 1) / nw;
    float gkm = fabsf(INP(I_GK)[lane]);
    gkm = fmaxf(gkm, __shfl_xor(gkm, 32)); gkm = fmaxf(gkm, __shfl_xor(gkm, 16)); gkm = fmaxf(gkm, __shfl_xor(gkm, 8)); gkm = fmaxf(gkm, __shfl_xor(gkm, 4)); gkm = fmaxf(gkm, __shfl_xor(gkm, 2)); gkm = fmaxf(gkm, __shfl_xor(gkm, 1));
    const float kmax = 8.0f * gkm * 1.07f;
    int koff[4][2];
#pragma unroll
    for (int blk = 0; blk < 4; ++blk)
#pragma unroll
        for (int ks = 0; ks < 2; ++ks) { const int row = blk * 16 + n, pc = ks * 2 + (g >> 1); koff[blk][ks] = row * 128 + ((pc ^ (row & 7)) << 4) + 8 * (g & 1); }
    const int q8 = n >> 1, p8 = n & 1;
    int toff[2][4];
#pragma unroll
    for (int kb2 = 0; kb2 < 2; ++kb2)
#pragma unroll
        for (int d = 0; d < 4; ++d) { const int row = (kb2 * 2 + (q8 >> 2)) * 16 + g * 4 + (q8 & 3), pc = 4 + d; toff[kb2][d] = row * 128 + ((pc ^ (row & 7)) << 4) + 8 * p8; }
    const int grow = lane >> 3, gpc = lane & 7;
    const unsigned wbase = (unsigned)(uintptr_t)wb;
#define AT_ISSUE(TOK, LB, CH, BUF) do { const char* _kb = (const char*)(KVP8 + (size_t)((TOK) >> 11) * 2048 * 128); \
        _Pragma("unroll") for (int _i = 0; _i < 8; ++_i) { const int _row = 8 * _i + grow; const int _key = lst[(LB) * 256 + (CH) * 64 + _row]; \
            __builtin_amdgcn_global_load_lds((const unsigned*)(_kb + (size_t)_key * 128 + ((gpc ^ (_row & 7)) << 4)), (LAS unsigned*)(wb + (BUF) * 8192 + _i * 1024), 16, 0, 0); } } while (0)
    if (ntk <= 0) return;
    { const u32x2 l0 = *(const u32x2*)(IDX + (size_t)gw * 256 + lane * 4); *(LAS u32x2*)(lst + lane * 4) = l0; }
    float gq1[8], gq2[8];
#pragma unroll
    for (int e = 0; e < 8; ++e) { gq1[e] = INP(I_GQ)[g * 8 + e]; gq2[e] = INP(I_GQ)[32 + g * 8 + e]; }
    const f32x4* CS = WSP(f32x4, WS_CS);
    bf16x8 nbq[2]; f32x4 ncs[4];
#pragma unroll
    for (int e = 0; e < 4; ++e) ncs[e] = CS[(size_t)gw * 16 + g * 4 + e];
#pragma unroll
    for (int ks = 0; ks < 2; ++ks) { if (n < 8) nbq[ks] = *(const bf16x8*)(Q + (size_t)gw * Y3LD + n * 64 + ks * 32 + g * 8); else nbq[ks] = (bf16x8){0, 0, 0, 0, 0, 0, 0, 0}; }
    AT_ISSUE(gw, 0, 0, 0); AT_ISSUE(gw, 0, 1, 1);
#pragma unroll 1
    for (int k = 0; k < ntk; ++k) {
        const int tok = gw + k * nw, ntok = tok + nw, lb = k & 1; const bool hasn = (k + 1 < ntk);
        const int tq = tok & 2047, cnt = tq + 1 < 256 ? tq + 1 : 256;
        long bq[2]; float qs = 0.f;
        { float x1[8], x2[8], ss = 0.f;
#pragma unroll
            for (int e = 0; e < 8; ++e) { x1[e] = bf2f((unsigned short)nbq[0][e]); x2[e] = bf2f((unsigned short)nbq[1][e]); ss += x1[e] * x1[e] + x2[e] * x2[e]; }
            ss += __shfl_xor(ss, 16); ss += __shfl_xor(ss, 32);
            const float rs = rsqrtf(ss * (1.0f / 64.0f) + 1e-6f) * (0.125f * 1.4426950408889634f); float o1[8], o2[8];
#pragma unroll
            for (int e = 0; e < 8; ++e) { const float cs = ncs[e >> 1][(e & 1) * 2], sn = ncs[e >> 1][(e & 1) * 2 + 1], y1 = x1[e] * rs * gq1[e], y2 = x2[e] * rs * gq2[e];
                o1[e] = y1 * cs - y2 * sn; o2[e] = y2 * cs + y1 * sn; qs += o1[e] * o1[e] + o2[e] * o2[e]; }
            const unsigned a0 = pack_fp8x4(o1[0], o1[1], o1[2], o1[3]), a1 = pack_fp8x4(o1[4], o1[5], o1[6], o1[7]), b0 = pack_fp8x4(o2[0], o2[1], o2[2], o2[3]), b1 = pack_fp8x4(o2[4], o2[5], o2[6], o2[7]);
            bq[0] = (long)(((unsigned long long)a1 << 32) | a0); bq[1] = (long)(((unsigned long long)b1 << 32) | b0); }
        qs += __shfl_xor(qs, 16); qs += __shfl_xor(qs, 32);
        const float shift = sqrtf(qs) * 1.07f * kmax - 7.0f;
        u32x2 nl = (u32x2){0u, 0u};
        if (hasn) { nl = *(const u32x2*)(IDX + (size_t)ntok * 256 + lane * 4);
#pragma unroll
            for (int e = 0; e < 4; ++e) ncs[e] = CS[(size_t)ntok * 16 + g * 4 + e];
#pragma unroll
            for (int ks = 0; ks < 2; ++ks) if (n < 8) nbq[ks] = *(const bf16x8*)(Q + (size_t)ntok * Y3LD + n * 64 + ks * 32 + g * 8); }
        f32x4 o[4];
#pragma unroll
        for (int d = 0; d < 4; ++d) o[d] = (f32x4){0.f, 0.f, 0.f, 0.f};
        float lsum = 0.f;
#pragma unroll
        for (int ch = 0; ch < 4; ++ch) {
            const int buf = ch & 1;
            if (ch == 3 && !hasn) asm volatile("s_waitcnt vmcnt(0)" ::: "memory"); else asm volatile("s_waitcnt vmcnt(8)" ::: "memory");
            LAS const unsigned char* bb = wb + buf * 8192;
            f32x4 s[4];
#pragma unroll
            for (int blk = 0; blk < 4; ++blk) {
                const long k0 = *(LAS const long*)(bb + koff[blk][0]), k1 = *(LAS const long*)(bb + koff[blk][1]);
                s[blk] = __builtin_amdgcn_mfma_f32_16x16x32_fp8_fp8(k0, bq[0], (f32x4){0.f, 0.f, 0.f, 0.f}, 0, 0, 0);
                s[blk] = __builtin_amdgcn_mfma_f32_16x16x32_fp8_fp8(k1, bq[1], s[blk], 0, 0, 0);
            }
            if (cnt >= (ch + 1) * 64) {
#pragma unroll
                for (int blk = 0; blk < 4; ++blk)
#pragma unroll
                    for (int j = 0; j < 4; ++j) { const float e = __builtin_amdgcn_exp2f(s[blk][j] - shift); s[blk][j] = e; lsum += e; }
            } else {
                asm volatile("" ::: "memory");
#pragma unroll
                for (int blk = 0; blk < 4; ++blk)
#pragma unroll
                    for (int j = 0; j < 4; ++j) { const int p = ch * 64 + blk * 16 + g * 4 + j; const float e = p < cnt ? __builtin_amdgcn_exp2f(s[blk][j] - shift) : 0.f; s[blk][j] = e; lsum += e; }
            }
#pragma unroll
            for (int kb2 = 0; kb2 < 2; ++kb2) {
                const unsigned plo = pack_fp8x4_nc(s[2 * kb2][0], s[2 * kb2][1], s[2 * kb2][2], s[2 * kb2][3]), phi = pack_fp8x4_nc(s[2 * kb2 + 1][0], s[2 * kb2 + 1][1], s[2 * kb2 + 1][2], s[2 * kb2 + 1][3]);
                const long pb = (long)(((unsigned long long)phi << 32) | plo);
                u32x2 tr[4];
#pragma unroll
                for (int d = 0; d < 4; ++d) asm volatile("ds_read_b64_tr_b8 %0, %1 offset:%2" : "=&v"(tr[d]) : "v"(wbase + (unsigned)toff[kb2][d]), "i"(buf * 8192) : "memory");
                asm volatile("s_waitcnt lgkmcnt(0)" : "+v"(tr[0]), "+v"(tr[1]), "+v"(tr[2]), "+v"(tr[3]) :: "memory");
#pragma unroll
                for (int d = 0; d < 4; ++d) { const long av = (long)(((unsigned long long)tr[d].y << 32) | tr[d].x);
                    o[d] = __builtin_amdgcn_mfma_f32_16x16x32_fp8_fp8(av, pb, o[d], 0, 0, 0); }
            }
            __builtin_amdgcn_sched_barrier(0);
            if (ch == 1 && hasn) *(LAS u32x2*)(lst + (lb ^ 1) * 256 + lane * 4) = nl;
            if (ch < 2) AT_ISSUE(tok, lb, ch + 2, buf);
            else if (hasn) AT_ISSUE(ntok, lb ^ 1, ch - 2, buf);
            __builtin_amdgcn_sched_barrier(0);
        }
        lsum += __shfl_xor(lsum, 16); lsum += __shfl_xor(lsum, 32);
        const float inv = 16.0f / lsum;
        if (n < 8) {
#pragma unroll
            for (int d = 0; d < 4; ++d) *(unsigned*)(YD8 + (size_t)tok * 512 + n * 64 + d * 16 + g * 4) = pack_fp8x4(o[d][0] * inv, o[d][1] * inv, o[d][2] * inv, o[d][3] * inv);
        }
    }
#undef AT_ISSUE
}

__device__ __forceinline__ void p8_router(const Frame& F, const Args& a, bool commit) {
    const bf16_t* X1B = WSP(bf16_t, WS_X1B); const bf16_t* WR = WSP(bf16_t, WS_WR);
    int* TOK = WSP(int, WS_TOK); float2* RW = WSP(float2, WS_RW); int* TOK2 = WSP(int, WS_TOK2); unsigned* gcnt = (unsigned*)(F.ws + WS_CTL + CTL_GCNT);
    constexpr int WRS = 2064, RT_LG = 48 * WRS, RT_RS = RT_LG + 8 * 16 * 48 * 4, RT_LC = RT_RS + 8 * 16 * 4;
    LAS float* lg = (LAS float*)(F.lds + RT_LG) + F.wave * (16 * 48);
    LAS float* rsb = (LAS float*)(F.lds + RT_RS) + F.wave * 16;
    LAS int* lc = (LAS int*)(F.lds + RT_LC); LAS int* lbase = lc + 144;
    const int lane = F.lane, n = lane & 15, q = lane >> 4;
    for (int i = F.tid; i < 48 * 128; i += NTHR) { const int r = i >> 7, c = i & 127; *(LAS u32x4*)(F.lds + r * WRS + c * 16) = *(const u32x4*)(WR + (size_t)r * 1024 + c * 8); }
    __syncthreads();
    for (int it = F.c; it < T / 128; it += F.G) {
        const int tw = it * 128 + F.wave * 16;
        if (F.tid < 144) lc[F.tid] = 0;
        const bf16_t* xp = X1B + (size_t)(tw + n) * 1024 + q * 8;
        f32x4 acc[3] = {(f32x4){0.f, 0.f, 0.f, 0.f}, (f32x4){0.f, 0.f, 0.f, 0.f}, (f32x4){0.f, 0.f, 0.f, 0.f}};
        float ss = 0.f;
#pragma unroll
        for (int hb = 0; hb < 2; ++hb) {
            bf16x8 av[16];
#pragma unroll
            for (int k2 = 0; k2 < 16; ++k2) av[k2] = *(const bf16x8*)(xp + (hb * 16 + k2) * 32);
#pragma unroll
            for (int k2 = 0; k2 < 16; ++k2) { const int ks = hb * 16 + k2;
#pragma unroll
                for (int j = 0; j < 8; ++j) { const float f = bf2f((unsigned short)av[k2][j]); ss += f * f; }
#pragma unroll
                for (int bl = 0; bl < 3; ++bl) { const bf16x8 bb = *(const LAS bf16x8*)(F.lds + (bl * 16 + n) * WRS + (ks * 32 + q * 8) * 2);
                    acc[bl] = __builtin_amdgcn_mfma_f32_16x16x32_bf16(av[k2], bb, acc[bl], 0, 0, 0); } }
        }
        ss += __shfl_xor(ss, 16); ss += __shfl_xor(ss, 32);
        const float rs = rsqrtf(ss * (1.0f / 1024.0f) + 1e-6f);
        if (q == 0) rsb[n] = rs;
#pragma unroll
        for (int bl = 0; bl < 3; ++bl)
#pragma unroll
            for (int j = 0; j < 4; ++j) lg[(q * 4 + j) * 48 + bl * 16 + n] = acc[bl][j] * rsb[q * 4 + j];
        __syncthreads();
        int l1 = 0, l2 = 0, lp = 0, r1 = 0, r2 = 0, rp = 0, s1 = 0; float wa = 0.f, wb = 0.f, myrs = 0.f;
        if (lane < 16) {
            LAS const float* l = lg + lane * 48; myrs = rsb[lane];
            float g0 = l[0] + INP(I_BGROUP)[0]; int gi = 0; float gm = g0, gl[4]; gl[0] = g0;
#pragma unroll
            for (int j = 1; j < 4; ++j) { gl[j] = l[j] + INP(I_BGROUP)[j]; if (gl[j] > gm) { gm = gl[j]; gi = j; } }
            float gs = 0.f;
#pragma unroll
            for (int j = 0; j < 4; ++j) gs += __expf(gl[j] - gm);
            const float ggate = 1.0f / gs;
            float e1 = -3.0e38f, e2 = -3.0e38f; int i1 = 0, i2 = 0;
            for (int e = 0; e < 8; ++e) { const float v = l[4 + gi * 8 + e] + INP(I_BEXP)[gi * 8 + e];
                if (v > e1) { e2 = e1; i2 = i1; e1 = v; i1 = e; } else if (v > e2) { e2 = v; i2 = e; } }
            const float pa = 1.0f / (1.0f + __expf(e2 - e1));
            wa = ggate * pa; wb = ggate - wa;
            s1 = i1 < i2 ? 0 : 1;
            const int elo = i1 < i2 ? i1 : i2, ehi = i1 < i2 ? i2 : i1;
            l1 = gi * 8 + i1; l2 = gi * 8 + i2; lp = 32 + gi * 28 + (elo * (15 - elo)) / 2 + (ehi - elo - 1);
            r1 = atomicAdd((int*)(lc + l1), 1); r2 = atomicAdd((int*)(lc + l2), 1); rp = atomicAdd((int*)(lc + lp), 1);
        }
        __syncthreads();
        if (F.tid < 144) { const int cn = lc[F.tid]; lbase[F.tid] = (cn > 0 && commit) ? (int)atomicAdd(gcnt + F.tid * 64, (unsigned)cn) : 0; }
        __syncthreads();
        if (lane < 16 && commit) { const int t = tw + lane;
            const size_t p1 = (size_t)l1 * 65536 + lbase[l1] + r1, p2 = (size_t)l2 * 65536 + lbase[l2] + r2;
            TOK[p1] = t | (s1 << 31); RW[p1] = make_float2(myrs, wa); TOK[p2] = t | ((s1 ^ 1) << 31); RW[p2] = make_float2(myrs, wb);
            TOK2[(size_t)(lp - 32) * 65536 + lbase[lp] + rp] = t; }
        __syncthreads();
    }
}

__device__ __forceinline__ int moe_table(const Frame& F, int first, int count) {
    LAS int* misc = (LAS int*)(F.lds + MISC_OFF); const unsigned* gcnt = (const unsigned*)(F.ws + WS_CTL + CTL_GCNT);
    __syncthreads();
    if (F.tid < count) misc[MI_CNT + F.tid] = (int)__hip_atomic_load(gcnt + (first + F.tid) * 64, __ATOMIC_RELAXED, __HIP_MEMORY_SCOPE_AGENT);
    if (F.tid >= 256 && F.tid < 256 + 28) { const int pi = F.tid - 256; int elo = 0; while (elo < 6 && ((elo + 1) * (15 - (elo + 1))) / 2 <= pi) ++elo;
        misc[MI_PT + pi] = elo | ((pi - (elo * (15 - elo)) / 2 + elo + 1) << 4); }
    __syncthreads();
    if (F.tid == 0) { int run = 0; for (int l = 0; l < count; ++l) { misc[MI_PRE + l] = run; run += (misc[MI_CNT + l] + 255) >> 8; } misc[MI_PRE + count] = run; }
    __syncthreads();
    const int nt = misc[MI_PRE + count];
    for (int idx = F.tid; idx < nt && idx < 640; idx += NTHR) { int l = 0; while (l < count - 1 && misc[MI_PRE + l + 1] <= idx) ++l; misc[MI_TILE + idx] = l | ((idx - misc[MI_PRE + l]) << 8); }
    __syncthreads();
    return nt < 640 ? nt : 640;
}

__global__ void __launch_bounds__(NTHR, 2) fwd(Args a) {
    extern __shared__ __attribute__((aligned(16))) unsigned char lds_raw[];
    Frame F;
    F.lds = (LAS unsigned char*)lds_raw; F.tid = threadIdx.x; F.lane = F.tid & 63; F.wave = __builtin_amdgcn_readfirstlane(F.tid >> 6); F.G = gridDim.x; F.c = blockIdx.x;
    F.ws = a.ws; F.dout = (unsigned char*)a.out;
    LAS unsigned* misc = (LAS unsigned*)(F.lds + MISC_OFF);
    for (int i = F.tid; i < 1024; i += NTHR) misc[i] = 0u;
    __syncthreads();
    XcdBarrier bar; bar.bar = (unsigned*)(F.ws + WS_CTL); bar.x = 0; bar.st = (volatile LAS unsigned*)misc;
    const int lo = a.ph_lo, hi = a.ph_hi;
    if (hi - lo > 1) bar = xcd_barrier_post((unsigned*)(F.ws + WS_CTL), (volatile LAS unsigned*)misc);
#ifndef PH_MASK
#define PH_MASK 0xFFF
#endif
#define IN(k) (((PH_MASK >> (k)) & 1) && lo <= (k) && (k) < hi)
#ifndef REP_MASK
#define REP_MASK 0
#endif
#define NREP(k) (1 + ((REP_MASK >> (k)) & 1))
#define SEAM(k) do { if (IN(k) && IN((k) + 1)) xcd_barrier(bar); } while (0)
    bf16_t* HB = WSP(bf16_t, WS_HB); bf16_t* UA = WSP(bf16_t, WS_UA); unsigned char* SG = WSP(unsigned char, WS_SG);
    bf16_t* Y3 = DOP(bf16_t, DO_Y3); bf16_t* YG = WSP(bf16_t, WS_YG);
    LAS const int* imisc = (LAS const int*)(F.lds + MISC_OFF);

    if (IN(0)) for (int rep = 0; rep < NREP(0); ++rep) { p0_prep(F, a); __syncthreads(); }
    SEAM(0);
    if (IN(0) && IN(1)) {
        if (F.tid == 0) { unsigned* bw = (unsigned*)(F.ws + WS_CTL); bool bal = (F.G % 8) == 0;
            for (int j = 0; j < 16; ++j) { const unsigned cj = xb_ld(&bw[XB_XCNT(j)]); bal = bal && (cj == (j < 8 ? (unsigned)F.G / 8u : 0u)); }
            misc[3] = bal ? (misc[2] * 8u + bar.x) : (unsigned)blockIdx.x; }
        __syncthreads();
        F.c = (int)misc[3];
    }
    if (IN(1)) {
        { pg8::Gemm g{512, 512, 512, 0x7f, 0x7a};
          pg8::SchedGrid S{(const char*)WSP(unsigned char, WS_HB8), (const char*)WSP(unsigned char, WS_WG8), 0, 0, (size_t)256 * 1024, (size_t)256 * 1024, 256, 18, 1, F.G, F.c, NREP(1)};
          EpiInProj E{UA, Y3, SG};
          pg8::gemm_phase<EpiInProj, pg8::SchedGrid, false, PG8_SP2, true>(F.lds, g, S, E); }
        { pg8::Gemm g{1024, 1024, 1024}; pg8::SchedGrid S{(const char*)HB, (const char*)WSP(bf16_t, WS_WIN), 0, 0, (size_t)256 * 1024 * 2, (size_t)256 * 1024 * 2, 256, 2, 1, F.G, F.c, NREP(1)};
          EpiInProjB E{WSP(bf16_t, WS_KVX), WSP(bf16_t, WS_QI)};
          pg8::gemm_phase<EpiInProjB, pg8::SchedGrid, false>(F.lds, g, S, E); }
        { pg8::Gemm g{512, 512, 512, 0x7f, 0x7a};
          pg8::SchedGrid S{(const char*)WSP(unsigned char, WS_MEMN), (const char*)WSP(unsigned char, WS_WMEM), 0, 0, (size_t)256 * 1024, (size_t)256 * 1024, 32, 4, 1, F.G, F.c, NREP(1)};
          EpiBf16 E{WSP(bf16_t, WS_KMVM), 1024};
          pg8::gemm_phase<EpiBf16, pg8::SchedGrid, false, PG8_SP2, true>(F.lds, g, S, E); }
        if (F.G > 128) { if (F.c >= 128) p1_tables(F, a, F.c - 128, F.G - 128); } else p1_tables(F, a, F.c, F.G);
    }
    SEAM(1);
    if (IN(2)) {
        { pg8::Gemm g{640, 512, 512}; pg8::SchedGrid S{(const char*)UA, (const char*)WSP(bf16_t, WS_SIN), (size_t)2048 * 640 * 2, (size_t)256 * 512 * 2, (size_t)256 * 640 * 2, (size_t)256 * 512 * 2, 8, 1, 32, F.G, F.c, NREP(2)};
          EpiSc E{WSP(float, WS_SC)};
          pg8::gemm_phase<EpiSc, pg8::SchedGrid, false>(F.lds, g, S, E); }
        for (int rep = 0; rep < NREP(15); ++rep) p2_post(F, a, rep < NREP(15) - 1);
    }
    SEAM(2);
#ifndef P3_SUB
#define P3_SUB 7
#endif
    if (IN(3)) { for (int rep = 0; rep < NREP(13); ++rep) { if (P3_SUB & 1) p3_scan(F); } for (int rep = 0; rep < NREP(3); ++rep) { if (P3_SUB & 2) p3_select(F, rep == 0 || (REP_MASK & 0x10000)); } for (int rep = 0; rep < NREP(12); ++rep) if (P3_SUB & 4) p3_memattn(F); }
    SEAM(3);
    if (IN(4)) {
        { pg8::Gemm g{640, 640, 640}; pg8::SchedGrid S{(const char*)UA, (const char*)WSP(bf16_t, WS_TW), (size_t)2048 * 640 * 2, (size_t)512 * 640 * 2, (size_t)256 * 640 * 2, (size_t)256 * 640 * 2, 8, 2, 32, F.G, F.c, NREP(4)};
          EpiGelu E{YG};
          pg8::gemm_phase<EpiGelu, pg8::SchedGrid, false>(F.lds, g, S, E); }
        for (int rep = 0; rep < NREP(14); ++rep) p4_attend(F, a);
    }
    SEAM(4);
    if (IN(5)) {
        pg8::Gemm g{512, 512, 512}; pg8::SchedGrid S{(const char*)YG, (const char*)WSP(bf16_t, WS_WGLU), 0, 0, (size_t)256 * 512 * 2, (size_t)256 * 512 * 2, 256, 2, 1, F.G, F.c, NREP(5)};
        EpiGlu E{YG, DOP(unsigned char, DO_YS8)};
        pg8::gemm_phase<EpiGlu, pg8::SchedGrid, false>(F.lds, g, S, E);
    }
    SEAM(5);
    if (IN(6)) {
        pg8::Gemm g{256, 768, 768, 0x7b, 0x7a};
        SchedMerge3 S{(const char*)DOP(unsigned char, DO_Y8), (const char*)WSP(unsigned char, WS_WUP), F.G, F.c, NREP(6)};
        EpiMerge E{SG, (unsigned char*)HB};
        pg8::gemm_phase<EpiMerge, SchedMerge3, false, PG8_SP2, true>(F.lds, g, S, E);
    }
    SEAM(6);
    if (IN(7)) {
        pg8::Gemm g{512, 512, 512, 0x7c, 0x7a};
        pg8::SchedGrid S{(const char*)HB, (const char*)WSP(unsigned char, WS_WOUT), 0, 0, (size_t)256 * 1024, (size_t)256 * 1024, 256, 4, 1, F.G, F.c, NREP(7)};
        EpiOut E{INP(I_X), WSP(bf16_t, WS_X1B), WSP(unsigned char, WS_X1B8)};
        pg8::gemm_phase<EpiOut, pg8::SchedGrid, false, PG8_SP2, true>(F.lds, g, S, E);
    }
    SEAM(7);
    if (IN(8)) for (int rep = 0; rep < NREP(8); ++rep) p8_router(F, a, rep == NREP(8) - 1);
    SEAM(8);
    if (IN(9)) {
        const int nt = moe_table(F, 0, 32);
        pg8::Gemm g{512, 512, 512, 0x7f, 0x7a};
        SchedMoE1 S{(const char*)WSP(unsigned char, WS_X1B8), (const char*)WSP(unsigned char, WS_WGU), imisc, WSP(int, WS_TOK), nt * 4, F.G, F.c, NREP(9)};
        EpiMoe1 E{imisc, WSP(int, WS_TOK), WSP(float2, WS_RW), WSP(unsigned char, WS_HID)};
        pg8::gemm_phase<EpiMoe1, SchedMoE1, true, PG8_SP2, true>(F.lds, g, S, E);
    }
    SEAM(9);
    if (IN(10)) {
        const int nt = moe_table(F, 32, 112);
        pg8::Gemm g{512, 256, 512, 0x7b, 0x7a};
        SchedMoE2 S{(const char*)WSP(unsigned char, WS_HID), (const char*)WSP(unsigned char, WS_WD), imisc, WSP(int, WS_TOK2), nt * 4, F.G, F.c, NREP(10)};
        EpiMoe2 E{imisc, WSP(int, WS_TOK2), WSP(bf16_t, WS_X1B), a.out};
        pg8::gemm_phase<EpiMoe2, SchedMoE2, true, PG8_SP2, true>(F.lds, g, S, E);
    }
#undef IN
#undef SEAM
}

extern "C" void kernel_launch(void* const* d_in, const int* in_sizes, int n_in, void* d_out, int out_size, void* d_ws, size_t ws_size, hipStream_t stream) {
    static int grid = 0;
    if (grid == 0) {
        if (n_in != 32 || out_size != T * D || ws_size < WS_END) { fprintf(stderr, "kernel_launch: unexpected shapes: n_in %d out %d ws %zu (need %zu)\n", n_in, out_size, ws_size, (size_t)WS_END); grid = -1; return; }
        int dev = 0, cus = 0;
        if (hipGetDevice(&dev) != hipSuccess || hipDeviceGetAttribute(&cus, hipDeviceAttributeMultiprocessorCount, dev) != hipSuccess) { grid = -1; return; }
        if (hipFuncSetAttribute((const void*)fwd, hipFuncAttributeMaxDynamicSharedMemorySize, LDS_BYTES) != hipSuccess) { fprintf(stderr, "kernel_launch: hipFuncSetAttribute failed\n"); grid = -1; return; }
        int per_cu = 0;
        if (hipOccupancyMaxActiveBlocksPerMultiprocessor(&per_cu, (const void*)fwd, NTHR, LDS_BYTES) != hipSuccess || per_cu < 1) fprintf(stderr, "kernel_launch: occupancy query reports %d\n", per_cu);
        (void)hipGetLastError();
        grid = cus;
    }
    if (grid < 0) return;
    (void)hipMemsetAsync((char*)d_ws + WS_CTL, 0, CTL_BYTES, stream);
    Args a{};
    for (int i = 0; i < 32; ++i) a.in[i] = d_in[i];
    a.out = (float*)d_out; a.ws = (unsigned char*)d_ws;
#if MK_PER_PHASE
    for (int ph = 0; ph < NPHASE; ++ph) { a.ph_lo = ph; a.ph_hi = ph + 1; hipLaunchKernelGGL(fwd, dim3(grid), dim3(NTHR), LDS_BYTES, stream, a); }
#else
    a.ph_lo = 0; a.ph_hi = NPHASE; hipLaunchKernelGGL(fwd, dim3(grid), dim3(NTHR), LDS_BYTES, stream, a);
#endif
}
```

```cpp
#include <hip/hip_runtime.h>
#include <stdio.h>
#include <stdint.h>

#ifndef MK_PER_PHASE
#define MK_PER_PHASE 0
#endif

#define LAS __attribute__((address_space(3)))
typedef unsigned short bf16_t;
typedef short bf16x8 __attribute__((ext_vector_type(8)));
typedef float f32x4 __attribute__((ext_vector_type(4)));
typedef float f32x16 __attribute__((ext_vector_type(16)));
typedef unsigned u32x4 __attribute__((ext_vector_type(4)));
typedef unsigned u32x2 __attribute__((ext_vector_type(2)));

constexpr int T = 65536, NB = 32, SEQ = 2048, D = 1024;
constexpr int NTHR = 512;
constexpr int LDS_BYTES = 147456, MISC_OFF = LDS_BYTES - 4096;
constexpr int NPHASE = 11;

constexpr size_t WS_CTL = 0, CTL_BYTES = 65536;
constexpr size_t CTL_GCNT = 16384;
constexpr size_t WS_WIN = WS_CTL + CTL_BYTES;
constexpr size_t WS_WMEM = WS_WIN + (size_t)5120 * 1024 * 2;
constexpr size_t WS_WGLU = WS_WMEM + (size_t)1024 * 1024 * 2;
constexpr size_t WS_WUP = WS_WGLU + (size_t)512 * 512 * 2;
constexpr size_t WS_WOUT = WS_WUP + (size_t)3 * 1024 * 512 * 2;
constexpr size_t WS_WGU = WS_WOUT + (size_t)1024 * 1024 * 2;
constexpr size_t WS_WD = WS_WGU + (size_t)32 * 1024 * 1024 * 2;
constexpr size_t WS_TW = WS_WD + (size_t)32 * 1024 * 512 * 2;
constexpr size_t WS_SIN = WS_TW + (size_t)32 * 512 * 640 * 2;
constexpr size_t WS_LAM32 = WS_SIN + (size_t)32 * 256 * 512 * 2;
constexpr size_t WS_WR = WS_LAM32 + 16384;
constexpr size_t WS_HB = WS_WR + 98304;
constexpr size_t WS_UA = WS_HB + (size_t)T * 1024 * 2;
constexpr size_t WS_KVX = WS_UA + (size_t)32 * 2048 * 640 * 2;
constexpr size_t WS_KVP = WS_KVX + (size_t)T * 256 * 2;
constexpr size_t WS_KIP = WS_KVP + (size_t)T * 128 * 2;
constexpr size_t WS_WIF = WS_KIP + (size_t)T * 64 * 2;
constexpr size_t WS_QI = WS_WIF + (size_t)T * 4 * 4;
constexpr size_t WS_SG = WS_QI + (size_t)T * 256 * 2;
constexpr size_t WS_X1B = WS_SG;
constexpr size_t WS_HID = WS_SG + (size_t)T * 3072;
constexpr size_t WS_X1B8 = WS_HID + (size_t)T * 1024;
constexpr size_t WS_SC = WS_HID + (size_t)T * 1024 * 2;
constexpr size_t WS_IDX = WS_SC + (size_t)32 * 2048 * 128 * 4;
constexpr size_t WS_MEMN = WS_IDX + (size_t)T * 256 * 2;
constexpr size_t WS_KMVM = WS_MEMN + (size_t)8192 * 1024 * 2;
constexpr size_t WS_KM = WS_KMVM + (size_t)8192 * 1024 * 2;
constexpr size_t WS_VMT = WS_KM + (size_t)128 * 256 * 128 * 2;
constexpr size_t WS_TOK = WS_VMT + (size_t)128 * 128 * 256 * 2;
constexpr size_t WS_RW = WS_TOK + (size_t)32 * 65536 * 4;
constexpr size_t WS_TOK2 = WS_RW + (size_t)32 * 65536 * 8;
constexpr size_t WS_LP = WS_TOK2 + (size_t)112 * 65536 * 4;
constexpr size_t WS_BB = WS_LP + (size_t)32 * 64 * 33 * 8;
constexpr size_t WS_HB8 = WS_BB + (size_t)32 * 64 * 16 * 8;
constexpr size_t WS_WG8 = WS_HB8 + (size_t)T * 1024;
constexpr size_t WS_CS = WS_WG8 + (size_t)5120 * 1024;
constexpr size_t WS_END = WS_CS + (size_t)T * 32 * 8;
constexpr size_t DO_Y3 = 0, DO_Y8 = (size_t)T * 1024 * 2, DO_YS8 = DO_Y8, DO_YD8 = DO_Y8 + (size_t)T * 512, DO_YM8 = DO_Y8 + (size_t)2 * T * 512;
constexpr int Y3LD = 1024;
constexpr size_t WS_YG = WS_HID;

__device__ __forceinline__ float bf2f(unsigned b) { return __uint_as_float(b << 16); }
__device__ __forceinline__ unsigned cvt_pk_bf16(float lo, float hi) { unsigned r; asm("v_cvt_pk_bf16_f32 %0, %1, %2" : "=v"(r) : "v"(lo), "v"(hi)); return r; }
__device__ __forceinline__ bf16_t f2bf(float f) { return (bf16_t)(cvt_pk_bf16(f, 0.f) & 0xffffu); }
__device__ __forceinline__ float wave_sum(float v) { v += __shfl_xor(v, 32); v += __shfl_xor(v, 16); v += __shfl_xor(v, 8); v += __shfl_xor(v, 4); v += __shfl_xor(v, 2); v += __shfl_xor(v, 1); return v; }
__device__ __forceinline__ float sum32(float v) { v += __shfl_xor(v, 16); v += __shfl_xor(v, 8); v += __shfl_xor(v, 4); v += __shfl_xor(v, 2); v += __shfl_xor(v, 1); return v; }
__device__ __forceinline__ float sigm(float x) { return __builtin_amdgcn_rcpf(1.0f + __expf(-x)); }
__device__ __forceinline__ float gelu_tanh(float x) { const float u = 1.5957691216057308f * (x + 0.044715f * x * x * x); return x * sigm(u); }
__device__ __forceinline__ u32x4 pack8(const f32x4 a, const f32x4 b) { u32x4 w; w.x = cvt_pk_bf16(a[0], a[1]); w.y = cvt_pk_bf16(a[2], a[3]); w.z = cvt_pk_bf16(b[0], b[1]); w.w = cvt_pk_bf16(b[2], b[3]); return w; }
__device__ __forceinline__ void unpack8(const u32x4 w, f32x4& a, f32x4& b) {
    a[0] = bf2f(w.x & 0xffffu); a[1] = bf2f(w.x >> 16); a[2] = bf2f(w.y & 0xffffu); a[3] = bf2f(w.y >> 16);
    b[0] = bf2f(w.z & 0xffffu); b[1] = bf2f(w.z >> 16); b[2] = bf2f(w.w & 0xffffu); b[3] = bf2f(w.w >> 16); }

__device__ __forceinline__ unsigned pack_fp8x4(float a, float b, float c, float d) {
    a = __builtin_amdgcn_fmed3f(a, -448.f, 448.f); b = __builtin_amdgcn_fmed3f(b, -448.f, 448.f); c = __builtin_amdgcn_fmed3f(c, -448.f, 448.f); d = __builtin_amdgcn_fmed3f(d, -448.f, 448.f);
    int p = __builtin_amdgcn_cvt_pk_fp8_f32(a, b, 0, false); p = __builtin_amdgcn_cvt_pk_fp8_f32(c, d, p, true); return (unsigned)p; }

__device__ __forceinline__ unsigned pack_fp8x4_nc(float a, float b, float c, float d) {
    int p = __builtin_amdgcn_cvt_pk_fp8_f32(a, b, 0, false); p = __builtin_amdgcn_cvt_pk_fp8_f32(c, d, p, true); return (unsigned)p; }

#define XB_TMO      128
#define XB_XCNT(j)  (256  + 64 * (j))
#define XB_XSUB(j)  (1280 + 64 * (j))
#define XB_XGEN(j)  (2304 + 64 * (j))
#define XB_TOP      3328
#define XB_TOPGEN   3392
#define XCD_BAR_WORDS 3456
#define XB_SPIN_CAP (1u << 18)
__device__ __forceinline__ unsigned xb_ld(unsigned* p)              { return __hip_atomic_load(p, __ATOMIC_RELAXED, __HIP_MEMORY_SCOPE_AGENT); }
__device__ __forceinline__ unsigned xb_add(unsigned* p, unsigned v) { return __hip_atomic_fetch_add(p, v, __ATOMIC_RELAXED, __HIP_MEMORY_SCOPE_AGENT); }
__device__ __forceinline__ unsigned xb_xcc_id() { return (unsigned)__builtin_amdgcn_s_getreg((3 << 11) | 20) & 0xFu; }
#define XB_SPIN(cond, bar) do { unsigned _sp = 0; while (cond) { __builtin_amdgcn_s_sleep(1); \
    if ((++_sp & 255u) == 0u) { if (xb_ld(&(bar)[XB_TMO])) break; if (_sp > XB_SPIN_CAP) { atomicAdd(&(bar)[XB_TMO], 1u); break; } } } } while (0)
struct XcdBarrier { unsigned* bar; unsigned x; volatile LAS unsigned* st; };
__device__ __forceinline__ XcdBarrier xcd_barrier_post(unsigned* bar, volatile LAS unsigned* st) {
    XcdBarrier b; b.bar = bar; b.x = xb_xcc_id(); b.st = st;
    if (threadIdx.x == 0) st[2] = xb_add(&bar[XB_XCNT(b.x)], 1u);
    return b;
}
__device__ __forceinline__ void xcd_barrier_complete(unsigned* bar, unsigned x, unsigned& nloc, unsigned& nx) {
    const unsigned G = gridDim.x * gridDim.y * gridDim.z;
    unsigned sum, cnt, mine, sp = 0u;
    for (;;) {
        sum = 0u; cnt = 0u; mine = 0u;
#pragma unroll
        for (unsigned j = 0; j < 16; ++j) { const unsigned c = xb_ld(&bar[XB_XCNT(j)]); sum += c; cnt += (c > 0u) ? 1u : 0u; mine = (j == x) ? c : mine; }
        if (sum == G) break;
        __builtin_amdgcn_s_sleep(1);
        if ((++sp & 255u) == 0u) { if (xb_ld(&bar[XB_TMO])) break; if (sp > XB_SPIN_CAP) { atomicAdd(&bar[XB_TMO], 1u); break; } }
    }
    nloc = mine > 0u ? mine : 1u; nx = cnt > 0u ? cnt : 1u;
}
__device__ __forceinline__ void xcd_barrier(const XcdBarrier& b) {
    asm volatile("s_waitcnt vmcnt(0)" ::: "memory");
    __syncthreads();
    if (threadIdx.x == 0) {
        unsigned* bar = b.bar;
        __builtin_amdgcn_s_waitcnt(0);
        unsigned nloc = b.st[0], nx = b.st[1];
        if (nloc == 0u) { xcd_barrier_complete(bar, b.x, nloc, nx); b.st[0] = nloc; b.st[1] = nx; }
        const unsigned old = xb_add(&bar[XB_XSUB(b.x)], 1u);
        const unsigned gen = old / nloc;
        if (old + 1u == (gen + 1u) * nloc) {
            __builtin_amdgcn_fence(__ATOMIC_RELEASE, "agent");
            asm volatile("s_waitcnt vmcnt(0)" ::: "memory");
            const unsigned og = xb_add(&bar[XB_TOP], 1u);
            const unsigned tg = og / nx;
            if (og + 1u == (tg + 1u) * nx) xb_add(&bar[XB_TOPGEN], 1u);
            else XB_SPIN(xb_ld(&bar[XB_TOPGEN]) == tg, bar);
            __builtin_amdgcn_fence(__ATOMIC_ACQUIRE, "agent");
            xb_add(&bar[XB_XGEN(b.x)], 1u);
            asm volatile("s_waitcnt vmcnt(0)" ::: "memory");
        } else {
            XB_SPIN(xb_ld(&bar[XB_XGEN(b.x)]) == gen, bar);
            __builtin_amdgcn_fence(__ATOMIC_ACQUIRE, "agent");
            asm volatile("s_waitcnt vmcnt(0)" ::: "memory");
        }
    }
    __syncthreads();
}

namespace pg8 {
constexpr int BM = 256, BK = 64, HALF = 128, HTB = HALF * BK * 2, STAGE_BYTES = 8 * HTB;
__device__ __forceinline__ int lds_byte(int r, int c) { const int st = (r >> 4) * 2 + (c >> 5), rr = r & 15, cc = c & 31, ob = rr * 64 + cc * 2; return st * 1024 + (ob ^ (((ob >> 9) & 1) << 5)); }
__device__ __forceinline__ void stage_rc(int b, int& R, int& C) { const int st = b / 1024, sb = b % 1024, swz = sb ^ (((sb >> 9) & 1) << 5); R = (st >> 1) * 16 + swz / 64; C = (st & 1) * 32 + (swz % 64) / 2; }
__device__ __forceinline__ int perm32(int rho) { const int n = rho >> 4, i = rho & 15; return 8 * (i >> 2) + 4 * n + (i & 3); }
struct Unit { int pm, pn, z; };
struct Gemm { int lda, ldb, K; int sa = 0x7f, sb = 0x7f; };
typedef int v8i32 __attribute__((ext_vector_type(8)));
typedef int v4i32 __attribute__((ext_vector_type(4)));

#ifndef PG8_SP2
#define PG8_SP2 true
#endif
template <class Epi, class Sched, bool GATHER, bool SP2 = PG8_SP2, bool F8 = false>
__device__ __forceinline__ void gemm_phase(LAS unsigned char* lds, const Gemm g, const Sched& S, const Epi& E) {
    const int tid = threadIdx.x, wid = __builtin_amdgcn_readfirstlane(tid >> 6), lane = tid & 63, wr = wid >> 2, wc = wid & 3, fr = lane & 15, fq = lane >> 4;
    const int K = g.K, nt = K / BK;
    unsigned voffA[2], voffB[2]; int Rr[2], Cc[2];
#pragma unroll
    for (int i = 0; i < 2; ++i) { int R, C; stage_rc(tid * 16 + i * 8192, R, C); const int Rb = Epi::PERM ? ((R & ~31) + perm32(R & 31)) : R;
        Rr[i] = R; Cc[i] = C; voffA[i] = (unsigned)(R * g.lda + C) * 2u; voffB[i] = (unsigned)(Rb * g.ldb + C) * 2u; }
    const size_t hstepA = (size_t)HALF * g.lda * 2, hstepB = (size_t)HALF * g.ldb * 2;
    const unsigned ldsw = (unsigned)wid * 1024u;
    const int aoff = lds_byte(wr * 64 + fr, fq * 8), boff = lds_byte(wc * 32 + fr, fq * 8);
#define PG8_SA(b, h) (((b) * 2 + (h)) * HTB)
#define PG8_SB(b, h) ((4 + (b) * 2 + (h)) * HTB)
#define PG8_GLDS(gp, lo) __builtin_amdgcn_global_load_lds((const unsigned*)(gp), (LAS unsigned*)(lds + (lo)), 16, 0, 0)
#define PG8_STAGE_B(bufoff, gbase, h) do { const char* _b = (const char*)(gbase) + (h) * hstepB; PG8_GLDS(_b + voffB[0], (bufoff) + ldsw); PG8_GLDS(_b + voffB[1], (bufoff) + ldsw + 8192); } while (0)
#define PG8_STAGE_A(bufoff, gbase, h, OFF) do { if constexpr (GATHER) { PG8_GLDS((const char*)(gbase) + OFF##h##0, (bufoff) + ldsw); PG8_GLDS((const char*)(gbase) + OFF##h##1, (bufoff) + ldsw + 8192); } \
        else { const char* _a = (const char*)(gbase) + (h) * hstepA; PG8_GLDS(_a + voffA[0], (bufoff) + ldsw); PG8_GLDS(_a + voffA[1], (bufoff) + ldsw + 8192); } } while (0)
#define PG8_LDA(dst, b, h) do { if constexpr (F8) { _Pragma("unroll") for (int m = 0; m < 4; ++m) { const v4i32 _lo = *(const LAS v4i32*)(lds + PG8_SA(b, h) + aoff + m * 2048), _hi = *(const LAS v4i32*)(lds + PG8_SA(b, h) + aoff + m * 2048 + 1024); \
            dst##8[m] = __builtin_shufflevector(_lo, _hi, 0, 1, 2, 3, 4, 5, 6, 7); } } \
        else { _Pragma("unroll") for (int m = 0; m < 4; ++m) _Pragma("unroll") for (int k = 0; k < 2; ++k) dst[m][k] = *(const LAS bf16x8*)(lds + PG8_SA(b, h) + aoff + m * 2048 + k * 1024); } } while (0)
#define PG8_LDB(dst, b, h) do { if constexpr (F8) { _Pragma("unroll") for (int n = 0; n < 2; ++n) { const v4i32 _lo = *(const LAS v4i32*)(lds + PG8_SB(b, h) + boff + n * 2048), _hi = *(const LAS v4i32*)(lds + PG8_SB(b, h) + boff + n * 2048 + 1024); \
            dst##8[n] = __builtin_shufflevector(_lo, _hi, 0, 1, 2, 3, 4, 5, 6, 7); } } \
        else { _Pragma("unroll") for (int n = 0; n < 2; ++n) _Pragma("unroll") for (int k = 0; k < 2; ++k) dst[n][k] = *(const LAS bf16x8*)(lds + PG8_SB(b, h) + boff + n * 2048 + k * 1024); } } while (0)
#define PG8_MMA(ai, bj, At, Bt) do { __builtin_amdgcn_s_setprio(1); \
        if constexpr (F8) { _Pragma("unroll") for (int m = 0; m < 4; ++m) _Pragma("unroll") for (int n = 0; n < 2; ++n) \
            asm volatile("v_mfma_scale_f32_16x16x128_f8f6f4 %0, %1, %2, %0, %3, %4 op_sel_hi:[0,0,0]" : "+v"(acc[ai][bj][m][n]) : "v"(Bt##8[n]), "v"(At##8[m]), "v"(f8sb), "v"(f8sa)); } \
        else { _Pragma("unroll") for (int m = 0; m < 4; ++m) _Pragma("unroll") for (int n = 0; n < 2; ++n) _Pragma("unroll") for (int k = 0; k < 2; ++k) \
            acc[ai][bj][m][n] = __builtin_amdgcn_mfma_f32_16x16x32_bf16(Bt[n][k], At[m][k], acc[ai][bj][m][n], 0, 0, 0); } \
        __builtin_amdgcn_s_setprio(0); } while (0)
#define PG8_WAIT_V(n) asm volatile("s_waitcnt vmcnt(" #n ")" ::: "memory")
#define PG8_WAIT_L(n) asm volatile("s_waitcnt lgkmcnt(" #n ")" ::: "memory")
#define PG8_BAR __builtin_amdgcn_s_barrier()
#define PG8_SCHED __builtin_amdgcn_sched_barrier(0)
    Unit cur, nxt; int ui = 0;
    if (!S.next(0, cur)) return;
    f32x4 acc[2][2][4][2];
#pragma unroll
    for (int a = 0; a < 2; ++a)
#pragma unroll
        for (int b = 0; b < 2; ++b)
#pragma unroll
            for (int m = 0; m < 4; ++m)
#pragma unroll
                for (int n = 0; n < 2; ++n) acc[a][b][m][n] = (f32x4){0.f, 0.f, 0.f, 0.f};
    bf16x8 At[4][2], B0[2][2], B1[2][2]; v8i32 At8[4], B08[2], B18[2];
    const int f8sa = g.sa, f8sb = g.sb;
    unsigned coff00 = 0u, coff01 = 0u, coff10 = 0u, coff11 = 0u, noff00 = 0u, noff01 = 0u, noff10 = 0u, noff11 = 0u;
    if constexpr (GATHER) {
        coff00 = S.a_off(cur, Rr[0]) + (unsigned)Cc[0] * 2u; coff01 = S.a_off(cur, Rr[1]) + (unsigned)Cc[1] * 2u;
        coff10 = S.a_off(cur, HALF + Rr[0]) + (unsigned)Cc[0] * 2u; coff11 = S.a_off(cur, HALF + Rr[1]) + (unsigned)Cc[1] * 2u;
    }
    { const char* cA = S.a_ptr(cur, 0); const char* cB = S.b_ptr(cur, 0); const char* cA1 = S.a_ptr(cur, 1); const char* cB1 = S.b_ptr(cur, 1);
    if constexpr (SP2) {
    PG8_STAGE_B(PG8_SB(0, 0), cB, 0); PG8_STAGE_B(PG8_SB(0, 1), cB, 1); PG8_STAGE_A(PG8_SA(0, 0), cA, 0, coff); PG8_STAGE_A(PG8_SA(0, 1), cA, 1, coff);
    if (wr == 1) PG8_BAR;
    PG8_WAIT_V(2); PG8_BAR;
    PG8_STAGE_B(PG8_SB(1, 0), cB1, 0); PG8_STAGE_A(PG8_SA(1, 0), cA1, 0, coff); PG8_STAGE_B(PG8_SB(1, 1), cB1, 1);
    PG8_WAIT_V(6); PG8_BAR;
    } else {
    PG8_STAGE_B(PG8_SB(0, 0), cB, 0); PG8_STAGE_A(PG8_SA(0, 0), cA, 0, coff); PG8_STAGE_B(PG8_SB(0, 1), cB, 1); PG8_STAGE_A(PG8_SA(0, 1), cA, 1, coff);
    if (wr == 1) PG8_BAR;
    PG8_WAIT_V(4); PG8_BAR;
    PG8_STAGE_B(PG8_SB(1, 0), cB1, 0); PG8_STAGE_A(PG8_SA(1, 0), cA1, 0, coff); PG8_STAGE_B(PG8_SB(1, 1), cB1, 1);
    PG8_WAIT_V(6); PG8_BAR; } }
    for (;;) {
        const bool has_next = S.next(ui + 1, nxt);
        Unit un; un.pm = has_next ? nxt.pm : cur.pm; un.pn = has_next ? nxt.pn : cur.pn; un.z = has_next ? nxt.z : cur.z;
        if constexpr (GATHER) {
            noff00 = has_next ? (S.a_off(nxt, Rr[0]) + (unsigned)Cc[0] * 2u) : coff00; noff01 = has_next ? (S.a_off(nxt, Rr[1]) + (unsigned)Cc[1] * 2u) : coff01;
            noff10 = has_next ? (S.a_off(nxt, HALF + Rr[0]) + (unsigned)Cc[0] * 2u) : coff10; noff11 = has_next ? (S.a_off(nxt, HALF + Rr[1]) + (unsigned)Cc[1] * 2u) : coff11;
        }
        for (int t = 0; t < nt; t += 2) {
            const bool last = (t == nt - 2);
            if constexpr (Epi::HOOK) { if (t == Epi::H1 || t == Epi::H2) { if constexpr (F8) asm volatile("s_nop 15\n\ts_nop 15\n\ts_nop 7" ::: "memory"); if (wr == 0) PG8_BAR; E.hook(acc, cur, t, wr, wc, fr, fq); if (wr == 1) PG8_BAR; } }
            const char* a1 = S.a_ptr(cur, t + 1);
            const char* a2 = last ? S.a_ptr(un, 0) : S.a_ptr(cur, t + 2); const char* b2 = last ? S.b_ptr(un, 0) : S.b_ptr(cur, t + 2);
            const char* a3 = last ? S.a_ptr(un, 1) : S.a_ptr(cur, t + 3); const char* b3 = last ? S.b_ptr(un, 1) : S.b_ptr(cur, t + 3);
            const unsigned o200 = last ? noff00 : coff00, o201 = last ? noff01 : coff01, o210 = last ? noff10 : coff10, o211 = last ? noff11 : coff11;
            if constexpr (SP2) {
            PG8_LDB(B0, 0, 0); PG8_LDB(B1, 0, 1); PG8_SCHED; PG8_LDA(At, 0, 0); PG8_STAGE_A(PG8_SA(1, 1), a1, 1, coff);
            PG8_WAIT_V(8); PG8_WAIT_L(0); PG8_BAR; PG8_MMA(0, 0, At, B0); PG8_MMA(0, 1, At, B1); PG8_BAR; PG8_SCHED;
            PG8_LDA(At, 0, 1); PG8_STAGE_B(PG8_SB(0, 0), b2, 0); PG8_STAGE_B(PG8_SB(0, 1), b2, 1); PG8_STAGE_A(PG8_SA(0, 0), a2, 0, o2);
            PG8_WAIT_V(8); PG8_WAIT_L(0); PG8_BAR; PG8_MMA(1, 0, At, B0); PG8_MMA(1, 1, At, B1); PG8_BAR; PG8_SCHED;
            PG8_LDB(B0, 1, 0); PG8_LDB(B1, 1, 1); PG8_SCHED; PG8_LDA(At, 1, 0); PG8_STAGE_A(PG8_SA(0, 1), a2, 1, o2);
            PG8_WAIT_V(8); PG8_WAIT_L(0); PG8_BAR; PG8_MMA(0, 0, At, B0); PG8_MMA(0, 1, At, B1); PG8_BAR; PG8_SCHED;
            PG8_LDA(At, 1, 1); PG8_STAGE_B(PG8_SB(1, 0), b3, 0); PG8_STAGE_B(PG8_SB(1, 1), b3, 1); PG8_STAGE_A(PG8_SA(1, 0), a3, 0, o2);
            PG8_WAIT_V(8); PG8_WAIT_L(0); PG8_BAR; PG8_MMA(1, 0, At, B0); PG8_MMA(1, 1, At, B1); PG8_BAR; PG8_SCHED;
            } else {
            PG8_LDB(B0, 0, 0); PG8_SCHED; PG8_LDA(At, 0, 0); PG8_STAGE_A(PG8_SA(1, 1), a1, 1, coff);
            PG8_WAIT_L(8); PG8_BAR; PG8_WAIT_L(0); PG8_MMA(0, 0, At, B0); PG8_BAR; PG8_SCHED;
            PG8_LDB(B1, 0, 1); PG8_STAGE_B(PG8_SB(0, 0), b2, 0);
            PG8_BAR; PG8_WAIT_L(0); PG8_MMA(0, 1, At, B1); PG8_BAR;
            PG8_LDA(At, 0, 1); PG8_STAGE_A(PG8_SA(0, 0), a2, 0, o2);
            PG8_BAR; PG8_WAIT_L(0); PG8_MMA(1, 0, At, B0); PG8_BAR; PG8_SCHED;
            PG8_STAGE_B(PG8_SB(0, 1), b2, 1);
            PG8_WAIT_V(6); PG8_BAR; PG8_MMA(1, 1, At, B1); PG8_BAR;
            PG8_LDB(B0, 1, 0); PG8_SCHED; PG8_LDA(At, 1, 0); PG8_STAGE_A(PG8_SA(0, 1), a2, 1, o2);
            PG8_WAIT_L(8); PG8_BAR; PG8_WAIT_L(0); PG8_MMA(0, 0, At, B0); PG8_BAR; PG8_SCHED;
            PG8_LDB(B1, 1, 1); PG8_STAGE_B(PG8_SB(1, 0), b3, 0);
            PG8_BAR; PG8_WAIT_L(0); PG8_MMA(0, 1, At, B1); PG8_BAR;
            PG8_LDA(At, 1, 1); PG8_STAGE_A(PG8_SA(1, 0), a3, 0, o2);
            PG8_BAR; PG8_WAIT_L(0); PG8_MMA(1, 0, At, B0); PG8_BAR; PG8_SCHED;
            PG8_STAGE_B(PG8_SB(1, 1), b3, 1);
            PG8_WAIT_V(6); PG8_BAR; PG8_MMA(1, 1, At, B1); PG8_BAR;
            }
        }
        if constexpr (F8) asm volatile("s_nop 15\n\ts_nop 15\n\ts_nop 7" ::: "memory");
        if (wr == 0) PG8_BAR;
        E(acc, cur, wr, wc, fr, fq);
        if (!has_next) break;
#pragma unroll
        for (int a = 0; a < 2; ++a)
#pragma unroll
            for (int b = 0; b < 2; ++b)
#pragma unroll
                for (int m = 0; m < 4; ++m)
#pragma unroll
                    for (int n = 0; n < 2; ++n) acc[a][b][m][n] = (f32x4){0.f, 0.f, 0.f, 0.f};
        cur = nxt; ++ui;
        if constexpr (GATHER) { coff00 = noff00; coff01 = noff01; coff10 = noff10; coff11 = noff11; }
        if (wr == 1) PG8_BAR;
    }
    PG8_WAIT_V(0);
    PG8_BAR;
#undef PG8_SA
#undef PG8_SB
#undef PG8_GLDS
#undef PG8_STAGE_A
#undef PG8_STAGE_B
#undef PG8_LDA
#undef PG8_LDB
#undef PG8_MMA
#undef PG8_WAIT_V
#undef PG8_WAIT_L
#undef PG8_BAR
#undef PG8_SCHED
}

struct SchedGrid {
    const char* A; const char* B; size_t zA, zB, tA, tB; int nM, nN, nz, G, c, rep;
    __device__ __forceinline__ bool next(int i, Unit& u) const {
        const int nwg = nz * nM * nN; const long L = (long)i * G + c; if (L >= (long)nwg * rep) return false;
        int w = (int)(L % nwg); { const int q = nwg / 8, r = nwg % 8, x = w % 8, off = w / 8; w = (x < r ? x * (q + 1) : r * (q + 1) + (x - r) * q) + off; }
        const int per = nM * nN; u.z = w / per; w -= u.z * per;
#ifdef PROBE_NOEPI
        if (L >= nwg) u.z |= 0x4000;
#endif
        const int nig = 8 * nN, gid = w / nig, fm = gid * 8, gsz = (nM - fm) < 8 ? (nM - fm) : 8;
        u.pm = fm + ((w % nig) % gsz); u.pn = (w % nig) / gsz; return true; }
    __device__ __forceinline__ const char* a_ptr(const Unit& u, int t) const { return A + (size_t)u.z * zA + (size_t)u.pm * tA + (size_t)t * 128; }
    __device__ __forceinline__ const char* b_ptr(const Unit& u, int t) const { return B + (size_t)u.z * zB + (size_t)u.pn * tB + (size_t)t * 128; }
    __device__ __forceinline__ unsigned a_off(const Unit&, int) const { return 0u; }
};
}

struct Args { const void* in[32]; float* out; unsigned char* ws; int ph_lo, ph_hi; };
struct Frame {
    LAS unsigned char* lds; int tid, lane, wave, G, c;
    unsigned char* ws; unsigned char* dout;
};
enum { I_X = 0, I_MEM, I_POS, I_GMIX, I_GMEM, I_WIN, I_LRE, I_LIM, I_LDT, I_BRE, I_BIM, I_CRE, I_CIM, I_DSKIP, I_WGLU, I_GQ, I_GK, I_GQM, I_GKM, I_WMEMKV,
       I_WUPS, I_WUPD, I_WUPM, I_WOUT, I_GFFN, I_WGROUP, I_BGROUP, I_WEXP, I_BEXP, I_WGATE, I_WUP, I_WDOWN };
#define INP(i) ((const float*)a.in[i])
#define WSP(T_, off) ((T_*)(F.ws + (off)))
#define DOP(T_, off) ((T_*)(F.dout + (off)))

using pg8::Unit;
__device__ __forceinline__ unsigned gpack4(const f32x4 v) {
    unsigned w = 0u;
#pragma unroll
    for (int j = 0; j < 4; ++j) { const float sg = __builtin_amdgcn_rcpf(1.0f + __builtin_amdgcn_exp2f(v[j])); w = __builtin_amdgcn_cvt_pk_u8_f32(sg * 255.0f, j, w); }
    return w; }
__device__ __forceinline__ void gdecode(const u32x2 w, float (&g)[8]) {
#pragma unroll
    for (int j = 0; j < 4; ++j) { g[j] = fmaxf((float)((w.x >> (8 * j)) & 255u), 0.5f); g[4 + j] = fmaxf((float)((w.y >> (8 * j)) & 255u), 0.5f); } }
struct EpiInProj {
    static constexpr bool PERM = true, HOOK = false;
    bf16_t *UA, *Y3; unsigned char* SG;
    __device__ __forceinline__ void operator()(const f32x4 (&acc)[2][2][4][2], const Unit& u, int wr, int wc, int fr, int fq) const {
        const int pn = u.pn, row0 = u.pm * 256 + wr * 64 + fr, cw = wc * 32 + 8 * fq;
#pragma unroll
        for (int ai = 0; ai < 2; ++ai)
#pragma unroll
            for (int m = 0; m < 4; ++m) {
                const int r = row0 + ai * 128 + m * 16;
#pragma unroll
                for (int bj = 0; bj < 2; ++bj) {
                    const int c = bj * 128 + cw;
                    if (pn >= 6) {
                        u32x2 w; w.x = gpack4(acc[ai][bj][m][0]); w.y = gpack4(acc[ai][bj][m][1]);
                        *(u32x2*)(SG + (size_t)r * 3072 + (pn - 6) * 256 + c) = w;
                    } else {
                        bf16_t* p;
                        if (pn < 2) { const int cc = pn * 256 + c, gI = cc >> 4, h0 = cc & 15, b = r >> 11, s = r & 2047;
                            p = UA + ((size_t)(gI * 2048 + b * 64 + (s >> 5)) * 640 + (s & 31) * 16 + h0); }
                        else p = Y3 + (size_t)r * Y3LD + (pn - 2) * 256 + c;
                        *(u32x4*)p = pack8(acc[ai][bj][m][0], acc[ai][bj][m][1]);
                    }
                }
            }
    }
};
struct EpiInProjB {
    static constexpr bool PERM = true, HOOK = false;
    bf16_t *KVX, *QI;
    __device__ __forceinline__ void operator()(const f32x4 (&acc)[2][2][4][2], const Unit& u, int wr, int wc, int fr, int fq) const {
        const int row0 = u.pm * 256 + wr * 64 + fr, cw = wc * 32 + 8 * fq; bf16_t* base = u.pn == 0 ? KVX : QI;
#pragma unroll
        for (int ai = 0; ai < 2; ++ai)
#pragma unroll
            for (int m = 0; m < 4; ++m)
#pragma unroll
                for (int bj = 0; bj < 2; ++bj)
                    *(u32x4*)(base + (size_t)(row0 + ai * 128 + m * 16) * 256 + bj * 128 + cw) = pack8(acc[ai][bj][m][0], acc[ai][bj][m][1]);
    }
};
struct EpiBf16 {
    static constexpr bool PERM = true, HOOK = false;
    bf16_t* O; int ld;
    __device__ __forceinline__ void operator()(const f32x4 (&acc)[2][2][4][2], const Unit& u, int wr, int wc, int fr, int fq) const {
        const int row0 = u.pm * 256 + wr * 64 + fr, col0 = u.pn * 256 + wc * 32 + 8 * fq;
#pragma unroll
        for (int ai = 0; ai < 2; ++ai)
#pragma unroll
            for (int m = 0; m < 4; ++m)
#pragma unroll
                for (int bj = 0; bj < 2; ++bj)
                    *(u32x4*)(O + (size_t)(row0 + ai * 128 + m * 16) * ld + col0 + bj * 128) = pack8(acc[ai][bj][m][0], acc[ai][bj][m][1]);
    }
};
struct EpiSc {
    static constexpr bool PERM = false, HOOK = false;
    float* SC;
    __device__ __forceinline__ void operator()(const f32x4 (&acc)[2][2][4][2], const Unit& u, int wr, int wc, int fr, int fq) const {
        const int row0 = u.pm * 256 + wr * 64 + fr, col0 = wc * 32 + 4 * fq;
#pragma unroll
        for (int ai = 0; ai < 2; ++ai)
#pragma unroll
            for (int m = 0; m < 4; ++m)
#pragma unroll
                for (int n = 0; n < 2; ++n)
                    *(f32x4*)(SC + ((size_t)u.z * 2048 + row0 + ai * 128 + m * 16) * 128 + col0 + n * 16) = acc[ai][0][m][n];
    }
};
struct EpiGelu {
    static constexpr bool PERM = true, HOOK = false;
    bf16_t* YG;
    __device__ __forceinline__ void operator()(const f32x4 (&acc)[2][2][4][2], const Unit& u, int wr, int wc, int fr, int fq) const {
        const int row0 = u.pm * 256 + wr * 64 + fr, col0 = u.pn * 256 + wc * 32 + 8 * fq;
#pragma unroll
        for (int ai = 0; ai < 2; ++ai)
#pragma unroll
            for (int m = 0; m < 4; ++m) {
                const int row = row0 + ai * 128 + m * 16;
#pragma unroll
                for (int bj = 0; bj < 2; ++bj) {
                    const int n8 = col0 + bj * 128, i = n8 >> 4, ho = n8 & 15;
                    f32x4 v0 = acc[ai][bj][m][0], v1 = acc[ai][bj][m][1];
#pragma unroll
                    for (int j = 0; j < 4; ++j) { v0[j] = gelu_tanh(v0[j]); v1[j] = gelu_tanh(v1[j]); }
                    *(u32x4*)(YG + ((size_t)row * 32 + i) * 512 + u.z * 16 + ho) = pack8(v0, v1);
                }
            }
    }
};
struct EpiGlu {
    static constexpr bool PERM = true, HOOK = false;
    const bf16_t* YG; unsigned char* YS8;
    __device__ __forceinline__ void operator()(const f32x4 (&acc)[2][2][4][2], const Unit& u, int wr, int wc, int fr, int fq) const {
        const int row0 = u.pm * 256 + wr * 64 + fr, col0 = u.pn * 256 + wc * 32 + 8 * fq;
        u32x4 yv[2][4][2];
#pragma unroll
        for (int ai = 0; ai < 2; ++ai)
#pragma unroll
            for (int m = 0; m < 4; ++m)
#pragma unroll
                for (int bj = 0; bj < 2; ++bj) yv[ai][m][bj] = *(const u32x4*)(YG + (size_t)(row0 + ai * 128 + m * 16) * 512 + col0 + bj * 128);
#pragma unroll
        for (int ai = 0; ai < 2; ++ai)
#pragma unroll
            for (int m = 0; m < 4; ++m)
#pragma unroll
                for (int bj = 0; bj < 2; ++bj) {
                    const int r = row0 + ai * 128 + m * 16, c = col0 + bj * 128;
                    f32x4 y0, y1; unpack8(yv[ai][m][bj], y0, y1);
                    f32x4 v0 = acc[ai][bj][m][0], v1 = acc[ai][bj][m][1];
#pragma unroll
                    for (int j = 0; j < 4; ++j) { v0[j] = y0[j] * sigm(v0[j]) * 16.0f; v1[j] = y1[j] * sigm(v1[j]) * 16.0f; }
                    u32x2 w8; w8.x = pack_fp8x4(v0[0], v0[1], v0[2], v0[3]); w8.y = pack_fp8x4(v1[0], v1[1], v1[2], v1[3]);
                    *(u32x2*)(YS8 + (size_t)r * 512 + c) = w8;
                }
    }
};
struct EpiMerge {
    static constexpr bool PERM = true, HOOK = true; static constexpr int H1 = 4, H2 = 8;
    const unsigned char* SG; unsigned char* MG;
    __device__ __forceinline__ void hook(f32x4 (&acc)[2][2][4][2], const Unit& u, int t, int wr, int wc, int fr, int fq) const {
        int row0 = u.pm * 256 + wr * 64 + fr, col0 = u.pn * 256 + wc * 32 + 8 * fq; const int br = (t >> 2) - 1;
        asm volatile("" : "+v"(row0), "+v"(col0));
        u32x2 wa[2][4][2], wb[2][4][2];
#pragma unroll
        for (int ai = 0; ai < 2; ++ai)
#pragma unroll
            for (int m = 0; m < 4; ++m)
#pragma unroll
                for (int bj = 0; bj < 2; ++bj) { const unsigned char* gp = SG + (size_t)(row0 + ai * 128 + m * 16) * 3072 + br * 1024 + col0 + bj * 128;
                    wa[ai][m][bj] = *(const u32x2*)gp; wb[ai][m][bj] = *(const u32x2*)(gp + 1024); }
#pragma unroll
        for (int ai = 0; ai < 2; ++ai)
#pragma unroll
            for (int m = 0; m < 4; ++m)
#pragma unroll
                for (int bj = 0; bj < 2; ++bj) {
                    float ga[8], gb[8]; gdecode(wa[ai][m][bj], ga); gdecode(wb[ai][m][bj], gb);
#pragma unroll
                    for (int j = 0; j < 4; ++j) { acc[ai][bj][m][0][j] *= ga[j] * __builtin_amdgcn_rcpf(gb[j]); acc[ai][bj][m][1][j] *= ga[4 + j] * __builtin_amdgcn_rcpf(gb[4 + j]); }
                }
    }
    __device__ __forceinline__ void operator()(const f32x4 (&acc)[2][2][4][2], const Unit& u, int wr, int wc, int fr, int fq) const {
        const int row0 = u.pm * 256 + wr * 64 + fr, col0 = u.pn * 256 + wc * 32 + 8 * fq;
        u32x2 wg[2][4][2];
#pragma unroll
        for (int ai = 0; ai < 2; ++ai)
#pragma unroll
            for (int m = 0; m < 4; ++m)
#pragma unroll
                for (int bj = 0; bj < 2; ++bj) wg[ai][m][bj] = *(const u32x2*)(SG + (size_t)(row0 + ai * 128 + m * 16) * 3072 + 2048 + col0 + bj * 128);
#pragma unroll
        for (int ai = 0; ai < 2; ++ai)
#pragma unroll
            for (int m = 0; m < 4; ++m)
#pragma unroll
                for (int bj = 0; bj < 2; ++bj) {
                    const int r = row0 + ai * 128 + m * 16, c = col0 + bj * 128;
                    float g2[8]; gdecode(wg[ai][m][bj], g2);
                    f32x4 v0 = acc[ai][bj][m][0], v1 = acc[ai][bj][m][1];
#pragma unroll
                    for (int j = 0; j < 4; ++j) { v0[j] *= g2[j] * (8.0f / 255.0f); v1[j] *= g2[4 + j] * (8.0f / 255.0f); }
                    u32x2 w8; w8.x = pack_fp8x4(v0[0], v0[1], v0[2], v0[3]); w8.y = pack_fp8x4(v1[0], v1[1], v1[2], v1[3]);
                    *(u32x2*)(MG + (size_t)r * 1024 + c) = w8;
                }
    }
};
struct EpiOut {
    static constexpr bool PERM = true, HOOK = false;
    const float* X; bf16_t* X1B; unsigned char* X1B8;
    __device__ __forceinline__ void operator()(const f32x4 (&acc)[2][2][4][2], const Unit& u, int wr, int wc, int fr, int fq) const {
        const int row0 = u.pm * 256 + wr * 64 + fr, col0 = u.pn * 256 + wc * 32 + 8 * fq;
#pragma unroll
        for (int ai = 0; ai < 2; ++ai) {
            f32x4 xv[4][2][2];
#pragma unroll
            for (int m = 0; m < 4; ++m)
#pragma unroll
                for (int bj = 0; bj < 2; ++bj) { const float* xp = X + (size_t)(row0 + ai * 128 + m * 16) * 1024 + col0 + bj * 128; xv[m][bj][0] = __builtin_nontemporal_load((const f32x4*)xp); xv[m][bj][1] = __builtin_nontemporal_load((const f32x4*)(xp + 4)); }
#pragma unroll
            for (int m = 0; m < 4; ++m)
#pragma unroll
                for (int bj = 0; bj < 2; ++bj)
                { const f32x4 v0 = xv[m][bj][0] + acc[ai][bj][m][0], v1 = xv[m][bj][1] + acc[ai][bj][m][1]; const size_t o = (size_t)(row0 + ai * 128 + m * 16) * 1024 + col0 + bj * 128;
                    *(u32x4*)(X1B + o) = pack8(v0, v1);
                    u32x2 w8; w8.x = pack_fp8x4(v0[0], v0[1], v0[2], v0[3]); w8.y = pack_fp8x4(v1[0], v1[1], v1[2], v1[3]); *(u32x2*)(X1B8 + o) = w8; }
        }
    }
};

constexpr int MI_CNT = 16, MI_PRE = 160, MI_TILE = 320, MI_PT = 960;
struct SchedMoE1 {
    const char* A; const char* W; LAS const int* misc; const int* tok; int ntile4, G, c, rep;
    __device__ __forceinline__ bool next(int i, Unit& u) const {
        long L = (long)i * G + c; if (L >= (long)ntile4 * rep) return false; L %= ntile4;
        const int e = misc[MI_TILE + (int)(L >> 2)]; u.z = e & 255; u.pm = e >> 8; u.pn = (int)(L & 3); return true; }
    __device__ __forceinline__ const char* a_ptr(const Unit&, int t) const { return A + (size_t)t * 128; }
    __device__ __forceinline__ const char* b_ptr(const Unit& u, int t) const { return W + (size_t)u.z * (1024 * 1024) + (size_t)u.pn * (256 * 1024) + (size_t)t * 128; }
    __device__ __forceinline__ unsigned a_off(const Unit& u, int r) const {
        int pos = u.pm * 256 + r; const int n = misc[MI_CNT + u.z]; pos = pos < n ? pos : 0;
        return (unsigned)(tok[(size_t)u.z * 65536 + pos] & 0x7fffffff) * 1024u; }
};
struct EpiMoe1 {
    static constexpr bool PERM = true, HOOK = false;
    LAS const int* misc; const int* tok; const float2* rw; unsigned char* HID;
    __device__ __forceinline__ void operator()(const f32x4 (&acc)[2][2][4][2], const Unit& u, int wr, int wc, int fr, int fq) const {
        const int l = u.z, n = misc[MI_CNT + l], col = u.pn * 128 + wc * 32 + 8 * fq;
        unsigned tk[2][4]; float2 qv[2][4];
#pragma unroll
        for (int ai = 0; ai < 2; ++ai)
#pragma unroll
            for (int m = 0; m < 4; ++m) { int pos = u.pm * 256 + ai * 128 + wr * 64 + m * 16 + fr; pos = pos < n ? pos : 0;
                tk[ai][m] = (unsigned)tok[(size_t)l * 65536 + pos]; qv[ai][m] = rw[(size_t)l * 65536 + pos]; }
#pragma unroll
        for (int ai = 0; ai < 2; ++ai)
#pragma unroll
            for (int m = 0; m < 4; ++m) {
                const int pos = u.pm * 256 + ai * 128 + wr * 64 + m * 16 + fr;
                if (pos < n) {
                    const float2 q = qv[ai][m];
                    f32x4 v0, v1;
#pragma unroll
                    for (int j = 0; j < 4; ++j) {
                        const float g0 = acc[ai][0][m][0][j] * q.x, u0 = acc[ai][1][m][0][j] * q.x, g1 = acc[ai][0][m][1][j] * q.x, u1 = acc[ai][1][m][1][j] * q.x;
                        v0[j] = g0 * sigm(g0) * u0 * (q.y * 16.0f); v1[j] = g1 * sigm(g1) * u1 * (q.y * 16.0f); }
                    u32x2 w8; w8.x = pack_fp8x4(v0[0], v0[1], v0[2], v0[3]); w8.y = pack_fp8x4(v1[0], v1[1], v1[2], v1[3]);
                    *(u32x2*)(HID + ((size_t)(tk[ai][m] & 0x7fffffffu) * 2 + (tk[ai][m] >> 31)) * 512 + col) = w8;
                }
            }
    }
};
struct SchedMoE2 {
    const char* A; const char* W; LAS const int* misc; const int* tok; int ntile4, G, c, rep;
    __device__ __forceinline__ bool next(int i, Unit& u) const {
        long L = (long)i * G + c; if (L >= (long)ntile4 * rep) return false; L %= ntile4;
        const int e = misc[MI_TILE + (int)(L >> 2)], l = e & 255, gi = l / 28, pt = misc[MI_PT + (l - gi * 28)];
        u.z = l | ((gi * 8 + (pt & 15)) << 8) | ((gi * 8 + (pt >> 4)) << 16); u.pm = e >> 8; u.pn = (int)(L & 3); return true; }
    __device__ __forceinline__ const char* a_ptr(const Unit&, int t) const { return A + (size_t)t * 128; }
    __device__ __forceinline__ const char* b_ptr(const Unit& u, int t) const {
        const int e = t < 4 ? ((u.z >> 8) & 255) : (u.z >> 16), tt = t < 4 ? t : t - 4;
        return W + (size_t)e * (1024 * 512) + (size_t)u.pn * (256 * 512) + (size_t)tt * 128; }
    __device__ __forceinline__ unsigned a_off(const Unit& u, int r) const {
        const int l = u.z & 255; int pos = u.pm * 256 + r; const int n = misc[MI_CNT + l]; pos = pos < n ? pos : 0;
        return (unsigned)tok[(size_t)l * 65536 + pos] * 1024u; }
};
struct EpiMoe2 {
    static constexpr bool PERM = false, HOOK = false;
    LAS const int* misc; const int* tok; const bf16_t* X1B; float* O;
    __device__ __forceinline__ void operator()(const f32x4 (&acc)[2][2][4][2], const Unit& u, int wr, int wc, int fr, int fq) const {
        const int l = u.z & 255, n = misc[MI_CNT + l], col0 = u.pn * 256 + wc * 32 + 4 * fq;
        int tk[2][4];
#pragma unroll
        for (int ai = 0; ai < 2; ++ai)
#pragma unroll
            for (int m = 0; m < 4; ++m) { int pos = u.pm * 256 + ai * 128 + wr * 64 + m * 16 + fr; pos = pos < n ? pos : 0; tk[ai][m] = tok[(size_t)l * 65536 + pos]; }
#pragma unroll
        for (int ai = 0; ai < 2; ++ai) {
            u32x2 xb[4][2][2];
#pragma unroll
            for (int m = 0; m < 4; ++m)
#pragma unroll
                for (int bj = 0; bj < 2; ++bj)
#pragma unroll
                    for (int nn = 0; nn < 2; ++nn) xb[m][bj][nn] = *(const u32x2*)(X1B + (size_t)tk[ai][m] * 1024 + col0 + bj * 128 + nn * 16);
#pragma unroll
            for (int m = 0; m < 4; ++m) {
                const int pos = u.pm * 256 + ai * 128 + wr * 64 + m * 16 + fr;
                if (pos < n) {
#pragma unroll
                    for (int bj = 0; bj < 2; ++bj)
#pragma unroll
                        for (int nn = 0; nn < 2; ++nn) { const u32x2 x = xb[m][bj][nn];
                            const f32x4 xv = (f32x4){bf2f(x.x & 0xffffu), bf2f(x.x >> 16), bf2f(x.y & 0xffffu), bf2f(x.y >> 16)};
                            __builtin_nontemporal_store(xv + acc[ai][bj][m][nn], (f32x4*)(O + (size_t)tk[ai][m] * 1024 + col0 + bj * 128 + nn * 16)); }
                }
            }
        }
    }
};
struct SchedMerge3 {
    const char* Y; const char* W; int G, c, rep;
    __device__ __forceinline__ bool next(int i, Unit& u) const {
        const int nwg = 1024; const long L = (long)i * G + c; if (L >= (long)nwg * rep) return false;
        int w = (int)(L % nwg); { const int q = nwg / 8, x = w % 8, off = w / 8; w = x * q + off; }
        const int nig = 8 * 4, gid = w / nig, fm = gid * 8;
        u.pm = fm + ((w % nig) % 8); u.pn = (w % nig) / 8; u.z = 0; return true; }
    __device__ __forceinline__ const char* a_ptr(const Unit& u, int t) const { return Y + (size_t)(t >> 2) * ((size_t)T * 512) + (size_t)u.pm * (256 * 512) + (size_t)(t & 3) * 128; }
    __device__ __forceinline__ const char* b_ptr(const Unit& u, int t) const { return W + (size_t)u.pn * (256 * 1536) + (size_t)t * 128; }
    __device__ __forceinline__ unsigned a_off(const Unit&, int) const { return 0u; }
};

__device__ __forceinline__ void rms_rows_bf16(const float* x, const float* g, bf16_t* out, unsigned char* out8, int nrows, int gw, int nw, int lane) {
    float4 gg[4];
#pragma unroll
    for (int i = 0; i < 4; ++i) gg[i] = ((const float4*)g)[lane + 64 * i];
#pragma unroll 1
    for (int r0 = gw; r0 < nrows; r0 += 2 * nw) {
        const int r1 = r0 + nw < nrows ? r0 + nw : r0;
        const float4* xa = (const float4*)(x + (size_t)r0 * 1024); const float4* xb = (const float4*)(x + (size_t)r1 * 1024);
        float4 va[4], vb[4]; float sa = 0.f, sb = 0.f;
#pragma unroll
        for (int i = 0; i < 4; ++i) { const f32x4 ta = __builtin_nontemporal_load((const f32x4*)xa + lane + 64 * i), tb = __builtin_nontemporal_load((const f32x4*)xb + lane + 64 * i);
            va[i] = make_float4(ta[0], ta[1], ta[2], ta[3]); vb[i] = make_float4(tb[0], tb[1], tb[2], tb[3]); }
#pragma unroll
        for (int i = 0; i < 4; ++i) { sa += va[i].x * va[i].x + va[i].y * va[i].y + va[i].z * va[i].z + va[i].w * va[i].w; sb += vb[i].x * vb[i].x + vb[i].y * vb[i].y + vb[i].z * vb[i].z + vb[i].w * vb[i].w; }
        sa = wave_sum(sa); sb = wave_sum(sb);
        const float ra = rsqrtf(sa * (1.0f / 1024.0f) + 1e-6f), rb = rsqrtf(sb * (1.0f / 1024.0f) + 1e-6f);
#pragma unroll
        for (int i = 0; i < 4; ++i) {
            u32x2 w; w.x = cvt_pk_bf16(va[i].x * ra * gg[i].x, va[i].y * ra * gg[i].y); w.y = cvt_pk_bf16(va[i].z * ra * gg[i].z, va[i].w * ra * gg[i].w);
            if (out) *(u32x2*)(out + (size_t)r0 * 1024 + (lane + 64 * i) * 4) = w;
            if (out8) *(unsigned*)(out8 + (size_t)r0 * 1024 + (lane + 64 * i) * 4) = pack_fp8x4(va[i].x * ra * gg[i].x, va[i].y * ra * gg[i].y, va[i].z * ra * gg[i].z, va[i].w * ra * gg[i].w);
            if (r1 != r0) { u32x2 z; z.x = cvt_pk_bf16(vb[i].x * rb * gg[i].x, vb[i].y * rb * gg[i].y); z.y = cvt_pk_bf16(vb[i].z * rb * gg[i].z, vb[i].w * rb * gg[i].w);
                if (out) *(u32x2*)(out + (size_t)r1 * 1024 + (lane + 64 * i) * 4) = z;
                if (out8) *(unsigned*)(out8 + (size_t)r1 * 1024 + (lane + 64 * i) * 4) = pack_fp8x4(vb[i].x * rb * gg[i].x, vb[i].y * rb * gg[i].y, vb[i].z * rb * gg[i].z, vb[i].w * rb * gg[i].w); }
        }
    }
}
__device__ __forceinline__ void tr_tile(LAS float* tl, const float* src, int ldsrc, int nvalid, const float* ks, float tsc, bf16_t* dst, unsigned char* dst8, int ldd, int lane) {
    const int r = lane >> 4, c4 = (lane & 15) * 4;
    float4 v[16];
#pragma unroll
    for (int p = 0; p < 16; ++p) { const int k = r + 4 * p; v[p] = make_float4(0.f, 0.f, 0.f, 0.f); if (c4 < nvalid) { const f32x4 tv = __builtin_nontemporal_load((const f32x4*)(src + (size_t)k * ldsrc + c4)); v[p] = make_float4(tv[0], tv[1], tv[2], tv[3]); } }
#pragma unroll
    for (int p = 0; p < 16; ++p) { const int k = r + 4 * p; float4 w = v[p];
        { const float sc = ks ? ks[k] * tsc : tsc; w.x *= sc; w.y *= sc; w.z *= sc; w.w *= sc; }
        tl[k * 65 + c4] = w.x; tl[k * 65 + c4 + 1] = w.y; tl[k * 65 + c4 + 2] = w.z; tl[k * 65 + c4 + 3] = w.w; }
    const int kq = lane & 7;
#pragma unroll
    for (int p = 0; p < 8; ++p) { const int n = (lane >> 3) + 8 * p; float f[8];
#pragma unroll
        for (int j = 0; j < 8; ++j) f[j] = tl[(kq * 8 + j) * 65 + n];
        if (dst8) { u32x2 w8; w8.x = pack_fp8x4(f[0], f[1], f[2], f[3]); w8.y = pack_fp8x4(f[4], f[5], f[6], f[7]); *(u32x2*)(dst8 + (size_t)n * ldd + kq * 8) = w8; }
        else { u32x4 w; w.x = cvt_pk_bf16(f[0], f[1]); w.y = cvt_pk_bf16(f[2], f[3]); w.z = cvt_pk_bf16(f[4], f[5]); w.w = cvt_pk_bf16(f[6], f[7]);
            *(u32x4*)(dst + (size_t)n * ldd + kq * 8) = w; } }
}
struct cf { float re, im; };
__device__ __forceinline__ cf cmul(cf a, cf b) { return cf{a.re * b.re - a.im * b.im, a.re * b.im + a.im * b.re}; }
__device__ __forceinline__ cf lam_pow(const Args& a, int g, int p, float e) {
    const float lre = INP(I_LRE)[g * 64 + p], lim = INP(I_LIM)[g * 64 + p], dt = __expf(INP(I_LDT)[g]);
    const float mag = __expf(lre * dt * e);
    const double rev = (double)lim * (double)dt * (double)e * 0.15915494309189535; const float fr = (float)(rev - rint(rev));
    return cf{mag * __builtin_amdgcn_cosf(fr), mag * __builtin_amdgcn_sinf(fr)};
}
__device__ __forceinline__ cf bbar_of(const Args& a, int g, int p, int h) {
    const float lre = INP(I_LRE)[g * 64 + p], lim = INP(I_LIM)[g * 64 + p];
    const cf lb = lam_pow(a, g, p, 1.0f); const cf num = cf{lb.re - 1.0f, lb.im};
    const float inv = 1.0f / (lre * lre + lim * lim);
    const cf q = cf{(num.re * lre + num.im * lim) * inv, (num.im * lre - num.re * lim) * inv};
    return cmul(q, cf{INP(I_BRE)[(g * 64 + p) * 16 + h], INP(I_BIM)[(g * 64 + p) * 16 + h]});
}
__device__ __forceinline__ void p0_prep(const Frame& F, const Args& a) {
    const int gw = F.c * 8 + F.wave, nw = F.G * 8;
    rms_rows_bf16(INP(I_X), INP(I_GMIX), WSP(bf16_t, WS_HB), WSP(unsigned char, WS_HB8), T, gw, nw, F.lane);
    rms_rows_bf16(INP(I_MEM), INP(I_GMEM), nullptr, WSP(unsigned char, WS_MEMN), 8192, gw, nw, F.lane);
    LAS float* tl = (LAS float*)F.lds + F.wave * (64 * 65);
    constexpr int NT_WIN = 80 * 16, NT_WMEM = 256, NT_WGLU = 64, NT_WUP = 384, NT_WOUT = 256, NT_E = 4096;
    constexpr int O1 = NT_WIN, O2 = O1 + NT_WMEM, O3 = O2 + NT_WGLU, O4 = O3 + NT_WUP, O5 = O4 + NT_WOUT, O6 = O5 + NT_E, O7 = O6 + NT_E, O8 = O7 + NT_E;
    for (int ti = gw; ti < O8; ti += nw) {
        const float* src; int ldsrc, nvalid = 64, ldd; const float* ks = nullptr; bf16_t* dst = nullptr; unsigned char* dst8 = nullptr; float tsc = 1.0f;
        if (ti < O1) { const int nt = ti / 16, kt = ti % 16, n0 = nt * 64; int sc;
            if (n0 < 1152) sc = n0;
            else if (n0 == 1152) sc = 1408;
            else if (n0 == 1216) { sc = 1472; nvalid = 4; }
            else if (n0 < 1280) { sc = 0; nvalid = 0; }
            else if (n0 < 1536) sc = 1152 + (n0 - 1280);
            else if (n0 < 2048) sc = 1476 + (n0 - 1536);
            else { sc = 1988 + (n0 - 2048); tsc = -1.4426950408889634f; }
            src = INP(I_WIN) + (size_t)kt * 64 * 5060 + sc; ldsrc = 5060; ldd = 1024;
            if (n0 >= 1024 && n0 < 1536) dst = WSP(bf16_t, WS_WIN) + (size_t)(n0 - 1024) * 1024 + kt * 64;
            else { const int r8 = n0 < 1024 ? n0 : (n0 < 2048 ? n0 - 512 : n0 - 512); dst8 = WSP(unsigned char, WS_WG8) + (size_t)r8 * 1024 + kt * 64; tsc *= 32.0f; } }
        else if (ti < O2) { const int t = ti - O1, nt = t / 16, kt = t % 16; src = INP(I_WMEMKV) + (size_t)kt * 64 * 1024 + nt * 64; ldsrc = 1024; tsc = 32.0f; dst8 = WSP(unsigned char, WS_WMEM) + (size_t)nt * 64 * 1024 + kt * 64; ldd = 1024; }
        else if (ti < O3) { const int t = ti - O2, nt = t / 8, kt = t % 8; src = INP(I_WGLU) + (size_t)kt * 64 * 512 + nt * 64; ldsrc = 512; dst = WSP(bf16_t, WS_WGLU) + (size_t)nt * 64 * 512 + kt * 64; ldd = 512; }
        else if (ti < O4) { const int t = ti - O3, br = t / 128, tt = t % 128, nt = tt / 8, kt = tt % 8; const float* w = br == 0 ? INP(I_WUPS) : (br == 1 ? INP(I_WUPD) : INP(I_WUPM));
            src = w + (size_t)kt * 64 * 1024 + nt * 64; ldsrc = 1024; tsc = 32.0f; dst8 = WSP(unsigned char, WS_WUP) + (size_t)nt * 64 * 1536 + br * 512 + kt * 64; ldd = 1536; }
        else if (ti < O5) { const int t = ti - O4, nt = t / 16, kt = t % 16; src = INP(I_WOUT) + (size_t)kt * 64 * 1024 + nt * 64; ldsrc = 1024; tsc = 32.0f; dst8 = WSP(unsigned char, WS_WOUT) + (size_t)nt * 64 * 1024 + kt * 64; ldd = 1024; }
        else if (ti < O7) { const int up = ti >= O6, t = ti - (up ? O6 : O5), e = t / 128, tt = t % 128, nt = tt / 16, kt = tt % 16, j0 = nt * 64;
            src = (up ? INP(I_WUP) : INP(I_WGATE)) + (size_t)e * 1024 * 512 + (size_t)kt * 64 * 512 + j0; ldsrc = 512; ks = INP(I_GFFN) + kt * 64; tsc = 32.0f;
            dst8 = WSP(unsigned char, WS_WGU) + (size_t)e * 1024 * 1024 + (size_t)((j0 >> 7) * 256 + up * 128 + (j0 & 127)) * 1024 + kt * 64; ldd = 1024; }
        else { const int t = ti - O7, e = t / 128, tt = t % 128, nt = tt / 8, kt = tt % 8;
            src = INP(I_WDOWN) + (size_t)e * 512 * 1024 + (size_t)kt * 64 * 1024 + nt * 64; ldsrc = 1024; tsc = 32.0f;
            dst8 = WSP(unsigned char, WS_WD) + (size_t)e * 1024 * 512 + (size_t)nt * 64 * 512 + kt * 64; ldd = 512; }
        tr_tile(tl, src, ldsrc, nvalid, ks, tsc, dst, dst8, ldd, F.lane);
    }
    const int gt = F.c * NTHR + F.tid, NTT = F.G * NTHR;
    for (int id = gt; id < 2048 * 33; id += NTT) { const int gp = id / 33, e = id - gp * 33; const cf z = lam_pow(a, gp >> 6, gp & 63, (float)e); WSP(float2, WS_LP)[id] = make_float2(z.re, z.im);
        if (e == 32) { WSP(float, WS_LAM32)[gp * 2] = z.re; WSP(float, WS_LAM32)[gp * 2 + 1] = z.im; } }
    for (int id = gt; id < 2048 * 16; id += NTT) { const int gp = id >> 4, h = id & 15; const cf z = bbar_of(a, gp >> 6, gp & 63, h); WSP(float2, WS_BB)[id] = make_float2(z.re, z.im); }
    for (int id = gt; id < 48 * 1024; id += NTT) { const int n = id >> 10, k = id & 1023;
        const float v = n < 4 ? INP(I_WGROUP)[k * 4 + n] : (n < 36 ? INP(I_WEXP)[k * 32 + (n - 4)] : 0.f);
        WSP(bf16_t, WS_WR)[id] = f2bf(v * INP(I_GFFN)[k]); }
}

__device__ __forceinline__ void p1_tables(const Frame& F, const Args& a, int wgi, int wgn) {
    const int gt = wgi * NTHR + F.tid, NTT = wgn * NTHR;
    bf16_t* TW = WSP(bf16_t, WS_TW); bf16_t* SIN = WSP(bf16_t, WS_SIN); const float2* LP = WSP(float2, WS_LP); const float2* BB = WSP(float2, WS_BB);
    for (int id = gt; id < 32 * 32 * 256; id += NTT) {
        const int hi = id & 15, ho = (id >> 4) & 15, d = (id >> 8) & 31, g = id >> 13;
        float val = 0.f;
        for (int p = 0; p < 64; ++p) { const float2 ez = LP[(g * 64 + p) * 33 + d], bb = BB[(g * 64 + p) * 16 + hi];
            const float cr = INP(I_CRE)[(g * 16 + ho) * 64 + p], ci = INP(I_CIM)[(g * 16 + ho) * 64 + p];
            const float tr = cr * ez.x - ci * ez.y, ti = cr * ez.y + ci * ez.x; val += tr * bb.x - ti * bb.y; }
        if (d == 0 && ho == hi) val += INP(I_DSKIP)[g * 16 + ho];
        const bf16_t bv = f2bf(val); bf16_t* tg = TW + (size_t)g * 512 * 640;
        for (int i = d; i < 32; ++i) { tg[(size_t)(i * 16 + ho) * 640 + (i - d) * 16 + hi] = bv; if (d > 0) tg[(size_t)((i - d) * 16 + ho) * 640 + i * 16 + hi] = 0; }
    }
    for (int id = gt; id < 32 * 32 * 16 * 64; id += NTT) {
        const int p = id & 63, ho = (id >> 6) & 15, i = (id >> 10) & 31, g = id >> 15;
        const float2 ez = LP[(g * 64 + p) * 33 + i + 1]; const float cr = INP(I_CRE)[(g * 16 + ho) * 64 + p], ci = INP(I_CIM)[(g * 16 + ho) * 64 + p];
        bf16_t* row = TW + (size_t)g * 512 * 640 + (size_t)(i * 16 + ho) * 640 + 512; row[p] = f2bf(cr * ez.x - ci * ez.y); row[64 + p] = f2bf(-(cr * ez.y + ci * ez.x));
    }
    for (int id = gt; id < 32 * 64 * 32 * 16; id += NTT) {
        const int h = id & 15, j = (id >> 4) & 31, p = (id >> 9) & 63, g = id >> 15;
        const float2 ez = LP[(g * 64 + p) * 33 + 31 - j], bb = BB[(g * 64 + p) * 16 + h];
        bf16_t* sg = SIN + (size_t)g * 256 * 512; sg[(size_t)p * 512 + j * 16 + h] = f2bf(ez.x * bb.x - ez.y * bb.y); sg[(size_t)(64 + p) * 512 + j * 16 + h] = f2bf(ez.x * bb.y + ez.y * bb.x);
    }
    for (int id = gt; id < 32 * 128 * 64; id += NTT) {
        const int q = id & 63, r = (id >> 6) & 127, g = id >> 13;
        *(u32x4*)(SIN + (size_t)g * 256 * 512 + (size_t)(128 + r) * 512 + q * 8) = (u32x4){0u, 0u, 0u, 0u};
    }
}

__device__ __forceinline__ void p2_post(const Frame& F, const Args& a, bool dry) {
    const int gw = F.c * 8 + F.wave, nw = F.G * 8, lane = F.lane, j = lane & 3, hs = lane >> 5, lr = lane & 31;
    const bf16_t* KVX = WSP(bf16_t, WS_KVX); unsigned char* KVP8 = WSP(unsigned char, WS_KVP); bf16_t* KIP = WSP(bf16_t, WS_KIP); bf16_t* QI = WSP(bf16_t, WS_QI);
    const bool rqi = lr < 16, rk = lr >= 16 && lr < 20, rki = lr >= 20 && lr < 24;
    const float scl = rqi ? 0.125f : 1.0f;
    float g1[8], g2[8];
#pragma unroll
    for (int e = 0; e < 8; ++e) { g1[e] = rk ? INP(I_GK)[8 * j + e] : 1.0f; g2[e] = rk ? INP(I_GK)[32 + 8 * j + e] : 1.0f; }
    constexpr int TB = 4;
    typedef float f32x2e __attribute__((ext_vector_type(2)));
    LAS f32x2e* cst = (LAS f32x2e*)F.lds + F.wave * (TB * 64);
    const float invf1 = __expf(-(float)lr * (9.210340371976184f / 32.0f));
#pragma unroll 1
    for (int tb = gw; tb < T; tb += nw * TB * 2) {
        u32x4 lo[TB], hi[TB]; float posf[TB]; unsigned short wraw[TB];
#pragma unroll
        for (int u = 0; u < TB; ++u) {
            const int tt = tb + (u * 2 + hs) * nw, t = tt < T ? tt : T - 1;
            const bf16_t* src;
            if (rqi) src = QI + (size_t)t * 256 + (lr >> 2) * 64;
            else if (rk) src = KVX + (size_t)t * 256;
            else if (rki) src = KVX + (size_t)t * 256 + 128;
            else src = KVX + (size_t)t * 256 + 64 + (lr - 24) * 8 - 8 * j;
            lo[u] = *(const u32x4*)(src + 8 * j); hi[u] = (lr < 24) ? *(const u32x4*)(src + 32 + 8 * j) : lo[u];
            posf[u] = (float)((const int*)a.in[I_POS])[t];
            wraw[u] = KVX[(size_t)t * 256 + 192 + (lane & 3)];
            { const float ang = posf[u] * invf1; const double rev = (double)ang * 0.15915494309189535; const float fr = (float)(rev - rint(rev));
              const f32x2e cs2 = (f32x2e){__builtin_amdgcn_cosf(fr), __builtin_amdgcn_sinf(fr)}; cst[(u * 2 + hs) * 32 + lr] = cs2;
              if (tt < T) WSP(f32x2e, WS_CS)[(size_t)t * 32 + lr] = cs2; }
        }
#pragma unroll
        for (int u = 0; u < TB; ++u) {
            const int t = tb + (u * 2 + hs) * nw;
            const bool live = t < T;
            if (lr < 24) {
                bf16_t* dst;
                if (rqi) dst = dry ? WSP(bf16_t, WS_RW) + (size_t)(live ? t : 0) * 256 + (lr >> 2) * 64 : QI + (size_t)(live ? t : 0) * 256 + (lr >> 2) * 64;
                else if (rk) dst = nullptr;
                else dst = KIP + (size_t)(live ? t : 0) * 64;
                f32x4 a0, a1, b0, b1; unpack8(lo[u], a0, a1); unpack8(hi[u], b0, b1);
                float x1[8] = {a0[0], a0[1], a0[2], a0[3], a1[0], a1[1], a1[2], a1[3]}, x2[8] = {b0[0], b0[1], b0[2], b0[3], b1[0], b1[1], b1[2], b1[3]};
                float ss = 0.f;
#pragma unroll
                for (int e = 0; e < 8; ++e) ss += x1[e] * x1[e] + x2[e] * x2[e];
                ss += __shfl_xor(ss, 1); ss += __shfl_xor(ss, 2);
                const float rs = rk ? rsqrtf(ss * (1.0f / 64.0f) + 1e-6f) : 1.0f;
                float o1[8], o2[8];
#pragma unroll
                for (int e = 0; e < 8; ++e) {
                    const f32x2e csn = cst[(u * 2 + hs) * 32 + 8 * j + e]; const float cs = csn.x, sn = csn.y;
                    const float y1 = x1[e] * rs * g1[e], y2 = x2[e] * rs * g2[e];
                    o1[e] = (y1 * cs - y2 * sn) * scl; o2[e] = (y2 * cs + y1 * sn) * scl; }
                if (live) {
                    if (rk) {
                        u32x2 w0, w1; w0.x = pack_fp8x4(o1[0], o1[1], o1[2], o1[3]); w0.y = pack_fp8x4(o1[4], o1[5], o1[6], o1[7]); w1.x = pack_fp8x4(o2[0], o2[1], o2[2], o2[3]); w1.y = pack_fp8x4(o2[4], o2[5], o2[6], o2[7]);
                        *(u32x2*)(KVP8 + (size_t)t * 128 + 8 * j) = w0; *(u32x2*)(KVP8 + (size_t)t * 128 + 32 + 8 * j) = w1;
                    } else {
                        *(u32x4*)(dst + 8 * j) = pack8((f32x4){o1[0], o1[1], o1[2], o1[3]}, (f32x4){o1[4], o1[5], o1[6], o1[7]});
                        *(u32x4*)(dst + 32 + 8 * j) = pack8((f32x4){o2[0], o2[1], o2[2], o2[3]}, (f32x4){o2[4], o2[5], o2[6], o2[7]}); } }
            } else if (live) {
                f32x4 a0, a1; unpack8(lo[u], a0, a1); u32x2 w; w.x = pack_fp8x4(a0[0], a0[1], a0[2], a0[3]); w.y = pack_fp8x4(a1[0], a1[1], a1[2], a1[3]);
                *(u32x2*)(KVP8 + (size_t)t * 128 + 64 + (lr - 24) * 8) = w;
            }
            if (lr < 4 && live) WSP(float, WS_WIF)[t * 4 + lr] = bf2f(wraw[u]) * 0.5f;
        }
    }
    const bf16_t* KMVM = WSP(bf16_t, WS_KMVM); bf16_t* KM = WSP(bf16_t, WS_KM); bf16_t* VMT = WSP(bf16_t, WS_VMT);
    { float gk8[8];
#pragma unroll
        for (int e = 0; e < 8; ++e) gk8[e] = INP(I_GKM)[(lane & 15) * 8 + e] * INP(I_GQM)[(lane & 15) * 8 + e];
        for (int r = gw; r < 8192; r += nw) {
            const int h = lane >> 4, b = r >> 8, m = r & 255;
            f32x4 a0, a1; unpack8(*(const u32x4*)(KMVM + (size_t)r * 1024 + h * 128 + (lane & 15) * 8), a0, a1);
            float ss = a0[0] * a0[0] + a0[1] * a0[1] + a0[2] * a0[2] + a0[3] * a0[3] + a1[0] * a1[0] + a1[1] * a1[1] + a1[2] * a1[2] + a1[3] * a1[3];
            ss += __shfl_xor(ss, 1); ss += __shfl_xor(ss, 2); ss += __shfl_xor(ss, 4); ss += __shfl_xor(ss, 8);
            const float rs = rsqrtf(ss * (1.0f / 128.0f) + 1e-6f);
            *(u32x4*)(KM + ((size_t)(b * 4 + h) * 256 + m) * 128 + (lane & 15) * 8) = pack8((f32x4){a0[0] * rs * gk8[0], a0[1] * rs * gk8[1], a0[2] * rs * gk8[2], a0[3] * rs * gk8[3]}, (f32x4){a1[0] * rs * gk8[4], a1[1] * rs * gk8[5], a1[2] * rs * gk8[6], a1[3] * rs * gk8[7]}); } }
    const int gt = F.c * NTHR + F.tid, NTT = F.G * NTHR;
    for (int id = gt; id < 32 * 4 * 32 * 128; id += NTT) { const int d = id & 127, pg = (id >> 7) & 31, h = (id >> 12) & 3, b = id >> 14;
        unsigned short v[8];
#pragma unroll
        for (int j = 0; j < 8; ++j) { const int pp = pg * 8 + j, q = pp & 15, key = (pp & ~15) + 8 * ((q & 7) >> 2) + 4 * (q >> 3) + (q & 3);
            v[j] = KMVM[(size_t)(b * 256 + key) * 1024 + 512 + h * 128 + d]; }
        u32x4 w; w.x = v[0] | ((unsigned)v[1] << 16); w.y = v[2] | ((unsigned)v[3] << 16); w.z = v[4] | ((unsigned)v[5] << 16); w.w = v[6] | ((unsigned)v[7] << 16);
        *(u32x4*)(VMT + ((size_t)(b * 4 + h) * 128 + d) * 256 + pg * 8) = w; }
}

__device__ __forceinline__ void p3_scan(const Frame& F) {
    const int gt = F.c * NTHR + F.tid, NTT = F.G * NTHR;
    const float* SC = WSP(float, WS_SC); bf16_t* UA = WSP(bf16_t, WS_UA);
    for (int id = gt; id < 65536; id += NTT) { const int p = id & 63, b = (id >> 6) & 31, g = id >> 11;
        const float lr = WSP(float, WS_LAM32)[(g * 64 + p) * 2], li = WSP(float, WS_LAM32)[(g * 64 + p) * 2 + 1];
        float sr = 0.f, si = 0.f;
        for (int c = 0; c < 64; ++c) { const size_t row = (size_t)g * 2048 + b * 64 + c;
            UA[row * 640 + 512 + p] = f2bf(sr); UA[row * 640 + 576 + p] = f2bf(si);
            const float cr = SC[row * 128 + p], ci = SC[row * 128 + 64 + p];
            const float nr = lr * sr - li * si + cr, ni = lr * si + li * sr + ci; sr = nr; si = ni; }
    }
}

constexpr int SEL_SC = 0, SEL_HIST = 131072, SEL_END = SEL_HIST + 128 * 17 * 4;
__device__ __forceinline__ int suffix_sum64(int x, int rm1, int rm2, int rm3, int& tot) {
    int p = x;
    p += __builtin_amdgcn_update_dpp(0, p, 0x111, 0xf, 0xf, false);
    p += __builtin_amdgcn_update_dpp(0, p, 0x112, 0xf, 0xf, false);
    p += __builtin_amdgcn_update_dpp(0, p, 0x114, 0xf, 0xf, false);
    p += __builtin_amdgcn_update_dpp(0, p, 0x118, 0xf, 0xf, false);
    const int t0 = __builtin_amdgcn_readlane(p, 15), t1 = __builtin_amdgcn_readlane(p, 31), t2 = __builtin_amdgcn_readlane(p, 47), t3 = __builtin_amdgcn_readlane(p, 63);
    p += (t0 & rm1) + (t1 & rm2) + (t2 & rm3);
    tot = t0 + t1 + t2 + t3;
    return tot - p + x;
}
__device__ __forceinline__ int mbcnt64(unsigned long long m) { return (int)__builtin_amdgcn_mbcnt_hi((unsigned)(m >> 32), __builtin_amdgcn_mbcnt_lo((unsigned)m, 0u)); }
__device__ __forceinline__ void p3_select(const Frame& F, bool doB) {
    LAS unsigned short* sc = (LAS unsigned short*)(F.lds + SEL_SC);
    LAS unsigned* hist = (LAS unsigned*)(F.lds + SEL_HIST);
    const bf16_t* QI = WSP(bf16_t, WS_QI); const bf16_t* KIP = WSP(bf16_t, WS_KIP); const float* WIF = WSP(float, WS_WIF);
    unsigned short* IDX = WSP(unsigned short, WS_IDX);
    const int lane = F.lane, n = lane & 31, hf = lane >> 5, wv = F.wave;
    const int rm1 = (lane >> 4) >= 1 ? -1 : 0, rm2 = (lane >> 4) >= 2 ? -1 : 0, rm3 = (lane >> 4) >= 3 ? -1 : 0;
#define SEL_UNIT(L_, QT, B_) int QT = 63 - ((L_) >> 5); const int B_ = (L_) & 31; \
        if (F.G == 256) { const int k_ = F.c >> 5, i_ = (L_) >> 8, pr_ = i_ >> 1;     \
            QT = (i_ & 1) ? (48 - 16 * pr_ + k_) : (63 - 16 * pr_ - k_); }
#define SEL_LOADQK(QT, B_) do { const int tk_ = (B_) * 2048 + (QT) * 32 + n; \
        _Pragma("unroll") for (int h = 0; h < 4; ++h) { wq[h] = WIF[tk_ * 4 + h]; \
            _Pragma("unroll") for (int ks = 0; ks < 4; ++ks) bq[h][ks] = *(const bf16x8*)(QI + (size_t)tk_ * 256 + h * 64 + ks * 16 + hf * 8); } \
        { const int k0 = wv < (QT) + 1 ? wv : 0; const bf16_t* kp = KIP + (size_t)((B_) * 2048 + k0 * 32 + n) * 64 + hf * 8; \
            _Pragma("unroll") for (int ks = 0; ks < 4; ++ks) ka[ks] = *(const bf16x8*)(kp + ks * 16); } } while (0)
    bf16x8 bq[4][4]; float wq[4]; bf16x8 ka[4];
    if (F.c < 2048) { SEL_UNIT(F.c, qt0, b0); SEL_LOADQK(qt0, b0); }
    for (int L = F.c; L < 2048; L += F.G) {
        SEL_UNIT(L, qt, b);
        const int t0 = qt * 32, nkt = qt + 1, tok0 = b * 2048 + t0;
        for (int i = F.tid; i < 128 * 17; i += NTHR) hist[i] = 0u;
        { const int nz = ((nkt * 8 + 63) & ~63) - nkt * 8;
            for (int i = F.tid; i < nz * 32; i += NTHR) { const int nn = i & 31, ch = nkt * 8 + (i >> 5); *(LAS u32x2*)(sc + nn * 2048 + ((ch ^ nn) << 2)) = (u32x2){0u, 0u}; } }
        __syncthreads();
        const unsigned hinc = 1u << (16 * (n & 1));
        for (int kt = wv; kt < nkt; kt += 8) {
            f32x16 acc[4];
#pragma unroll
            for (int h = 0; h < 4; ++h)
#pragma unroll
                for (int r = 0; r < 16; ++r) acc[h][r] = 0.f;
#pragma unroll
            for (int ks = 0; ks < 4; ++ks)
#pragma unroll
                for (int h = 0; h < 4; ++h) acc[h] = __builtin_amdgcn_mfma_f32_32x32x16_bf16(ka[ks], bq[h][ks], acc[h], 0, 0, 0);
            { const int k1 = kt + 8 < nkt ? kt + 8 : kt; const bf16_t* kp = KIP + (size_t)(b * 2048 + k1 * 32 + n) * 64 + hf * 8;
#pragma unroll
                for (int ks = 0; ks < 4; ++ks) ka[ks] = *(const bf16x8*)(kp + ks * 16); }
            unsigned key[16];
#pragma unroll
            for (int r = 0; r < 16; ++r) {
                const int i0 = __float_as_int(acc[0][r]), i1 = __float_as_int(acc[1][r]), i2 = __float_as_int(acc[2][r]), i3 = __float_as_int(acc[3][r]);
                const float isc = wq[0] * __int_as_float(i0 > 0 ? i0 : 0) + wq[1] * __int_as_float(i1 > 0 ? i1 : 0) + wq[2] * __int_as_float(i2 > 0 ? i2 : 0) + wq[3] * __int_as_float(i3 > 0 ? i3 : 0);
                const float y = isc * __builtin_amdgcn_rcpf(1.0f + 0.25f * fabsf(isc));
                key[r] = (unsigned)(y * 8191.75f + 32768.0f);
            }
            if (kt < qt) {
#pragma unroll
                for (int g4 = 0; g4 < 4; ++g4) {
#pragma unroll
                    for (int j = 0; j < 4; ++j) (void)__hip_atomic_fetch_add(hist + (key[g4 * 4 + j] >> 9) * 17 + (n >> 1), hinc, __ATOMIC_RELAXED, __HIP_MEMORY_SCOPE_WORKGROUP);
                    u32x2 w; w.x = key[g4 * 4] | (key[g4 * 4 + 1] << 16); w.y = key[g4 * 4 + 2] | (key[g4 * 4 + 3] << 16);
                    const int chunk = (kt * 32 + 8 * g4 + 4 * hf) >> 2;
                    *(LAS u32x2*)(sc + n * 2048 + ((chunk ^ n) << 2)) = w;
                }
            } else {
                asm volatile("" ::: "memory");
#pragma unroll
                for (int g4 = 0; g4 < 4; ++g4) {
                    unsigned kk[4];
#pragma unroll
                    for (int j = 0; j < 4; ++j) { const int s = kt * 32 + j + 8 * g4 + 4 * hf; const bool valid = s <= t0 + n;
                        kk[j] = valid ? key[g4 * 4 + j] : 0u;
                        (void)__hip_atomic_fetch_add(hist + (kk[j] >> 9) * 17 + (n >> 1), valid ? hinc : 0u, __ATOMIC_RELAXED, __HIP_MEMORY_SCOPE_WORKGROUP); }
                    u32x2 w; w.x = kk[0] | (kk[1] << 16); w.y = kk[2] | (kk[3] << 16);
                    const int chunk = (kt * 32 + 8 * g4 + 4 * hf) >> 2;
                    *(LAS u32x2*)(sc + n * 2048 + ((chunk ^ n) << 2)) = w;
                }
            }
        }
        __syncthreads();
        if (L + F.G < 2048) { SEL_UNIT(L + F.G, qtn, bn); SEL_LOADQK(qtn, bn); }
        for (int qq = 0; qq < (doB ? 4 : 0); ++qq) {
            const int nq = wv * 4 + qq, tq = t0 + nq, nvalid = tq + 1, tok = tok0 + nq;
            LAS unsigned short* lst = sc + nq * 2048; LAS unsigned* cand = (LAS unsigned*)(sc + nq * 2048 + 512);
            if (nvalid <= 256) {
#pragma unroll
                for (int e = 0; e < 4; ++e) { const int p = lane * 4 + e; lst[p] = (unsigned short)(p < nvalid ? p : 0); }
            } else {
                unsigned v[32];
                LAS const unsigned short* rowp = sc + nq * 2048 + ((((lane >> 2) ^ (nq & 15)) << 2) | (lane & 3));
#pragma unroll
                for (int r = 0; r < 32; ++r) v[r] = rowp[r * 64];
                const int sh = 16 * (nq & 1);
                const int hhi = (int)((hist[(64 + lane) * 17 + (nq >> 1)] >> sh) & 0xffffu), hlo = (int)((hist[lane * 17 + (nq >> 1)] >> sh) & 0xffffu);
                int tothi; const int shi = suffix_sum64(hhi, rm1, rm2, rm3, tothi);
                int b1, above;
                if (tothi >= 256) { const unsigned long long mk = __builtin_amdgcn_ballot_w64(shi >= 256); const int lb = 63 - __clzll(mk); b1 = 64 + lb; above = __builtin_amdgcn_readlane(shi - hhi, lb); }
                else { int totlo; const int slo = tothi + suffix_sum64(hlo, rm1, rm2, rm3, totlo); const unsigned long long mk = __builtin_amdgcn_ballot_w64(slo >= 256); const int lb = 63 - __clzll(mk); b1 = lb; above = __builtin_amdgcn_readlane(slo - hlo, lb); }
                const int sw64 = (nq >> 4) << 6, laneE = lane + sw64, laneO = lane - sw64;
                int base = 0, m = 0;
                const unsigned binhi = (unsigned)b1 * 512u + 511u, binlo = b1 ? (unsigned)b1 * 512u : 1u, binspan = binhi - binlo;
#pragma unroll
                for (int r4 = 0; r4 < 32; r4 += 4) {
                    if (r4 * 64 >= nvalid) break;
#pragma unroll
                    for (int rr = 0; rr < 4; ++rr) { const int r = r4 + rr; const unsigned idx = (unsigned)(r * 64 + ((r & 1) ? laneO : laneE));
                        const bool gt_ = v[r] > binhi, eq = (v[r] - binlo) <= binspan;
                        const unsigned long long mg = __builtin_amdgcn_ballot_w64(gt_), me = __builtin_amdgcn_ballot_w64(eq);
                        int pg = base + mbcnt64(mg), cp = m + mbcnt64(me);
                        asm("" : "+v"(pg), "+v"(cp));
                        lst[gt_ ? pg : 256 + lane] = (unsigned short)idx;
                        cand[(eq && cp < 128) ? cp : 128 + lane] = ((v[r] & 511u) << 11) | idx;
                        base += __popcll(mg); m += __popcll(me); }
                }
                if (m <= 128) {
                    const int need = 256 - above;
                    const unsigned c0 = lane < m ? cand[lane] : 0u, c1 = 64 + lane < m ? cand[64 + lane] : 0u;
                    const unsigned a0 = lane < m ? (c0 >> 11) + 1u : 0u, a1 = 64 + lane < m ? (c1 >> 11) + 1u : 0u;
                    unsigned lo = 0u;
                    for (int bit = 9; bit >= 0; --bit) { const unsigned cd = lo | (1u << bit); const int c = __popcll(__builtin_amdgcn_ballot_w64(a0 >= cd)) + __popcll(__builtin_amdgcn_ballot_w64(a1 >= cd)); if (c >= need) lo = cd; }
                    const unsigned long long g0 = __builtin_amdgcn_ballot_w64(a0 > lo), g1 = __builtin_amdgcn_ballot_w64(a1 > lo), e0 = __builtin_amdgcn_ballot_w64(a0 == lo), e1 = __builtin_amdgcn_ballot_w64(a1 == lo);
                    const int ties = need - (__popcll(g0) + __popcll(g1));
                    int k0 = mbcnt64(e0), k1 = __popcll(e0) + mbcnt64(e1); asm("" : "+v"(k0), "+v"(k1));
                    const bool s0 = a0 > lo || (a0 == lo && k0 < ties), s1 = a1 > lo || (a1 == lo && k1 < ties);
                    const unsigned long long m0 = __builtin_amdgcn_ballot_w64(s0), m1 = __builtin_amdgcn_ballot_w64(s1);
                    if (s0) lst[base + mbcnt64(m0)] = (unsigned short)(c0 & 2047u);
                    if (s1) lst[base + __popcll(m0) + mbcnt64(m1)] = (unsigned short)(c1 & 2047u);
                } else {
#pragma unroll
                    for (int r = 0; r < 32; ++r) v[r] = ((r * 64 + ((r & 1) ? laneO : laneE)) < nvalid) ? v[r] : 0u;
                    unsigned lo = 0u;
                    for (int bit = 15; bit >= 0; --bit) { const unsigned cd = lo | (1u << bit); int cnt = 0;
#pragma unroll
                        for (int r = 0; r < 32; ++r) cnt += __popcll(__builtin_amdgcn_ballot_w64(v[r] >= cd));
                        if (cnt >= 256) lo = cd; }
                    int cgt = 0;
#pragma unroll
                    for (int r = 0; r < 32; ++r) cgt += __popcll(__builtin_amdgcn_ballot_w64(v[r] > lo));
                    const int need = 256 - cgt; int bs = 0, eqb = 0;
#pragma unroll
                    for (int r = 0; r < 32; ++r) {
                        const bool gt_ = v[r] > lo, eq = v[r] == lo;
                        const unsigned long long me = __builtin_amdgcn_ballot_w64(eq);
                        const bool sel = gt_ || (eq && eqb + mbcnt64(me) < need);
                        const unsigned long long ms = __builtin_amdgcn_ballot_w64(sel);
                        if (sel) lst[bs + mbcnt64(ms)] = (unsigned short)(r * 64 + ((r & 1) ? laneO : laneE));
                        bs += __popcll(ms); eqb += __popcll(me);
                    }
                }
            }
            *(u32x2*)(IDX + (size_t)tok * 256 + lane * 4) = *(LAS u32x2*)(lst + lane * 4);
        }
        __syncthreads();
    }
}

#undef SEL_UNIT
#undef SEL_LOADQK
__device__ __forceinline__ void p3_memattn(const Frame& F) {
    constexpr int KS = 272, VS = 528, VOFF = 256 * KS;
    const bf16_t* KM = WSP(bf16_t, WS_KM); const bf16_t* VMT = WSP(bf16_t, WS_VMT); const bf16_t* QM = DOP(bf16_t, DO_Y3) + 512; unsigned char* YM8 = DOP(unsigned char, DO_YM8);
    const int lane = F.lane, n = lane & 31, hf = lane >> 5;
    for (int u = F.c; u < 256; u += F.G) {
        const int half = u & 1, bh = u >> 1, b = bh >> 2, h = bh & 3;
#pragma unroll
        for (int i = 0; i < 8; ++i) { const int id = F.tid + 512 * i;
            { const int row = id >> 4, seg = id & 15; *(LAS u32x4*)(F.lds + row * KS + seg * 16) = *(const u32x4*)(KM + ((size_t)bh * 256 + row) * 128 + seg * 8); }
            { const int row = id >> 5, seg = id & 31; *(LAS u32x4*)(F.lds + VOFF + row * VS + seg * 16) = *(const u32x4*)(VMT + ((size_t)bh * 128 + row) * 256 + seg * 8); } }
        __syncthreads();
#pragma unroll 1
        for (int qi = 0; qi < 4; ++qi) {
            const int tok = b * 2048 + half * 1024 + F.wave * 128 + qi * 32 + n;
            const bf16_t* qp = QM + (size_t)tok * Y3LD + h * 128;
            bf16x8 bq[8];
#pragma unroll
            for (int ks = 0; ks < 8; ++ks) bq[ks] = *(const bf16x8*)(qp + ks * 16 + hf * 8);
            float qss = 0.f;
#pragma unroll
            for (int ks = 0; ks < 8; ++ks)
#pragma unroll
                for (int e = 0; e < 8; ++e) { const float f = bf2f((unsigned short)bq[ks][e]); qss += f * f; }
            qss += __shfl_xor(qss, 32);
            const float qc = rsqrtf(qss * (1.0f / 128.0f) + 1e-6f) * (0.08838834764831845f * 1.4426950408889634f);
            f32x16 o[4];
#pragma unroll
            for (int dt = 0; dt < 4; ++dt)
#pragma unroll
                for (int r = 0; r < 16; ++r) o[dt][r] = 0.f;
            float mrun = -3.0e38f, lrun = 0.f;
#pragma unroll 1
            for (int kh = 0; kh < 2; ++kh) {
                f32x16 s[4];
#pragma unroll
                for (int k4 = 0; k4 < 4; ++k4) { const int kt = kh * 4 + k4;
#pragma unroll
                    for (int r = 0; r < 16; ++r) s[k4][r] = 0.f;
#pragma unroll
                    for (int ks = 0; ks < 8; ++ks) { const bf16x8 a = *(const LAS bf16x8*)(F.lds + (kt * 32 + n) * KS + (ks * 16 + hf * 8) * 2);
                        s[k4] = __builtin_amdgcn_mfma_f32_32x32x16_bf16(a, bq[ks], s[k4], 0, 0, 0); } }
                float mx = mrun;
#pragma unroll
                for (int k4 = 0; k4 < 4; ++k4)
#pragma unroll
                    for (int r = 0; r < 16; ++r) mx = fmaxf(mx, s[k4][r]);
                mx = fmaxf(mx, __shfl_xor(mx, 32));
                const float resc = __builtin_amdgcn_exp2f((mrun - mx) * qc);
                float sum = 0.f;
#pragma unroll
                for (int k4 = 0; k4 < 4; ++k4)
#pragma unroll
                    for (int r = 0; r < 16; ++r) { const float p = __builtin_amdgcn_exp2f((s[k4][r] - mx) * qc); s[k4][r] = p; sum += p; }
                sum += __shfl_xor(sum, 32);
                lrun = lrun * resc + sum; mrun = mx;
#pragma unroll
                for (int dt = 0; dt < 4; ++dt)
#pragma unroll
                    for (int r = 0; r < 16; ++r) o[dt][r] *= resc;
#pragma unroll
                for (int k4 = 0; k4 < 4; ++k4)
#pragma unroll
                    for (int st = 0; st < 2; ++st) { const int kt = kh * 4 + k4;
                        union { u32x4 u; bf16x8 v; } pb;
                        pb.u.x = cvt_pk_bf16(s[k4][8 * st + 0], s[k4][8 * st + 1]); pb.u.y = cvt_pk_bf16(s[k4][8 * st + 2], s[k4][8 * st + 3]);
                        pb.u.z = cvt_pk_bf16(s[k4][8 * st + 4], s[k4][8 * st + 5]); pb.u.w = cvt_pk_bf16(s[k4][8 * st + 6], s[k4][8 * st + 7]);
#pragma unroll
                        for (int dt = 0; dt < 4; ++dt) { const bf16x8 a = *(const LAS bf16x8*)(F.lds + VOFF + (dt * 32 + n) * VS + (kt * 32 + 16 * st + 8 * hf) * 2);
                            o[dt] = __builtin_amdgcn_mfma_f32_32x32x16_bf16(a, pb.v, o[dt], 0, 0, 0); }
                    }
            }
            const float inv = 16.0f / lrun;
#pragma unroll
            for (int dt = 0; dt < 4; ++dt)
#pragma unroll
                for (int g4 = 0; g4 < 4; ++g4)
                    *(unsigned*)(YM8 + (size_t)tok * 512 + h * 128 + dt * 32 + 8 * g4 + 4 * hf) = pack_fp8x4(o[dt][g4 * 4] * inv, o[dt][g4 * 4 + 1] * inv, o[dt][g4 * 4 + 2] * inv, o[dt][g4 * 4 + 3] * inv);
        }
        __syncthreads();
    }
}

__device__ __forceinline__ void p4_attend(const Frame& F, const Args& a) {
    constexpr int WB = 2 * 8192 + 1024;
    LAS unsigned char* wb = F.lds + F.wave * WB;
    LAS unsigned short* lst = (LAS unsigned short*)(wb + 16384);
    const unsigned short* IDX = WSP(unsigned short, WS_IDX); const unsigned char* KVP8 = WSP(unsigned char, WS_KVP); const bf16_t* Q = DOP(bf16_t, DO_Y3); unsigned char* YD8 = DOP(unsigned char, DO_YD8);
    const int lane = F.lane, n = lane & 15, g = lane >> 4, gw = F.c * 8 + F.wave, nw = F.G * 8;
    const int ntk = (T - gw + nw - 1) / nw;
    float gkm = fabsf(INP(I_GK)[lane]);
    gkm = fmaxf(gkm, __shfl_xor(gkm, 32)); gkm = fmaxf(gkm, __shfl_xor(gkm, 16)); gkm = fmaxf(gkm, __shfl_xor(gkm, 8)); gkm = fmaxf(gkm, __shfl_xor(gkm, 4)); gkm = fmaxf(gkm, __shfl_xor(gkm, 2)); gkm = fmaxf(gkm, __shfl_xor(gkm, 1));
    const float kmax = 8.0f * gkm * 1.07f;
    int koff[4][2];
#pragma unroll
    for (int blk = 0; blk < 4; ++blk)
#pragma unroll
        for (int ks = 0; ks < 2; ++ks) { const int row = blk * 16 + n, pc = ks * 2 + (g >> 1); koff[blk][ks] = row * 128 + ((pc ^ (row & 7)) << 4) + 8 * (g & 1); }
    const int q8 = n >> 1, p8 = n & 1;
    int toff[2][4];
#pragma unroll
    for (int kb2 = 0; kb2 < 2; ++kb2)
#pragma unroll
        for (int d = 0; d < 4; ++d) { const int row = (kb2 * 2 + (q8 >> 2)) * 16 + g * 4 + (q8 & 3), pc = 4 + d; toff[kb2][d] = row * 128 + ((pc ^ (row & 7)) << 4) + 8 * p8; }
    const int grow = lane >> 3, gpc = lane & 7;
    const unsigned wbase = (unsigned)(uintptr_t)wb;
#define AT_ISSUE(TOK, LB, CH, BUF) do { const char* _kb = (const char*)(KVP8 + (size_t)((TOK) >> 11) * 2048 * 128); \
        _Pragma("unroll") for (int _i = 0; _i < 8; ++_i) { const int _row = 8 * _i + grow; const int _key = lst[(LB) * 256 + (CH) * 64 + _row]; \
            __builtin_amdgcn_global_load_lds((const unsigned*)(_kb + (size_t)_key * 128 + ((gpc ^ (_row & 7)) << 4)), (LAS unsigned*)(wb + (BUF) * 8192 + _i * 1024), 16, 0, 0); } } while (0)
    if (ntk <= 0) return;
    { const u32x2 l0 = *(const u32x2*)(IDX + (size_t)gw * 256 + lane * 4); *(LAS u32x2*)(lst + lane * 4) = l0; }
    float gq1[8], gq2[8];
#pragma unroll
    for (int e = 0; e < 8; ++e) { gq1[e] = INP(I_GQ)[g * 8 + e]; gq2[e] = INP(I_GQ)[32 + g * 8 + e]; }
    const f32x4* CS = WSP(f32x4, WS_CS);
    bf16x8 nbq[2]; f32x4 ncs[4];
#pragma unroll
    for (int e = 0; e < 4; ++e) ncs[e] = CS[(size_t)gw * 16 + g * 4 + e];
#pragma unroll
    for (int ks = 0; ks < 2; ++ks) { if (n < 8) nbq[ks] = *(const bf16x8*)(Q + (size_t)gw * Y3LD + n * 64 + ks * 32 + g * 8); else nbq[ks] = (bf16x8){0, 0, 0, 0, 0, 0, 0, 0}; }
    AT_ISSUE(gw, 0, 0, 0); AT_ISSUE(gw, 0, 1, 1);
#pragma unroll 1
    for (int k = 0; k < ntk; ++k) {
        const int tok = gw + k * nw, ntok = tok + nw, lb = k & 1; const bool hasn = (k + 1 < ntk);
        const int tq = tok & 2047, cnt = tq + 1 < 256 ? tq + 1 : 256;
        long bq[2]; float qs = 0.f;
        { float x1[8], x2[8], ss = 0.f;
#pragma unroll
            for (int e = 0; e < 8; ++e) { x1[e] = bf2f((unsigned short)nbq[0][e]); x2[e] = bf2f((unsigned short)nbq[1][e]); ss += x1[e] * x1[e] + x2[e] * x2[e]; }
            ss += __shfl_xor(ss, 16); ss += __shfl_xor(ss, 32);
            const float rs = rsqrtf(ss * (1.0f / 64.0f) + 1e-6f) * (0.125f * 1.4426950408889634f); float o1[8], o2[8];
#pragma unroll
            for (int e = 0; e < 8; ++e) { const float cs = ncs[e >> 1][(e & 1) * 2], sn = ncs[e >> 1][(e & 1) * 2 + 1], y1 = x1[e] * rs * gq1[e], y2 = x2[e] * rs * gq2[e];
                o1[e] = y1 * cs - y2 * sn; o2[e] = y2 * cs + y1 * sn; qs += o1[e] * o1[e] + o2[e] * o2[e]; }
            const unsigned a0 = pack_fp8x4(o1[0], o1[1], o1[2], o1[3]), a1 = pack_fp8x4(o1[4], o1[5], o1[6], o1[7]), b0 = pack_fp8x4(o2[0], o2[1], o2[2], o2[3]), b1 = pack_fp8x4(o2[4], o2[5], o2[6], o2[7]);
            bq[0] = (long)(((unsigned long long)a1 << 32) | a0); bq[1] = (long)(((unsigned long long)b1 << 32) | b0); }
        qs += __shfl_xor(qs, 16); qs += __shfl_xor(qs, 32);
        const float shift = __builtin_amdgcn_sqrtf(qs) * 1.07f * kmax - 7.0f;
        const f32x4 nsh = (f32x4){-shift, -shift, -shift, -shift};
        u32x2 nl = (u32x2){0u, 0u};
        if (hasn) { nl = *(const u32x2*)(IDX + (size_t)ntok * 256 + lane * 4);
#pragma unroll
            for (int e = 0; e < 4; ++e) ncs[e] = CS[(size_t)ntok * 16 + g * 4 + e];
#pragma unroll
            for (int ks = 0; ks < 2; ++ks) if (n < 8) nbq[ks] = *(const bf16x8*)(Q + (size_t)ntok * Y3LD + n * 64 + ks * 32 + g * 8); }
        f32x4 o[4];
#pragma unroll
        for (int d = 0; d < 4; ++d) o[d] = (f32x4){0.f, 0.f, 0.f, 0.f};
        float lsum = 0.f;
#pragma unroll
        for (int ch = 0; ch < 4; ++ch) {
            const int buf = ch & 1;
            if (ch == 3 && !hasn) asm volatile("s_waitcnt vmcnt(0)" ::: "memory"); else asm volatile("s_waitcnt vmcnt(8)" ::: "memory");
            LAS const unsigned char* bb = wb + buf * 8192;
            f32x4 s[4];
#pragma unroll
            for (int blk = 0; blk < 4; ++blk) {
                const long k0 = *(LAS const long*)(bb + koff[blk][0]), k1 = *(LAS const long*)(bb + koff[blk][1]);
                s[blk] = __builtin_amdgcn_mfma_f32_16x16x32_fp8_fp8(k0, bq[0], nsh, 0, 0, 0);
                s[blk] = __builtin_amdgcn_mfma_f32_16x16x32_fp8_fp8(k1, bq[1], s[blk], 0, 0, 0);
            }
            if (cnt >= (ch + 1) * 64) {
#pragma unroll
                for (int blk = 0; blk < 4; ++blk)
#pragma unroll
                    for (int j = 0; j < 4; ++j) { const float e = __builtin_amdgcn_exp2f(s[blk][j]); s[blk][j] = e; lsum += e; }
            } else {
                asm volatile("" ::: "memory");
#pragma unroll
                for (int blk = 0; blk < 4; ++blk)
#pragma unroll
                    for (int j = 0; j < 4; ++j) { const int p = ch * 64 + blk * 16 + g * 4 + j; const float e = p < cnt ? __builtin_amdgcn_exp2f(s[blk][j]) : 0.f; s[blk][j] = e; lsum += e; }
            }
#pragma unroll
            for (int kb2 = 0; kb2 < 2; ++kb2) {
                const unsigned plo = pack_fp8x4_nc(s[2 * kb2][0], s[2 * kb2][1], s[2 * kb2][2], s[2 * kb2][3]), phi = pack_fp8x4_nc(s[2 * kb2 + 1][0], s[2 * kb2 + 1][1], s[2 * kb2 + 1][2], s[2 * kb2 + 1][3]);
                const long pb = (long)(((unsigned long long)phi << 32) | plo);
                u32x2 tr[4];
#pragma unroll
                for (int d = 0; d < 4; ++d) asm volatile("ds_read_b64_tr_b8 %0, %1 offset:%2" : "=&v"(tr[d]) : "v"(wbase + (unsigned)toff[kb2][d]), "i"(buf * 8192) : "memory");
                asm volatile("s_waitcnt lgkmcnt(0)" : "+v"(tr[0]), "+v"(tr[1]), "+v"(tr[2]), "+v"(tr[3]) :: "memory");
#pragma unroll
                for (int d = 0; d < 4; ++d) { const long av = (long)(((unsigned long long)tr[d].y << 32) | tr[d].x);
                    o[d] = __builtin_amdgcn_mfma_f32_16x16x32_fp8_fp8(av, pb, o[d], 0, 0, 0); }
            }
            __builtin_amdgcn_sched_barrier(0);
            if (ch == 1 && hasn) *(LAS u32x2*)(lst + (lb ^ 1) * 256 + lane * 4) = nl;
            if (ch < 2) AT_ISSUE(tok, lb, ch + 2, buf);
            else if (hasn) AT_ISSUE(ntok, lb ^ 1, ch - 2, buf);
            __builtin_amdgcn_sched_barrier(0);
        }
        lsum += __shfl_xor(lsum, 16); lsum += __shfl_xor(lsum, 32);
        const float inv = 16.0f / lsum;
        if (n < 8) {
#pragma unroll
            for (int d = 0; d < 4; ++d) *(unsigned*)(YD8 + (size_t)tok * 512 + n * 64 + d * 16 + g * 4) = pack_fp8x4(o[d][0] * inv, o[d][1] * inv, o[d][2] * inv, o[d][3] * inv);
        }
    }
#undef AT_ISSUE
}

__device__ __forceinline__ void p8_router(const Frame& F, const Args& a, bool commit) {
    const bf16_t* X1B = WSP(bf16_t, WS_X1B); const bf16_t* WR = WSP(bf16_t, WS_WR);
    int* TOK = WSP(int, WS_TOK); float2* RW = WSP(float2, WS_RW); int* TOK2 = WSP(int, WS_TOK2); unsigned* gcnt = (unsigned*)(F.ws + WS_CTL + CTL_GCNT);
    constexpr int WRS = 2064, RT_LG = 48 * WRS, RT_RS = RT_LG + 8 * 16 * 48 * 4, RT_LC = RT_RS + 8 * 16 * 4;
    LAS float* lg = (LAS float*)(F.lds + RT_LG) + F.wave * (16 * 48);
    LAS float* rsb = (LAS float*)(F.lds + RT_RS) + F.wave * 16;
    LAS int* lc = (LAS int*)(F.lds + RT_LC); LAS int* lbase = lc + 144;
    const int lane = F.lane, n = lane & 15, q = lane >> 4;
    for (int i = F.tid; i < 48 * 128; i += NTHR) { const int r = i >> 7, c = i & 127; *(LAS u32x4*)(F.lds + r * WRS + c * 16) = *(const u32x4*)(WR + (size_t)r * 1024 + c * 8); }
    __syncthreads();
    for (int it = F.c; it < T / 128; it += F.G) {
        const int tw = it * 128 + F.wave * 16;
        if (F.tid < 144) lc[F.tid] = 0;
        const bf16_t* xp = X1B + (size_t)(tw + n) * 1024 + q * 8;
        f32x4 acc[3] = {(f32x4){0.f, 0.f, 0.f, 0.f}, (f32x4){0.f, 0.f, 0.f, 0.f}, (f32x4){0.f, 0.f, 0.f, 0.f}};
        float ss = 0.f;
#pragma unroll
        for (int hb = 0; hb < 2; ++hb) {
            bf16x8 av[16];
#pragma unroll
            for (int k2 = 0; k2 < 16; ++k2) av[k2] = *(const bf16x8*)(xp + (hb * 16 + k2) * 32);
#pragma unroll
            for (int k2 = 0; k2 < 16; ++k2) { const int ks = hb * 16 + k2;
#pragma unroll
                for (int j = 0; j < 8; ++j) { const float f = bf2f((unsigned short)av[k2][j]); ss += f * f; }
#pragma unroll
                for (int bl = 0; bl < 3; ++bl) { const bf16x8 bb = *(const LAS bf16x8*)(F.lds + (bl * 16 + n) * WRS + (ks * 32 + q * 8) * 2);
                    acc[bl] = __builtin_amdgcn_mfma_f32_16x16x32_bf16(av[k2], bb, acc[bl], 0, 0, 0); } }
        }
        ss += __shfl_xor(ss, 16); ss += __shfl_xor(ss, 32);
        const float rs = rsqrtf(ss * (1.0f / 1024.0f) + 1e-6f);
        if (q == 0) rsb[n] = rs;
#pragma unroll
        for (int bl = 0; bl < 3; ++bl)
#pragma unroll
            for (int j = 0; j < 4; ++j) lg[(q * 4 + j) * 48 + bl * 16 + n] = acc[bl][j] * rsb[q * 4 + j];
        __syncthreads();
        int l1 = 0, l2 = 0, lp = 0, r1 = 0, r2 = 0, rp = 0, s1 = 0; float wa = 0.f, wb = 0.f, myrs = 0.f;
        if (lane < 16) {
            LAS const float* l = lg + lane * 48; myrs = rsb[lane];
            float g0 = l[0] + INP(I_BGROUP)[0]; int gi = 0; float gm = g0, gl[4]; gl[0] = g0;
#pragma unroll
            for (int j = 1; j < 4; ++j) { gl[j] = l[j] + INP(I_BGROUP)[j]; if (gl[j] > gm) { gm = gl[j]; gi = j; } }
            float gs = 0.f;
#pragma unroll
            for (int j = 0; j < 4; ++j) gs += __expf(gl[j] - gm);
            const float ggate = 1.0f / gs;
            float e1 = -3.0e38f, e2 = -3.0e38f; int i1 = 0, i2 = 0;
            for (int e = 0; e < 8; ++e) { const float v = l[4 + gi * 8 + e] + INP(I_BEXP)[gi * 8 + e];
                if (v > e1) { e2 = e1; i2 = i1; e1 = v; i1 = e; } else if (v > e2) { e2 = v; i2 = e; } }
            const float pa = 1.0f / (1.0f + __expf(e2 - e1));
            wa = ggate * pa; wb = ggate - wa;
            s1 = i1 < i2 ? 0 : 1;
            const int elo = i1 < i2 ? i1 : i2, ehi = i1 < i2 ? i2 : i1;
            l1 = gi * 8 + i1; l2 = gi * 8 + i2; lp = 32 + gi * 28 + (elo * (15 - elo)) / 2 + (ehi - elo - 1);
            r1 = atomicAdd((int*)(lc + l1), 1); r2 = atomicAdd((int*)(lc + l2), 1); rp = atomicAdd((int*)(lc + lp), 1);
        }
        __syncthreads();
        if (F.tid < 144) { const int cn = lc[F.tid]; lbase[F.tid] = (cn > 0 && commit) ? (int)atomicAdd(gcnt + F.tid * 64, (unsigned)cn) : 0; }
        __syncthreads();
        if (lane < 16 && commit) { const int t = tw + lane;
            const size_t p1 = (size_t)l1 * 65536 + lbase[l1] + r1, p2 = (size_t)l2 * 65536 + lbase[l2] + r2;
            TOK[p1] = t | (s1 << 31); RW[p1] = make_float2(myrs, wa); TOK[p2] = t | ((s1 ^ 1) << 31); RW[p2] = make_float2(myrs, wb);
            TOK2[(size_t)(lp - 32) * 65536 + lbase[lp] + rp] = t; }
        __syncthreads();
    }
}

__device__ __forceinline__ int moe_table(const Frame& F, int first, int count) {
    LAS int* misc = (LAS int*)(F.lds + MISC_OFF); const unsigned* gcnt = (const unsigned*)(F.ws + WS_CTL + CTL_GCNT);
    __syncthreads();
    if (F.tid < count) misc[MI_CNT + F.tid] = (int)__hip_atomic_load(gcnt + (first + F.tid) * 64, __ATOMIC_RELAXED, __HIP_MEMORY_SCOPE_AGENT);
    if (F.tid >= 256 && F.tid < 256 + 28) { const int pi = F.tid - 256; int elo = 0; while (elo < 6 && ((elo + 1) * (15 - (elo + 1))) / 2 <= pi) ++elo;
        misc[MI_PT + pi] = elo | ((pi - (elo * (15 - elo)) / 2 + elo + 1) << 4); }
    __syncthreads();
    if (F.tid == 0) { int run = 0; for (int l = 0; l < count; ++l) { misc[MI_PRE + l] = run; run += (misc[MI_CNT + l] + 255) >> 8; } misc[MI_PRE + count] = run; }
    __syncthreads();
    const int nt = misc[MI_PRE + count];
    for (int idx = F.tid; idx < nt && idx < 640; idx += NTHR) { int l = 0; while (l < count - 1 && misc[MI_PRE + l + 1] <= idx) ++l; misc[MI_TILE + idx] = l | ((idx - misc[MI_PRE + l]) << 8); }
    __syncthreads();
    return nt < 640 ? nt : 640;
}

__global__ void __launch_bounds__(NTHR, 2) fwd(Args a) {
    extern __shared__ __attribute__((aligned(16))) unsigned char lds_raw[];
    Frame F;
    F.lds = (LAS unsigned char*)lds_raw; F.tid = threadIdx.x; F.lane = F.tid & 63; F.wave = __builtin_amdgcn_readfirstlane(F.tid >> 6); F.G = gridDim.x; F.c = blockIdx.x;
    F.ws = a.ws; F.dout = (unsigned char*)a.out;
    LAS unsigned* misc = (LAS unsigned*)(F.lds + MISC_OFF);
    for (int i = F.tid; i < 1024; i += NTHR) misc[i] = 0u;
    __syncthreads();
    XcdBarrier bar; bar.bar = (unsigned*)(F.ws + WS_CTL); bar.x = 0; bar.st = (volatile LAS unsigned*)misc;
    const int lo = a.ph_lo, hi = a.ph_hi;
    if (hi - lo > 1) bar = xcd_barrier_post((unsigned*)(F.ws + WS_CTL), (volatile LAS unsigned*)misc);
#ifndef PH_MASK
#define PH_MASK 0xFFF
#endif
#define IN(k) (((PH_MASK >> (k)) & 1) && lo <= (k) && (k) < hi)
#ifndef REP_MASK
#define REP_MASK 0
#endif
#define NREP(k) (1 + ((REP_MASK >> (k)) & 1))
#define SEAM(k) do { if (IN(k) && IN((k) + 1)) xcd_barrier(bar); } while (0)
    bf16_t* HB = WSP(bf16_t, WS_HB); bf16_t* UA = WSP(bf16_t, WS_UA); unsigned char* SG = WSP(unsigned char, WS_SG);
    bf16_t* Y3 = DOP(bf16_t, DO_Y3); bf16_t* YG = WSP(bf16_t, WS_YG);
    LAS const int* imisc = (LAS const int*)(F.lds + MISC_OFF);

    if (IN(0)) for (int rep = 0; rep < NREP(0); ++rep) { p0_prep(F, a); __syncthreads(); }
    SEAM(0);
    if (IN(0) && IN(1)) {
        if (F.tid == 0) { unsigned* bw = (unsigned*)(F.ws + WS_CTL); bool bal = (F.G % 8) == 0;
            for (int j = 0; j < 16; ++j) { const unsigned cj = xb_ld(&bw[XB_XCNT(j)]); bal = bal && (cj == (j < 8 ? (unsigned)F.G / 8u : 0u)); }
            misc[3] = bal ? (misc[2] * 8u + bar.x) : (unsigned)blockIdx.x; }
        __syncthreads();
        F.c = (int)misc[3];
    }
    if (IN(1)) {
        { pg8::Gemm g{512, 512, 512, 0x7f, 0x7a};
          pg8::SchedGrid S{(const char*)WSP(unsigned char, WS_HB8), (const char*)WSP(unsigned char, WS_WG8), 0, 0, (size_t)256 * 1024, (size_t)256 * 1024, 256, 18, 1, F.G, F.c, NREP(1)};
          EpiInProj E{UA, Y3, SG};
          pg8::gemm_phase<EpiInProj, pg8::SchedGrid, false, PG8_SP2, true>(F.lds, g, S, E); }
        { pg8::Gemm g{1024, 1024, 1024}; pg8::SchedGrid S{(const char*)HB, (const char*)WSP(bf16_t, WS_WIN), 0, 0, (size_t)256 * 1024 * 2, (size_t)256 * 1024 * 2, 256, 2, 1, F.G, F.c, NREP(1)};
          EpiInProjB E{WSP(bf16_t, WS_KVX), WSP(bf16_t, WS_QI)};
          pg8::gemm_phase<EpiInProjB, pg8::SchedGrid, false>(F.lds, g, S, E); }
        { pg8::Gemm g{512, 512, 512, 0x7f, 0x7a};
          pg8::SchedGrid S{(const char*)WSP(unsigned char, WS_MEMN), (const char*)WSP(unsigned char, WS_WMEM), 0, 0, (size_t)256 * 1024, (size_t)256 * 1024, 32, 4, 1, F.G, F.c, NREP(1)};
          EpiBf16 E{WSP(bf16_t, WS_KMVM), 1024};
          pg8::gemm_phase<EpiBf16, pg8::SchedGrid, false, PG8_SP2, true>(F.lds, g, S, E); }
        if (F.G > 128) { if (F.c >= 128) p1_tables(F, a, F.c - 128, F.G - 128); } else p1_tables(F, a, F.c, F.G);
    }
    SEAM(1);
    if (IN(2)) {
        { pg8::Gemm g{640, 512, 512}; pg8::SchedGrid S{(const char*)UA, (const char*)WSP(bf16_t, WS_SIN), (size_t)2048 * 640 * 2, (size_t)256 * 512 * 2, (size_t)256 * 640 * 2, (size_t)256 * 512 * 2, 8, 1, 32, F.G, F.c, NREP(2)};
          EpiSc E{WSP(float, WS_SC)};
          pg8::gemm_phase<EpiSc, pg8::SchedGrid, false>(F.lds, g, S, E); }
        for (int rep = 0; rep < NREP(15); ++rep) p2_post(F, a, rep < NREP(15) - 1);
    }
    SEAM(2);
#ifndef P3_SUB
#define P3_SUB 7
#endif
    if (IN(3)) { for (int rep = 0; rep < NREP(13); ++rep) { if (P3_SUB & 1) p3_scan(F); } for (int rep = 0; rep < NREP(3); ++rep) { if (P3_SUB & 2) p3_select(F, rep == 0 || (REP_MASK & 0x10000)); } for (int rep = 0; rep < NREP(12); ++rep) if (P3_SUB & 4) p3_memattn(F); }
    SEAM(3);
    if (IN(4)) {
        { pg8::Gemm g{640, 640, 640}; pg8::SchedGrid S{(const char*)UA, (const char*)WSP(bf16_t, WS_TW), (size_t)2048 * 640 * 2, (size_t)512 * 640 * 2, (size_t)256 * 640 * 2, (size_t)256 * 640 * 2, 8, 2, 32, F.G, F.c, NREP(4)};
          EpiGelu E{YG};
          pg8::gemm_phase<EpiGelu, pg8::SchedGrid, false>(F.lds, g, S, E); }
        for (int rep = 0; rep < NREP(14); ++rep) p4_attend(F, a);
    }
    SEAM(4);
    if (IN(5)) {
        pg8::Gemm g{512, 512, 512}; pg8::SchedGrid S{(const char*)YG, (const char*)WSP(bf16_t, WS_WGLU), 0, 0, (size_t)256 * 512 * 2, (size_t)256 * 512 * 2, 256, 2, 1, F.G, F.c, NREP(5)};
        EpiGlu E{YG, DOP(unsigned char, DO_YS8)};
        pg8::gemm_phase<EpiGlu, pg8::SchedGrid, false>(F.lds, g, S, E);
    }
    SEAM(5);
    if (IN(6)) {
        pg8::Gemm g{256, 768, 768, 0x7b, 0x7a};
        SchedMerge3 S{(const char*)DOP(unsigned char, DO_Y8), (const char*)WSP(unsigned char, WS_WUP), F.G, F.c, NREP(6)};
        EpiMerge E{SG, (unsigned char*)HB};
        pg8::gemm_phase<EpiMerge, SchedMerge3, false, PG8_SP2, true>(F.lds, g, S, E);
    }
    SEAM(6);
    if (IN(7)) {
        pg8::Gemm g{512, 512, 512, 0x7c, 0x7a};
        pg8::SchedGrid S{(const char*)HB, (const char*)WSP(unsigned char, WS_WOUT), 0, 0, (size_t)256 * 1024, (size_t)256 * 1024, 256, 4, 1, F.G, F.c, NREP(7)};
        EpiOut E{INP(I_X), WSP(bf16_t, WS_X1B), WSP(unsigned char, WS_X1B8)};
        pg8::gemm_phase<EpiOut, pg8::SchedGrid, false, PG8_SP2, true>(F.lds, g, S, E);
    }
    SEAM(7);
    if (IN(8)) for (int rep = 0; rep < NREP(8); ++rep) p8_router(F, a, rep == NREP(8) - 1);
    SEAM(8);
    if (IN(9)) {
        const int nt = moe_table(F, 0, 32);
        pg8::Gemm g{512, 512, 512, 0x7f, 0x7a};
        SchedMoE1 S{(const char*)WSP(unsigned char, WS_X1B8), (const char*)WSP(unsigned char, WS_WGU), imisc, WSP(int, WS_TOK), nt * 4, F.G, F.c, NREP(9)};
        EpiMoe1 E{imisc, WSP(int, WS_TOK), WSP(float2, WS_RW), WSP(unsigned char, WS_HID)};
        pg8::gemm_phase<EpiMoe1, SchedMoE1, true, PG8_SP2, true>(F.lds, g, S, E);
    }
    SEAM(9);
    if (IN(10)) {
        const int nt = moe_table(F, 32, 112);
        pg8::Gemm g{512, 256, 512, 0x7b, 0x7a};
        SchedMoE2 S{(const char*)WSP(unsigned char, WS_HID), (const char*)WSP(unsigned char, WS_WD), imisc, WSP(int, WS_TOK2), nt * 4, F.G, F.c, NREP(10)};
        EpiMoe2 E{imisc, WSP(int, WS_TOK2), WSP(bf16_t, WS_X1B), a.out};
        pg8::gemm_phase<EpiMoe2, SchedMoE2, true, PG8_SP2, true>(F.lds, g, S, E);
    }
#undef IN
#undef SEAM
}

extern "C" void kernel_launch(void* const* d_in, const int* in_sizes, int n_in, void* d_out, int out_size, void* d_ws, size_t ws_size, hipStream_t stream) {
    static int grid = 0;
    if (grid == 0) {
        if (n_in != 32 || out_size != T * D || ws_size < WS_END) { fprintf(stderr, "kernel_launch: unexpected shapes: n_in %d out %d ws %zu (need %zu)\n", n_in, out_size, ws_size, (size_t)WS_END); grid = -1; return; }
        int dev = 0, cus = 0;
        if (hipGetDevice(&dev) != hipSuccess || hipDeviceGetAttribute(&cus, hipDeviceAttributeMultiprocessorCount, dev) != hipSuccess) { grid = -1; return; }
        if (hipFuncSetAttribute((const void*)fwd, hipFuncAttributeMaxDynamicSharedMemorySize, LDS_BYTES) != hipSuccess) { fprintf(stderr, "kernel_launch: hipFuncSetAttribute failed\n"); grid = -1; return; }
        int per_cu = 0;
        if (hipOccupancyMaxActiveBlocksPerMultiprocessor(&per_cu, (const void*)fwd, NTHR, LDS_BYTES) != hipSuccess || per_cu < 1) fprintf(stderr, "kernel_launch: occupancy query reports %d\n", per_cu);
        (void)hipGetLastError();
        grid = cus;
    }
    if (grid < 0) return;
    (void)hipMemsetAsync((char*)d_ws + WS_CTL, 0, CTL_BYTES, stream);
    Args a{};
    for (int i = 0; i < 32; ++i) a.in[i] = d_in[i];
    a.out = (float*)d_out; a.ws = (unsigned char*)d_ws;
#if MK_PER_PHASE
    for (int ph = 0; ph < NPHASE; ++ph) { a.ph_lo = ph; a.ph_hi = ph + 1; hipLaunchKernelGGL(fwd, dim3(grid), dim3(NTHR), LDS_BYTES, stream, a); }
#else
    a.ph_lo = 0; a.ph_hi = NPHASE; hipLaunchKernelGGL(fwd, dim3(grid), dim3(NTHR), LDS_BYTES, stream, a);
#endif
}
```

```cpp
#include <hip/hip_runtime.h>
#include <stdio.h>
#include <stdint.h>

#ifndef MK_PER_PHASE
#define MK_PER_PHASE 0
#endif

#define LAS __attribute__((address_space(3)))
typedef unsigned short bf16_t;
typedef short bf16x8 __attribute__((ext_vector_type(8)));
typedef float f32x4 __attribute__((ext_vector_type(4)));
typedef float f32x16 __attribute__((ext_vector_type(16)));
typedef unsigned u32x4 __attribute__((ext_vector_type(4)));
typedef unsigned u32x2 __attribute__((ext_vector_type(2)));

constexpr int T = 65536, NB = 32, SEQ = 2048, D = 1024;
constexpr int NTHR = 512;
constexpr int LDS_BYTES = 147456, MISC_OFF = LDS_BYTES - 4096;
constexpr int NPHASE = 11;

constexpr size_t WS_CTL = 0, CTL_BYTES = 65536;
constexpr size_t CTL_GCNT = 16384;
constexpr size_t WS_WIN = WS_CTL + CTL_BYTES;
constexpr size_t WS_WMEM = WS_WIN + (size_t)5120 * 1024 * 2;
constexpr size_t WS_WGLU = WS_WMEM + (size_t)1024 * 1024 * 2;
constexpr size_t WS_WUP = WS_WGLU + (size_t)512 * 512 * 2;
constexpr size_t WS_WOUT = WS_WUP + (size_t)3 * 1024 * 512 * 2;
constexpr size_t WS_WGU = WS_WOUT + (size_t)1024 * 1024 * 2;
constexpr size_t WS_WD = WS_WGU + (size_t)32 * 1024 * 1024 * 2;
constexpr size_t WS_TW = WS_WD + (size_t)32 * 1024 * 512 * 2;
constexpr size_t WS_SIN = WS_TW + (size_t)32 * 512 * 640 * 2;
constexpr size_t WS_LAM32 = WS_SIN + (size_t)32 * 256 * 512 * 2;
constexpr size_t WS_WR = WS_LAM32 + 16384;
constexpr size_t WS_HB = WS_WR + 98304;
constexpr size_t WS_UA = WS_HB + (size_t)T * 1024 * 2;
constexpr size_t WS_KVX = WS_UA + (size_t)32 * 2048 * 640 * 2;
constexpr size_t WS_KVP = WS_KVX + (size_t)T * 256 * 2;
constexpr size_t WS_KIP = WS_KVP + (size_t)T * 128 * 2;
constexpr size_t WS_WIF = WS_KIP + (size_t)T * 64 * 2;
constexpr size_t WS_QI = WS_WIF + (size_t)T * 4 * 4;
constexpr size_t WS_SG = WS_QI + (size_t)T * 256 * 2;
constexpr size_t WS_X1B = WS_SG;
constexpr size_t WS_HID = WS_SG + (size_t)T * 3072;
constexpr size_t WS_X1B8 = WS_HID + (size_t)T * 1024;
constexpr size_t WS_SC = WS_HID + (size_t)T * 1024 * 2;
constexpr size_t WS_IDX = WS_SC + (size_t)32 * 2048 * 128 * 4;
constexpr size_t WS_MEMN = WS_IDX + (size_t)T * 256 * 2;
constexpr size_t WS_KMVM = WS_MEMN + (size_t)8192 * 1024 * 2;
constexpr size_t WS_KM = WS_KMVM + (size_t)8192 * 1024 * 2;
constexpr size_t WS_VMT = WS_KM + (size_t)128 * 256 * 128 * 2;
constexpr size_t WS_TOK = WS_VMT + (size_t)128 * 128 * 256 * 2;
constexpr size_t WS_RW = WS_TOK + (size_t)32 * 65536 * 4;
constexpr size_t WS_TOK2 = WS_RW + (size_t)32 * 65536 * 8;
constexpr size_t WS_LP = WS_TOK2 + (size_t)112 * 65536 * 4;
constexpr size_t WS_BB = WS_LP + (size_t)32 * 64 * 33 * 8;
constexpr size_t WS_HB8 = WS_BB + (size_t)32 * 64 * 16 * 8;
constexpr size_t WS_WG8 = WS_HB8 + (size_t)T * 1024;
constexpr size_t WS_CS = WS_WG8 + (size_t)5120 * 1024;
constexpr size_t WS_END = WS_CS + (size_t)T * 32 * 8;
constexpr size_t DO_Y3 = 0, DO_Y8 = (size_t)T * 1024 * 2, DO_YS8 = DO_Y8, DO_YD8 = DO_Y8 + (size_t)T * 512, DO_YM8 = DO_Y8 + (size_t)2 * T * 512;
constexpr int Y3LD = 1024;
constexpr size_t WS_YG = WS_HID;

__device__ __forceinline__ float bf2f(unsigned b) { return __uint_as_float(b << 16); }
__device__ __forceinline__ unsigned cvt_pk_bf16(float lo, float hi) { unsigned r; asm("v_cvt_pk_bf16_f32 %0, %1, %2" : "=v"(r) : "v"(lo), "v"(hi)); return r; }
__device__ __forceinline__ bf16_t f2bf(float f) { return (bf16_t)(cvt_pk_bf16(f, 0.f) & 0xffffu); }
__device__ __forceinline__ float wave_sum(float v) { v += __shfl_xor(v, 32); v += __shfl_xor(v, 16); v += __shfl_xor(v, 8); v += __shfl_xor(v, 4); v += __shfl_xor(v, 2); v += __shfl_xor(v, 1); return v; }
__device__ __forceinline__ float sum32(float v) { v += __shfl_xor(v, 16); v += __shfl_xor(v, 8); v += __shfl_xor(v, 4); v += __shfl_xor(v, 2); v += __shfl_xor(v, 1); return v; }
__device__ __forceinline__ float sigm(float x) { return __builtin_amdgcn_rcpf(1.0f + __expf(-x)); }
__device__ __forceinline__ float gelu_tanh(float x) { const float u = 1.5957691216057308f * (x + 0.044715f * x * x * x); return x * sigm(u); }
__device__ __forceinline__ u32x4 pack8(const f32x4 a, const f32x4 b) { u32x4 w; w.x = cvt_pk_bf16(a[0], a[1]); w.y = cvt_pk_bf16(a[2], a[3]); w.z = cvt_pk_bf16(b[0], b[1]); w.w = cvt_pk_bf16(b[2], b[3]); return w; }
__device__ __forceinline__ void unpack8(const u32x4 w, f32x4& a, f32x4& b) {
    a[0] = bf2f(w.x & 0xffffu); a[1] = bf2f(w.x >> 16); a[2] = bf2f(w.y & 0xffffu); a[3] = bf2f(w.y >> 16);
    b[0] = bf2f(w.z & 0xffffu); b[1] = bf2f(w.z >> 16); b[2] = bf2f(w.w & 0xffffu); b[3] = bf2f(w.w >> 16); }

__device__ __forceinline__ unsigned pack_fp8x4(float a, float b, float c, float d) {
    a = __builtin_amdgcn_fmed3f(a, -448.f, 448.f); b = __builtin_amdgcn_fmed3f(b, -448.f, 448.f); c = __builtin_amdgcn_fmed3f(c, -448.f, 448.f); d = __builtin_amdgcn_fmed3f(d, -448.f, 448.f);
    int p = __builtin_amdgcn_cvt_pk_fp8_f32(a, b, 0, false); p = __builtin_amdgcn_cvt_pk_fp8_f32(c, d, p, true); return (unsigned)p; }

__device__ __forceinline__ unsigned pack_fp8x4_nc(float a, float b, float c, float d) {
    int p = __builtin_amdgcn_cvt_pk_fp8_f32(a, b, 0, false); p = __builtin_amdgcn_cvt_pk_fp8_f32(c, d, p, true); return (unsigned)p; }

#define XB_TMO      128
#define XB_XCNT(j)  (256  + 64 * (j))
#define XB_XSUB(j)  (1280 + 64 * (j))
#define XB_XGEN(j)  (2304 + 64 * (j))
#define XB_TOP      3328
#define XB_TOPGEN   3392
#define XCD_BAR_WORDS 3456
#define XB_SPIN_CAP (1u << 18)
__device__ __forceinline__ unsigned xb_ld(unsigned* p)              { return __hip_atomic_load(p, __ATOMIC_RELAXED, __HIP_MEMORY_SCOPE_AGENT); }
__device__ __forceinline__ unsigned xb_add(unsigned* p, unsigned v) { return __hip_atomic_fetch_add(p, v, __ATOMIC_RELAXED, __HIP_MEMORY_SCOPE_AGENT); }
__device__ __forceinline__ unsigned xb_xcc_id() { return (unsigned)__builtin_amdgcn_s_getreg((3 << 11) | 20) & 0xFu; }
#define XB_SPIN(cond, bar) do { unsigned _sp = 0; while (cond) { __builtin_amdgcn_s_sleep(1); \
    if ((++_sp & 255u) == 0u) { if (xb_ld(&(bar)[XB_TMO])) break; if (_sp > XB_SPIN_CAP) { atomicAdd(&(bar)[XB_TMO], 1u); break; } } } } while (0)
struct XcdBarrier { unsigned* bar; unsigned x; volatile LAS unsigned* st; };
__device__ __forceinline__ XcdBarrier xcd_barrier_post(unsigned* bar, volatile LAS unsigned* st) {
    XcdBarrier b; b.bar = bar; b.x = xb_xcc_id(); b.st = st;
    if (threadIdx.x == 0) st[2] = xb_add(&bar[XB_XCNT(b.x)], 1u);
    return b;
}
__device__ __forceinline__ void xcd_barrier_complete(unsigned* bar, unsigned x, unsigned& nloc, unsigned& nx) {
    const unsigned G = gridDim.x * gridDim.y * gridDim.z;
    unsigned sum, cnt, mine, sp = 0u;
    for (;;) {
        sum = 0u; cnt = 0u; mine = 0u;
#pragma unroll
        for (unsigned j = 0; j < 16; ++j) { const unsigned c = xb_ld(&bar[XB_XCNT(j)]); sum += c; cnt += (c > 0u) ? 1u : 0u; mine = (j == x) ? c : mine; }
        if (sum == G) break;
        __builtin_amdgcn_s_sleep(1);
        if ((++sp & 255u) == 0u) { if (xb_ld(&bar[XB_TMO])) break; if (sp > XB_SPIN_CAP) { atomicAdd(&bar[XB_TMO], 1u); break; } }
    }
    nloc = mine > 0u ? mine : 1u; nx = cnt > 0u ? cnt : 1u;
}
__device__ __forceinline__ void xcd_barrier(const XcdBarrier& b) {
    asm volatile("s_waitcnt vmcnt(0)" ::: "memory");
    __syncthreads();
    if (threadIdx.x == 0) {
        unsigned* bar = b.bar;
        __builtin_amdgcn_s_waitcnt(0);
        unsigned nloc = b.st[0], nx = b.st[1];
        if (nloc == 0u) { xcd_barrier_complete(bar, b.x, nloc, nx); b.st[0] = nloc; b.st[1] = nx; }
        const unsigned old = xb_add(&bar[XB_XSUB(b.x)], 1u);
        const unsigned gen = old / nloc;
        if (old + 1u == (gen + 1u) * nloc) {
            __builtin_amdgcn_fence(__ATOMIC_RELEASE, "agent");
            asm volatile("s_waitcnt vmcnt(0)" ::: "memory");
            const unsigned og = xb_add(&bar[XB_TOP], 1u);
            const unsigned tg = og / nx;
            if (og + 1u == (tg + 1u) * nx) xb_add(&bar[XB_TOPGEN], 1u);
            else XB_SPIN(xb_ld(&bar[XB_TOPGEN]) == tg, bar);
            __builtin_amdgcn_fence(__ATOMIC_ACQUIRE, "agent");
            xb_add(&bar[XB_XGEN(b.x)], 1u);
            asm volatile("s_waitcnt vmcnt(0)" ::: "memory");
        } else {
            XB_SPIN(xb_ld(&bar[XB_XGEN(b.x)]) == gen, bar);
            __builtin_amdgcn_fence(__ATOMIC_ACQUIRE, "agent");
            asm volatile("s_waitcnt vmcnt(0)" ::: "memory");
        }
    }
    __syncthreads();
}

namespace pg8 {
constexpr int BM = 256, BK = 64, HALF = 128, HTB = HALF * BK * 2, STAGE_BYTES = 8 * HTB;
__device__ __forceinline__ int lds_byte(int r, int c) { const int st = (r >> 4) * 2 + (c >> 5), rr = r & 15, cc = c & 31, ob = rr * 64 + cc * 2; return st * 1024 + (ob ^ (((ob >> 9) & 1) << 5)); }
__device__ __forceinline__ void stage_rc(int b, int& R, int& C) { const int st = b / 1024, sb = b % 1024, swz = sb ^ (((sb >> 9) & 1) << 5); R = (st >> 1) * 16 + swz / 64; C = (st & 1) * 32 + (swz % 64) / 2; }
__device__ __forceinline__ int perm32(int rho) { const int n = rho >> 4, i = rho & 15; return 8 * (i >> 2) + 4 * n + (i & 3); }
struct Unit { int pm, pn, z; };
struct Gemm { int lda, ldb, K; int sa = 0x7f, sb = 0x7f; };
typedef int v8i32 __attribute__((ext_vector_type(8)));
typedef int v4i32 __attribute__((ext_vector_type(4)));

#ifndef PG8_SP2
#define PG8_SP2 true
#endif
template <class Epi, class Sched, bool GATHER, bool SP2 = PG8_SP2, bool F8 = false>
__device__ __forceinline__ void gemm_phase(LAS unsigned char* lds, const Gemm g, const Sched& S, const Epi& E) {
    const int tid = threadIdx.x, wid = __builtin_amdgcn_readfirstlane(tid >> 6), lane = tid & 63, wr = wid >> 2, wc = wid & 3, fr = lane & 15, fq = lane >> 4;
    const int K = g.K, nt = K / BK;
    unsigned voffA[2], voffB[2]; int Rr[2], Cc[2];
#pragma unroll
    for (int i = 0; i < 2; ++i) { int R, C; stage_rc(tid * 16 + i * 8192, R, C); const int Rb = Epi::PERM ? ((R & ~31) + perm32(R & 31)) : R;
        Rr[i] = R; Cc[i] = C; voffA[i] = (unsigned)(R * g.lda + C) * 2u; voffB[i] = (unsigned)(Rb * g.ldb + C) * 2u; }
    const size_t hstepA = (size_t)HALF * g.lda * 2, hstepB = (size_t)HALF * g.ldb * 2;
    const unsigned ldsw = (unsigned)wid * 1024u;
    const int aoff = lds_byte(wr * 64 + fr, fq * 8), boff = lds_byte(wc * 32 + fr, fq * 8);
#define PG8_SA(b, h) (((b) * 2 + (h)) * HTB)
#define PG8_SB(b, h) ((4 + (b) * 2 + (h)) * HTB)
#define PG8_GLDS(gp, lo) __builtin_amdgcn_global_load_lds((const unsigned*)(gp), (LAS unsigned*)(lds + (lo)), 16, 0, 0)
#define PG8_STAGE_B(bufoff, gbase, h) do { const char* _b = (const char*)(gbase) + (h) * hstepB; PG8_GLDS(_b + voffB[0], (bufoff) + ldsw); PG8_GLDS(_b + voffB[1], (bufoff) + ldsw + 8192); } while (0)
#define PG8_STAGE_A(bufoff, gbase, h, OFF) do { if constexpr (GATHER) { PG8_GLDS((const char*)(gbase) + OFF##h##0, (bufoff) + ldsw); PG8_GLDS((const char*)(gbase) + OFF##h##1, (bufoff) + ldsw + 8192); } \
        else { const char* _a = (const char*)(gbase) + (h) * hstepA; PG8_GLDS(_a + voffA[0], (bufoff) + ldsw); PG8_GLDS(_a + voffA[1], (bufoff) + ldsw + 8192); } } while (0)
#define PG8_LDA(dst, b, h) do { if constexpr (F8) { _Pragma("unroll") for (int m = 0; m < 4; ++m) { const v4i32 _lo = *(const LAS v4i32*)(lds + PG8_SA(b, h) + aoff + m * 2048), _hi = *(const LAS v4i32*)(lds + PG8_SA(b, h) + aoff + m * 2048 + 1024); \
            dst##8[m] = __builtin_shufflevector(_lo, _hi, 0, 1, 2, 3, 4, 5, 6, 7); } } \
        else { _Pragma("unroll") for (int m = 0; m < 4; ++m) _Pragma("unroll") for (int k = 0; k < 2; ++k) dst[m][k] = *(const LAS bf16x8*)(lds + PG8_SA(b, h) + aoff + m * 2048 + k * 1024); } } while (0)
#define PG8_LDB(dst, b, h) do { if constexpr (F8) { _Pragma("unroll") for (int n = 0; n < 2; ++n) { const v4i32 _lo = *(const LAS v4i32*)(lds + PG8_SB(b, h) + boff + n * 2048), _hi = *(const LAS v4i32*)(lds + PG8_SB(b, h) + boff + n * 2048 + 1024); \
            dst##8[n] = __builtin_shufflevector(_lo, _hi, 0, 1, 2, 3, 4, 5, 6, 7); } } \
        else { _Pragma("unroll") for (int n = 0; n < 2; ++n) _Pragma("unroll") for (int k = 0; k < 2; ++k) dst[n][k] = *(const LAS bf16x8*)(lds + PG8_SB(b, h) + boff + n * 2048 + k * 1024); } } while (0)
#define PG8_MMA(ai, bj, At, Bt) do { __builtin_amdgcn_s_setprio(1); \
        if constexpr (F8) { _Pragma("unroll") for (int m = 0; m < 4; ++m) _Pragma("unroll") for (int n = 0; n < 2; ++n) \
            asm volatile("v_mfma_scale_f32_16x16x128_f8f6f4 %0, %1, %2, %0, %3, %4 op_sel_hi:[0,0,0]" : "+v"(acc[ai][bj][m][n]) : "v"(Bt##8[n]), "v"(At##8[m]), "v"(f8sb), "v"(f8sa)); } \
        else { _Pragma("unroll") for (int m = 0; m < 4; ++m) _Pragma("unroll") for (int n = 0; n < 2; ++n) _Pragma("unroll") for (int k = 0; k < 2; ++k) \
            acc[ai][bj][m][n] = __builtin_amdgcn_mfma_f32_16x16x32_bf16(Bt[n][k], At[m][k], acc[ai][bj][m][n], 0, 0, 0); } \
        __builtin_amdgcn_s_setprio(0); } while (0)
#define PG8_WAIT_V(n) asm volatile("s_waitcnt vmcnt(" #n ")" ::: "memory")
#define PG8_WAIT_L(n) asm volatile("s_waitcnt lgkmcnt(" #n ")" ::: "memory")
#define PG8_BAR __builtin_amdgcn_s_barrier()
#define PG8_SCHED __builtin_amdgcn_sched_barrier(0)
    Unit cur, nxt; int ui = 0;
    if (!S.next(0, cur)) return;
    f32x4 acc[2][2][4][2];
#pragma unroll
    for (int a = 0; a < 2; ++a)
#pragma unroll
        for (int b = 0; b < 2; ++b)
#pragma unroll
            for (int m = 0; m < 4; ++m)
#pragma unroll
                for (int n = 0; n < 2; ++n) acc[a][b][m][n] = (f32x4){0.f, 0.f, 0.f, 0.f};
    bf16x8 At[4][2], B0[2][2], B1[2][2]; v8i32 At8[4], B08[2], B18[2];
    const int f8sa = g.sa, f8sb = g.sb;
    unsigned coff00 = 0u, coff01 = 0u, coff10 = 0u, coff11 = 0u, noff00 = 0u, noff01 = 0u, noff10 = 0u, noff11 = 0u;
    if constexpr (GATHER) {
        coff00 = S.a_off(cur, Rr[0]) + (unsigned)Cc[0] * 2u; coff01 = S.a_off(cur, Rr[1]) + (unsigned)Cc[1] * 2u;
        coff10 = S.a_off(cur, HALF + Rr[0]) + (unsigned)Cc[0] * 2u; coff11 = S.a_off(cur, HALF + Rr[1]) + (unsigned)Cc[1] * 2u;
    }
    { const char* cA = S.a_ptr(cur, 0); const char* cB = S.b_ptr(cur, 0); const char* cA1 = S.a_ptr(cur, 1); const char* cB1 = S.b_ptr(cur, 1);
    if constexpr (SP2) {
    PG8_STAGE_B(PG8_SB(0, 0), cB, 0); PG8_STAGE_B(PG8_SB(0, 1), cB, 1); PG8_STAGE_A(PG8_SA(0, 0), cA, 0, coff); PG8_STAGE_A(PG8_SA(0, 1), cA, 1, coff);
    if (wr == 1) PG8_BAR;
    PG8_WAIT_V(2); PG8_BAR;
    PG8_STAGE_B(PG8_SB(1, 0), cB1, 0); PG8_STAGE_A(PG8_SA(1, 0), cA1, 0, coff); PG8_STAGE_B(PG8_SB(1, 1), cB1, 1);
    PG8_WAIT_V(6); PG8_BAR;
    } else {
    PG8_STAGE_B(PG8_SB(0, 0), cB, 0); PG8_STAGE_A(PG8_SA(0, 0), cA, 0, coff); PG8_STAGE_B(PG8_SB(0, 1), cB, 1); PG8_STAGE_A(PG8_SA(0, 1), cA, 1, coff);
    if (wr == 1) PG8_BAR;
    PG8_WAIT_V(4); PG8_BAR;
    PG8_STAGE_B(PG8_SB(1, 0), cB1, 0); PG8_STAGE_A(PG8_SA(1, 0), cA1, 0, coff); PG8_STAGE_B(PG8_SB(1, 1), cB1, 1);
    PG8_WAIT_V(6); PG8_BAR; } }
    for (;;) {
        const bool has_next = S.next(ui + 1, nxt);
        Unit un; un.pm = has_next ? nxt.pm : cur.pm; un.pn = has_next ? nxt.pn : cur.pn; un.z = has_next ? nxt.z : cur.z;
        if constexpr (GATHER) {
            noff00 = has_next ? (S.a_off(nxt, Rr[0]) + (unsigned)Cc[0] * 2u) : coff00; noff01 = has_next ? (S.a_off(nxt, Rr[1]) + (unsigned)Cc[1] * 2u) : coff01;
            noff10 = has_next ? (S.a_off(nxt, HALF + Rr[0]) + (unsigned)Cc[0] * 2u) : coff10; noff11 = has_next ? (S.a_off(nxt, HALF + Rr[1]) + (unsigned)Cc[1] * 2u) : coff11;
        }
        for (int t = 0; t < nt; t += 2) {
            const bool last = (t == nt - 2);
            if constexpr (Epi::HOOK) { if (t == Epi::H1 || t == Epi::H2) { if constexpr (F8) asm volatile("s_nop 15\n\ts_nop 15\n\ts_nop 7" ::: "memory"); if (wr == 0) PG8_BAR; E.hook(acc, cur, t, wr, wc, fr, fq); if (wr == 1) PG8_BAR; } }
            const char* a1 = S.a_ptr(cur, t + 1);
            const char* a2 = last ? S.a_ptr(un, 0) : S.a_ptr(cur, t + 2); const char* b2 = last ? S.b_ptr(un, 0) : S.b_ptr(cur, t + 2);
            const char* a3 = last ? S.a_ptr(un, 1) : S.a_ptr(cur, t + 3); const char* b3 = last ? S.b_ptr(un, 1) : S.b_ptr(cur, t + 3);
            const unsigned o200 = last ? noff00 : coff00, o201 = last ? noff01 : coff01, o210 = last ? noff10 : coff10, o211 = last ? noff11 : coff11;
            if constexpr (SP2) {
            PG8_LDB(B0, 0, 0); PG8_LDB(B1, 0, 1); PG8_SCHED; PG8_LDA(At, 0, 0); PG8_STAGE_A(PG8_SA(1, 1), a1, 1, coff);
            PG8_WAIT_V(8); PG8_WAIT_L(0); PG8_BAR; PG8_MMA(0, 0, At, B0); PG8_MMA(0, 1, At, B1); PG8_BAR; PG8_SCHED;
            PG8_LDA(At, 0, 1); PG8_STAGE_B(PG8_SB(0, 0), b2, 0); PG8_STAGE_B(PG8_SB(0, 1), b2, 1); PG8_STAGE_A(PG8_SA(0, 0), a2, 0, o2);
            PG8_WAIT_V(8); PG8_WAIT_L(0); PG8_BAR; PG8_MMA(1, 0, At, B0); PG8_MMA(1, 1, At, B1); PG8_BAR; PG8_SCHED;
            PG8_LDB(B0, 1, 0); PG8_LDB(B1, 1, 1); PG8_SCHED; PG8_LDA(At, 1, 0); PG8_STAGE_A(PG8_SA(0, 1), a2, 1, o2);
            PG8_WAIT_V(8); PG8_WAIT_L(0); PG8_BAR; PG8_MMA(0, 0, At, B0); PG8_MMA(0, 1, At, B1); PG8_BAR; PG8_SCHED;
            PG8_LDA(At, 1, 1); PG8_STAGE_B(PG8_SB(1, 0), b3, 0); PG8_STAGE_B(PG8_SB(1, 1), b3, 1); PG8_STAGE_A(PG8_SA(1, 0), a3, 0, o2);
            PG8_WAIT_V(8); PG8_WAIT_L(0); PG8_BAR; PG8_MMA(1, 0, At, B0); PG8_MMA(1, 1, At, B1); PG8_BAR; PG8_SCHED;
            } else {
            PG8_LDB(B0, 0, 0); PG8_SCHED; PG8_LDA(At, 0, 0); PG8_STAGE_A(PG8_SA(1, 1), a1, 1, coff);
            PG8_WAIT_L(8); PG8_BAR; PG8_WAIT_L(0); PG8_MMA(0, 0, At, B0); PG8_BAR; PG8_SCHED;
            PG8_LDB(B1, 0, 1); PG8_STAGE_B(PG8_SB(0, 0), b2, 0);
            PG8_BAR; PG8_WAIT_L(0); PG8_MMA(0, 1, At, B1); PG8_BAR;
            PG8_LDA(At, 0, 1); PG8_STAGE_A(PG8_SA(0, 0), a2, 0, o2);
            PG8_BAR; PG8_WAIT_L(0); PG8_MMA(1, 0, At, B0); PG8_BAR; PG8_SCHED;
            PG8_STAGE_B(PG8_SB(0, 1), b2, 1);
            PG8_WAIT_V(6); PG8_BAR; PG8_MMA(1, 1, At, B1); PG8_BAR;
            PG8_LDB(B0, 1, 0); PG8_SCHED; PG8_LDA(At, 1, 0); PG8_STAGE_A(PG8_SA(0, 1), a2, 1, o2);
            PG8_WAIT_L(8); PG8_BAR; PG8_WAIT_L(0); PG8_MMA(0, 0, At, B0); PG8_BAR; PG8_SCHED;
            PG8_LDB(B1, 1, 1); PG8_STAGE_B(PG8_SB(1, 0), b3, 0);
            PG8_BAR; PG8_WAIT_L(0); PG8_MMA(0, 1, At, B1); PG8_BAR;
            PG8_LDA(At, 1, 1); PG8_STAGE_A(PG8_SA(1, 0), a3, 0, o2);
            PG8_BAR; PG8_WAIT_L(0); PG8_MMA(1, 0, At, B0); PG8_BAR; PG8_SCHED;
            PG8_STAGE_B(PG8_SB(1, 1), b3, 1);
            PG8_WAIT_V(6); PG8_BAR; PG8_MMA(1, 1, At, B1); PG8_BAR;
            }
        }
        if constexpr (F8) asm volatile("s_nop 15\n\ts_nop 15\n\ts_nop 7" ::: "memory");
        if (wr == 0) PG8_BAR;
        E(acc, cur, wr, wc, fr, fq);
        if (!has_next) break;
#pragma unroll
        for (int a = 0; a < 2; ++a)
#pragma unroll
            for (int b = 0; b < 2; ++b)
#pragma unroll
                for (int m = 0; m < 4; ++m)
#pragma unroll
                    for (int n = 0; n < 2; ++n) acc[a][b][m][n] = (f32x4){0.f, 0.f, 0.f, 0.f};
        cur = nxt; ++ui;
        if constexpr (GATHER) { coff00 = noff00; coff01 = noff01; coff10 = noff10; coff11 = noff11; }
        if (wr == 1) PG8_BAR;
    }
    PG8_WAIT_V(0);
    PG8_BAR;
#undef PG8_SA
#undef PG8_SB
#undef PG8_GLDS
#undef PG8_STAGE_A
#undef PG8_STAGE_B
#undef PG8_LDA
#undef PG8_LDB
#undef PG8_MMA
#undef PG8_WAIT_V
#undef PG8_WAIT_L
#undef PG8_BAR
#undef PG8_SCHED
}

struct SchedGrid {
    const char* A; const char* B; size_t zA, zB, tA, tB; int nM, nN, nz, G, c, rep;
    __device__ __forceinline__ bool next(int i, Unit& u) const {
        const int nwg = nz * nM * nN; const long L = (long)i * G + c; if (L >= (long)nwg * rep) return false;
        int w = (int)(L % nwg); { const int q = nwg / 8, r = nwg % 8, x = w % 8, off = w / 8; w = (x < r ? x * (q + 1) : r * (q + 1) + (x - r) * q) + off; }
        const int per = nM * nN; u.z = w / per; w -= u.z * per;
#ifdef PROBE_NOEPI
        if (L >= nwg) u.z |= 0x4000;
#endif
        const int nig = 8 * nN, gid = w / nig, fm = gid * 8, gsz = (nM - fm) < 8 ? (nM - fm) : 8;
        u.pm = fm + ((w % nig) % gsz); u.pn = (w % nig) / gsz; return true; }
    __device__ __forceinline__ const char* a_ptr(const Unit& u, int t) const { return A + (size_t)u.z * zA + (size_t)u.pm * tA + (size_t)t * 128; }
    __device__ __forceinline__ const char* b_ptr(const Unit& u, int t) const { return B + (size_t)u.z * zB + (size_t)u.pn * tB + (size_t)t * 128; }
    __device__ __forceinline__ unsigned a_off(const Unit&, int) const { return 0u; }
};
}

struct Args { const void* in[32]; float* out; unsigned char* ws; int ph_lo, ph_hi; };
struct Frame {
    LAS unsigned char* lds; int tid, lane, wave, G, c;
    unsigned char* ws; unsigned char* dout;
};
enum { I_X = 0, I_MEM, I_POS, I_GMIX, I_GMEM, I_WIN, I_LRE, I_LIM, I_LDT, I_BRE, I_BIM, I_CRE, I_CIM, I_DSKIP, I_WGLU, I_GQ, I_GK, I_GQM, I_GKM, I_WMEMKV,
       I_WUPS, I_WUPD, I_WUPM, I_WOUT, I_GFFN, I_WGROUP, I_BGROUP, I_WEXP, I_BEXP, I_WGATE, I_WUP, I_WDOWN };
#define INP(i) ((const float*)a.in[i])
#define WSP(T_, off) ((T_*)(F.ws + (off)))
#define DOP(T_, off) ((T_*)(F.dout + (off)))

using pg8::Unit;
__device__ __forceinline__ unsigned gpack4(const f32x4 v) {
    unsigned w = 0u;
#pragma unroll
    for (int j = 0; j < 4; ++j) { const float sg = __builtin_amdgcn_rcpf(1.0f + __builtin_amdgcn_exp2f(v[j])); w = __builtin_amdgcn_cvt_pk_u8_f32(sg * 255.0f, j, w); }
    return w; }
__device__ __forceinline__ void gdecode(const u32x2 w, float (&g)[8]) {
#pragma unroll
    for (int j = 0; j < 4; ++j) { g[j] = fmaxf((float)((w.x >> (8 * j)) & 255u), 0.5f); g[4 + j] = fmaxf((float)((w.y >> (8 * j)) & 255u), 0.5f); } }
struct EpiInProj {
    static constexpr bool PERM = true, HOOK = false;
    bf16_t *UA, *Y3; unsigned char* SG;
    __device__ __forceinline__ void operator()(const f32x4 (&acc)[2][2][4][2], const Unit& u, int wr, int wc, int fr, int fq) const {
        const int pn = u.pn, row0 = u.pm * 256 + wr * 64 + fr, cw = wc * 32 + 8 * fq;
#pragma unroll
        for (int ai = 0; ai < 2; ++ai)
#pragma unroll
            for (int m = 0; m < 4; ++m) {
                const int r = row0 + ai * 128 + m * 16;
#pragma unroll
                for (int bj = 0; bj < 2; ++bj) {
                    const int c = bj * 128 + cw;
                    if (pn >= 6) {
                        u32x2 w; w.x = gpack4(acc[ai][bj][m][0]); w.y = gpack4(acc[ai][bj][m][1]);
                        *(u32x2*)(SG + (size_t)r * 3072 + (pn - 6) * 256 + c) = w;
                    } else {
                        bf16_t* p;
                        if (pn < 2) { const int cc = pn * 256 + c, gI = cc >> 4, h0 = cc & 15, b = r >> 11, s = r & 2047;
                            p = UA + ((size_t)(gI * 2048 + b * 64 + (s >> 5)) * 640 + (s & 31) * 16 + h0); }
                        else p = Y3 + (size_t)r * Y3LD + (pn - 2) * 256 + c;
                        *(u32x4*)p = pack8(acc[ai][bj][m][0], acc[ai][bj][m][1]);
                    }
                }
            }
    }
};
struct EpiInProjB {
    static constexpr bool PERM = true, HOOK = false;
    bf16_t *KVX, *QI;
    __device__ __forceinline__ void operator()(const f32x4 (&acc)[2][2][4][2], const Unit& u, int wr, int wc, int fr, int fq) const {
        const int row0 = u.pm * 256 + wr * 64 + fr, cw = wc * 32 + 8 * fq; bf16_t* base = u.pn == 0 ? KVX : QI;
#pragma unroll
        for (int ai = 0; ai < 2; ++ai)
#pragma unroll
            for (int m = 0; m < 4; ++m)
#pragma unroll
                for (int bj = 0; bj < 2; ++bj)
                    *(u32x4*)(base + (size_t)(row0 + ai * 128 + m * 16) * 256 + bj * 128 + cw) = pack8(acc[ai][bj][m][0], acc[ai][bj][m][1]);
    }
};
struct EpiBf16 {
    static constexpr bool PERM = true, HOOK = false;
    bf16_t* O; int ld;
    __device__ __forceinline__ void operator()(const f32x4 (&acc)[2][2][4][2], const Unit& u, int wr, int wc, int fr, int fq) const {
        const int row0 = u.pm * 256 + wr * 64 + fr, col0 = u.pn * 256 + wc * 32 + 8 * fq;
#pragma unroll
        for (int ai = 0; ai < 2; ++ai)
#pragma unroll
            for (int m = 0; m < 4; ++m)
#pragma unroll
                for (int bj = 0; bj < 2; ++bj)
                    *(u32x4*)(O + (size_t)(row0 + ai * 128 + m * 16) * ld + col0 + bj * 128) = pack8(acc[ai][bj][m][0], acc[ai][bj][m][1]);
    }
};
struct EpiSc {
    static constexpr bool PERM = false, HOOK = false;
    float* SC;
    __device__ __forceinline__ void operator()(const f32x4 (&acc)[2][2][4][2], const Unit& u, int wr, int wc, int fr, int fq) const {
        const int row0 = u.pm * 256 + wr * 64 + fr, col0 = wc * 32 + 4 * fq;
#pragma unroll
        for (int ai = 0; ai < 2; ++ai)
#pragma unroll
            for (int m = 0; m < 4; ++m)
#pragma unroll
                for (int n = 0; n < 2; ++n)
                    *(f32x4*)(SC + ((size_t)u.z * 2048 + row0 + ai * 128 + m * 16) * 128 + col0 + n * 16) = acc[ai][0][m][n];
    }
};
struct EpiGelu {
    static constexpr bool PERM = true, HOOK = false;
    bf16_t* YG;
    __device__ __forceinline__ void operator()(const f32x4 (&acc)[2][2][4][2], const Unit& u, int wr, int wc, int fr, int fq) const {
        const int row0 = u.pm * 256 + wr * 64 + fr, col0 = u.pn * 256 + wc * 32 + 8 * fq;
#pragma unroll
        for (int ai = 0; ai < 2; ++ai)
#pragma unroll
            for (int m = 0; m < 4; ++m) {
                const int row = row0 + ai * 128 + m * 16;
#pragma unroll
                for (int bj = 0; bj < 2; ++bj) {
                    const int n8 = col0 + bj * 128, i = n8 >> 4, ho = n8 & 15;
                    f32x4 v0 = acc[ai][bj][m][0], v1 = acc[ai][bj][m][1];
#pragma unroll
                    for (int j = 0; j < 4; ++j) { v0[j] = gelu_tanh(v0[j]); v1[j] = gelu_tanh(v1[j]); }
                    *(u32x4*)(YG + ((size_t)row * 32 + i) * 512 + u.z * 16 + ho) = pack8(v0, v1);
                }
            }
    }
};
struct EpiGlu {
    static constexpr bool PERM = true, HOOK = false;
    const bf16_t* YG; unsigned char* YS8;
    __device__ __forceinline__ void operator()(const f32x4 (&acc)[2][2][4][2], const Unit& u, int wr, int wc, int fr, int fq) const {
        const int row0 = u.pm * 256 + wr * 64 + fr, col0 = u.pn * 256 + wc * 32 + 8 * fq;
        u32x4 yv[2][4][2];
#pragma unroll
        for (int ai = 0; ai < 2; ++ai)
#pragma unroll
            for (int m = 0; m < 4; ++m)
#pragma unroll
                for (int bj = 0; bj < 2; ++bj) yv[ai][m][bj] = *(const u32x4*)(YG + (size_t)(row0 + ai * 128 + m * 16) * 512 + col0 + bj * 128);
#pragma unroll
        for (int ai = 0; ai < 2; ++ai)
#pragma unroll
            for (int m = 0; m < 4; ++m)
#pragma unroll
                for (int bj = 0; bj < 2; ++bj) {
                    const int r = row0 + ai * 128 + m * 16, c = col0 + bj * 128;
                    f32x4 y0, y1; unpack8(yv[ai][m][bj], y0, y1);
                    f32x4 v0 = acc[ai][bj][m][0], v1 = acc[ai][bj][m][1];
#pragma unroll
                    for (int j = 0; j < 4; ++j) { v0[j] = y0[j] * sigm(v0[j]) * 16.0f; v1[j] = y1[j] * sigm(v1[j]) * 16.0f; }
                    u32x2 w8; w8.x = pack_fp8x4(v0[0], v0[1], v0[2], v0[3]); w8.y = pack_fp8x4(v1[0], v1[1], v1[2], v1[3]);
                    *(u32x2*)(YS8 + (size_t)r * 512 + c) = w8;
                }
    }
};
struct EpiMerge {
    static constexpr bool PERM = true, HOOK = true; static constexpr int H1 = 4, H2 = 8;
    const unsigned char* SG; unsigned char* MG;
    __device__ __forceinline__ void hook(f32x4 (&acc)[2][2][4][2], const Unit& u, int t, int wr, int wc, int fr, int fq) const {
        int row0 = u.pm * 256 + wr * 64 + fr, col0 = u.pn * 256 + wc * 32 + 8 * fq; const int br = (t >> 2) - 1;
        asm volatile("" : "+v"(row0), "+v"(col0));
        u32x2 wa[2][4][2], wb[2][4][2];
#pragma unroll
        for (int ai = 0; ai < 2; ++ai)
#pragma unroll
            for (int m = 0; m < 4; ++m)
#pragma unroll
                for (int bj = 0; bj < 2; ++bj) { const unsigned char* gp = SG + (size_t)(row0 + ai * 128 + m * 16) * 3072 + br * 1024 + col0 + bj * 128;
                    wa[ai][m][bj] = *(const u32x2*)gp; wb[ai][m][bj] = *(const u32x2*)(gp + 1024); }
#pragma unroll
        for (int ai = 0; ai < 2; ++ai)
#pragma unroll
            for (int m = 0; m < 4; ++m)
#pragma unroll
                for (int bj = 0; bj < 2; ++bj) {
                    float ga[8], gb[8]; gdecode(wa[ai][m][bj], ga); gdecode(wb[ai][m][bj], gb);
#pragma unroll
                    for (int j = 0; j < 4; ++j) { acc[ai][bj][m][0][j] *= ga[j] * __builtin_amdgcn_rcpf(gb[j]); acc[ai][bj][m][1][j] *= ga[4 + j] * __builtin_amdgcn_rcpf(gb[4 + j]); }
                }
    }
    __device__ __forceinline__ void operator()(const f32x4 (&acc)[2][2][4][2], const Unit& u, int wr, int wc, int fr, int fq) const {
        const int row0 = u.pm * 256 + wr * 64 + fr, col0 = u.pn * 256 + wc * 32 + 8 * fq;
        u32x2 wg[2][4][2];
#pragma unroll
        for (int ai = 0; ai < 2; ++ai)
#pragma unroll
            for (int m = 0; m < 4; ++m)
#pragma unroll
                for (int bj = 0; bj < 2; ++bj) wg[ai][m][bj] = *(const u32x2*)(SG + (size_t)(row0 + ai * 128 + m * 16) * 3072 + 2048 + col0 + bj * 128);
#pragma unroll
        for (int ai = 0; ai < 2; ++ai)
#pragma unroll
            for (int m = 0; m < 4; ++m)
#pragma unroll
                for (int bj = 0; bj < 2; ++bj) {
                    const int r = row0 + ai * 128 + m * 16, c = col0 + bj * 128;
                    float g2[8]; gdecode(wg[ai][m][bj], g2);
                    f32x4 v0 = acc[ai][bj][m][0], v1 = acc[ai][bj][m][1];
#pragma unroll
                    for (int j = 0; j < 4; ++j) { v0[j] *= g2[j] * (8.0f / 255.0f); v1[j] *= g2[4 + j] * (8.0f / 255.0f); }
                    u32x2 w8; w8.x = pack_fp8x4(v0[0], v0[1], v0[2], v0[3]); w8.y = pack_fp8x4(v1[0], v1[1], v1[2], v1[3]);
                    *(u32x2*)(MG + (size_t)r * 1024 + c) = w8;
                }
    }
};
struct EpiOut {
    static constexpr bool PERM = true, HOOK = false;
    const float* X; bf16_t* X1B; unsigned char* X1B8;
    __device__ __forceinline__ void operator()(const f32x4 (&acc)[2][2][4][2], const Unit& u, int wr, int wc, int fr, int fq) const {
        const int row0 = u.pm * 256 + wr * 64 + fr, col0 = u.pn * 256 + wc * 32 + 8 * fq;
#pragma unroll
        for (int ai = 0; ai < 2; ++ai) {
            f32x4 xv[4][2][2];
#pragma unroll
            for (int m = 0; m < 4; ++m)
#pragma unroll
                for (int bj = 0; bj < 2; ++bj) { const float* xp = X + (size_t)(row0 + ai * 128 + m * 16) * 1024 + col0 + bj * 128; xv[m][bj][0] = __builtin_nontemporal_load((const f32x4*)xp); xv[m][bj][1] = __builtin_nontemporal_load((const f32x4*)(xp + 4)); }
#pragma unroll
            for (int m = 0; m < 4; ++m)
#pragma unroll
                for (int bj = 0; bj < 2; ++bj)
                { const f32x4 v0 = xv[m][bj][0] + acc[ai][bj][m][0], v1 = xv[m][bj][1] + acc[ai][bj][m][1]; const size_t o = (size_t)(row0 + ai * 128 + m * 16) * 1024 + col0 + bj * 128;
                    *(u32x4*)(X1B + o) = pack8(v0, v1);
                    u32x2 w8; w8.x = pack_fp8x4(v0[0], v0[1], v0[2], v0[3]); w8.y = pack_fp8x4(v1[0], v1[1], v1[2], v1[3]); *(u32x2*)(X1B8 + o) = w8; }
        }
    }
};

constexpr int MI_CNT = 16, MI_PRE = 160, MI_TILE = 320, MI_PT = 960;
struct SchedMoE1 {
    const char* A; const char* W; LAS const int* misc; const int* tok; int ntile4, G, c, rep;
    __device__ __forceinline__ bool next(int i, Unit& u) const {
        long L = (long)i * G + c; if (L >= (long)ntile4 * rep) return false; L %= ntile4;
        const int e = misc[MI_TILE + (int)(L >> 2)]; u.z = e & 255; u.pm = e >> 8; u.pn = (int)(L & 3); return true; }
    __device__ __forceinline__ const char* a_ptr(const Unit&, int t) const { return A + (size_t)t * 128; }
    __device__ __forceinline__ const char* b_ptr(const Unit& u, int t) const { return W + (size_t)u.z * (1024 * 1024) + (size_t)u.pn * (256 * 1024) + (size_t)t * 128; }
    __device__ __forceinline__ unsigned a_off(const Unit& u, int r) const {
        int pos = u.pm * 256 + r; const int n = misc[MI_CNT + u.z]; pos = pos < n ? pos : 0;
        return (unsigned)(tok[(size_t)u.z * 65536 + pos] & 0x7fffffff) * 1024u; }
};
struct EpiMoe1 {
    static constexpr bool PERM = true, HOOK = false;
    LAS const int* misc; const int* tok; const float2* rw; unsigned char* HID;
    __device__ __forceinline__ void operator()(const f32x4 (&acc)[2][2][4][2], const Unit& u, int wr, int wc, int fr, int fq) const {
        const int l = u.z, n = misc[MI_CNT + l], col = u.pn * 128 + wc * 32 + 8 * fq;
        unsigned tk[2][4]; float2 qv[2][4];
#pragma unroll
        for (int ai = 0; ai < 2; ++ai)
#pragma unroll
            for (int m = 0; m < 4; ++m) { int pos = u.pm * 256 + ai * 128 + wr * 64 + m * 16 + fr; pos = pos < n ? pos : 0;
                tk[ai][m] = (unsigned)tok[(size_t)l * 65536 + pos]; qv[ai][m] = rw[(size_t)l * 65536 + pos]; }
#pragma unroll
        for (int ai = 0; ai < 2; ++ai)
#pragma unroll
            for (int m = 0; m < 4; ++m) {
                const int pos = u.pm * 256 + ai * 128 + wr * 64 + m * 16 + fr;
                if (pos < n) {
                    const float2 q = qv[ai][m];
                    f32x4 v0, v1;
#pragma unroll
                    for (int j = 0; j < 4; ++j) {
                        const float g0 = acc[ai][0][m][0][j] * q.x, u0 = acc[ai][1][m][0][j] * q.x, g1 = acc[ai][0][m][1][j] * q.x, u1 = acc[ai][1][m][1][j] * q.x;
                        v0[j] = g0 * sigm(g0) * u0 * (q.y * 16.0f); v1[j] = g1 * sigm(g1) * u1 * (q.y * 16.0f); }
                    u32x2 w8; w8.x = pack_fp8x4(v0[0], v0[1], v0[2], v0[3]); w8.y = pack_fp8x4(v1[0], v1[1], v1[2], v1[3]);
                    *(u32x2*)(HID + ((size_t)(tk[ai][m] & 0x7fffffffu) * 2 + (tk[ai][m] >> 31)) * 512 + col) = w8;
                }
            }
    }
};
struct SchedMoE2 {
    const char* A; const char* W; LAS const int* misc; const int* tok; int ntile4, G, c, rep;
    __device__ __forceinline__ bool next(int i, Unit& u) const {
        long L = (long)i * G + c; if (L >= (long)ntile4 * rep) return false; L %= ntile4;
        const int e = misc[MI_TILE + (int)(L >> 2)], l = e & 255, gi = l / 28, pt = misc[MI_PT + (l - gi * 28)];
        u.z = l | ((gi * 8 + (pt & 15)) << 8) | ((gi * 8 + (pt >> 4)) << 16); u.pm = e >> 8; u.pn = (int)(L & 3); return true; }
    __device__ __forceinline__ const char* a_ptr(const Unit&, int t) const { return A + (size_t)t * 128; }
    __device__ __forceinline__ const char* b_ptr(const Unit& u, int t) const {
        const int e = t < 4 ? ((u.z >> 8) & 255) : (u.z >> 16), tt = t < 4 ? t : t - 4;
        return W + (size_t)e * (1024 * 512) + (size_t)u.pn * (256 * 512) + (size_t)tt * 128; }
    __device__ __forceinline__ unsigned a_off(const Unit& u, int r) const {
        const int l = u.z & 255; int pos = u.pm * 256 + r; const int n = misc[MI_CNT + l]; pos = pos < n ? pos : 0;
        return (unsigned)tok[(size_t)l * 65536 + pos] * 1024u; }
};
struct EpiMoe2 {
    static constexpr bool PERM = false, HOOK = false;
    LAS const int* misc; const int* tok; const bf16_t* X1B; float* O;
    __device__ __forceinline__ void operator()(const f32x4 (&acc)[2][2][4][2], const Unit& u, int wr, int wc, int fr, int fq) const {
        const int l = u.z & 255, n = misc[MI_CNT + l], col0 = u.pn * 256 + wc * 32 + 4 * fq;
        int tk[2][4];
#pragma unroll
        for (int ai = 0; ai < 2; ++ai)
#pragma unroll
            for (int m = 0; m < 4; ++m) { int pos = u.pm * 256 + ai * 128 + wr * 64 + m * 16 + fr; pos = pos < n ? pos : 0; tk[ai][m] = tok[(size_t)l * 65536 + pos]; }
#pragma unroll
        for (int ai = 0; ai < 2; ++ai) {
            u32x2 xb[4][2][2];
#pragma unroll
            for (int m = 0; m < 4; ++m)
#pragma unroll
                for (int bj = 0; bj < 2; ++bj)
#pragma unroll
                    for (int nn = 0; nn < 2; ++nn) xb[m][bj][nn] = *(const u32x2*)(X1B + (size_t)tk[ai][m] * 1024 + col0 + bj * 128 + nn * 16);
#pragma unroll
            for (int m = 0; m < 4; ++m) {
                const int pos = u.pm * 256 + ai * 128 + wr * 64 + m * 16 + fr;
                if (pos < n) {
#pragma unroll
                    for (int bj = 0; bj < 2; ++bj)
#pragma unroll
                        for (int nn = 0; nn < 2; ++nn) { const u32x2 x = xb[m][bj][nn];
                            const f32x4 xv = (f32x4){bf2f(x.x & 0xffffu), bf2f(x.x >> 16), bf2f(x.y & 0xffffu), bf2f(x.y >> 16)};
                            __builtin_nontemporal_store(xv + acc[ai][bj][m][nn], (f32x4*)(O + (size_t)tk[ai][m] * 1024 + col0 + bj * 128 + nn * 16)); }
                }
            }
        }
    }
};
struct SchedMerge3 {
    const char* Y; const char* W; int G, c, rep;
    __device__ __forceinline__ bool next(int i, Unit& u) const {
        const int nwg = 1024; const long L = (long)i * G + c; if (L >= (long)nwg * rep) return false;
        int w = (int)(L % nwg); { const int q = nwg / 8, x = w % 8, off = w / 8; w = x * q + off; }
        const int nig = 8 * 4, gid = w / nig, fm = gid * 8;
        u.pm = fm + ((w % nig) % 8); u.pn = (w % nig) / 8; u.z = 0; return true; }
    __device__ __forceinline__ const char* a_ptr(const Unit& u, int t) const { return Y + (size_t)(t >> 2) * ((size_t)T * 512) + (size_t)u.pm * (256 * 512) + (size_t)(t & 3) * 128; }
    __device__ __forceinline__ const char* b_ptr(const Unit& u, int t) const { return W + (size_t)u.pn * (256 * 1536) + (size_t)t * 128; }
    __device__ __forceinline__ unsigned a_off(const Unit&, int) const { return 0u; }
};

__device__ __forceinline__ void rms_rows_bf16(const float* x, const float* g, bf16_t* out, unsigned char* out8, int nrows, int gw, int nw, int lane) {
    float4 gg[4];
#pragma unroll
    for (int i = 0; i < 4; ++i) gg[i] = ((const float4*)g)[lane + 64 * i];
#pragma unroll 1
    for (int r0 = gw; r0 < nrows; r0 += 2 * nw) {
        const int r1 = r0 + nw < nrows ? r0 + nw : r0;
        const float4* xa = (const float4*)(x + (size_t)r0 * 1024); const float4* xb = (const float4*)(x + (size_t)r1 * 1024);
        float4 va[4], vb[4]; float sa = 0.f, sb = 0.f;
#pragma unroll
        for (int i = 0; i < 4; ++i) { const f32x4 ta = __builtin_nontemporal_load((const f32x4*)xa + lane + 64 * i), tb = __builtin_nontemporal_load((const f32x4*)xb + lane + 64 * i);
            va[i] = make_float4(ta[0], ta[1], ta[2], ta[3]); vb[i] = make_float4(tb[0], tb[1], tb[2], tb[3]); }
#pragma unroll
        for (int i = 0; i < 4; ++i) { sa += va[i].x * va[i].x + va[i].y * va[i].y + va[i].z * va[i].z + va[i].w * va[i].w; sb += vb[i].x * vb[i].x + vb[i].y * vb[i].y + vb[i].z * vb[i].z + vb[i].w * vb[i].w; }
        sa = wave_sum(sa); sb = wave_sum(sb);
        const float ra = rsqrtf(sa * (1.0f / 1024.0f) + 1e-6f), rb = rsqrtf(sb * (1.0f / 1024.0f) + 1e-6f);
#pragma unroll
        for (int i = 0; i < 4; ++i) {
            u32x2 w; w.x = cvt_pk_bf16(va[i].x * ra * gg[i].x, va[i].y * ra * gg[i].y); w.y = cvt_pk_bf16(va[i].z * ra * gg[i].z, va[i].w * ra * gg[i].w);
            if (out) *(u32x2*)(out + (size_t)r0 * 1024 + (lane + 64 * i) * 4) = w;
            if (out8) *(unsigned*)(out8 + (size_t)r0 * 1024 + (lane + 64 * i) * 4) = pack_fp8x4(va[i].x * ra * gg[i].x, va[i].y * ra * gg[i].y, va[i].z * ra * gg[i].z, va[i].w * ra * gg[i].w);
            if (r1 != r0) { u32x2 z; z.x = cvt_pk_bf16(vb[i].x * rb * gg[i].x, vb[i].y * rb * gg[i].y); z.y = cvt_pk_bf16(vb[i].z * rb * gg[i].z, vb[i].w * rb * gg[i].w);
                if (out) *(u32x2*)(out + (size_t)r1 * 1024 + (lane + 64 * i) * 4) = z;
                if (out8) *(unsigned*)(out8 + (size_t)r1 * 1024 + (lane + 64 * i) * 4) = pack_fp8x4(vb[i].x * rb * gg[i].x, vb[i].y * rb * gg[i].y, vb[i].z * rb * gg[i].z, vb[i].w * rb * gg[i].w); }
        }
    }
}
__device__ __forceinline__ void tr_tile(LAS float* tl, const float* src, int ldsrc, int nvalid, const float* ks, float tsc, bf16_t* dst, unsigned char* dst8, int ldd, int lane) {
    const int r = lane >> 4, c4 = (lane & 15) * 4;
    float4 v[16];
#pragma unroll
    for (int p = 0; p < 16; ++p) { const int k = r + 4 * p; v[p] = make_float4(0.f, 0.f, 0.f, 0.f); if (c4 < nvalid) { const f32x4 tv = __builtin_nontemporal_load((const f32x4*)(src + (size_t)k * ldsrc + c4)); v[p] = make_float4(tv[0], tv[1], tv[2], tv[3]); } }
#pragma unroll
    for (int p = 0; p < 16; ++p) { const int k = r + 4 * p; float4 w = v[p];
        { const float sc = ks ? ks[k] * tsc : tsc; w.x *= sc; w.y *= sc; w.z *= sc; w.w *= sc; }
        tl[k * 65 + c4] = w.x; tl[k * 65 + c4 + 1] = w.y; tl[k * 65 + c4 + 2] = w.z; tl[k * 65 + c4 + 3] = w.w; }
    const int kq = lane & 7;
#pragma unroll
    for (int p = 0; p < 8; ++p) { const int n = (lane >> 3) + 8 * p; float f[8];
#pragma unroll
        for (int j = 0; j < 8; ++j) f[j] = tl[(kq * 8 + j) * 65 + n];
        if (dst8) { u32x2 w8; w8.x = pack_fp8x4(f[0], f[1], f[2], f[3]); w8.y = pack_fp8x4(f[4], f[5], f[6], f[7]); *(u32x2*)(dst8 + (size_t)n * ldd + kq * 8) = w8; }
        else { u32x4 w; w.x = cvt_pk_bf16(f[0], f[1]); w.y = cvt_pk_bf16(f[2], f[3]); w.z = cvt_pk_bf16(f[4], f[5]); w.w = cvt_pk_bf16(f[6], f[7]);
            *(u32x4*)(dst + (size_t)n * ldd + kq * 8) = w; } }
}
struct cf { float re, im; };
__device__ __forceinline__ cf cmul(cf a, cf b) { return cf{a.re * b.re - a.im * b.im, a.re * b.im + a.im * b.re}; }
__device__ __forceinline__ cf lam_pow(const Args& a, int g, int p, float e) {
    const float lre = INP(I_LRE)[g * 64 + p], lim = INP(I_LIM)[g * 64 + p], dt = __expf(INP(I_LDT)[g]);
    const float mag = __expf(lre * dt * e);
    const double rev = (double)lim * (double)dt * (double)e * 0.15915494309189535; const float fr = (float)(rev - rint(rev));
    return cf{mag * __builtin_amdgcn_cosf(fr), mag * __builtin_amdgcn_sinf(fr)};
}
__device__ __forceinline__ cf bbar_of(const Args& a, int g, int p, int h) {
    const float lre = INP(I_LRE)[g * 64 + p], lim = INP(I_LIM)[g * 64 + p];
    const cf lb = lam_pow(a, g, p, 1.0f); const cf num = cf{lb.re - 1.0f, lb.im};
    const float inv = 1.0f / (lre * lre + lim * lim);
    const cf q = cf{(num.re * lre + num.im * lim) * inv, (num.im * lre - num.re * lim) * inv};
    return cmul(q, cf{INP(I_BRE)[(g * 64 + p) * 16 + h], INP(I_BIM)[(g * 64 + p) * 16 + h]});
}
__device__ __forceinline__ void p0_prep(const Frame& F, const Args& a) {
    const int gw = F.c * 8 + F.wave, nw = F.G * 8;
    rms_rows_bf16(INP(I_X), INP(I_GMIX), WSP(bf16_t, WS_HB), WSP(unsigned char, WS_HB8), T, gw, nw, F.lane);
    rms_rows_bf16(INP(I_MEM), INP(I_GMEM), nullptr, WSP(unsigned char, WS_MEMN), 8192, gw, nw, F.lane);
    LAS float* tl = (LAS float*)F.lds + F.wave * (64 * 65);
    constexpr int NT_WIN = 80 * 16, NT_WMEM = 256, NT_WGLU = 64, NT_WUP = 384, NT_WOUT = 256, NT_E = 4096;
    constexpr int O1 = NT_WIN, O2 = O1 + NT_WMEM, O3 = O2 + NT_WGLU, O4 = O3 + NT_WUP, O5 = O4 + NT_WOUT, O6 = O5 + NT_E, O7 = O6 + NT_E, O8 = O7 + NT_E;
    for (int ti = gw; ti < O8; ti += nw) {
        const float* src; int ldsrc, nvalid = 64, ldd; const float* ks = nullptr; bf16_t* dst = nullptr; unsigned char* dst8 = nullptr; float tsc = 1.0f;
        if (ti < O1) { const int nt = ti / 16, kt = ti % 16, n0 = nt * 64; int sc;
            if (n0 < 1152) sc = n0;
            else if (n0 == 1152) sc = 1408;
            else if (n0 == 1216) { sc = 1472; nvalid = 4; }
            else if (n0 < 1280) { sc = 0; nvalid = 0; }
            else if (n0 < 1536) sc = 1152 + (n0 - 1280);
            else if (n0 < 2048) sc = 1476 + (n0 - 1536);
            else { sc = 1988 + (n0 - 2048); tsc = -1.4426950408889634f; }
            src = INP(I_WIN) + (size_t)kt * 64 * 5060 + sc; ldsrc = 5060; ldd = 1024;
            if (n0 >= 1024 && n0 < 1536) dst = WSP(bf16_t, WS_WIN) + (size_t)(n0 - 1024) * 1024 + kt * 64;
            else { const int r8 = n0 < 1024 ? n0 : (n0 < 2048 ? n0 - 512 : n0 - 512); dst8 = WSP(unsigned char, WS_WG8) + (size_t)r8 * 1024 + kt * 64; tsc *= 32.0f; } }
        else if (ti < O2) { const int t = ti - O1, nt = t / 16, kt = t % 16; src = INP(I_WMEMKV) + (size_t)kt * 64 * 1024 + nt * 64; ldsrc = 1024; tsc = 32.0f; dst8 = WSP(unsigned char, WS_WMEM) + (size_t)nt * 64 * 1024 + kt * 64; ldd = 1024; }
        else if (ti < O3) { const int t = ti - O2, nt = t / 8, kt = t % 8; src = INP(I_WGLU) + (size_t)kt * 64 * 512 + nt * 64; ldsrc = 512; dst = WSP(bf16_t, WS_WGLU) + (size_t)nt * 64 * 512 + kt * 64; ldd = 512; }
        else if (ti < O4) { const int t = ti - O3, br = t / 128, tt = t % 128, nt = tt / 8, kt = tt % 8; const float* w = br == 0 ? INP(I_WUPS) : (br == 1 ? INP(I_WUPD) : INP(I_WUPM));
            src = w + (size_t)kt * 64 * 1024 + nt * 64; ldsrc = 1024; tsc = 32.0f; dst8 = WSP(unsigned char, WS_WUP) + (size_t)nt * 64 * 1536 + br * 512 + kt * 64; ldd = 1536; }
        else if (ti < O5) { const int t = ti - O4, nt = t / 16, kt = t % 16; src = INP(I_WOUT) + (size_t)kt * 64 * 1024 + nt * 64; ldsrc = 1024; tsc = 32.0f; dst8 = WSP(unsigned char, WS_WOUT) + (size_t)nt * 64 * 1024 + kt * 64; ldd = 1024; }
        else if (ti < O7) { const int up = ti >= O6, t = ti - (up ? O6 : O5), e = t / 128, tt = t % 128, nt = tt / 16, kt = tt % 16, j0 = nt * 64;
            src = (up ? INP(I_WUP) : INP(I_WGATE)) + (size_t)e * 1024 * 512 + (size_t)kt * 64 * 512 + j0; ldsrc = 512; ks = INP(I_GFFN) + kt * 64; tsc = 32.0f;
            dst8 = WSP(unsigned char, WS_WGU) + (size_t)e * 1024 * 1024 + (size_t)((j0 >> 7) * 256 + up * 128 + (j0 & 127)) * 1024 + kt * 64; ldd = 1024; }
        else { const int t = ti - O7, e = t / 128, tt = t % 128, nt = tt / 8, kt = tt % 8;
            src = INP(I_WDOWN) + (size_t)e * 512 * 1024 + (size_t)kt * 64 * 1024 + nt * 64; ldsrc = 1024; tsc = 32.0f;
            dst8 = WSP(unsigned char, WS_WD) + (size_t)e * 1024 * 512 + (size_t)nt * 64 * 512 + kt * 64; ldd = 512; }
        tr_tile(tl, src, ldsrc, nvalid, ks, tsc, dst, dst8, ldd, F.lane);
    }
    const int gt = F.c * NTHR + F.tid, NTT = F.G * NTHR;
    for (int id = gt; id < 2048 * 33; id += NTT) { const int gp = id / 33, e = id - gp * 33; const cf z = lam_pow(a, gp >> 6, gp & 63, (float)e); WSP(float2, WS_LP)[id] = make_float2(z.re, z.im);
        if (e == 32) { WSP(float, WS_LAM32)[gp * 2] = z.re; WSP(float, WS_LAM32)[gp * 2 + 1] = z.im; } }
    for (int id = gt; id < 2048 * 16; id += NTT) { const int gp = id >> 4, h = id & 15; const cf z = bbar_of(a, gp >> 6, gp & 63, h); WSP(float2, WS_BB)[id] = make_float2(z.re, z.im); }
    for (int id = gt; id < 48 * 1024; id += NTT) { const int n = id >> 10, k = id & 1023;
        const float v = n < 4 ? INP(I_WGROUP)[k * 4 + n] : (n < 36 ? INP(I_WEXP)[k * 32 + (n - 4)] : 0.f);
        WSP(bf16_t, WS_WR)[id] = f2bf(v * INP(I_GFFN)[k]); }
}

__device__ __forceinline__ void p1_tables(const Frame& F, const Args& a, int wgi, int wgn) {
    const int gt = wgi * NTHR + F.tid, NTT = wgn * NTHR;
    bf16_t* TW = WSP(bf16_t, WS_TW); bf16_t* SIN = WSP(bf16_t, WS_SIN); const float2* LP = WSP(float2, WS_LP); const float2* BB = WSP(float2, WS_BB);
    for (int id = gt; id < 32 * 32 * 256; id += NTT) {
        const int hi = id & 15, ho = (id >> 4) & 15, d = (id >> 8) & 31, g = id >> 13;
        float val = 0.f;
        for (int p = 0; p < 64; ++p) { const float2 ez = LP[(g * 64 + p) * 33 + d], bb = BB[(g * 64 + p) * 16 + hi];
            const float cr = INP(I_CRE)[(g * 16 + ho) * 64 + p], ci = INP(I_CIM)[(g * 16 + ho) * 64 + p];
            const float tr = cr * ez.x - ci * ez.y, ti = cr * ez.y + ci * ez.x; val += tr * bb.x - ti * bb.y; }
        if (d == 0 && ho == hi) val += INP(I_DSKIP)[g * 16 + ho];
        const bf16_t bv = f2bf(val); bf16_t* tg = TW + (size_t)g * 512 * 640;
        for (int i = d; i < 32; ++i) { tg[(size_t)(i * 16 + ho) * 640 + (i - d) * 16 + hi] = bv; if (d > 0) tg[(size_t)((i - d) * 16 + ho) * 640 + i * 16 + hi] = 0; }
    }
    for (int id = gt; id < 32 * 32 * 16 * 64; id += NTT) {
        const int p = id & 63, ho = (id >> 6) & 15, i = (id >> 10) & 31, g = id >> 15;
        const float2 ez = LP[(g * 64 + p) * 33 + i + 1]; const float cr = INP(I_CRE)[(g * 16 + ho) * 64 + p], ci = INP(I_CIM)[(g * 16 + ho) * 64 + p];
        bf16_t* row = TW + (size_t)g * 512 * 640 + (size_t)(i * 16 + ho) * 640 + 512; row[p] = f2bf(cr * ez.x - ci * ez.y); row[64 + p] = f2bf(-(cr * ez.y + ci * ez.x));
    }
    for (int id = gt; id < 32 * 64 * 32 * 16; id += NTT) {
        const int h = id & 15, j = (id >> 4) & 31, p = (id >> 9) & 63, g = id >> 15;
        const float2 ez = LP[(g * 64 + p) * 33 + 31 - j], bb = BB[(g * 64 + p) * 16 + h];
        bf16_t* sg = SIN + (size_t)g * 256 * 512; sg[(size_t)p * 512 + j * 16 + h] = f2bf(ez.x * bb.x - ez.y * bb.y); sg[(size_t)(64 + p) * 512 + j * 16 + h] = f2bf(ez.x * bb.y + ez.y * bb.x);
    }
    for (int id = gt; id < 32 * 128 * 64; id += NTT) {
        const int q = id & 63, r = (id >> 6) & 127, g = id >> 13;
        *(u32x4*)(SIN + (size_t)g * 256 * 512 + (size_t)(128 + r) * 512 + q * 8) = (u32x4){0u, 0u, 0u, 0u};
    }
}

__device__ __forceinline__ void p2_post(const Frame& F, const Args& a, bool dry) {
    const int gw = F.c * 8 + F.wave, nw = F.G * 8, lane = F.lane, j = lane & 3, hs = lane >> 5, lr = lane & 31;
    const bf16_t* KVX = WSP(bf16_t, WS_KVX); unsigned char* KVP8 = WSP(unsigned char, WS_KVP); bf16_t* KIP = WSP(bf16_t, WS_KIP); bf16_t* QI = WSP(bf16_t, WS_QI);
    const bool rqi = lr < 16, rk = lr >= 16 && lr < 20, rki = lr >= 20 && lr < 24;
    const float scl = rqi ? 0.125f : 1.0f;
    float g1[8], g2[8];
#pragma unroll
    for (int e = 0; e < 8; ++e) { g1[e] = rk ? INP(I_GK)[8 * j + e] : 1.0f; g2[e] = rk ? INP(I_GK)[32 + 8 * j + e] : 1.0f; }
    constexpr int TB = 4;
    typedef float f32x2e __attribute__((ext_vector_type(2)));
    LAS f32x2e* cst = (LAS f32x2e*)F.lds + F.wave * (TB * 64);
    const float invf1 = __expf(-(float)lr * (9.210340371976184f / 32.0f));
#pragma unroll 1
    for (int tb = gw; tb < T; tb += nw * TB * 2) {
        u32x4 lo[TB], hi[TB]; float posf[TB]; unsigned short wraw[TB];
#pragma unroll
        for (int u = 0; u < TB; ++u) {
            const int tt = tb + (u * 2 + hs) * nw, t = tt < T ? tt : T - 1;
            const bf16_t* src;
            if (rqi) src = QI + (size_t)t * 256 + (lr >> 2) * 64;
            else if (rk) src = KVX + (size_t)t * 256;
            else if (rki) src = KVX + (size_t)t * 256 + 128;
            else src = KVX + (size_t)t * 256 + 64 + (lr - 24) * 8 - 8 * j;
            lo[u] = *(const u32x4*)(src + 8 * j); hi[u] = (lr < 24) ? *(const u32x4*)(src + 32 + 8 * j) : lo[u];
            posf[u] = (float)((const int*)a.in[I_POS])[t];
            wraw[u] = KVX[(size_t)t * 256 + 192 + (lane & 3)];
            { const float ang = posf[u] * invf1; const double rev = (double)ang * 0.15915494309189535; const float fr = (float)(rev - rint(rev));
              const f32x2e cs2 = (f32x2e){__builtin_amdgcn_cosf(fr), __builtin_amdgcn_sinf(fr)}; cst[(u * 2 + hs) * 32 + lr] = cs2;
              if (tt < T) WSP(f32x2e, WS_CS)[(size_t)t * 32 + lr] = cs2; }
        }
#pragma unroll
        for (int u = 0; u < TB; ++u) {
            const int t = tb + (u * 2 + hs) * nw;
            const bool live = t < T;
            if (lr < 24) {
                bf16_t* dst;
                if (rqi) dst = dry ? WSP(bf16_t, WS_RW) + (size_t)(live ? t : 0) * 256 + (lr >> 2) * 64 : QI + (size_t)(live ? t : 0) * 256 + (lr >> 2) * 64;
                else if (rk) dst = nullptr;
                else dst = KIP + (size_t)(live ? t : 0) * 64;
                f32x4 a0, a1, b0, b1; unpack8(lo[u], a0, a1); unpack8(hi[u], b0, b1);
                float x1[8] = {a0[0], a0[1], a0[2], a0[3], a1[0], a1[1], a1[2], a1[3]}, x2[8] = {b0[0], b0[1], b0[2], b0[3], b1[0], b1[1], b1[2], b1[3]};
                float ss = 0.f;
#pragma unroll
                for (int e = 0; e < 8; ++e) ss += x1[e] * x1[e] + x2[e] * x2[e];
                ss += __shfl_xor(ss, 1); ss += __shfl_xor(ss, 2);
                const float rs = rk ? rsqrtf(ss * (1.0f / 64.0f) + 1e-6f) : 1.0f;
                float o1[8], o2[8];
#pragma unroll
                for (int e = 0; e < 8; ++e) {
                    const f32x2e csn = cst[(u * 2 + hs) * 32 + 8 * j + e]; const float cs = csn.x, sn = csn.y;
                    const float y1 = x1[e] * rs * g1[e], y2 = x2[e] * rs * g2[e];
                    o1[e] = (y1 * cs - y2 * sn) * scl; o2[e] = (y2 * cs + y1 * sn) * scl; }
                if (live) {
                    if (rk) {
                        u32x2 w0, w1; w0.x = pack_fp8x4(o1[0], o1[1], o1[2], o1[3]); w0.y = pack_fp8x4(o1[4], o1[5], o1[6], o1[7]); w1.x = pack_fp8x4(o2[0], o2[1], o2[2], o2[3]); w1.y = pack_fp8x4(o2[4], o2[5], o2[6], o2[7]);
                        *(u32x2*)(KVP8 + (size_t)t * 128 + 8 * j) = w0; *(u32x2*)(KVP8 + (size_t)t * 128 + 32 + 8 * j) = w1;
                    } else {
                        *(u32x4*)(dst + 8 * j) = pack8((f32x4){o1[0], o1[1], o1[2], o1[3]}, (f32x4){o1[4], o1[5], o1[6], o1[7]});
                        *(u32x4*)(dst + 32 + 8 * j) = pack8((f32x4){o2[0], o2[1], o2[2], o2[3]}, (f32x4){o2[4], o2[5], o2[6], o2[7]}); } }
            } else if (live) {
                f32x4 a0, a1; unpack8(lo[u], a0, a1); u32x2 w; w.x = pack_fp8x4(a0[0], a0[1], a0[2], a0[3]); w.y = pack_fp8x4(a1[0], a1[1], a1[2], a1[3]);
                *(u32x2*)(KVP8 + (size_t)t * 128 + 64 + (lr - 24) * 8) = w;
            }
            if (lr < 4 && live) WSP(float, WS_WIF)[t * 4 + lr] = bf2f(wraw[u]) * 0.5f;
        }
    }
    const bf16_t* KMVM = WSP(bf16_t, WS_KMVM); bf16_t* KM = WSP(bf16_t, WS_KM); bf16_t* VMT = WSP(bf16_t, WS_VMT);
    { float gk8[8];
#pragma unroll
        for (int e = 0; e < 8; ++e) gk8[e] = INP(I_GKM)[(lane & 15) * 8 + e] * INP(I_GQM)[(lane & 15) * 8 + e];
        for (int r = gw; r < 8192; r += nw) {
            const int h = lane >> 4, b = r >> 8, m = r & 255;
            f32x4 a0, a1; unpack8(*(const u32x4*)(KMVM + (size_t)r * 1024 + h * 128 + (lane & 15) * 8), a0, a1);
            float ss = a0[0] * a0[0] + a0[1] * a0[1] + a0[2] * a0[2] + a0[3] * a0[3] + a1[0] * a1[0] + a1[1] * a1[1] + a1[2] * a1[2] + a1[3] * a1[3];
            ss += __shfl_xor(ss, 1); ss += __shfl_xor(ss, 2); ss += __shfl_xor(ss, 4); ss += __shfl_xor(ss, 8);
            const float rs = rsqrtf(ss * (1.0f / 128.0f) + 1e-6f);
            *(u32x4*)(KM + ((size_t)(b * 4 + h) * 256 + m) * 128 + (lane & 15) * 8) = pack8((f32x4){a0[0] * rs * gk8[0], a0[1] * rs * gk8[1], a0[2] * rs * gk8[2], a0[3] * rs * gk8[3]}, (f32x4){a1[0] * rs * gk8[4], a1[1] * rs * gk8[5], a1[2] * rs * gk8[6], a1[3] * rs * gk8[7]}); } }
    const int gt = F.c * NTHR + F.tid, NTT = F.G * NTHR;
    for (int id = gt; id < 32 * 4 * 32 * 128; id += NTT) { const int d = id & 127, pg = (id >> 7) & 31, h = (id >> 12) & 3, b = id >> 14;
        unsigned short v[8];
#pragma unroll
        for (int j = 0; j < 8; ++j) { const int pp = pg * 8 + j, q = pp & 15, key = (pp & ~15) + 8 * ((q & 7) >> 2) + 4 * (q >> 3) + (q & 3);
            v[j] = KMVM[(size_t)(b * 256 + key) * 1024 + 512 + h * 128 + d]; }
        u32x4 w; w.x = v[0] | ((unsigned)v[1] << 16); w.y = v[2] | ((unsigned)v[3] << 16); w.z = v[4] | ((unsigned)v[5] << 16); w.w = v[6] | ((unsigned)v[7] << 16);
        *(u32x4*)(VMT + ((size_t)(b * 4 + h) * 128 + d) * 256 + pg * 8) = w; }
}

__device__ __forceinline__ void p3_scan(const Frame& F) {
    const int gt = F.c * NTHR + F.tid, NTT = F.G * NTHR;
    const float* SC = WSP(float, WS_SC); bf16_t* UA = WSP(bf16_t, WS_UA);
    for (int id = gt; id < 65536; id += NTT) { const int p = id & 63, b = (id >> 6) & 31, g = id >> 11;
        const float lr = WSP(float, WS_LAM32)[(g * 64 + p) * 2], li = WSP(float, WS_LAM32)[(g * 64 + p) * 2 + 1];
        float sr = 0.f, si = 0.f;
        for (int c = 0; c < 64; ++c) { const size_t row = (size_t)g * 2048 + b * 64 + c;
            UA[row * 640 + 512 + p] = f2bf(sr); UA[row * 640 + 576 + p] = f2bf(si);
            const float cr = SC[row * 128 + p], ci = SC[row * 128 + 64 + p];
            const float nr = lr * sr - li * si + cr, ni = lr * si + li * sr + ci; sr = nr; si = ni; }
    }
}

constexpr int SEL_SC = 0, SEL_HIST = 131072, SEL_END = SEL_HIST + 128 * 17 * 4;
__device__ __forceinline__ int suffix_sum64(int x, int rm1, int rm2, int rm3, int& tot) {
    int p = x;
    p += __builtin_amdgcn_update_dpp(0, p, 0x111, 0xf, 0xf, false);
    p += __builtin_amdgcn_update_dpp(0, p, 0x112, 0xf, 0xf, false);
    p += __builtin_amdgcn_update_dpp(0, p, 0x114, 0xf, 0xf, false);
    p += __builtin_amdgcn_update_dpp(0, p, 0x118, 0xf, 0xf, false);
    const int t0 = __builtin_amdgcn_readlane(p, 15), t1 = __builtin_amdgcn_readlane(p, 31), t2 = __builtin_amdgcn_readlane(p, 47), t3 = __builtin_amdgcn_readlane(p, 63);
    p += (t0 & rm1) + (t1 & rm2) + (t2 & rm3);
    tot = t0 + t1 + t2 + t3;
    return tot - p + x;
}
__device__ __forceinline__ int mbcnt64(unsigned long long m) { return (int)__builtin_amdgcn_mbcnt_hi((unsigned)(m >> 32), __builtin_amdgcn_mbcnt_lo((unsigned)m, 0u)); }
__device__ __forceinline__ void p3_select(const Frame& F, bool doB) {
    LAS unsigned short* sc = (LAS unsigned short*)(F.lds + SEL_SC);
    LAS unsigned* hist = (LAS unsigned*)(F.lds + SEL_HIST);
    const bf16_t* QI = WSP(bf16_t, WS_QI); const bf16_t* KIP = WSP(bf16_t, WS_KIP); const float* WIF = WSP(float, WS_WIF);
    unsigned short* IDX = WSP(unsigned short, WS_IDX);
    const int lane = F.lane, n = lane & 31, hf = lane >> 5, wv = F.wave;
    const int rm1 = (lane >> 4) >= 1 ? -1 : 0, rm2 = (lane >> 4) >= 2 ? -1 : 0, rm3 = (lane >> 4) >= 3 ? -1 : 0;
#define SEL_UNIT(L_, QT, B_) int QT = 63 - ((L_) >> 5); const int B_ = (L_) & 31; \
        if (F.G == 256) { const int k_ = F.c >> 5, i_ = (L_) >> 8, pr_ = i_ >> 1;     \
            QT = (i_ & 1) ? (48 - 16 * pr_ + k_) : (63 - 16 * pr_ - k_); }
#define SEL_LOADQK(QT, B_) do { const int tk_ = (B_) * 2048 + (QT) * 32 + n; \
        _Pragma("unroll") for (int h = 0; h < 4; ++h) { wq[h] = WIF[tk_ * 4 + h]; \
            _Pragma("unroll") for (int ks = 0; ks < 4; ++ks) bq[h][ks] = *(const bf16x8*)(QI + (size_t)tk_ * 256 + h * 64 + ks * 16 + hf * 8); } \
        { const int k0 = wv < (QT) + 1 ? wv : 0; const bf16_t* kp = KIP + (size_t)((B_) * 2048 + k0 * 32 + n) * 64 + hf * 8; \
            _Pragma("unroll") for (int ks = 0; ks < 4; ++ks) ka[ks] = *(const bf16x8*)(kp + ks * 16); } } while (0)
    bf16x8 bq[4][4]; float wq[4]; bf16x8 ka[4];
    if (F.c < 2048) { SEL_UNIT(F.c, qt0, b0); SEL_LOADQK(qt0, b0); }
    for (int L = F.c; L < 2048; L += F.G) {
        SEL_UNIT(L, qt, b);
        const int t0 = qt * 32, nkt = qt + 1, tok0 = b * 2048 + t0;
        for (int i = F.tid; i < 128 * 17; i += NTHR) hist[i] = 0u;
        { const int nz = ((nkt * 8 + 63) & ~63) - nkt * 8;
            for (int i = F.tid; i < nz * 32; i += NTHR) { const int nn = i & 31, ch = nkt * 8 + (i >> 5); *(LAS u32x2*)(sc + nn * 2048 + ((ch ^ nn) << 2)) = (u32x2){0u, 0u}; } }
        __syncthreads();
        const unsigned hinc = 1u << (16 * (n & 1));
        for (int kt = wv; kt < nkt; kt += 8) {
            f32x16 acc[4];
#pragma unroll
            for (int h = 0; h < 4; ++h)
#pragma unroll
                for (int r = 0; r < 16; ++r) acc[h][r] = 0.f;
#pragma unroll
            for (int ks = 0; ks < 4; ++ks)
#pragma unroll
                for (int h = 0; h < 4; ++h) acc[h] = __builtin_amdgcn_mfma_f32_32x32x16_bf16(ka[ks], bq[h][ks], acc[h], 0, 0, 0);
            { const int k1 = kt + 8 < nkt ? kt + 8 : kt; const bf16_t* kp = KIP + (size_t)(b * 2048 + k1 * 32 + n) * 64 + hf * 8;
#pragma unroll
                for (int ks = 0; ks < 4; ++ks) ka[ks] = *(const bf16x8*)(kp + ks * 16); }
            unsigned key[16];
#pragma unroll
            for (int r = 0; r < 16; ++r) {
                const int i0 = __float_as_int(acc[0][r]), i1 = __float_as_int(acc[1][r]), i2 = __float_as_int(acc[2][r]), i3 = __float_as_int(acc[3][r]);
                const float isc = wq[0] * __int_as_float(i0 > 0 ? i0 : 0) + wq[1] * __int_as_float(i1 > 0 ? i1 : 0) + wq[2] * __int_as_float(i2 > 0 ? i2 : 0) + wq[3] * __int_as_float(i3 > 0 ? i3 : 0);
                const float y = isc * __builtin_amdgcn_rcpf(1.0f + 0.25f * fabsf(isc));
                key[r] = (unsigned)(y * 8191.75f + 32768.0f);
            }
            if (kt < qt) {
#pragma unroll
                for (int g4 = 0; g4 < 4; ++g4) {
#pragma unroll
                    for (int j = 0; j < 4; ++j) (void)__hip_atomic_fetch_add(hist + (key[g4 * 4 + j] >> 9) * 17 + (n >> 1), hinc, __ATOMIC_RELAXED, __HIP_MEMORY_SCOPE_WORKGROUP);
                    u32x2 w; w.x = key[g4 * 4] | (key[g4 * 4 + 1] << 16); w.y = key[g4 * 4 + 2] | (key[g4 * 4 + 3] << 16);
                    const int chunk = (kt * 32 + 8 * g4 + 4 * hf) >> 2;
                    *(LAS u32x2*)(sc + n * 2048 + ((chunk ^ n) << 2)) = w;
                }
            } else {
                asm volatile("" ::: "memory");
#pragma unroll
                for (int g4 = 0; g4 < 4; ++g4) {
                    unsigned kk[4];
#pragma unroll
                    for (int j = 0; j < 4; ++j) { const int s = kt * 32 + j + 8 * g4 + 4 * hf; const bool valid = s <= t0 + n;
                        kk[j] = valid ? key[g4 * 4 + j] : 0u;
                        (void)__hip_atomic_fetch_add(hist + (kk[j] >> 9) * 17 + (n >> 1), valid ? hinc : 0u, __ATOMIC_RELAXED, __HIP_MEMORY_SCOPE_WORKGROUP); }
                    u32x2 w; w.x = kk[0] | (kk[1] << 16); w.y = kk[2] | (kk[3] << 16);
                    const int chunk = (kt * 32 + 8 * g4 + 4 * hf) >> 2;
                    *(LAS u32x2*)(sc + n * 2048 + ((chunk ^ n) << 2)) = w;
                }
            }
        }
        __syncthreads();
        if (L + F.G < 2048) { SEL_UNIT(L + F.G, qtn, bn); SEL_LOADQK(qtn, bn); }
        for (int qq = 0; qq < (doB ? 4 : 0); ++qq) {
            const int nq = wv * 4 + qq, tq = t0 + nq, nvalid = tq + 1, tok = tok0 + nq;
            LAS unsigned short* lst = sc + nq * 2048; LAS unsigned* cand = (LAS unsigned*)(sc + nq * 2048 + 512);
            if (nvalid <= 256) {
#pragma unroll
                for (int e = 0; e < 4; ++e) { const int p = lane * 4 + e; lst[p] = (unsigned short)(p < nvalid ? p : 0); }
            } else {
                unsigned v[32];
                LAS const unsigned short* rowp = sc + nq * 2048 + ((((lane >> 2) ^ (nq & 15)) << 2) | (lane & 3));
#pragma unroll
                for (int r = 0; r < 32; ++r) v[r] = rowp[r * 64];
                const int sh = 16 * (nq & 1);
                const int hhi = (int)((hist[(64 + lane) * 17 + (nq >> 1)] >> sh) & 0xffffu), hlo = (int)((hist[lane * 17 + (nq >> 1)] >> sh) & 0xffffu);
                int tothi; const int shi = suffix_sum64(hhi, rm1, rm2, rm3, tothi);
                int b1, above;
                if (tothi >= 256) { const unsigned long long mk = __builtin_amdgcn_ballot_w64(shi >= 256); const int lb = 63 - __clzll(mk); b1 = 64 + lb; above = __builtin_amdgcn_readlane(shi - hhi, lb); }
                else { int totlo; const int slo = tothi + suffix_sum64(hlo, rm1, rm2, rm3, totlo); const unsigned long long mk = __builtin_amdgcn_ballot_w64(slo >= 256); const int lb = 63 - __clzll(mk); b1 = lb; above = __builtin_amdgcn_readlane(slo - hlo, lb); }
                const int sw64 = (nq >> 4) << 6, laneE = lane + sw64, laneO = lane - sw64;
                int base = 0, m = 0;
                const unsigned binhi = (unsigned)b1 * 512u + 511u, binlo = b1 ? (unsigned)b1 * 512u : 1u, binspan = binhi - binlo;
#pragma unroll
                for (int r4 = 0; r4 < 32; r4 += 4) {
                    if (r4 * 64 >= nvalid) break;
#pragma unroll
                    for (int rr = 0; rr < 4; ++rr) { const int r = r4 + rr; const unsigned idx = (unsigned)(r * 64 + ((r & 1) ? laneO : laneE));
                        const bool gt_ = v[r] > binhi, eq = (v[r] - binlo) <= binspan;
                        const unsigned long long mg = __builtin_amdgcn_ballot_w64(gt_), me = __builtin_amdgcn_ballot_w64(eq);
                        int pg = base + mbcnt64(mg), cp = m + mbcnt64(me);
                        asm("" : "+v"(pg), "+v"(cp));
                        lst[gt_ ? pg : 256 + lane] = (unsigned short)idx;
                        cand[(eq && cp < 128) ? cp : 128 + lane] = ((v[r] & 511u) << 11) | idx;
                        base += __popcll(mg); m += __popcll(me); }
                }
                if (m <= 128) {
                    const int need = 256 - above;
                    const unsigned c0 = lane < m ? cand[lane] : 0u, c1 = 64 + lane < m ? cand[64 + lane] : 0u;
                    const unsigned a0 = lane < m ? (c0 >> 11) + 1u : 0u, a1 = 64 + lane < m ? (c1 >> 11) + 1u : 0u;
                    unsigned lo = 0u;
                    for (int bit = 9; bit >= 0; --bit) { const unsigned cd = lo | (1u << bit); const int c = __popcll(__builtin_amdgcn_ballot_w64(a0 >= cd)) + __popcll(__builtin_amdgcn_ballot_w64(a1 >= cd)); if (c >= need) lo = cd; }
                    const unsigned long long g0 = __builtin_amdgcn_ballot_w64(a0 > lo), g1 = __builtin_amdgcn_ballot_w64(a1 > lo), e0 = __builtin_amdgcn_ballot_w64(a0 == lo), e1 = __builtin_amdgcn_ballot_w64(a1 == lo);
                    const int ties = need - (__popcll(g0) + __popcll(g1));
                    int k0 = mbcnt64(e0), k1 = __popcll(e0) + mbcnt64(e1); asm("" : "+v"(k0), "+v"(k1));
                    const bool s0 = a0 > lo || (a0 == lo && k0 < ties), s1 = a1 > lo || (a1 == lo && k1 < ties);
                    const unsigned long long m0 = __builtin_amdgcn_ballot_w64(s0), m1 = __builtin_amdgcn_ballot_w64(s1);
                    if (s0) lst[base + mbcnt64(m0)] = (unsigned short)(c0 & 2047u);
                    if (s1) lst[base + __popcll(m0) + mbcnt64(m1)] = (unsigned short)(c1 & 2047u);
                } else {
#pragma unroll
                    for (int r = 0; r < 32; ++r) v[r] = ((r * 64 + ((r & 1) ? laneO : laneE)) < nvalid) ? v[r] : 0u;
                    unsigned lo = 0u;
                    for (int bit = 15; bit >= 0; --bit) { const unsigned cd = lo | (1u << bit); int cnt = 0;
#pragma unroll
                        for (int r = 0; r < 32; ++r) cnt += __popcll(__builtin_amdgcn_ballot_w64(v[r] >= cd));
                        if (cnt >= 256) lo = cd; }
                    int cgt = 0;
#pragma unroll
                    for (int r = 0; r < 32; ++r) cgt += __popcll(__builtin_amdgcn_ballot_w64(v[r] > lo));
                    const int need = 256 - cgt; int bs = 0, eqb = 0;
#pragma unroll
                    for (int r = 0; r < 32; ++r) {
                        const bool gt_ = v[r] > lo, eq = v[r] == lo;
                        const unsigned long long me = __builtin_amdgcn_ballot_w64(eq);
                        const bool sel = gt_ || (eq && eqb + mbcnt64(me) < need);
                        const unsigned long long ms = __builtin_amdgcn_ballot_w64(sel);
                        if (sel) lst[bs + mbcnt64(ms)] = (unsigned short)(r * 64 + ((r & 1) ? laneO : laneE));
                        bs += __popcll(ms); eqb += __popcll(me);
                    }
                }
            }
            *(u32x2*)(IDX + (size_t)tok * 256 + lane * 4) = *(LAS u32x2*)(lst + lane * 4);
        }
        __syncthreads();
    }
}

#undef SEL_UNIT
#undef SEL_LOADQK
__device__ __forceinline__ void p3_memattn(const Frame& F) {
    constexpr int KS = 272, VS = 528, VOFF = 256 * KS;
    const bf16_t* KM = WSP(bf16_t, WS_KM); const bf16_t* VMT = WSP(bf16_t, WS_VMT); const bf16_t* QM = DOP(bf16_t, DO_Y3) + 512; unsigned char* YM8 = DOP(unsigned char, DO_YM8);
    const int lane = F.lane, n = lane & 31, hf = lane >> 5;
    for (int u = F.c; u < 256; u += F.G) {
        const int half = u & 1, bh = u >> 1, b = bh >> 2, h = bh & 3;
#pragma unroll
        for (int i = 0; i < 8; ++i) { const int id = F.tid + 512 * i;
            { const int row = id >> 4, seg = id & 15; *(LAS u32x4*)(F.lds + row * KS + seg * 16) = *(const u32x4*)(KM + ((size_t)bh * 256 + row) * 128 + seg * 8); }
            { const int row = id >> 5, seg = id & 31; *(LAS u32x4*)(F.lds + VOFF + row * VS + seg * 16) = *(const u32x4*)(VMT + ((size_t)bh * 128 + row) * 256 + seg * 8); } }
        __syncthreads();
#pragma unroll 1
        for (int qi = 0; qi < 4; ++qi) {
            const int tok = b * 2048 + half * 1024 + F.wave * 128 + qi * 32 + n;
            const bf16_t* qp = QM + (size_t)tok * Y3LD + h * 128;
            bf16x8 bq[8];
#pragma unroll
            for (int ks = 0; ks < 8; ++ks) bq[ks] = *(const bf16x8*)(qp + ks * 16 + hf * 8);
            float qss = 0.f;
#pragma unroll
            for (int ks = 0; ks < 8; ++ks)
#pragma unroll
                for (int e = 0; e < 8; ++e) { const float f = bf2f((unsigned short)bq[ks][e]); qss += f * f; }
            qss += __shfl_xor(qss, 32);
            const float qc = rsqrtf(qss * (1.0f / 128.0f) + 1e-6f) * (0.08838834764831845f * 1.4426950408889634f);
            f32x16 o[4];
#pragma unroll
            for (int dt = 0; dt < 4; ++dt)
#pragma unroll
                for (int r = 0; r < 16; ++r) o[dt][r] = 0.f;
            float mrun = -3.0e38f, lrun = 0.f;
#pragma unroll 1
            for (int kh = 0; kh < 2; ++kh) {
                f32x16 s[4];
#pragma unroll
                for (int k4 = 0; k4 < 4; ++k4) { const int kt = kh * 4 + k4;
#pragma unroll
                    for (int r = 0; r < 16; ++r) s[k4][r] = 0.f;
#pragma unroll
                    for (int ks = 0; ks < 8; ++ks) { const bf16x8 a = *(const LAS bf16x8*)(F.lds + (kt * 32 + n) * KS + (ks * 16 + hf * 8) * 2);
                        s[k4] = __builtin_amdgcn_mfma_f32_32x32x16_bf16(a, bq[ks], s[k4], 0, 0, 0); } }
                float mx = mrun;
#pragma unroll
                for (int k4 = 0; k4 < 4; ++k4)
#pragma unroll
                    for (int r = 0; r < 16; ++r) mx = fmaxf(mx, s[k4][r]);
                mx = fmaxf(mx, __shfl_xor(mx, 32));
                const float resc = __builtin_amdgcn_exp2f((mrun - mx) * qc);
                float sum = 0.f;
#pragma unroll
                for (int k4 = 0; k4 < 4; ++k4)
#pragma unroll
                    for (int r = 0; r < 16; ++r) { const float p = __builtin_amdgcn_exp2f((s[k4][r] - mx) * qc); s[k4][r] = p; sum += p; }
                sum += __shfl_xor(sum, 32);
                lrun = lrun * resc + sum; mrun = mx;
#pragma unroll
                for (int dt = 0; dt < 4; ++dt)
#pragma unroll
                    for (int r = 0; r < 16; ++r) o[dt][r] *= resc;
#pragma unroll
                for (int k4 = 0; k4 < 4; ++k4)
#pragma unroll
                    for (int st = 0; st < 2; ++st) { const int kt = kh * 4 + k4;
                        union { u32x4 u; bf16x8 v; } pb;
                        pb.u.x = cvt_pk_bf16(s[k4][8 * st + 0], s[k4][8 * st + 1]); pb.u.y = cvt_pk_bf16(s[k4][8 * st + 2], s[k4][8 * st + 3]);
                        pb.u.z = cvt_pk_bf16(s[k4][8 * st + 4], s[k4][8 * st + 5]); pb.u.w = cvt_pk_bf16(s[k4][8 * st + 6], s[k4][8 * st + 7]);
#pragma unroll
                        for (int dt = 0; dt < 4; ++dt) { const bf16x8 a = *(const LAS bf16x8*)(F.lds + VOFF + (dt * 32 + n) * VS + (kt * 32 + 16 * st + 8 * hf) * 2);
                            o[dt] = __builtin_amdgcn_mfma_f32_32x32x16_bf16(a, pb.v, o[dt], 0, 0, 0); }
                    }
            }
            const float inv = 16.0f / lrun;
#pragma unroll
            for (int dt = 0; dt < 4; ++dt)
#pragma unroll
                for (int g4 = 0; g4 < 4; ++g4)
                    *(unsigned*)(YM8 + (size_t)tok * 512 + h * 128 + dt * 32 + 8 * g4 + 4 * hf) = pack_fp8x4(o[dt][g4 * 4] * inv, o[dt][g4 * 4 + 1] * inv, o[dt][g4 * 4 + 2] * inv, o[dt][g4 * 4 + 3] * inv);
        }
        __syncthreads();
    }
}

__device__ __forceinline__ void p4_attend(const Frame& F, const Args& a) {
    constexpr int WB = 2 * 8192 + 1024;
    LAS unsigned char* wb = F.lds + F.wave * WB;
    LAS unsigned short* lst = (LAS unsigned short*)(wb + 16384);
    const unsigned short* IDX = WSP(unsigned short, WS_IDX); const unsigned char* KVP8 = WSP(unsigned char, WS_KVP); const bf16_t* Q = DOP(bf16_t, DO_Y3); unsigned char* YD8 = DOP(unsigned char, DO_YD8);
    const int lane = F.lane, n = lane & 15, g = lane >> 4, gw = F.c * 8 + F.wave, nw = F.G * 8;
    const int ntk = (T - gw + nw - 1) / nw;
    float gkm = fabsf(INP(I_GK)[lane]);
    gkm = fmaxf(gkm, __shfl_xor(gkm, 32)); gkm = fmaxf(gkm, __shfl_xor(gkm, 16)); gkm = fmaxf(gkm, __shfl_xor(gkm, 8)); gkm = fmaxf(gkm, __shfl_xor(gkm, 4)); gkm = fmaxf(gkm, __shfl_xor(gkm, 2)); gkm = fmaxf(gkm, __shfl_xor(gkm, 1));
    const float kmax = 8.0f * gkm * 1.07f;
    int koff[4][2];
#pragma unroll
    for (int blk = 0; blk < 4; ++blk)
#pragma unroll
        for (int ks = 0; ks < 2; ++ks) { const int row = blk * 16 + n, pc = ks * 2 + (g >> 1); koff[blk][ks] = row * 128 + ((pc ^ (row & 7)) << 4) + 8 * (g & 1); }
    const int q8 = n >> 1, p8 = n & 1;
    int toff[2][4];
#pragma unroll
    for (int kb2 = 0; kb2 < 2; ++kb2)
#pragma unroll
        for (int d = 0; d < 4; ++d) { const int row = (kb2 * 2 + (q8 >> 2)) * 16 + g * 4 + (q8 & 3), pc = 4 + d; toff[kb2][d] = row * 128 + ((pc ^ (row & 7)) << 4) + 8 * p8; }
    const int grow = lane >> 3, gpc = lane & 7;
    const unsigned wbase = (unsigned)(uintptr_t)wb;
#define AT_ISSUE(TOK, LB, CH, BUF) do { const char* _kb = (const char*)(KVP8 + (size_t)((TOK) >> 11) * 2048 * 128); \
        _Pragma("unroll") for (int _i = 0; _i < 8; ++_i) { const int _row = 8 * _i + grow; const int _key = lst[(LB) * 256 + (CH) * 64 + _row]; \
            __builtin_amdgcn_global_load_lds((const unsigned*)(_kb + (size_t)_key * 128 + ((gpc ^ (_row & 7)) << 4)), (LAS unsigned*)(wb + (BUF) * 8192 + _i * 1024), 16, 0, 0); } } while (0)
    if (ntk <= 0) return;
    { const u32x2 l0 = *(const u32x2*)(IDX + (size_t)gw * 256 + lane * 4); *(LAS u32x2*)(lst + lane * 4) = l0; }
    float gq1[8], gq2[8];
#pragma unroll
    for (int e = 0; e < 8; ++e) { gq1[e] = INP(I_GQ)[g * 8 + e]; gq2[e] = INP(I_GQ)[32 + g * 8 + e]; }
    const f32x4* CS = WSP(f32x4, WS_CS);
    bf16x8 nbq[2]; f32x4 ncs[4];
#pragma unroll
    for (int e = 0; e < 4; ++e) ncs[e] = CS[(size_t)gw * 16 + g * 4 + e];
#pragma unroll
    for (int ks = 0; ks < 2; ++ks) { if (n < 8) nbq[ks] = *(const bf16x8*)(Q + (size_t)gw * Y3LD + n * 64 + ks * 32 + g * 8); else nbq[ks] = (bf16x8){0, 0, 0, 0, 0, 0, 0, 0}; }
    AT_ISSUE(gw, 0, 0, 0); AT_ISSUE(gw, 0, 1, 1);
#pragma unroll 1
    for (int k = 0; k < ntk; ++k) {
        const int tok = gw + k * nw, ntok = tok + nw, lb = k & 1; const bool hasn = (k + 1 < ntk);
        const int tq = tok & 2047, cnt = tq + 1 < 256 ? tq + 1 : 256;
        long bq[2]; float qs = 0.f;
        { float x1[8], x2[8], ss = 0.f;
#pragma unroll
            for (int e = 0; e < 8; ++e) { x1[e] = bf2f((unsigned short)nbq[0][e]); x2[e] = bf2f((unsigned short)nbq[1][e]); ss += x1[e] * x1[e] + x2[e] * x2[e]; }
            ss += __shfl_xor(ss, 16); ss += __shfl_xor(ss, 32);
            const float rs = rsqrtf(ss * (1.0f / 64.0f) + 1e-6f) * (0.125f * 1.4426950408889634f); float o1[8], o2[8];
#pragma unroll
            for (int e = 0; e < 8; ++e) { const float cs = ncs[e >> 1][(e & 1) * 2], sn = ncs[e >> 1][(e & 1) * 2 + 1], y1 = x1[e] * rs * gq1[e], y2 = x2[e] * rs * gq2[e];
                o1[e] = y1 * cs - y2 * sn; o2[e] = y2 * cs + y1 * sn; qs += o1[e] * o1[e] + o2[e] * o2[e]; }
            const unsigned a0 = pack_fp8x4(o1[0], o1[1], o1[2], o1[3]), a1 = pack_fp8x4(o1[4], o1[5], o1[6], o1[7]), b0 = pack_fp8x4(o2[0], o2[1], o2[2], o2[3]), b1 = pack_fp8x4(o2[4], o2[5], o2[6], o2[7]);
            bq[0] = (long)(((unsigned long long)a1 << 32) | a0); bq[1] = (long)(((unsigned long long)b1 << 32) | b0); }
        qs += __shfl_xor(qs, 16); qs += __shfl_xor(qs, 32);
        const float shift = __builtin_amdgcn_sqrtf(qs) * 1.07f * kmax - 7.0f;
        const f32x4 nsh = (f32x4){-shift, -shift, -shift, -shift};
        u32x2 nl = (u32x2){0u, 0u};
        if (hasn) { nl = *(const u32x2*)(IDX + (size_t)ntok * 256 + lane * 4);
#pragma unroll
            for (int e = 0; e < 4; ++e) ncs[e] = CS[(size_t)ntok * 16 + g * 4 + e];
#pragma unroll
            for (int ks = 0; ks < 2; ++ks) if (n < 8) nbq[ks] = *(const bf16x8*)(Q + (size_t)ntok * Y3LD + n * 64 + ks * 32 + g * 8); }
        f32x4 o[4];
#pragma unroll
        for (int d = 0; d < 4; ++d) o[d] = (f32x4){0.f, 0.f, 0.f, 0.f};
        float lsum = 0.f;
#pragma unroll
        for (int ch = 0; ch < 4; ++ch) {
            const int buf = ch & 1;
            if (ch == 3 && !hasn) asm volatile("s_waitcnt vmcnt(0)" ::: "memory"); else asm volatile("s_waitcnt vmcnt(8)" ::: "memory");
            LAS const unsigned char* bb = wb + buf * 8192;
            f32x4 s[4];
#pragma unroll
            for (int blk = 0; blk < 4; ++blk) {
                const long k0 = *(LAS const long*)(bb + koff[blk][0]), k1 = *(LAS const long*)(bb + koff[blk][1]);
                s[blk] = __builtin_amdgcn_mfma_f32_16x16x32_fp8_fp8(k0, bq[0], nsh, 0, 0, 0);
                s[blk] = __builtin_amdgcn_mfma_f32_16x16x32_fp8_fp8(k1, bq[1], s[blk], 0, 0, 0);
            }
            float e[2][4];
#pragma unroll
            for (int b2 = 0; b2 < 2; ++b2)
#pragma unroll
                for (int j = 0; j < 4; ++j) e[b2][j] = __int_as_float(__builtin_amdgcn_update_dpp(__float_as_int(s[b2][j]), __float_as_int(s[b2 + 2][j]), 0x118, 0xf, 0xc, false));
            if (cnt >= (ch + 1) * 64) {
#pragma unroll
                for (int b2 = 0; b2 < 2; ++b2)
#pragma unroll
                    for (int j = 0; j < 4; ++j) { const float x = __builtin_amdgcn_exp2f(e[b2][j]); e[b2][j] = x; lsum += x; }
            } else {
                asm volatile("" ::: "memory");
#pragma unroll
                for (int b2 = 0; b2 < 2; ++b2)
#pragma unroll
                    for (int j = 0; j < 4; ++j) { const int p = ch * 64 + (b2 + (n >> 3) * 2) * 16 + g * 4 + j; const float x = p < cnt ? __builtin_amdgcn_exp2f(e[b2][j]) : 0.f; e[b2][j] = x; lsum += x; }
            }
            const unsigned w0 = pack_fp8x4_nc(e[0][0], e[0][1], e[0][2], e[0][3]), w1 = pack_fp8x4_nc(e[1][0], e[1][1], e[1][2], e[1][3]);
#pragma unroll
            for (int kb2 = 0; kb2 < 2; ++kb2) {
                const unsigned plo = kb2 == 0 ? w0 : (unsigned)__builtin_amdgcn_update_dpp(0, (int)w0, 0x108, 0xf, 0xf, true), phi = kb2 == 0 ? w1 : (unsigned)__builtin_amdgcn_update_dpp(0, (int)w1, 0x108, 0xf, 0xf, true);
                const long pb = (long)(((unsigned long long)phi << 32) | plo);
                u32x2 tr[4];
#pragma unroll
                for (int d = 0; d < 4; ++d) asm volatile("ds_read_b64_tr_b8 %0, %1 offset:%2" : "=&v"(tr[d]) : "v"(wbase + (unsigned)toff[kb2][d]), "i"(buf * 8192) : "memory");
                asm volatile("s_waitcnt lgkmcnt(0)" : "+v"(tr[0]), "+v"(tr[1]), "+v"(tr[2]), "+v"(tr[3]) :: "memory");
#pragma unroll
                for (int d = 0; d < 4; ++d) { const long av = (long)(((unsigned long long)tr[d].y << 32) | tr[d].x);
                    o[d] = __builtin_amdgcn_mfma_f32_16x16x32_fp8_fp8(av, pb, o[d], 0, 0, 0); }
            }
            __builtin_amdgcn_sched_barrier(0);
            if (ch == 1 && hasn) *(LAS u32x2*)(lst + (lb ^ 1) * 256 + lane * 4) = nl;
            if (ch < 2) AT_ISSUE(tok, lb, ch + 2, buf);
            else if (hasn) AT_ISSUE(ntok, lb ^ 1, ch - 2, buf);
            __builtin_amdgcn_sched_barrier(0);
        }
        lsum += __int_as_float(__builtin_amdgcn_update_dpp(0, __float_as_int(lsum), 0x108, 0xf, 0xf, true));
        lsum += __shfl_xor(lsum, 16); lsum += __shfl_xor(lsum, 32);
        const float inv = 16.0f / lsum;
        if (n < 8) {
#pragma unroll
            for (int d = 0; d < 4; ++d) *(unsigned*)(YD8 + (size_t)tok * 512 + n * 64 + d * 16 + g * 4) = pack_fp8x4(o[d][0] * inv, o[d][1] * inv, o[d][2] * inv, o[d][3] * inv);
        }
    }
#undef AT_ISSUE
}

__device__ __forceinline__ void p8_router(const Frame& F, const Args& a, bool commit) {
    const bf16_t* X1B = WSP(bf16_t, WS_X1B); const bf16_t* WR = WSP(bf16_t, WS_WR);
    int* TOK = WSP(int, WS_TOK); float2* RW = WSP(float2, WS_RW); int* TOK2 = WSP(int, WS_TOK2); unsigned* gcnt = (unsigned*)(F.ws + WS_CTL + CTL_GCNT);
    constexpr int WRS = 2064, RT_LG = 48 * WRS, RT_RS = RT_LG + 8 * 16 * 48 * 4, RT_LC = RT_RS + 8 * 16 * 4;
    LAS float* lg = (LAS float*)(F.lds + RT_LG) + F.wave * (16 * 48);
    LAS float* rsb = (LAS float*)(F.lds + RT_RS) + F.wave * 16;
    LAS int* lc = (LAS int*)(F.lds + RT_LC); LAS int* lbase = lc + 144;
    const int lane = F.lane, n = lane & 15, q = lane >> 4;
    for (int i = F.tid; i < 48 * 128; i += NTHR) { const int r = i >> 7, c = i & 127; *(LAS u32x4*)(F.lds + r * WRS + c * 16) = *(const u32x4*)(WR + (size_t)r * 1024 + c * 8); }
    __syncthreads();
    for (int it = F.c; it < T / 128; it += F.G) {
        const int tw = it * 128 + F.wave * 16;
        if (F.tid < 144) lc[F.tid] = 0;
        const bf16_t* xp = X1B + (size_t)(tw + n) * 1024 + q * 8;
        f32x4 acc[3] = {(f32x4){0.f, 0.f, 0.f, 0.f}, (f32x4){0.f, 0.f, 0.f, 0.f}, (f32x4){0.f, 0.f, 0.f, 0.f}};
        float ss = 0.f;
#pragma unroll
        for (int hb = 0; hb < 2; ++hb) {
            bf16x8 av[16];
#pragma unroll
            for (int k2 = 0; k2 < 16; ++k2) av[k2] = *(const bf16x8*)(xp + (hb * 16 + k2) * 32);
#pragma unroll
            for (int k2 = 0; k2 < 16; ++k2) { const int ks = hb * 16 + k2;
#pragma unroll
                for (int j = 0; j < 8; ++j) { const float f = bf2f((unsigned short)av[k2][j]); ss += f * f; }
#pragma unroll
                for (int bl = 0; bl < 3; ++bl) { const bf16x8 bb = *(const LAS bf16x8*)(F.lds + (bl * 16 + n) * WRS + (ks * 32 + q * 8) * 2);
                    acc[bl] = __builtin_amdgcn_mfma_f32_16x16x32_bf16(av[k2], bb, acc[bl], 0, 0, 0); } }
        }
        ss += __shfl_xor(ss, 16); ss += __shfl_xor(ss, 32);
        const float rs = rsqrtf(ss * (1.0f / 1024.0f) + 1e-6f);
        if (q == 0) rsb[n] = rs;
#pragma unroll
        for (int bl = 0; bl < 3; ++bl)
#pragma unroll
            for (int j = 0; j < 4; ++j) lg[(q * 4 + j) * 48 + bl * 16 + n] = acc[bl][j] * rsb[q * 4 + j];
        __syncthreads();
        int l1 = 0, l2 = 0, lp = 0, r1 = 0, r2 = 0, rp = 0, s1 = 0; float wa = 0.f, wb = 0.f, myrs = 0.f;
        if (lane < 16) {
            LAS const float* l = lg + lane * 48; myrs = rsb[lane];
            float g0 = l[0] + INP(I_BGROUP)[0]; int gi = 0; float gm = g0, gl[4]; gl[0] = g0;
#pragma unroll
            for (int j = 1; j < 4; ++j) { gl[j] = l[j] + INP(I_BGROUP)[j]; if (gl[j] > gm) { gm = gl[j]; gi = j; } }
            float gs = 0.f;
#pragma unroll
            for (int j = 0; j < 4; ++j) gs += __expf(gl[j] - gm);
            const float ggate = 1.0f / gs;
            float e1 = -3.0e38f, e2 = -3.0e38f; int i1 = 0, i2 = 0;
            for (int e = 0; e < 8; ++e) { const float v = l[4 + gi * 8 + e] + INP(I_BEXP)[gi * 8 + e];
                if (v > e1) { e2 = e1; i2 = i1; e1 = v; i1 = e; } else if (v > e2) { e2 = v; i2 = e; } }
            const float pa = 1.0f / (1.0f + __expf(e2 - e1));
            wa = ggate * pa; wb = ggate - wa;
            s1 = i1 < i2 ? 0 : 1;
            const int elo = i1 < i2 ? i1 : i2, ehi = i1 < i2 ? i2 : i1;
            l1 = gi * 8 + i1; l2 = gi * 8 + i2; lp = 32 + gi * 28 + (elo * (15 - elo)) / 2 + (ehi - elo - 1);
            r1 = atomicAdd((int*)(lc + l1), 1); r2 = atomicAdd((int*)(lc + l2), 1); rp = atomicAdd((int*)(lc + lp), 1);
        }
        __syncthreads();
        if (F.tid < 144) { const int cn = lc[F.tid]; lbase[F.tid] = (cn > 0 && commit) ? (int)atomicAdd(gcnt + F.tid * 64, (unsigned)cn) : 0; }
        __syncthreads();
        if (lane < 16 && commit) { const int t = tw + lane;
            const size_t p1 = (size_t)l1 * 65536 + lbase[l1] + r1, p2 = (size_t)l2 * 65536 + lbase[l2] + r2;
            TOK[p1] = t | (s1 << 31); RW[p1] = make_float2(myrs, wa); TOK[p2] = t | ((s1 ^ 1) << 31); RW[p2] = make_float2(myrs, wb);
            TOK2[(size_t)(lp - 32) * 65536 + lbase[lp] + rp] = t; }
        __syncthreads();
    }
}

__device__ __forceinline__ int moe_table(const Frame& F, int first, int count) {
    LAS int* misc = (LAS int*)(F.lds + MISC_OFF); const unsigned* gcnt = (const unsigned*)(F.ws + WS_CTL + CTL_GCNT);
    __syncthreads();
    if (F.tid < count) misc[MI_CNT + F.tid] = (int)__hip_atomic_load(gcnt + (first + F.tid) * 64, __ATOMIC_RELAXED, __HIP_MEMORY_SCOPE_AGENT);
    if (F.tid >= 256 && F.tid < 256 + 28) { const int pi = F.tid - 256; int elo = 0; while (elo < 6 && ((elo + 1) * (15 - (elo + 1))) / 2 <= pi) ++elo;
        misc[MI_PT + pi] = elo | ((pi - (elo * (15 - elo)) / 2 + elo + 1) << 4); }
    __syncthreads();
    if (F.tid == 0) { int run = 0; for (int l = 0; l < count; ++l) { misc[MI_PRE + l] = run; run += (misc[MI_CNT + l] + 255) >> 8; } misc[MI_PRE + count] = run; }
    __syncthreads();
    const int nt = misc[MI_PRE + count];
    for (int idx = F.tid; idx < nt && idx < 640; idx += NTHR) { int l = 0; while (l < count - 1 && misc[MI_PRE + l + 1] <= idx) ++l; misc[MI_TILE + idx] = l | ((idx - misc[MI_PRE + l]) << 8); }
    __syncthreads();
    return nt < 640 ? nt : 640;
}

__global__ void __launch_bounds__(NTHR, 2) fwd(Args a) {
    extern __shared__ __attribute__((aligned(16))) unsigned char lds_raw[];
    Frame F;
    F.lds = (LAS unsigned char*)lds_raw; F.tid = threadIdx.x; F.lane = F.tid & 63; F.wave = __builtin_amdgcn_readfirstlane(F.tid >> 6); F.G = gridDim.x; F.c = blockIdx.x;
    F.ws = a.ws; F.dout = (unsigned char*)a.out;
    LAS unsigned* misc = (LAS unsigned*)(F.lds + MISC_OFF);
    for (int i = F.tid; i < 1024; i += NTHR) misc[i] = 0u;
    __syncthreads();
    XcdBarrier bar; bar.bar = (unsigned*)(F.ws + WS_CTL); bar.x = 0; bar.st = (volatile LAS unsigned*)misc;
    const int lo = a.ph_lo, hi = a.ph_hi;
    if (hi - lo > 1) bar = xcd_barrier_post((unsigned*)(F.ws + WS_CTL), (volatile LAS unsigned*)misc);
#ifndef PH_MASK
#define PH_MASK 0xFFF
#endif
#define IN(k) (((PH_MASK >> (k)) & 1) && lo <= (k) && (k) < hi)
#ifndef REP_MASK
#define REP_MASK 0
#endif
#define NREP(k) (1 + ((REP_MASK >> (k)) & 1))
#define SEAM(k) do { if (IN(k) && IN((k) + 1)) xcd_barrier(bar); } while (0)
    bf16_t* HB = WSP(bf16_t, WS_HB); bf16_t* UA = WSP(bf16_t, WS_UA); unsigned char* SG = WSP(unsigned char, WS_SG);
    bf16_t* Y3 = DOP(bf16_t, DO_Y3); bf16_t* YG = WSP(bf16_t, WS_YG);
    LAS const int* imisc = (LAS const int*)(F.lds + MISC_OFF);

    if (IN(0)) for (int rep = 0; rep < NREP(0); ++rep) { p0_prep(F, a); __syncthreads(); }
    SEAM(0);
    if (IN(0) && IN(1)) {
        if (F.tid == 0) { unsigned* bw = (unsigned*)(F.ws + WS_CTL); bool bal = (F.G % 8) == 0;
            for (int j = 0; j < 16; ++j) { const unsigned cj = xb_ld(&bw[XB_XCNT(j)]); bal = bal && (cj == (j < 8 ? (unsigned)F.G / 8u : 0u)); }
            misc[3] = bal ? (misc[2] * 8u + bar.x) : (unsigned)blockIdx.x; }
        __syncthreads();
        F.c = (int)misc[3];
    }
    if (IN(1)) {
        { pg8::Gemm g{512, 512, 512, 0x7f, 0x7a};
          pg8::SchedGrid S{(const char*)WSP(unsigned char, WS_HB8), (const char*)WSP(unsigned char, WS_WG8), 0, 0, (size_t)256 * 1024, (size_t)256 * 1024, 256, 18, 1, F.G, F.c, NREP(1)};
          EpiInProj E{UA, Y3, SG};
          pg8::gemm_phase<EpiInProj, pg8::SchedGrid, false, PG8_SP2, true>(F.lds, g, S, E); }
        { pg8::Gemm g{1024, 1024, 1024}; pg8::SchedGrid S{(const char*)HB, (const char*)WSP(bf16_t, WS_WIN), 0, 0, (size_t)256 * 1024 * 2, (size_t)256 * 1024 * 2, 256, 2, 1, F.G, F.c, NREP(1)};
          EpiInProjB E{WSP(bf16_t, WS_KVX), WSP(bf16_t, WS_QI)};
          pg8::gemm_phase<EpiInProjB, pg8::SchedGrid, false>(F.lds, g, S, E); }
        { pg8::Gemm g{512, 512, 512, 0x7f, 0x7a};
          pg8::SchedGrid S{(const char*)WSP(unsigned char, WS_MEMN), (const char*)WSP(unsigned char, WS_WMEM), 0, 0, (size_t)256 * 1024, (size_t)256 * 1024, 32, 4, 1, F.G, F.c, NREP(1)};
          EpiBf16 E{WSP(bf16_t, WS_KMVM), 1024};
          pg8::gemm_phase<EpiBf16, pg8::SchedGrid, false, PG8_SP2, true>(F.lds, g, S, E); }
        if (F.G > 128) { if (F.c >= 128) p1_tables(F, a, F.c - 128, F.G - 128); } else p1_tables(F, a, F.c, F.G);
    }
    SEAM(1);
    if (IN(2)) {
        { pg8::Gemm g{640, 512, 512}; pg8::SchedGrid S{(const char*)UA, (const char*)WSP(bf16_t, WS_SIN), (size_t)2048 * 640 * 2, (size_t)256 * 512 * 2, (size_t)256 * 640 * 2, (size_t)256 * 512 * 2, 8, 1, 32, F.G, F.c, NREP(2)};
          EpiSc E{WSP(float, WS_SC)};
          pg8::gemm_phase<EpiSc, pg8::SchedGrid, false>(F.lds, g, S, E); }
        for (int rep = 0; rep < NREP(15); ++rep) p2_post(F, a, rep < NREP(15) - 1);
    }
    SEAM(2);
#ifndef P3_SUB
#define P3_SUB 7
#endif
    if (IN(3)) { for (int rep = 0; rep < NREP(13); ++rep) { if (P3_SUB & 1) p3_scan(F); } for (int rep = 0; rep < NREP(3); ++rep) { if (P3_SUB & 2) p3_select(F, rep == 0 || (REP_MASK & 0x10000)); } for (int rep = 0; rep < NREP(12); ++rep) if (P3_SUB & 4) p3_memattn(F); }
    SEAM(3);
    if (IN(4)) {
        { pg8::Gemm g{640, 640, 640}; pg8::SchedGrid S{(const char*)UA, (const char*)WSP(bf16_t, WS_TW), (size_t)2048 * 640 * 2, (size_t)512 * 640 * 2, (size_t)256 * 640 * 2, (size_t)256 * 640 * 2, 8, 2, 32, F.G, F.c, NREP(4)};
          EpiGelu E{YG};
          pg8::gemm_phase<EpiGelu, pg8::SchedGrid, false>(F.lds, g, S, E); }
        for (int rep = 0; rep < NREP(14); ++rep) p4_attend(F, a);
    }
    SEAM(4);
    if (IN(5)) {
        pg8::Gemm g{512, 512, 512}; pg8::SchedGrid S{(const char*)YG, (const char*)WSP(bf16_t, WS_WGLU), 0, 0, (size_t)256 * 512 * 2, (size_t)256 * 512 * 2, 256, 2, 1, F.G, F.c, NREP(5)};
        EpiGlu E{YG, DOP(unsigned char, DO_YS8)};
        pg8::gemm_phase<EpiGlu, pg8::SchedGrid, false>(F.lds, g, S, E);
    }
    SEAM(5);
    if (IN(6)) {
        pg8::Gemm g{256, 768, 768, 0x7b, 0x7a};
        SchedMerge3 S{(const char*)DOP(unsigned char, DO_Y8), (const char*)WSP(unsigned char, WS_WUP), F.G, F.c, NREP(6)};
        EpiMerge E{SG, (unsigned char*)HB};
        pg8::gemm_phase<EpiMerge, SchedMerge3, false, PG8_SP2, true>(F.lds, g, S, E);
    }
    SEAM(6);
    if (IN(7)) {
        pg8::Gemm g{512, 512, 512, 0x7c, 0x7a};
        pg8::SchedGrid S{(const char*)HB, (const char*)WSP(unsigned char, WS_WOUT), 0, 0, (size_t)256 * 1024, (size_t)256 * 1024, 256, 4, 1, F.G, F.c, NREP(7)};
        EpiOut E{INP(I_X), WSP(bf16_t, WS_X1B), WSP(unsigned char, WS_X1B8)};
        pg8::gemm_phase<EpiOut, pg8::SchedGrid, false, PG8_SP2, true>(F.lds, g, S, E);
    }
    SEAM(7);
    if (IN(8)) for (int rep = 0; rep < NREP(8); ++rep) p8_router(F, a, rep == NREP(8) - 1);
    SEAM(8);
    if (IN(9)) {
        const int nt = moe_table(F, 0, 32);
        pg8::Gemm g{512, 512, 512, 0x7f, 0x7a};
        SchedMoE1 S{(const char*)WSP(unsigned char, WS_X1B8), (const char*)WSP(unsigned char, WS_WGU), imisc, WSP(int, WS_TOK), nt * 4, F.G, F.c, NREP(9)};
        EpiMoe1 E{imisc, WSP(int, WS_TOK), WSP(float2, WS_RW), WSP(unsigned char, WS_HID)};
        pg8::gemm_phase<EpiMoe1, SchedMoE1, true, PG8_SP2, true>(F.lds, g, S, E);
    }
    SEAM(9);
    if (IN(10)) {
        const int nt = moe_table(F, 32, 112);
        pg8::Gemm g{512, 256, 512, 0x7b, 0x7a};
        SchedMoE2 S{(const char*)WSP(unsigned char, WS_HID), (const char*)WSP(unsigned char, WS_WD), imisc, WSP(int, WS_TOK2), nt * 4, F.G, F.c, NREP(10)};
        EpiMoe2 E{imisc, WSP(int, WS_TOK2), WSP(bf16_t, WS_X1B), a.out};
        pg8::gemm_phase<EpiMoe2, SchedMoE2, true, PG8_SP2, true>(F.lds, g, S, E);
    }
#undef IN
#undef SEAM
}

extern "C" void kernel_launch(void* const* d_in, const int* in_sizes, int n_in, void* d_out, int out_size, void* d_ws, size_t ws_size, hipStream_t stream) {
    static int grid = 0;
    if (grid == 0) {
        if (n_in != 32 || out_size != T * D || ws_size < WS_END) { fprintf(stderr, "kernel_launch: unexpected shapes: n_in %d out %d ws %zu (need %zu)\n", n_in, out_size, ws_size, (size_t)WS_END); grid = -1; return; }
        int dev = 0, cus = 0;
        if (hipGetDevice(&dev) != hipSuccess || hipDeviceGetAttribute(&cus, hipDeviceAttributeMultiprocessorCount, dev) != hipSuccess) { grid = -1; return; }
        if (hipFuncSetAttribute((const void*)fwd, hipFuncAttributeMaxDynamicSharedMemorySize, LDS_BYTES) != hipSuccess) { fprintf(stderr, "kernel_launch: hipFuncSetAttribute failed\n"); grid = -1; return; }
        int per_cu = 0;
        if (hipOccupancyMaxActiveBlocksPerMultiprocessor(&per_cu, (const void*)fwd, NTHR, LDS_BYTES) != hipSuccess || per_cu < 1) fprintf(stderr, "kernel_launch: occupancy query reports %d\n", per_cu);
        (void)hipGetLastError();
        grid = cus;
    }
    if (grid < 0) return;
    (void)hipMemsetAsync((char*)d_ws + WS_CTL, 0, CTL_BYTES, stream);
    Args a{};
    for (int i = 0; i < 32; ++i) a.in[i] = d_in[i];
    a.out = (float*)d_out; a.ws = (unsigned char*)d_ws;
#if MK_PER_PHASE
    for (int ph = 0; ph < NPHASE; ++ph) { a.ph_lo = ph; a.ph_hi = ph + 1; hipLaunchKernelGGL(fwd, dim3(grid), dim3(NTHR), LDS_BYTES, stream, a); }
#else
    a.ph_lo = 0; a.ph_hi = NPHASE; hipLaunchKernelGGL(fwd, dim3(grid), dim3(NTHR), LDS_BYTES, stream, a);
#endif
}
```

```cpp
#include <hip/hip_runtime.h>
#include <stdio.h>
#include <stdint.h>

#ifndef MK_PER_PHASE
#define MK_PER_PHASE 0
#endif

#define LAS __attribute__((address_space(3)))
typedef unsigned short bf16_t;
typedef short bf16x8 __attribute__((ext_vector_type(8)));
typedef float f32x4 __attribute__((ext_vector_type(4)));
typedef float f32x16 __attribute__((ext_vector_type(16)));
typedef unsigned u32x4 __attribute__((ext_vector_type(4)));
typedef unsigned u32x2 __attribute__((ext_vector_type(2)));

constexpr int T = 65536, NB = 32, SEQ = 2048, D = 1024;
constexpr int NTHR = 512;
constexpr int LDS_BYTES = 147456, MISC_OFF = LDS_BYTES - 4096;
constexpr int NPHASE = 11;

constexpr size_t WS_CTL = 0, CTL_BYTES = 65536;
constexpr size_t CTL_GCNT = 16384;
constexpr size_t WS_WIN = WS_CTL + CTL_BYTES;
constexpr size_t WS_WMEM = WS_WIN + (size_t)5120 * 1024 * 2;
constexpr size_t WS_WGLU = WS_WMEM + (size_t)1024 * 1024 * 2;
constexpr size_t WS_WUP = WS_WGLU + (size_t)512 * 512 * 2;
constexpr size_t WS_WOUT = WS_WUP + (size_t)3 * 1024 * 512 * 2;
constexpr size_t WS_WGU = WS_WOUT + (size_t)1024 * 1024 * 2;
constexpr size_t WS_WD = WS_WGU + (size_t)32 * 1024 * 1024 * 2;
constexpr size_t WS_TW = WS_WD + (size_t)32 * 1024 * 512 * 2;
constexpr size_t WS_SIN = WS_TW + (size_t)32 * 512 * 640 * 2;
constexpr size_t WS_LAM32 = WS_SIN + (size_t)32 * 256 * 512 * 2;
constexpr size_t WS_WR = WS_LAM32 + 16384;
constexpr size_t WS_HB = WS_WR + 98304;
constexpr size_t WS_UA = WS_HB + (size_t)T * 1024 * 2;
constexpr size_t WS_KVX = WS_UA + (size_t)32 * 2048 * 640 * 2;
constexpr size_t WS_KVP = WS_KVX + (size_t)T * 256 * 2;
constexpr size_t WS_KIP = WS_KVP + (size_t)T * 128 * 2;
constexpr size_t WS_WIF = WS_KIP + (size_t)T * 64 * 2;
constexpr size_t WS_QI = WS_WIF + (size_t)T * 4 * 4;
constexpr size_t WS_SG = WS_QI + (size_t)T * 256 * 2;
constexpr size_t WS_X1B = WS_SG;
constexpr size_t WS_HID = WS_SG + (size_t)T * 3072;
constexpr size_t WS_X1B8 = WS_HID + (size_t)T * 1024;
constexpr size_t WS_SC = WS_HID + (size_t)T * 1024 * 2;
constexpr size_t WS_IDX = WS_SC + (size_t)32 * 2048 * 128 * 4;
constexpr size_t WS_MEMN = WS_IDX + (size_t)T * 256 * 2;
constexpr size_t WS_KMVM = WS_MEMN + (size_t)8192 * 1024 * 2;
constexpr size_t WS_KM = WS_KMVM + (size_t)8192 * 1024 * 2;
constexpr size_t WS_VMT = WS_KM + (size_t)128 * 256 * 128 * 2;
constexpr size_t WS_TOK = WS_VMT + (size_t)128 * 128 * 256 * 2;
constexpr size_t WS_RW = WS_TOK + (size_t)32 * 65536 * 4;
constexpr size_t WS_TOK2 = WS_RW + (size_t)32 * 65536 * 8;
constexpr size_t WS_LP = WS_TOK2 + (size_t)112 * 65536 * 4;
constexpr size_t WS_BB = WS_LP + (size_t)32 * 64 * 33 * 8;
constexpr size_t WS_HB8 = WS_BB + (size_t)32 * 64 * 16 * 8;
constexpr size_t WS_WG8 = WS_HB8 + (size_t)T * 1024;
constexpr size_t WS_CS = WS_WG8 + (size_t)5120 * 1024;
constexpr size_t WS_END = WS_CS + (size_t)T * 32 * 8;
constexpr size_t DO_Y3 = 0, DO_Y8 = (size_t)T * 1024 * 2, DO_YS8 = DO_Y8, DO_YD8 = DO_Y8 + (size_t)T * 512, DO_YM8 = DO_Y8 + (size_t)2 * T * 512;
constexpr int Y3LD = 1024;
constexpr size_t WS_YG = WS_HID;

__device__ __forceinline__ float bf2f(unsigned b) { return __uint_as_float(b << 16); }
__device__ __forceinline__ unsigned cvt_pk_bf16(float lo, float hi) { unsigned r; asm("v_cvt_pk_bf16_f32 %0, %1, %2" : "=v"(r) : "v"(lo), "v"(hi)); return r; }
__device__ __forceinline__ bf16_t f2bf(float f) { return (bf16_t)(cvt_pk_bf16(f, 0.f) & 0xffffu); }
__device__ __forceinline__ float wave_sum(float v) { v += __shfl_xor(v, 32); v += __shfl_xor(v, 16); v += __shfl_xor(v, 8); v += __shfl_xor(v, 4); v += __shfl_xor(v, 2); v += __shfl_xor(v, 1); return v; }
__device__ __forceinline__ float sum32(float v) { v += __shfl_xor(v, 16); v += __shfl_xor(v, 8); v += __shfl_xor(v, 4); v += __shfl_xor(v, 2); v += __shfl_xor(v, 1); return v; }
__device__ __forceinline__ float sigm(float x) { return __builtin_amdgcn_rcpf(1.0f + __expf(-x)); }
__device__ __forceinline__ float gelu_tanh(float x) { const float u = 1.5957691216057308f * (x + 0.044715f * x * x * x); return x * sigm(u); }
__device__ __forceinline__ u32x4 pack8(const f32x4 a, const f32x4 b) { u32x4 w; w.x = cvt_pk_bf16(a[0], a[1]); w.y = cvt_pk_bf16(a[2], a[3]); w.z = cvt_pk_bf16(b[0], b[1]); w.w = cvt_pk_bf16(b[2], b[3]); return w; }
__device__ __forceinline__ void unpack8(const u32x4 w, f32x4& a, f32x4& b) {
    a[0] = bf2f(w.x & 0xffffu); a[1] = bf2f(w.x >> 16); a[2] = bf2f(w.y & 0xffffu); a[3] = bf2f(w.y >> 16);
    b[0] = bf2f(w.z & 0xffffu); b[1] = bf2f(w.z >> 16); b[2] = bf2f(w.w & 0xffffu); b[3] = bf2f(w.w >> 16); }

__device__ __forceinline__ unsigned pack_fp8x4(float a, float b, float c, float d) {
    a = __builtin_amdgcn_fmed3f(a, -448.f, 448.f); b = __builtin_amdgcn_fmed3f(b, -448.f, 448.f); c = __builtin_amdgcn_fmed3f(c, -448.f, 448.f); d = __builtin_amdgcn_fmed3f(d, -448.f, 448.f);
    int p = __builtin_amdgcn_cvt_pk_fp8_f32(a, b, 0, false); p = __builtin_amdgcn_cvt_pk_fp8_f32(c, d, p, true); return (unsigned)p; }

__device__ __forceinline__ unsigned pack_fp8x4_nc(float a, float b, float c, float d) {
    int p = __builtin_amdgcn_cvt_pk_fp8_f32(a, b, 0, false); p = __builtin_amdgcn_cvt_pk_fp8_f32(c, d, p, true); return (unsigned)p; }

#define XB_TMO      128
#define XB_XCNT(j)  (256  + 64 * (j))
#define XB_XSUB(j)  (1280 + 64 * (j))
#define XB_XGEN(j)  (2304 + 64 * (j))
#define XB_TOP      3328
#define XB_TOPGEN   3392
#define XCD_BAR_WORDS 3456
#define XB_SPIN_CAP (1u << 18)
__device__ __forceinline__ unsigned xb_ld(unsigned* p)              { return __hip_atomic_load(p, __ATOMIC_RELAXED, __HIP_MEMORY_SCOPE_AGENT); }
__device__ __forceinline__ unsigned xb_add(unsigned* p, unsigned v) { return __hip_atomic_fetch_add(p, v, __ATOMIC_RELAXED, __HIP_MEMORY_SCOPE_AGENT); }
__device__ __forceinline__ unsigned xb_xcc_id() { return (unsigned)__builtin_amdgcn_s_getreg((3 << 11) | 20) & 0xFu; }
#define XB_SPIN(cond, bar) do { unsigned _sp = 0; while (cond) { __builtin_amdgcn_s_sleep(1); \
    if ((++_sp & 255u) == 0u) { if (xb_ld(&(bar)[XB_TMO])) break; if (_sp > XB_SPIN_CAP) { atomicAdd(&(bar)[XB_TMO], 1u); break; } } } } while (0)
struct XcdBarrier { unsigned* bar; unsigned x; volatile LAS unsigned* st; };
__device__ __forceinline__ XcdBarrier xcd_barrier_post(unsigned* bar, volatile LAS unsigned* st) {
    XcdBarrier b; b.bar = bar; b.x = xb_xcc_id(); b.st = st;
    if (threadIdx.x == 0) st[2] = xb_add(&bar[XB_XCNT(b.x)], 1u);
    return b;
}
__device__ __forceinline__ void xcd_barrier_complete(unsigned* bar, unsigned x, unsigned& nloc, unsigned& nx) {
    const unsigned G = gridDim.x * gridDim.y * gridDim.z;
    unsigned sum, cnt, mine, sp = 0u;
    for (;;) {
        sum = 0u; cnt = 0u; mine = 0u;
#pragma unroll
        for (unsigned j = 0; j < 16; ++j) { const unsigned c = xb_ld(&bar[XB_XCNT(j)]); sum += c; cnt += (c > 0u) ? 1u : 0u; mine = (j == x) ? c : mine; }
        if (sum == G) break;
        __builtin_amdgcn_s_sleep(1);
        if ((++sp & 255u) == 0u) { if (xb_ld(&bar[XB_TMO])) break; if (sp > XB_SPIN_CAP) { atomicAdd(&bar[XB_TMO], 1u); break; } }
    }
    nloc = mine > 0u ? mine : 1u; nx = cnt > 0u ? cnt : 1u;
}
__device__ __forceinline__ void xcd_barrier(const XcdBarrier& b) {
    asm volatile("s_waitcnt vmcnt(0)" ::: "memory");
    __syncthreads();
    if (threadIdx.x == 0) {
        unsigned* bar = b.bar;
        __builtin_amdgcn_s_waitcnt(0);
        unsigned nloc = b.st[0], nx = b.st[1];
        if (nloc == 0u) { xcd_barrier_complete(bar, b.x, nloc, nx); b.st[0] = nloc; b.st[1] = nx; }
        const unsigned old = xb_add(&bar[XB_XSUB(b.x)], 1u);
        const unsigned gen = old / nloc;
        if (old + 1u == (gen + 1u) * nloc) {
            __builtin_amdgcn_fence(__ATOMIC_RELEASE, "agent");
            asm volatile("s_waitcnt vmcnt(0)" ::: "memory");
            const unsigned og = xb_add(&bar[XB_TOP], 1u);
            const unsigned tg = og / nx;
            if (og + 1u == (tg + 1u) * nx) xb_add(&bar[XB_TOPGEN], 1u);
            else XB_SPIN(xb_ld(&bar[XB_TOPGEN]) == tg, bar);
            __builtin_amdgcn_fence(__ATOMIC_ACQUIRE, "agent");
            xb_add(&bar[XB_XGEN(b.x)], 1u);
            asm volatile("s_waitcnt vmcnt(0)" ::: "memory");
        } else {
            XB_SPIN(xb_ld(&bar[XB_XGEN(b.x)]) == gen, bar);
            __builtin_amdgcn_fence(__ATOMIC_ACQUIRE, "agent");
            asm volatile("s_waitcnt vmcnt(0)" ::: "memory");
        }
    }
    __syncthreads();
}

namespace pg8 {
constexpr int BM = 256, BK = 64, HALF = 128, HTB = HALF * BK * 2, STAGE_BYTES = 8 * HTB;
__device__ __forceinline__ int lds_byte(int r, int c) { const int st = (r >> 4) * 2 + (c >> 5), rr = r & 15, cc = c & 31, ob = rr * 64 + cc * 2; return st * 1024 + (ob ^ (((ob >> 9) & 1) << 5)); }
__device__ __forceinline__ void stage_rc(int b, int& R, int& C) { const int st = b / 1024, sb = b % 1024, swz = sb ^ (((sb >> 9) & 1) << 5); R = (st >> 1) * 16 + swz / 64; C = (st & 1) * 32 + (swz % 64) / 2; }
__device__ __forceinline__ int perm32(int rho) { const int n = rho >> 4, i = rho & 15; return 8 * (i >> 2) + 4 * n + (i & 3); }
struct Unit { int pm, pn, z; };
struct Gemm { int lda, ldb, K; int sa = 0x7f, sb = 0x7f; };
typedef int v8i32 __attribute__((ext_vector_type(8)));
typedef int v4i32 __attribute__((ext_vector_type(4)));

#ifndef PG8_SP2
#define PG8_SP2 true
#endif
template <class Epi, class Sched, bool GATHER, bool SP2 = PG8_SP2, bool F8 = false>
__device__ __forceinline__ void gemm_phase(LAS unsigned char* lds, const Gemm g, const Sched& S, const Epi& E) {
    const int tid = threadIdx.x, wid = __builtin_amdgcn_readfirstlane(tid >> 6), lane = tid & 63, wr = wid >> 2, wc = wid & 3, fr = lane & 15, fq = lane >> 4;
    const int K = g.K, nt = K / BK;
    unsigned voffA[2], voffB[2]; int Rr[2], Cc[2];
#pragma unroll
    for (int i = 0; i < 2; ++i) { int R, C; stage_rc(tid * 16 + i * 8192, R, C); const int Rb = Epi::PERM ? ((R & ~31) + perm32(R & 31)) : R;
        Rr[i] = R; Cc[i] = C; voffA[i] = (unsigned)(R * g.lda + C) * 2u; voffB[i] = (unsigned)(Rb * g.ldb + C) * 2u; }
    const size_t hstepA = (size_t)HALF * g.lda * 2, hstepB = (size_t)HALF * g.ldb * 2;
    const unsigned ldsw = (unsigned)wid * 1024u;
    const int aoff = lds_byte(wr * 64 + fr, fq * 8), boff = lds_byte(wc * 32 + fr, fq * 8);
#define PG8_SA(b, h) (((b) * 2 + (h)) * HTB)
#define PG8_SB(b, h) ((4 + (b) * 2 + (h)) * HTB)
#define PG8_GLDS(gp, lo) __builtin_amdgcn_global_load_lds((const unsigned*)(gp), (LAS unsigned*)(lds + (lo)), 16, 0, 0)
#define PG8_STAGE_B(bufoff, gbase, h) do { const char* _b = (const char*)(gbase) + (h) * hstepB; PG8_GLDS(_b + voffB[0], (bufoff) + ldsw); PG8_GLDS(_b + voffB[1], (bufoff) + ldsw + 8192); } while (0)
#define PG8_STAGE_A(bufoff, gbase, h, OFF) do { if constexpr (GATHER) { PG8_GLDS((const char*)(gbase) + OFF##h##0, (bufoff) + ldsw); PG8_GLDS((const char*)(gbase) + OFF##h##1, (bufoff) + ldsw + 8192); } \
        else { const char* _a = (const char*)(gbase) + (h) * hstepA; PG8_GLDS(_a + voffA[0], (bufoff) + ldsw); PG8_GLDS(_a + voffA[1], (bufoff) + ldsw + 8192); } } while (0)
#define PG8_LDA(dst, b, h) do { if constexpr (F8) { _Pragma("unroll") for (int m = 0; m < 4; ++m) { const v4i32 _lo = *(const LAS v4i32*)(lds + PG8_SA(b, h) + aoff + m * 2048), _hi = *(const LAS v4i32*)(lds + PG8_SA(b, h) + aoff + m * 2048 + 1024); \
            dst##8[m] = __builtin_shufflevector(_lo, _hi, 0, 1, 2, 3, 4, 5, 6, 7); } } \
        else { _Pragma("unroll") for (int m = 0; m < 4; ++m) _Pragma("unroll") for (int k = 0; k < 2; ++k) dst[m][k] = *(const LAS bf16x8*)(lds + PG8_SA(b, h) + aoff + m * 2048 + k * 1024); } } while (0)
#define PG8_LDB(dst, b, h) do { if constexpr (F8) { _Pragma("unroll") for (int n = 0; n < 2; ++n) { const v4i32 _lo = *(const LAS v4i32*)(lds + PG8_SB(b, h) + boff + n * 2048), _hi = *(const LAS v4i32*)(lds + PG8_SB(b, h) + boff + n * 2048 + 1024); \
            dst##8[n] = __builtin_shufflevector(_lo, _hi, 0, 1, 2, 3, 4, 5, 6, 7); } } \
        else { _Pragma("unroll") for (int n = 0; n < 2; ++n) _Pragma("unroll") for (int k = 0; k < 2; ++k) dst[n][k] = *(const LAS bf16x8*)(lds + PG8_SB(b, h) + boff + n * 2048 + k * 1024); } } while (0)
#define PG8_MMA(ai, bj, At, Bt) do { __builtin_amdgcn_s_setprio(1); \
        if constexpr (F8) { _Pragma("unroll") for (int m = 0; m < 4; ++m) _Pragma("unroll") for (int n = 0; n < 2; ++n) \
            asm volatile("v_mfma_scale_f32_16x16x128_f8f6f4 %0, %1, %2, %0, %3, %4 op_sel_hi:[0,0,0]" : "+v"(acc[ai][bj][m][n]) : "v"(Bt##8[n]), "v"(At##8[m]), "v"(f8sb), "v"(f8sa)); } \
        else { _Pragma("unroll") for (int m = 0; m < 4; ++m) _Pragma("unroll") for (int n = 0; n < 2; ++n) _Pragma("unroll") for (int k = 0; k < 2; ++k) \
            acc[ai][bj][m][n] = __builtin_amdgcn_mfma_f32_16x16x32_bf16(Bt[n][k], At[m][k], acc[ai][bj][m][n], 0, 0, 0); } \
        __builtin_amdgcn_s_setprio(0); } while (0)
#define PG8_WAIT_V(n) asm volatile("s_waitcnt vmcnt(" #n ")" ::: "memory")
#define PG8_WAIT_L(n) asm volatile("s_waitcnt lgkmcnt(" #n ")" ::: "memory")
#define PG8_BAR __builtin_amdgcn_s_barrier()
#define PG8_SCHED __builtin_amdgcn_sched_barrier(0)
    Unit cur, nxt; int ui = 0;
    if (!S.next(0, cur)) return;
    f32x4 acc[2][2][4][2];
#pragma unroll
    for (int a = 0; a < 2; ++a)
#pragma unroll
        for (int b = 0; b < 2; ++b)
#pragma unroll
            for (int m = 0; m < 4; ++m)
#pragma unroll
                for (int n = 0; n < 2; ++n) acc[a][b][m][n] = (f32x4){0.f, 0.f, 0.f, 0.f};
    bf16x8 At[4][2], B0[2][2], B1[2][2]; v8i32 At8[4], B08[2], B18[2];
    const int f8sa = g.sa, f8sb = g.sb;
    unsigned coff00 = 0u, coff01 = 0u, coff10 = 0u, coff11 = 0u, noff00 = 0u, noff01 = 0u, noff10 = 0u, noff11 = 0u;
    if constexpr (GATHER) {
        coff00 = S.a_off(cur, Rr[0]) + (unsigned)Cc[0] * 2u; coff01 = S.a_off(cur, Rr[1]) + (unsigned)Cc[1] * 2u;
        coff10 = S.a_off(cur, HALF + Rr[0]) + (unsigned)Cc[0] * 2u; coff11 = S.a_off(cur, HALF + Rr[1]) + (unsigned)Cc[1] * 2u;
    }
    { const char* cA = S.a_ptr(cur, 0); const char* cB = S.b_ptr(cur, 0); const char* cA1 = S.a_ptr(cur, 1); const char* cB1 = S.b_ptr(cur, 1);
    if constexpr (SP2) {
    PG8_STAGE_B(PG8_SB(0, 0), cB, 0); PG8_STAGE_B(PG8_SB(0, 1), cB, 1); PG8_STAGE_A(PG8_SA(0, 0), cA, 0, coff); PG8_STAGE_A(PG8_SA(0, 1), cA, 1, coff);
    if (wr == 1) PG8_BAR;
    PG8_WAIT_V(2); PG8_BAR;
    PG8_STAGE_B(PG8_SB(1, 0), cB1, 0); PG8_STAGE_A(PG8_SA(1, 0), cA1, 0, coff); PG8_STAGE_B(PG8_SB(1, 1), cB1, 1);
    PG8_WAIT_V(6); PG8_BAR;
    } else {
    PG8_STAGE_B(PG8_SB(0, 0), cB, 0); PG8_STAGE_A(PG8_SA(0, 0), cA, 0, coff); PG8_STAGE_B(PG8_SB(0, 1), cB, 1); PG8_STAGE_A(PG8_SA(0, 1), cA, 1, coff);
    if (wr == 1) PG8_BAR;
    PG8_WAIT_V(4); PG8_BAR;
    PG8_STAGE_B(PG8_SB(1, 0), cB1, 0); PG8_STAGE_A(PG8_SA(1, 0), cA1, 0, coff); PG8_STAGE_B(PG8_SB(1, 1), cB1, 1);
    PG8_WAIT_V(6); PG8_BAR; } }
    for (;;) {
        const bool has_next = S.next(ui + 1, nxt);
        Unit un; un.pm = has_next ? nxt.pm : cur.pm; un.pn = has_next ? nxt.pn : cur.pn; un.z = has_next ? nxt.z : cur.z;
        if constexpr (GATHER) {
            noff00 = has_next ? (S.a_off(nxt, Rr[0]) + (unsigned)Cc[0] * 2u) : coff00; noff01 = has_next ? (S.a_off(nxt, Rr[1]) + (unsigned)Cc[1] * 2u) : coff01;
            noff10 = has_next ? (S.a_off(nxt, HALF + Rr[0]) + (unsigned)Cc[0] * 2u) : coff10; noff11 = has_next ? (S.a_off(nxt, HALF + Rr[1]) + (unsigned)Cc[1] * 2u) : coff11;
        }
        for (int t = 0; t < nt; t += 2) {
            const bool last = (t == nt - 2);
            if constexpr (Epi::HOOK) { if (t == Epi::H1 || t == Epi::H2) { if constexpr (F8) asm volatile("s_nop 15\n\ts_nop 15\n\ts_nop 7" ::: "memory"); if (wr == 0) PG8_BAR; E.hook(acc, cur, t, wr, wc, fr, fq); if (wr == 1) PG8_BAR; } }
            const char* a1 = S.a_ptr(cur, t + 1);
            const char* a2 = last ? S.a_ptr(un, 0) : S.a_ptr(cur, t + 2); const char* b2 = last ? S.b_ptr(un, 0) : S.b_ptr(cur, t + 2);
            const char* a3 = last ? S.a_ptr(un, 1) : S.a_ptr(cur, t + 3); const char* b3 = last ? S.b_ptr(un, 1) : S.b_ptr(cur, t + 3);
            const unsigned o200 = last ? noff00 : coff00, o201 = last ? noff01 : coff01, o210 = last ? noff10 : coff10, o211 = last ? noff11 : coff11;
            if constexpr (SP2) {
            PG8_LDB(B0, 0, 0); PG8_LDB(B1, 0, 1); PG8_SCHED; PG8_LDA(At, 0, 0); PG8_STAGE_A(PG8_SA(1, 1), a1, 1, coff);
            PG8_WAIT_V(8); PG8_WAIT_L(0); PG8_BAR; PG8_MMA(0, 0, At, B0); PG8_MMA(0, 1, At, B1); PG8_BAR; PG8_SCHED;
            PG8_LDA(At, 0, 1); PG8_STAGE_B(PG8_SB(0, 0), b2, 0); PG8_STAGE_B(PG8_SB(0, 1), b2, 1); PG8_STAGE_A(PG8_SA(0, 0), a2, 0, o2);
            PG8_WAIT_V(8); PG8_WAIT_L(0); PG8_BAR; PG8_MMA(1, 0, At, B0); PG8_MMA(1, 1, At, B1); PG8_BAR; PG8_SCHED;
            PG8_LDB(B0, 1, 0); PG8_LDB(B1, 1, 1); PG8_SCHED; PG8_LDA(At, 1, 0); PG8_STAGE_A(PG8_SA(0, 1), a2, 1, o2);
            PG8_WAIT_V(8); PG8_WAIT_L(0); PG8_BAR; PG8_MMA(0, 0, At, B0); PG8_MMA(0, 1, At, B1); PG8_BAR; PG8_SCHED;
            PG8_LDA(At, 1, 1); PG8_STAGE_B(PG8_SB(1, 0), b3, 0); PG8_STAGE_B(PG8_SB(1, 1), b3, 1); PG8_STAGE_A(PG8_SA(1, 0), a3, 0, o2);
            PG8_WAIT_V(8); PG8_WAIT_L(0); PG8_BAR; PG8_MMA(1, 0, At, B0); PG8_MMA(1, 1, At, B1); PG8_BAR; PG8_SCHED;
            } else {
            PG8_LDB(B0, 0, 0); PG8_SCHED; PG8_LDA(At, 0, 0); PG8_STAGE_A(PG8_SA(1, 1), a1, 1, coff);
            PG8_WAIT_L(8); PG8_BAR; PG8_WAIT_L(0); PG8_MMA(0, 0, At, B0); PG8_BAR; PG8_SCHED;
            PG8_LDB(B1, 0, 1); PG8_STAGE_B(PG8_SB(0, 0), b2, 0);
            PG8_BAR; PG8_WAIT_L(0); PG8_MMA(0, 1, At, B1); PG8_BAR;
            PG8_LDA(At, 0, 1); PG8_STAGE_A(PG8_SA(0, 0), a2, 0, o2);
            PG8_BAR; PG8_WAIT_L(0); PG8_MMA(1, 0, At, B0); PG8_BAR; PG8_SCHED;
            PG8_STAGE_B(PG8_SB(0, 1), b2, 1);
            PG8_WAIT_V(6); PG8_BAR; PG8_MMA(1, 1, At, B1); PG8_BAR;
            PG8_LDB(B0, 1, 0); PG8_SCHED; PG8_LDA(At, 1, 0); PG8_STAGE_A(PG8_SA(0, 1), a2, 1, o2);
            PG8_WAIT_L(8); PG8_BAR; PG8_WAIT_L(0); PG8_MMA(0, 0, At, B0); PG8_BAR; PG8_SCHED;
            PG8_LDB(B1, 1, 1); PG8_STAGE_B(PG8_SB(1, 0), b3, 0);
            PG8_BAR; PG8_WAIT_L(0); PG8_MMA(0, 1, At, B1); PG8_BAR;
            PG8_LDA(At, 1, 1); PG8_STAGE_A(PG8_SA(1, 0), a3, 0, o2);
            PG8_BAR; PG8_WAIT_L(0); PG8_MMA(1, 0, At, B0); PG8_BAR; PG8_SCHED;
            PG8_STAGE_B(PG8_SB(1, 1), b3, 1);
            PG8_WAIT_V(6); PG8_BAR; PG8_MMA(1, 1, At, B1); PG8_BAR;
            }
        }
        if constexpr (F8) asm volatile("s_nop 15\n\ts_nop 15\n\ts_nop 7" ::: "memory");
        if (wr == 0) PG8_BAR;
        E(acc, cur, wr, wc, fr, fq);
        if (!has_next) break;
#pragma unroll
        for (int a = 0; a < 2; ++a)
#pragma unroll
            for (int b = 0; b < 2; ++b)
#pragma unroll
                for (int m = 0; m < 4; ++m)
#pragma unroll
                    for (int n = 0; n < 2; ++n) acc[a][b][m][n] = (f32x4){0.f, 0.f, 0.f, 0.f};
        cur = nxt; ++ui;
        if constexpr (GATHER) { coff00 = noff00; coff01 = noff01; coff10 = noff10; coff11 = noff11; }
        if (wr == 1) PG8_BAR;
    }
    PG8_WAIT_V(0);
    PG8_BAR;
#undef PG8_SA
#undef PG8_SB
#undef PG8_GLDS
#undef PG8_STAGE_A
#undef PG8_STAGE_B
#undef PG8_LDA
#undef PG8_LDB
#undef PG8_MMA
#undef PG8_WAIT_V
#undef PG8_WAIT_L
#undef PG8_BAR
#undef PG8_SCHED
}

struct SchedGrid {
    const char* A; const char* B; size_t zA, zB, tA, tB; int nM, nN, nz, G, c, rep;
    __device__ __forceinline__ bool next(int i, Unit& u) const {
        const int nwg = nz * nM * nN; const long L = (long)i * G + c; if (L >= (long)nwg * rep) return false;
        int w = (int)(L % nwg); { const int q = nwg / 8, r = nwg % 8, x = w % 8, off = w / 8; w = (x < r ? x * (q + 1) : r * (q + 1) + (x - r) * q) + off; }
        const int per = nM * nN; u.z = w / per; w -= u.z * per;
#ifdef PROBE_NOEPI
        if (L >= nwg) u.z |= 0x4000;
#endif
        const int nig = 8 * nN, gid = w / nig, fm = gid * 8, gsz = (nM - fm) < 8 ? (nM - fm) : 8;
        u.pm = fm + ((w % nig) % gsz); u.pn = (w % nig) / gsz; return true; }
    __device__ __forceinline__ const char* a_ptr(const Unit& u, int t) const { return A + (size_t)u.z * zA + (size_t)u.pm * tA + (size_t)t * 128; }
    __device__ __forceinline__ const char* b_ptr(const Unit& u, int t) const { return B + (size_t)u.z * zB + (size_t)u.pn * tB + (size_t)t * 128; }
    __device__ __forceinline__ unsigned a_off(const Unit&, int) const { return 0u; }
};
}

struct Args { const void* in[32]; float* out; unsigned char* ws; int ph_lo, ph_hi; };
struct Frame {
    LAS unsigned char* lds; int tid, lane, wave, G, c;
    unsigned char* ws; unsigned char* dout;
};
enum { I_X = 0, I_MEM, I_POS, I_GMIX, I_GMEM, I_WIN, I_LRE, I_LIM, I_LDT, I_BRE, I_BIM, I_CRE, I_CIM, I_DSKIP, I_WGLU, I_GQ, I_GK, I_GQM, I_GKM, I_WMEMKV,
       I_WUPS, I_WUPD, I_WUPM, I_WOUT, I_GFFN, I_WGROUP, I_BGROUP, I_WEXP, I_BEXP, I_WGATE, I_WUP, I_WDOWN };
#define INP(i) ((const float*)a.in[i])
#define WSP(T_, off) ((T_*)(F.ws + (off)))
#define DOP(T_, off) ((T_*)(F.dout + (off)))

using pg8::Unit;
__device__ __forceinline__ unsigned gpack4(const f32x4 v) {
    unsigned w = 0u;
#pragma unroll
    for (int j = 0; j < 4; ++j) { const float sg255 = __builtin_amdgcn_rcpf(__builtin_fmaf(__builtin_amdgcn_exp2f(v[j]), 1.0f / 255.0f, 1.0f / 255.0f)); w = __builtin_amdgcn_cvt_pk_u8_f32(sg255, j, w); }
    return w; }
__device__ __forceinline__ void gdecode(const u32x2 w, float (&g)[8]) {
#pragma unroll
    for (int j = 0; j < 4; ++j) { g[j] = fmaxf((float)((w.x >> (8 * j)) & 255u), 0.5f); g[4 + j] = fmaxf((float)((w.y >> (8 * j)) & 255u), 0.5f); } }
struct EpiInProj {
    static constexpr bool PERM = true, HOOK = false;
    bf16_t *UA, *Y3; unsigned char* SG;
    __device__ __forceinline__ void operator()(const f32x4 (&acc)[2][2][4][2], const Unit& u, int wr, int wc, int fr, int fq) const {
        const int pn = u.pn, row0 = u.pm * 256 + wr * 64 + fr, cw = wc * 32 + 8 * fq;
#pragma unroll
        for (int ai = 0; ai < 2; ++ai)
#pragma unroll
            for (int m = 0; m < 4; ++m) {
                const int r = row0 + ai * 128 + m * 16;
#pragma unroll
                for (int bj = 0; bj < 2; ++bj) {
                    const int c = bj * 128 + cw;
                    if (pn >= 6) {
                        u32x2 w; w.x = gpack4(acc[ai][bj][m][0]); w.y = gpack4(acc[ai][bj][m][1]);
                        *(u32x2*)(SG + (size_t)r * 3072 + (pn - 6) * 256 + c) = w;
                    } else {
                        bf16_t* p;
                        if (pn < 2) { const int cc = pn * 256 + c, gI = cc >> 4, h0 = cc & 15, b = r >> 11, s = r & 2047;
                            p = UA + ((size_t)(gI * 2048 + b * 64 + (s >> 5)) * 640 + (s & 31) * 16 + h0); }
                        else p = Y3 + (size_t)r * Y3LD + (pn - 2) * 256 + c;
                        *(u32x4*)p = pack8(acc[ai][bj][m][0], acc[ai][bj][m][1]);
                    }
                }
            }
    }
};
struct EpiInProjB {
    static constexpr bool PERM = true, HOOK = false;
    bf16_t *KVX, *QI;
    __device__ __forceinline__ void operator()(const f32x4 (&acc)[2][2][4][2], const Unit& u, int wr, int wc, int fr, int fq) const {
        const int row0 = u.pm * 256 + wr * 64 + fr, cw = wc * 32 + 8 * fq; bf16_t* base = u.pn == 0 ? KVX : QI;
#pragma unroll
        for (int ai = 0; ai < 2; ++ai)
#pragma unroll
            for (int m = 0; m < 4; ++m)
#pragma unroll
                for (int bj = 0; bj < 2; ++bj)
                    *(u32x4*)(base + (size_t)(row0 + ai * 128 + m * 16) * 256 + bj * 128 + cw) = pack8(acc[ai][bj][m][0], acc[ai][bj][m][1]);
    }
};
struct EpiBf16 {
    static constexpr bool PERM = true, HOOK = false;
    bf16_t* O; int ld;
    __device__ __forceinline__ void operator()(const f32x4 (&acc)[2][2][4][2], const Unit& u, int wr, int wc, int fr, int fq) const {
        const int row0 = u.pm * 256 + wr * 64 + fr, col0 = u.pn * 256 + wc * 32 + 8 * fq;
#pragma unroll
        for (int ai = 0; ai < 2; ++ai)
#pragma unroll
            for (int m = 0; m < 4; ++m)
#pragma unroll
                for (int bj = 0; bj < 2; ++bj)
                    *(u32x4*)(O + (size_t)(row0 + ai * 128 + m * 16) * ld + col0 + bj * 128) = pack8(acc[ai][bj][m][0], acc[ai][bj][m][1]);
    }
};
struct EpiSc {
    static constexpr bool PERM = false, HOOK = false;
    float* SC;
    __device__ __forceinline__ void operator()(const f32x4 (&acc)[2][2][4][2], const Unit& u, int wr, int wc, int fr, int fq) const {
        const int row0 = u.pm * 256 + wr * 64 + fr, col0 = wc * 32 + 4 * fq;
#pragma unroll
        for (int ai = 0; ai < 2; ++ai)
#pragma unroll
            for (int m = 0; m < 4; ++m)
#pragma unroll
                for (int n = 0; n < 2; ++n)
                    *(f32x4*)(SC + ((size_t)u.z * 2048 + row0 + ai * 128 + m * 16) * 128 + col0 + n * 16) = acc[ai][0][m][n];
    }
};
struct EpiGelu {
    static constexpr bool PERM = true, HOOK = false;
    bf16_t* YG;
    __device__ __forceinline__ void operator()(const f32x4 (&acc)[2][2][4][2], const Unit& u, int wr, int wc, int fr, int fq) const {
        const int row0 = u.pm * 256 + wr * 64 + fr, col0 = u.pn * 256 + wc * 32 + 8 * fq;
#pragma unroll
        for (int ai = 0; ai < 2; ++ai)
#pragma unroll
            for (int m = 0; m < 4; ++m) {
                const int row = row0 + ai * 128 + m * 16;
#pragma unroll
                for (int bj = 0; bj < 2; ++bj) {
                    const int n8 = col0 + bj * 128, i = n8 >> 4, ho = n8 & 15;
                    f32x4 v0 = acc[ai][bj][m][0], v1 = acc[ai][bj][m][1];
#pragma unroll
                    for (int j = 0; j < 4; ++j) { v0[j] = gelu_tanh(v0[j]); v1[j] = gelu_tanh(v1[j]); }
                    *(u32x4*)(YG + ((size_t)row * 32 + i) * 512 + u.z * 16 + ho) = pack8(v0, v1);
                }
            }
    }
};
struct EpiGlu {
    static constexpr bool PERM = true, HOOK = false;
    const bf16_t* YG; unsigned char* YS8;
    __device__ __forceinline__ void operator()(const f32x4 (&acc)[2][2][4][2], const Unit& u, int wr, int wc, int fr, int fq) const {
        const int row0 = u.pm * 256 + wr * 64 + fr, col0 = u.pn * 256 + wc * 32 + 8 * fq;
        u32x4 yv[2][4][2];
#pragma unroll
        for (int ai = 0; ai < 2; ++ai)
#pragma unroll
            for (int m = 0; m < 4; ++m)
#pragma unroll
                for (int bj = 0; bj < 2; ++bj) yv[ai][m][bj] = *(const u32x4*)(YG + (size_t)(row0 + ai * 128 + m * 16) * 512 + col0 + bj * 128);
#pragma unroll
        for (int ai = 0; ai < 2; ++ai)
#pragma unroll
            for (int m = 0; m < 4; ++m)
#pragma unroll
                for (int bj = 0; bj < 2; ++bj) {
                    const int r = row0 + ai * 128 + m * 16, c = col0 + bj * 128;
                    f32x4 y0, y1; unpack8(yv[ai][m][bj], y0, y1);
                    f32x4 v0 = acc[ai][bj][m][0], v1 = acc[ai][bj][m][1];
#pragma unroll
                    for (int j = 0; j < 4; ++j) { v0[j] = y0[j] * sigm(v0[j]) * 16.0f; v1[j] = y1[j] * sigm(v1[j]) * 16.0f; }
                    u32x2 w8; w8.x = pack_fp8x4(v0[0], v0[1], v0[2], v0[3]); w8.y = pack_fp8x4(v1[0], v1[1], v1[2], v1[3]);
                    *(u32x2*)(YS8 + (size_t)r * 512 + c) = w8;
                }
    }
};
struct EpiMerge {
    static constexpr bool PERM = true, HOOK = true; static constexpr int H1 = 4, H2 = 8;
    const unsigned char* SG; unsigned char* MG;
    __device__ __forceinline__ void hook(f32x4 (&acc)[2][2][4][2], const Unit& u, int t, int wr, int wc, int fr, int fq) const {
        int row0 = u.pm * 256 + wr * 64 + fr, col0 = u.pn * 256 + wc * 32 + 8 * fq; const int br = (t >> 2) - 1;
        asm volatile("" : "+v"(row0), "+v"(col0));
        u32x2 wa[2][4][2], wb[2][4][2];
#pragma unroll
        for (int ai = 0; ai < 2; ++ai)
#pragma unroll
            for (int m = 0; m < 4; ++m)
#pragma unroll
                for (int bj = 0; bj < 2; ++bj) { const unsigned char* gp = SG + (size_t)(row0 + ai * 128 + m * 16) * 3072 + br * 1024 + col0 + bj * 128;
                    wa[ai][m][bj] = *(const u32x2*)gp; wb[ai][m][bj] = *(const u32x2*)(gp + 1024); }
#pragma unroll
        for (int ai = 0; ai < 2; ++ai)
#pragma unroll
            for (int m = 0; m < 4; ++m)
#pragma unroll
                for (int bj = 0; bj < 2; ++bj) {
                    float ga[8], gb[8]; gdecode(wa[ai][m][bj], ga); gdecode(wb[ai][m][bj], gb);
#pragma unroll
                    for (int j = 0; j < 4; ++j) { acc[ai][bj][m][0][j] *= ga[j] * __builtin_amdgcn_rcpf(gb[j]); acc[ai][bj][m][1][j] *= ga[4 + j] * __builtin_amdgcn_rcpf(gb[4 + j]); }
                }
    }
    __device__ __forceinline__ void operator()(const f32x4 (&acc)[2][2][4][2], const Unit& u, int wr, int wc, int fr, int fq) const {
        const int row0 = u.pm * 256 + wr * 64 + fr, col0 = u.pn * 256 + wc * 32 + 8 * fq;
        u32x2 wg[2][4][2];
#pragma unroll
        for (int ai = 0; ai < 2; ++ai)
#pragma unroll
            for (int m = 0; m < 4; ++m)
#pragma unroll
                for (int bj = 0; bj < 2; ++bj) wg[ai][m][bj] = *(const u32x2*)(SG + (size_t)(row0 + ai * 128 + m * 16) * 3072 + 2048 + col0 + bj * 128);
#pragma unroll
        for (int ai = 0; ai < 2; ++ai)
#pragma unroll
            for (int m = 0; m < 4; ++m)
#pragma unroll
                for (int bj = 0; bj < 2; ++bj) {
                    const int r = row0 + ai * 128 + m * 16, c = col0 + bj * 128;
                    float g2[8]; gdecode(wg[ai][m][bj], g2);
                    f32x4 v0 = acc[ai][bj][m][0], v1 = acc[ai][bj][m][1];
#pragma unroll
                    for (int j = 0; j < 4; ++j) { v0[j] *= g2[j] * (8.0f / 255.0f); v1[j] *= g2[4 + j] * (8.0f / 255.0f); }
                    u32x2 w8; w8.x = pack_fp8x4(v0[0], v0[1], v0[2], v0[3]); w8.y = pack_fp8x4(v1[0], v1[1], v1[2], v1[3]);
                    *(u32x2*)(MG + (size_t)r * 1024 + c) = w8;
                }
    }
};
struct EpiOut {
    static constexpr bool PERM = true, HOOK = false;
    const float* X; bf16_t* X1B; unsigned char* X1B8;
    __device__ __forceinline__ void operator()(const f32x4 (&acc)[2][2][4][2], const Unit& u, int wr, int wc, int fr, int fq) const {
        const int row0 = u.pm * 256 + wr * 64 + fr, col0 = u.pn * 256 + wc * 32 + 8 * fq;
#pragma unroll
        for (int ai = 0; ai < 2; ++ai) {
            f32x4 xv[4][2][2];
#pragma unroll
            for (int m = 0; m < 4; ++m)
#pragma unroll
                for (int bj = 0; bj < 2; ++bj) { const float* xp = X + (size_t)(row0 + ai * 128 + m * 16) * 1024 + col0 + bj * 128; xv[m][bj][0] = __builtin_nontemporal_load((const f32x4*)xp); xv[m][bj][1] = __builtin_nontemporal_load((const f32x4*)(xp + 4)); }
#pragma unroll
            for (int m = 0; m < 4; ++m)
#pragma unroll
                for (int bj = 0; bj < 2; ++bj)
                { const f32x4 v0 = xv[m][bj][0] + acc[ai][bj][m][0], v1 = xv[m][bj][1] + acc[ai][bj][m][1]; const size_t o = (size_t)(row0 + ai * 128 + m * 16) * 1024 + col0 + bj * 128;
                    *(u32x4*)(X1B + o) = pack8(v0, v1);
                    u32x2 w8; w8.x = pack_fp8x4(v0[0], v0[1], v0[2], v0[3]); w8.y = pack_fp8x4(v1[0], v1[1], v1[2], v1[3]); *(u32x2*)(X1B8 + o) = w8; }
        }
    }
};

constexpr int MI_CNT = 16, MI_PRE = 160, MI_TILE = 320, MI_PT = 960;
struct SchedMoE1 {
    const char* A; const char* W; LAS const int* misc; const int* tok; int ntile4, G, c, rep;
    __device__ __forceinline__ bool next(int i, Unit& u) const {
        long L = (long)i * G + c; if (L >= (long)ntile4 * rep) return false; L %= ntile4;
        const int e = misc[MI_TILE + (int)(L >> 2)]; u.z = e & 255; u.pm = e >> 8; u.pn = (int)(L & 3); return true; }
    __device__ __forceinline__ const char* a_ptr(const Unit&, int t) const { return A + (size_t)t * 128; }
    __device__ __forceinline__ const char* b_ptr(const Unit& u, int t) const { return W + (size_t)u.z * (1024 * 1024) + (size_t)u.pn * (256 * 1024) + (size_t)t * 128; }
    __device__ __forceinline__ unsigned a_off(const Unit& u, int r) const {
        int pos = u.pm * 256 + r; const int n = misc[MI_CNT + u.z]; pos = pos < n ? pos : 0;
        return (unsigned)(tok[(size_t)u.z * 65536 + pos] & 0x7fffffff) * 1024u; }
};
struct EpiMoe1 {
    static constexpr bool PERM = true, HOOK = false;
    LAS const int* misc; const int* tok; const float2* rw; unsigned char* HID;
    __device__ __forceinline__ void operator()(const f32x4 (&acc)[2][2][4][2], const Unit& u, int wr, int wc, int fr, int fq) const {
        const int l = u.z, n = misc[MI_CNT + l], col = u.pn * 128 + wc * 32 + 8 * fq;
        unsigned tk[2][4]; float2 qv[2][4];
#pragma unroll
        for (int ai = 0; ai < 2; ++ai)
#pragma unroll
            for (int m = 0; m < 4; ++m) { int pos = u.pm * 256 + ai * 128 + wr * 64 + m * 16 + fr; pos = pos < n ? pos : 0;
                tk[ai][m] = (unsigned)tok[(size_t)l * 65536 + pos]; qv[ai][m] = rw[(size_t)l * 65536 + pos]; }
#pragma unroll
        for (int ai = 0; ai < 2; ++ai)
#pragma unroll
            for (int m = 0; m < 4; ++m) {
                const int pos = u.pm * 256 + ai * 128 + wr * 64 + m * 16 + fr;
                if (pos < n) {
                    const float2 q = qv[ai][m];
                    f32x4 v0, v1;
#pragma unroll
                    for (int j = 0; j < 4; ++j) {
                        const float g0 = acc[ai][0][m][0][j] * q.x, u0 = acc[ai][1][m][0][j] * q.x, g1 = acc[ai][0][m][1][j] * q.x, u1 = acc[ai][1][m][1][j] * q.x;
                        v0[j] = g0 * sigm(g0) * u0 * (q.y * 16.0f); v1[j] = g1 * sigm(g1) * u1 * (q.y * 16.0f); }
                    u32x2 w8; w8.x = pack_fp8x4(v0[0], v0[1], v0[2], v0[3]); w8.y = pack_fp8x4(v1[0], v1[1], v1[2], v1[3]);
                    *(u32x2*)(HID + ((size_t)(tk[ai][m] & 0x7fffffffu) * 2 + (tk[ai][m] >> 31)) * 512 + col) = w8;
                }
            }
    }
};
struct SchedMoE2 {
    const char* A; const char* W; LAS const int* misc; const int* tok; int ntile4, G, c, rep;
    __device__ __forceinline__ bool next(int i, Unit& u) const {
        long L = (long)i * G + c; if (L >= (long)ntile4 * rep) return false; L %= ntile4;
        const int e = misc[MI_TILE + (int)(L >> 2)], l = e & 255, gi = l / 28, pt = misc[MI_PT + (l - gi * 28)];
        u.z = l | ((gi * 8 + (pt & 15)) << 8) | ((gi * 8 + (pt >> 4)) << 16); u.pm = e >> 8; u.pn = (int)(L & 3); return true; }
    __device__ __forceinline__ const char* a_ptr(const Unit&, int t) const { return A + (size_t)t * 128; }
    __device__ __forceinline__ const char* b_ptr(const Unit& u, int t) const {
        const int e = t < 4 ? ((u.z >> 8) & 255) : (u.z >> 16), tt = t < 4 ? t : t - 4;
        return W + (size_t)e * (1024 * 512) + (size_t)u.pn * (256 * 512) + (size_t)tt * 128; }
    __device__ __forceinline__ unsigned a_off(const Unit& u, int r) const {
        const int l = u.z & 255; int pos = u.pm * 256 + r; const int n = misc[MI_CNT + l]; pos = pos < n ? pos : 0;
        return (unsigned)tok[(size_t)l * 65536 + pos] * 1024u; }
};
struct EpiMoe2 {
    static constexpr bool PERM = false, HOOK = false;
    LAS const int* misc; const int* tok; const bf16_t* X1B; float* O;
    __device__ __forceinline__ void operator()(const f32x4 (&acc)[2][2][4][2], const Unit& u, int wr, int wc, int fr, int fq) const {
        const int l = u.z & 255, n = misc[MI_CNT + l], col0 = u.pn * 256 + wc * 32 + 4 * fq;
        int tk[2][4];
#pragma unroll
        for (int ai = 0; ai < 2; ++ai)
#pragma unroll
            for (int m = 0; m < 4; ++m) { int pos = u.pm * 256 + ai * 128 + wr * 64 + m * 16 + fr; pos = pos < n ? pos : 0; tk[ai][m] = tok[(size_t)l * 65536 + pos]; }
#pragma unroll
        for (int ai = 0; ai < 2; ++ai) {
            u32x2 xb[4][2][2];
#pragma unroll
            for (int m = 0; m < 4; ++m)
#pragma unroll
                for (int bj = 0; bj < 2; ++bj)
#pragma unroll
                    for (int nn = 0; nn < 2; ++nn) xb[m][bj][nn] = *(const u32x2*)(X1B + (size_t)tk[ai][m] * 1024 + col0 + bj * 128 + nn * 16);
#pragma unroll
            for (int m = 0; m < 4; ++m) {
                const int pos = u.pm * 256 + ai * 128 + wr * 64 + m * 16 + fr;
                if (pos < n) {
#pragma unroll
                    for (int bj = 0; bj < 2; ++bj)
#pragma unroll
                        for (int nn = 0; nn < 2; ++nn) { const u32x2 x = xb[m][bj][nn];
                            const f32x4 xv = (f32x4){bf2f(x.x & 0xffffu), bf2f(x.x >> 16), bf2f(x.y & 0xffffu), bf2f(x.y >> 16)};
                            __builtin_nontemporal_store(xv + acc[ai][bj][m][nn], (f32x4*)(O + (size_t)tk[ai][m] * 1024 + col0 + bj * 128 + nn * 16)); }
                }
            }
        }
    }
};
struct SchedMerge3 {
    const char* Y; const char* W; int G, c, rep;
    __device__ __forceinline__ bool next(int i, Unit& u) const {
        const int nwg = 1024; const long L = (long)i * G + c; if (L >= (long)nwg * rep) return false;
        int w = (int)(L % nwg); { const int q = nwg / 8, x = w % 8, off = w / 8; w = x * q + off; }
        const int nig = 8 * 4, gid = w / nig, fm = gid * 8;
        u.pm = fm + ((w % nig) % 8); u.pn = (w % nig) / 8; u.z = 0; return true; }
    __device__ __forceinline__ const char* a_ptr(const Unit& u, int t) const { return Y + (size_t)(t >> 2) * ((size_t)T * 512) + (size_t)u.pm * (256 * 512) + (size_t)(t & 3) * 128; }
    __device__ __forceinline__ const char* b_ptr(const Unit& u, int t) const { return W + (size_t)u.pn * (256 * 1536) + (size_t)t * 128; }
    __device__ __forceinline__ unsigned a_off(const Unit&, int) const { return 0u; }
};

__device__ __forceinline__ void rms_rows_bf16(const float* x, const float* g, bf16_t* out, unsigned char* out8, int nrows, int gw, int nw, int lane) {
    float4 gg[4];
#pragma unroll
    for (int i = 0; i < 4; ++i) gg[i] = ((const float4*)g)[lane + 64 * i];
#pragma unroll 1
    for (int r0 = gw; r0 < nrows; r0 += 2 * nw) {
        const int r1 = r0 + nw < nrows ? r0 + nw : r0;
        const float4* xa = (const float4*)(x + (size_t)r0 * 1024); const float4* xb = (const float4*)(x + (size_t)r1 * 1024);
        float4 va[4], vb[4]; float sa = 0.f, sb = 0.f;
#pragma unroll
        for (int i = 0; i < 4; ++i) { const f32x4 ta = __builtin_nontemporal_load((const f32x4*)xa + lane + 64 * i), tb = __builtin_nontemporal_load((const f32x4*)xb + lane + 64 * i);
            va[i] = make_float4(ta[0], ta[1], ta[2], ta[3]); vb[i] = make_float4(tb[0], tb[1], tb[2], tb[3]); }
#pragma unroll
        for (int i = 0; i < 4; ++i) { sa += va[i].x * va[i].x + va[i].y * va[i].y + va[i].z * va[i].z + va[i].w * va[i].w; sb += vb[i].x * vb[i].x + vb[i].y * vb[i].y + vb[i].z * vb[i].z + vb[i].w * vb[i].w; }
        sa = wave_sum(sa); sb = wave_sum(sb);
        const float ra = rsqrtf(sa * (1.0f / 1024.0f) + 1e-6f), rb = rsqrtf(sb * (1.0f / 1024.0f) + 1e-6f);
#pragma unroll
        for (int i = 0; i < 4; ++i) {
            u32x2 w; w.x = cvt_pk_bf16(va[i].x * ra * gg[i].x, va[i].y * ra * gg[i].y); w.y = cvt_pk_bf16(va[i].z * ra * gg[i].z, va[i].w * ra * gg[i].w);
            if (out) *(u32x2*)(out + (size_t)r0 * 1024 + (lane + 64 * i) * 4) = w;
            if (out8) *(unsigned*)(out8 + (size_t)r0 * 1024 + (lane + 64 * i) * 4) = pack_fp8x4(va[i].x * ra * gg[i].x, va[i].y * ra * gg[i].y, va[i].z * ra * gg[i].z, va[i].w * ra * gg[i].w);
            if (r1 != r0) { u32x2 z; z.x = cvt_pk_bf16(vb[i].x * rb * gg[i].x, vb[i].y * rb * gg[i].y); z.y = cvt_pk_bf16(vb[i].z * rb * gg[i].z, vb[i].w * rb * gg[i].w);
                if (out) *(u32x2*)(out + (size_t)r1 * 1024 + (lane + 64 * i) * 4) = z;
                if (out8) *(unsigned*)(out8 + (size_t)r1 * 1024 + (lane + 64 * i) * 4) = pack_fp8x4(vb[i].x * rb * gg[i].x, vb[i].y * rb * gg[i].y, vb[i].z * rb * gg[i].z, vb[i].w * rb * gg[i].w); }
        }
    }
}
__device__ __forceinline__ void tr_tile(LAS float* tl, const float* src, int ldsrc, int nvalid, const float* ks, float tsc, bf16_t* dst, unsigned char* dst8, int ldd, int lane) {
    const int r = lane >> 4, c4 = (lane & 15) * 4;
    float4 v[16];
#pragma unroll
    for (int p = 0; p < 16; ++p) { const int k = r + 4 * p; v[p] = make_float4(0.f, 0.f, 0.f, 0.f); if (c4 < nvalid) { const f32x4 tv = __builtin_nontemporal_load((const f32x4*)(src + (size_t)k * ldsrc + c4)); v[p] = make_float4(tv[0], tv[1], tv[2], tv[3]); } }
#pragma unroll
    for (int p = 0; p < 16; ++p) { const int k = r + 4 * p; float4 w = v[p];
        { const float sc = ks ? ks[k] * tsc : tsc; w.x *= sc; w.y *= sc; w.z *= sc; w.w *= sc; }
        tl[k * 65 + c4] = w.x; tl[k * 65 + c4 + 1] = w.y; tl[k * 65 + c4 + 2] = w.z; tl[k * 65 + c4 + 3] = w.w; }
    const int kq = lane & 7;
#pragma unroll
    for (int p = 0; p < 8; ++p) { const int n = (lane >> 3) + 8 * p; float f[8];
#pragma unroll
        for (int j = 0; j < 8; ++j) f[j] = tl[(kq * 8 + j) * 65 + n];
        if (dst8) { u32x2 w8; w8.x = pack_fp8x4(f[0], f[1], f[2], f[3]); w8.y = pack_fp8x4(f[4], f[5], f[6], f[7]); *(u32x2*)(dst8 + (size_t)n * ldd + kq * 8) = w8; }
        else { u32x4 w; w.x = cvt_pk_bf16(f[0], f[1]); w.y = cvt_pk_bf16(f[2], f[3]); w.z = cvt_pk_bf16(f[4], f[5]); w.w = cvt_pk_bf16(f[6], f[7]);
            *(u32x4*)(dst + (size_t)n * ldd + kq * 8) = w; } }
}
struct cf { float re, im; };
__device__ __forceinline__ cf cmul(cf a, cf b) { return cf{a.re * b.re - a.im * b.im, a.re * b.im + a.im * b.re}; }
__device__ __forceinline__ cf lam_pow(const Args& a, int g, int p, float e) {
    const float lre = INP(I_LRE)[g * 64 + p], lim = INP(I_LIM)[g * 64 + p], dt = __expf(INP(I_LDT)[g]);
    const float mag = __expf(lre * dt * e);
    const double rev = (double)lim * (double)dt * (double)e * 0.15915494309189535; const float fr = (float)(rev - rint(rev));
    return cf{mag * __builtin_amdgcn_cosf(fr), mag * __builtin_amdgcn_sinf(fr)};
}
__device__ __forceinline__ cf bbar_of(const Args& a, int g, int p, int h) {
    const float lre = INP(I_LRE)[g * 64 + p], lim = INP(I_LIM)[g * 64 + p];
    const cf lb = lam_pow(a, g, p, 1.0f); const cf num = cf{lb.re - 1.0f, lb.im};
    const float inv = 1.0f / (lre * lre + lim * lim);
    const cf q = cf{(num.re * lre + num.im * lim) * inv, (num.im * lre - num.re * lim) * inv};
    return cmul(q, cf{INP(I_BRE)[(g * 64 + p) * 16 + h], INP(I_BIM)[(g * 64 + p) * 16 + h]});
}
__device__ __forceinline__ void p0_prep(const Frame& F, const Args& a) {
    const int gw = F.c * 8 + F.wave, nw = F.G * 8;
    rms_rows_bf16(INP(I_X), INP(I_GMIX), WSP(bf16_t, WS_HB), WSP(unsigned char, WS_HB8), T, gw, nw, F.lane);
    rms_rows_bf16(INP(I_MEM), INP(I_GMEM), nullptr, WSP(unsigned char, WS_MEMN), 8192, gw, nw, F.lane);
    LAS float* tl = (LAS float*)F.lds + F.wave * (64 * 65);
    constexpr int NT_WIN = 80 * 16, NT_WMEM = 256, NT_WGLU = 64, NT_WUP = 384, NT_WOUT = 256, NT_E = 4096;
    constexpr int O1 = NT_WIN, O2 = O1 + NT_WMEM, O3 = O2 + NT_WGLU, O4 = O3 + NT_WUP, O5 = O4 + NT_WOUT, O6 = O5 + NT_E, O7 = O6 + NT_E, O8 = O7 + NT_E;
    for (int ti = gw; ti < O8; ti += nw) {
        const float* src; int ldsrc, nvalid = 64, ldd; const float* ks = nullptr; bf16_t* dst = nullptr; unsigned char* dst8 = nullptr; float tsc = 1.0f;
        if (ti < O1) { const int nt = ti / 16, kt = ti % 16, n0 = nt * 64; int sc;
            if (n0 < 1152) sc = n0;
            else if (n0 == 1152) sc = 1408;
            else if (n0 == 1216) { sc = 1472; nvalid = 4; }
            else if (n0 < 1280) { sc = 0; nvalid = 0; }
            else if (n0 < 1536) sc = 1152 + (n0 - 1280);
            else if (n0 < 2048) sc = 1476 + (n0 - 1536);
            else { sc = 1988 + (n0 - 2048); tsc = -1.4426950408889634f; }
            src = INP(I_WIN) + (size_t)kt * 64 * 5060 + sc; ldsrc = 5060; ldd = 1024;
            if (n0 >= 1024 && n0 < 1536) dst = WSP(bf16_t, WS_WIN) + (size_t)(n0 - 1024) * 1024 + kt * 64;
            else { const int r8 = n0 < 1024 ? n0 : (n0 < 2048 ? n0 - 512 : n0 - 512); dst8 = WSP(unsigned char, WS_WG8) + (size_t)r8 * 1024 + kt * 64; tsc *= 32.0f; } }
        else if (ti < O2) { const int t = ti - O1, nt = t / 16, kt = t % 16; src = INP(I_WMEMKV) + (size_t)kt * 64 * 1024 + nt * 64; ldsrc = 1024; tsc = 32.0f; dst8 = WSP(unsigned char, WS_WMEM) + (size_t)nt * 64 * 1024 + kt * 64; ldd = 1024; }
        else if (ti < O3) { const int t = ti - O2, nt = t / 8, kt = t % 8; src = INP(I_WGLU) + (size_t)kt * 64 * 512 + nt * 64; ldsrc = 512; dst = WSP(bf16_t, WS_WGLU) + (size_t)nt * 64 * 512 + kt * 64; ldd = 512; }
        else if (ti < O4) { const int t = ti - O3, br = t / 128, tt = t % 128, nt = tt / 8, kt = tt % 8; const float* w = br == 0 ? INP(I_WUPS) : (br == 1 ? INP(I_WUPD) : INP(I_WUPM));
            src = w + (size_t)kt * 64 * 1024 + nt * 64; ldsrc = 1024; tsc = 32.0f; dst8 = WSP(unsigned char, WS_WUP) + (size_t)nt * 64 * 1536 + br * 512 + kt * 64; ldd = 1536; }
        else if (ti < O5) { const int t = ti - O4, nt = t / 16, kt = t % 16; src = INP(I_WOUT) + (size_t)kt * 64 * 1024 + nt * 64; ldsrc = 1024; tsc = 32.0f; dst8 = WSP(unsigned char, WS_WOUT) + (size_t)nt * 64 * 1024 + kt * 64; ldd = 1024; }
        else if (ti < O7) { const int up = ti >= O6, t = ti - (up ? O6 : O5), e = t / 128, tt = t % 128, nt = tt / 16, kt = tt % 16, j0 = nt * 64;
            src = (up ? INP(I_WUP) : INP(I_WGATE)) + (size_t)e * 1024 * 512 + (size_t)kt * 64 * 512 + j0; ldsrc = 512; ks = INP(I_GFFN) + kt * 64; tsc = 32.0f;
            dst8 = WSP(unsigned char, WS_WGU) + (size_t)e * 1024 * 1024 + (size_t)((j0 >> 7) * 256 + up * 128 + (j0 & 127)) * 1024 + kt * 64; ldd = 1024; }
        else { const int t = ti - O7, e = t / 128, tt = t % 128, nt = tt / 8, kt = tt % 8;
            src = INP(I_WDOWN) + (size_t)e * 512 * 1024 + (size_t)kt * 64 * 1024 + nt * 64; ldsrc = 1024; tsc = 32.0f;
            dst8 = WSP(unsigned char, WS_WD) + (size_t)e * 1024 * 512 + (size_t)nt * 64 * 512 + kt * 64; ldd = 512; }
        tr_tile(tl, src, ldsrc, nvalid, ks, tsc, dst, dst8, ldd, F.lane);
    }
    const int gt = F.c * NTHR + F.tid, NTT = F.G * NTHR;
    for (int id = gt; id < 2048 * 33; id += NTT) { const int gp = id / 33, e = id - gp * 33; const cf z = lam_pow(a, gp >> 6, gp & 63, (float)e); WSP(float2, WS_LP)[id] = make_float2(z.re, z.im);
        if (e == 32) { WSP(float, WS_LAM32)[gp * 2] = z.re; WSP(float, WS_LAM32)[gp * 2 + 1] = z.im; } }
    for (int id = gt; id < 2048 * 16; id += NTT) { const int gp = id >> 4, h = id & 15; const cf z = bbar_of(a, gp >> 6, gp & 63, h); WSP(float2, WS_BB)[id] = make_float2(z.re, z.im); }
    for (int id = gt; id < 48 * 1024; id += NTT) { const int n = id >> 10, k = id & 1023;
        const float v = n < 4 ? INP(I_WGROUP)[k * 4 + n] : (n < 36 ? INP(I_WEXP)[k * 32 + (n - 4)] : 0.f);
        WSP(bf16_t, WS_WR)[id] = f2bf(v * INP(I_GFFN)[k]); }
}

__device__ __forceinline__ void p1_tables(const Frame& F, const Args& a, int wgi, int wgn) {
    const int gt = wgi * NTHR + F.tid, NTT = wgn * NTHR;
    bf16_t* TW = WSP(bf16_t, WS_TW); bf16_t* SIN = WSP(bf16_t, WS_SIN); const float2* LP = WSP(float2, WS_LP); const float2* BB = WSP(float2, WS_BB);
    for (int id = gt; id < 32 * 32 * 256; id += NTT) {
        const int hi = id & 15, ho = (id >> 4) & 15, d = (id >> 8) & 31, g = id >> 13;
        float val = 0.f;
        for (int p = 0; p < 64; ++p) { const float2 ez = LP[(g * 64 + p) * 33 + d], bb = BB[(g * 64 + p) * 16 + hi];
            const float cr = INP(I_CRE)[(g * 16 + ho) * 64 + p], ci = INP(I_CIM)[(g * 16 + ho) * 64 + p];
            const float tr = cr * ez.x - ci * ez.y, ti = cr * ez.y + ci * ez.x; val += tr * bb.x - ti * bb.y; }
        if (d == 0 && ho == hi) val += INP(I_DSKIP)[g * 16 + ho];
        const bf16_t bv = f2bf(val); bf16_t* tg = TW + (size_t)g * 512 * 640;
        for (int i = d; i < 32; ++i) { tg[(size_t)(i * 16 + ho) * 640 + (i - d) * 16 + hi] = bv; if (d > 0) tg[(size_t)((i - d) * 16 + ho) * 640 + i * 16 + hi] = 0; }
    }
    for (int id = gt; id < 32 * 32 * 16 * 64; id += NTT) {
        const int p = id & 63, ho = (id >> 6) & 15, i = (id >> 10) & 31, g = id >> 15;
        const float2 ez = LP[(g * 64 + p) * 33 + i + 1]; const float cr = INP(I_CRE)[(g * 16 + ho) * 64 + p], ci = INP(I_CIM)[(g * 16 + ho) * 64 + p];
        bf16_t* row = TW + (size_t)g * 512 * 640 + (size_t)(i * 16 + ho) * 640 + 512; row[p] = f2bf(cr * ez.x - ci * ez.y); row[64 + p] = f2bf(-(cr * ez.y + ci * ez.x));
    }
    for (int id = gt; id < 32 * 64 * 32 * 16; id += NTT) {
        const int h = id & 15, j = (id >> 4) & 31, p = (id >> 9) & 63, g = id >> 15;
        const float2 ez = LP[(g * 64 + p) * 33 + 31 - j], bb = BB[(g * 64 + p) * 16 + h];
        bf16_t* sg = SIN + (size_t)g * 256 * 512; sg[(size_t)p * 512 + j * 16 + h] = f2bf(ez.x * bb.x - ez.y * bb.y); sg[(size_t)(64 + p) * 512 + j * 16 + h] = f2bf(ez.x * bb.y + ez.y * bb.x);
    }
    for (int id = gt; id < 32 * 128 * 64; id += NTT) {
        const int q = id & 63, r = (id >> 6) & 127, g = id >> 13;
        *(u32x4*)(SIN + (size_t)g * 256 * 512 + (size_t)(128 + r) * 512 + q * 8) = (u32x4){0u, 0u, 0u, 0u};
    }
}

__device__ __forceinline__ void p2_post(const Frame& F, const Args& a, bool dry) {
    const int gw = F.c * 8 + F.wave, nw = F.G * 8, lane = F.lane, j = lane & 3, hs = lane >> 5, lr = lane & 31;
    const bf16_t* KVX = WSP(bf16_t, WS_KVX); unsigned char* KVP8 = WSP(unsigned char, WS_KVP); bf16_t* KIP = WSP(bf16_t, WS_KIP); bf16_t* QI = WSP(bf16_t, WS_QI);
    const bool rqi = lr < 16, rk = lr >= 16 && lr < 20, rki = lr >= 20 && lr < 24;
    const float scl = rqi ? 0.125f : 1.0f;
    float g1[8], g2[8];
#pragma unroll
    for (int e = 0; e < 8; ++e) { g1[e] = rk ? INP(I_GK)[8 * j + e] : 1.0f; g2[e] = rk ? INP(I_GK)[32 + 8 * j + e] : 1.0f; }
    constexpr int TB = 4;
    typedef float f32x2e __attribute__((ext_vector_type(2)));
    LAS f32x2e* cst = (LAS f32x2e*)F.lds + F.wave * (TB * 64);
    const float invf1 = __expf(-(float)lr * (9.210340371976184f / 32.0f));
#pragma unroll 1
    for (int tb = gw; tb < T; tb += nw * TB * 2) {
        u32x4 lo[TB], hi[TB]; float posf[TB]; unsigned short wraw[TB];
#pragma unroll
        for (int u = 0; u < TB; ++u) {
            const int tt = tb + (u * 2 + hs) * nw, t = tt < T ? tt : T - 1;
            const bf16_t* src;
            if (rqi) src = QI + (size_t)t * 256 + (lr >> 2) * 64;
            else if (rk) src = KVX + (size_t)t * 256;
            else if (rki) src = KVX + (size_t)t * 256 + 128;
            else src = KVX + (size_t)t * 256 + 64 + (lr - 24) * 8 - 8 * j;
            lo[u] = *(const u32x4*)(src + 8 * j); hi[u] = (lr < 24) ? *(const u32x4*)(src + 32 + 8 * j) : lo[u];
            posf[u] = (float)((const int*)a.in[I_POS])[t];
            wraw[u] = KVX[(size_t)t * 256 + 192 + (lane & 3)];
            { const float ang = posf[u] * invf1; const double rev = (double)ang * 0.15915494309189535; const float fr = (float)(rev - rint(rev));
              const f32x2e cs2 = (f32x2e){__builtin_amdgcn_cosf(fr), __builtin_amdgcn_sinf(fr)}; cst[(u * 2 + hs) * 32 + lr] = cs2;
              if (tt < T) WSP(f32x2e, WS_CS)[(size_t)t * 32 + lr] = cs2; }
        }
#pragma unroll
        for (int u = 0; u < TB; ++u) {
            const int t = tb + (u * 2 + hs) * nw;
            const bool live = t < T;
            if (lr < 24) {
                bf16_t* dst;
                if (rqi) dst = dry ? WSP(bf16_t, WS_RW) + (size_t)(live ? t : 0) * 256 + (lr >> 2) * 64 : QI + (size_t)(live ? t : 0) * 256 + (lr >> 2) * 64;
                else if (rk) dst = nullptr;
                else dst = KIP + (size_t)(live ? t : 0) * 64;
                f32x4 a0, a1, b0, b1; unpack8(lo[u], a0, a1); unpack8(hi[u], b0, b1);
                float x1[8] = {a0[0], a0[1], a0[2], a0[3], a1[0], a1[1], a1[2], a1[3]}, x2[8] = {b0[0], b0[1], b0[2], b0[3], b1[0], b1[1], b1[2], b1[3]};
                float ss = 0.f;
#pragma unroll
                for (int e = 0; e < 8; ++e) ss += x1[e] * x1[e] + x2[e] * x2[e];
                ss += __shfl_xor(ss, 1); ss += __shfl_xor(ss, 2);
                const float rs = rk ? rsqrtf(ss * (1.0f / 64.0f) + 1e-6f) : 1.0f;
                float o1[8], o2[8];
#pragma unroll
                for (int e = 0; e < 8; ++e) {
                    const f32x2e csn = cst[(u * 2 + hs) * 32 + 8 * j + e]; const float cs = csn.x, sn = csn.y;
                    const float y1 = x1[e] * rs * g1[e], y2 = x2[e] * rs * g2[e];
                    o1[e] = (y1 * cs - y2 * sn) * scl; o2[e] = (y2 * cs + y1 * sn) * scl; }
                if (live) {
                    if (rk) {
                        u32x2 w0, w1; w0.x = pack_fp8x4(o1[0], o1[1], o1[2], o1[3]); w0.y = pack_fp8x4(o1[4], o1[5], o1[6], o1[7]); w1.x = pack_fp8x4(o2[0], o2[1], o2[2], o2[3]); w1.y = pack_fp8x4(o2[4], o2[5], o2[6], o2[7]);
                        *(u32x2*)(KVP8 + (size_t)t * 128 + 8 * j) = w0; *(u32x2*)(KVP8 + (size_t)t * 128 + 32 + 8 * j) = w1;
                    } else {
                        *(u32x4*)(dst + 8 * j) = pack8((f32x4){o1[0], o1[1], o1[2], o1[3]}, (f32x4){o1[4], o1[5], o1[6], o1[7]});
                        *(u32x4*)(dst + 32 + 8 * j) = pack8((f32x4){o2[0], o2[1], o2[2], o2[3]}, (f32x4){o2[4], o2[5], o2[6], o2[7]}); } }
            } else if (live) {
                f32x4 a0, a1; unpack8(lo[u], a0, a1); u32x2 w; w.x = pack_fp8x4(a0[0], a0[1], a0[2], a0[3]); w.y = pack_fp8x4(a1[0], a1[1], a1[2], a1[3]);
                *(u32x2*)(KVP8 + (size_t)t * 128 + 64 + (lr - 24) * 8) = w;
            }
            if (lr < 4 && live) WSP(float, WS_WIF)[t * 4 + lr] = bf2f(wraw[u]) * 0.5f;
        }
    }
    const bf16_t* KMVM = WSP(bf16_t, WS_KMVM); bf16_t* KM = WSP(bf16_t, WS_KM); bf16_t* VMT = WSP(bf16_t, WS_VMT);
    { float gk8[8];
#pragma unroll
        for (int e = 0; e < 8; ++e) gk8[e] = INP(I_GKM)[(lane & 15) * 8 + e] * INP(I_GQM)[(lane & 15) * 8 + e];
        for (int r = gw; r < 8192; r += nw) {
            const int h = lane >> 4, b = r >> 8, m = r & 255;
            f32x4 a0, a1; unpack8(*(const u32x4*)(KMVM + (size_t)r * 1024 + h * 128 + (lane & 15) * 8), a0, a1);
            float ss = a0[0] * a0[0] + a0[1] * a0[1] + a0[2] * a0[2] + a0[3] * a0[3] + a1[0] * a1[0] + a1[1] * a1[1] + a1[2] * a1[2] + a1[3] * a1[3];
            ss += __shfl_xor(ss, 1); ss += __shfl_xor(ss, 2); ss += __shfl_xor(ss, 4); ss += __shfl_xor(ss, 8);
            const float rs = rsqrtf(ss * (1.0f / 128.0f) + 1e-6f);
            *(u32x4*)(KM + ((size_t)(b * 4 + h) * 256 + m) * 128 + (lane & 15) * 8) = pack8((f32x4){a0[0] * rs * gk8[0], a0[1] * rs * gk8[1], a0[2] * rs * gk8[2], a0[3] * rs * gk8[3]}, (f32x4){a1[0] * rs * gk8[4], a1[1] * rs * gk8[5], a1[2] * rs * gk8[6], a1[3] * rs * gk8[7]}); } }
    const int gt = F.c * NTHR + F.tid, NTT = F.G * NTHR;
    for (int id = gt; id < 32 * 4 * 32 * 128; id += NTT) { const int d = id & 127, pg = (id >> 7) & 31, h = (id >> 12) & 3, b = id >> 14;
        unsigned short v[8];
#pragma unroll
        for (int j = 0; j < 8; ++j) { const int pp = pg * 8 + j, q = pp & 15, key = (pp & ~15) + 8 * ((q & 7) >> 2) + 4 * (q >> 3) + (q & 3);
            v[j] = KMVM[(size_t)(b * 256 + key) * 1024 + 512 + h * 128 + d]; }
        u32x4 w; w.x = v[0] | ((unsigned)v[1] << 16); w.y = v[2] | ((unsigned)v[3] << 16); w.z = v[4] | ((unsigned)v[5] << 16); w.w = v[6] | ((unsigned)v[7] << 16);
        *(u32x4*)(VMT + ((size_t)(b * 4 + h) * 128 + d) * 256 + pg * 8) = w; }
}

__device__ __forceinline__ void p3_scan(const Frame& F) {
    const int gt = F.c * NTHR + F.tid, NTT = F.G * NTHR;
    const float* SC = WSP(float, WS_SC); bf16_t* UA = WSP(bf16_t, WS_UA);
    for (int id = gt; id < 65536; id += NTT) { const int p = id & 63, b = (id >> 6) & 31, g = id >> 11;
        const float lr = WSP(float, WS_LAM32)[(g * 64 + p) * 2], li = WSP(float, WS_LAM32)[(g * 64 + p) * 2 + 1];
        float sr = 0.f, si = 0.f;
        for (int c = 0; c < 64; ++c) { const size_t row = (size_t)g * 2048 + b * 64 + c;
            UA[row * 640 + 512 + p] = f2bf(sr); UA[row * 640 + 576 + p] = f2bf(si);
            const float cr = SC[row * 128 + p], ci = SC[row * 128 + 64 + p];
            const float nr = lr * sr - li * si + cr, ni = lr * si + li * sr + ci; sr = nr; si = ni; }
    }
}

constexpr int SEL_SC = 0, SEL_HIST = 131072, SEL_END = SEL_HIST + 128 * 17 * 4;
__device__ __forceinline__ int suffix_sum64(int x, int rm1, int rm2, int rm3, int& tot) {
    int p = x;
    p += __builtin_amdgcn_update_dpp(0, p, 0x111, 0xf, 0xf, false);
    p += __builtin_amdgcn_update_dpp(0, p, 0x112, 0xf, 0xf, false);
    p += __builtin_amdgcn_update_dpp(0, p, 0x114, 0xf, 0xf, false);
    p += __builtin_amdgcn_update_dpp(0, p, 0x118, 0xf, 0xf, false);
    const int t0 = __builtin_amdgcn_readlane(p, 15), t1 = __builtin_amdgcn_readlane(p, 31), t2 = __builtin_amdgcn_readlane(p, 47), t3 = __builtin_amdgcn_readlane(p, 63);
    p += (t0 & rm1) + (t1 & rm2) + (t2 & rm3);
    tot = t0 + t1 + t2 + t3;
    return tot - p + x;
}
__device__ __forceinline__ int mbcnt64(unsigned long long m) { return (int)__builtin_amdgcn_mbcnt_hi((unsigned)(m >> 32), __builtin_amdgcn_mbcnt_lo((unsigned)m, 0u)); }
__device__ __forceinline__ void p3_select(const Frame& F, bool doB) {
    LAS unsigned short* sc = (LAS unsigned short*)(F.lds + SEL_SC);
    LAS unsigned* hist = (LAS unsigned*)(F.lds + SEL_HIST);
    const bf16_t* QI = WSP(bf16_t, WS_QI); const bf16_t* KIP = WSP(bf16_t, WS_KIP); const float* WIF = WSP(float, WS_WIF);
    unsigned short* IDX = WSP(unsigned short, WS_IDX);
    const int lane = F.lane, n = lane & 31, hf = lane >> 5, wv = F.wave;
    const int rm1 = (lane >> 4) >= 1 ? -1 : 0, rm2 = (lane >> 4) >= 2 ? -1 : 0, rm3 = (lane >> 4) >= 3 ? -1 : 0;
#define SEL_UNIT(L_, QT, B_) int QT = 63 - ((L_) >> 5); const int B_ = (L_) & 31; \
        if (F.G == 256) { const int k_ = F.c >> 5, i_ = (L_) >> 8, pr_ = i_ >> 1;     \
            QT = (i_ & 1) ? (48 - 16 * pr_ + k_) : (63 - 16 * pr_ - k_); }
#define SEL_LOADQK(QT, B_) do { const int tk_ = (B_) * 2048 + (QT) * 32 + n; \
        _Pragma("unroll") for (int h = 0; h < 4; ++h) { wq[h] = WIF[tk_ * 4 + h]; \
            _Pragma("unroll") for (int ks = 0; ks < 4; ++ks) bq[h][ks] = *(const bf16x8*)(QI + (size_t)tk_ * 256 + h * 64 + ks * 16 + hf * 8); } \
        { const int k0 = wv < (QT) + 1 ? wv : 0; const bf16_t* kp = KIP + (size_t)((B_) * 2048 + k0 * 32 + n) * 64 + hf * 8; \
            _Pragma("unroll") for (int ks = 0; ks < 4; ++ks) ka[ks] = *(const bf16x8*)(kp + ks * 16); } } while (0)
    bf16x8 bq[4][4]; float wq[4]; bf16x8 ka[4];
    if (F.c < 2048) { SEL_UNIT(F.c, qt0, b0); SEL_LOADQK(qt0, b0); }
    for (int L = F.c; L < 2048; L += F.G) {
        SEL_UNIT(L, qt, b);
        const int t0 = qt * 32, nkt = qt + 1, tok0 = b * 2048 + t0;
        for (int i = F.tid; i < 128 * 17; i += NTHR) hist[i] = 0u;
        { const int nz = ((nkt * 8 + 63) & ~63) - nkt * 8;
            for (int i = F.tid; i < nz * 32; i += NTHR) { const int nn = i & 31, ch = nkt * 8 + (i >> 5); *(LAS u32x2*)(sc + nn * 2048 + ((ch ^ nn) << 2)) = (u32x2){0u, 0u}; } }
        __syncthreads();
        const unsigned hinc = 1u << (16 * (n & 1));
        for (int kt = wv; kt < nkt; kt += 8) {
            f32x16 acc[4];
#pragma unroll
            for (int h = 0; h < 4; ++h)
#pragma unroll
                for (int r = 0; r < 16; ++r) acc[h][r] = 0.f;
#pragma unroll
            for (int ks = 0; ks < 4; ++ks)
#pragma unroll
                for (int h = 0; h < 4; ++h) acc[h] = __builtin_amdgcn_mfma_f32_32x32x16_bf16(ka[ks], bq[h][ks], acc[h], 0, 0, 0);
            { const int k1 = kt + 8 < nkt ? kt + 8 : kt; const bf16_t* kp = KIP + (size_t)(b * 2048 + k1 * 32 + n) * 64 + hf * 8;
#pragma unroll
                for (int ks = 0; ks < 4; ++ks) ka[ks] = *(const bf16x8*)(kp + ks * 16); }
            unsigned key[16];
#pragma unroll
            for (int r = 0; r < 16; ++r) {
                const int i0 = __float_as_int(acc[0][r]), i1 = __float_as_int(acc[1][r]), i2 = __float_as_int(acc[2][r]), i3 = __float_as_int(acc[3][r]);
                const float isc = wq[0] * __int_as_float(i0 > 0 ? i0 : 0) + wq[1] * __int_as_float(i1 > 0 ? i1 : 0) + wq[2] * __int_as_float(i2 > 0 ? i2 : 0) + wq[3] * __int_as_float(i3 > 0 ? i3 : 0);
                const float y = isc * __builtin_amdgcn_rcpf(1.0f + 0.25f * fabsf(isc));
                key[r] = (unsigned)(y * 8191.75f + 32768.0f);
            }
            if (kt < qt) {
#pragma unroll
                for (int g4 = 0; g4 < 4; ++g4) {
#pragma unroll
                    for (int j = 0; j < 4; ++j) (void)__hip_atomic_fetch_add(hist + (key[g4 * 4 + j] >> 9) * 17 + (n >> 1), hinc, __ATOMIC_RELAXED, __HIP_MEMORY_SCOPE_WORKGROUP);
                    u32x2 w; w.x = key[g4 * 4] | (key[g4 * 4 + 1] << 16); w.y = key[g4 * 4 + 2] | (key[g4 * 4 + 3] << 16);
                    const int chunk = (kt * 32 + 8 * g4 + 4 * hf) >> 2;
                    *(LAS u32x2*)(sc + n * 2048 + ((chunk ^ n) << 2)) = w;
                }
            } else {
                asm volatile("" ::: "memory");
#pragma unroll
                for (int g4 = 0; g4 < 4; ++g4) {
                    unsigned kk[4];
#pragma unroll
                    for (int j = 0; j < 4; ++j) { const int s = kt * 32 + j + 8 * g4 + 4 * hf; const bool valid = s <= t0 + n;
                        kk[j] = valid ? key[g4 * 4 + j] : 0u;
                        (void)__hip_atomic_fetch_add(hist + (kk[j] >> 9) * 17 + (n >> 1), valid ? hinc : 0u, __ATOMIC_RELAXED, __HIP_MEMORY_SCOPE_WORKGROUP); }
                    u32x2 w; w.x = kk[0] | (kk[1] << 16); w.y = kk[2] | (kk[3] << 16);
                    const int chunk = (kt * 32 + 8 * g4 + 4 * hf) >> 2;
                    *(LAS u32x2*)(sc + n * 2048 + ((chunk ^ n) << 2)) = w;
                }
            }
        }
        __syncthreads();
        if (L + F.G < 2048) { SEL_UNIT(L + F.G, qtn, bn); SEL_LOADQK(qtn, bn); }
        for (int qq = 0; qq < (doB ? 4 : 0); ++qq) {
            const int nq = wv * 4 + qq, tq = t0 + nq, nvalid = tq + 1, tok = tok0 + nq;
            LAS unsigned short* lst = sc + nq * 2048; LAS unsigned* cand = (LAS unsigned*)(sc + nq * 2048 + 512);
            if (nvalid <= 256) {
#pragma unroll
                for (int e = 0; e < 4; ++e) { const int p = lane * 4 + e; lst[p] = (unsigned short)(p < nvalid ? p : 0); }
            } else {
                unsigned v[32];
                LAS const unsigned short* rowp = sc + nq * 2048 + ((((lane >> 2) ^ (nq & 15)) << 2) | (lane & 3));
#pragma unroll
                for (int r = 0; r < 32; ++r) v[r] = rowp[r * 64];
                const int sh = 16 * (nq & 1);
                const int hhi = (int)((hist[(64 + lane) * 17 + (nq >> 1)] >> sh) & 0xffffu), hlo = (int)((hist[lane * 17 + (nq >> 1)] >> sh) & 0xffffu);
                int tothi; const int shi = suffix_sum64(hhi, rm1, rm2, rm3, tothi);
                int b1, above;
                if (tothi >= 256) { const unsigned long long mk = __builtin_amdgcn_ballot_w64(shi >= 256); const int lb = 63 - __clzll(mk); b1 = 64 + lb; above = __builtin_amdgcn_readlane(shi - hhi, lb); }
                else { int totlo; const int slo = tothi + suffix_sum64(hlo, rm1, rm2, rm3, totlo); const unsigned long long mk = __builtin_amdgcn_ballot_w64(slo >= 256); const int lb = 63 - __clzll(mk); b1 = lb; above = __builtin_amdgcn_readlane(slo - hlo, lb); }
                const int sw64 = (nq >> 4) << 6, laneE = lane + sw64, laneO = lane - sw64;
                int base = 0, m = 0;
                const unsigned binhi = (unsigned)b1 * 512u + 511u, binlo = b1 ? (unsigned)b1 * 512u : 1u, binspan = binhi - binlo;
#pragma unroll
                for (int r4 = 0; r4 < 32; r4 += 4) {
                    if (r4 * 64 >= nvalid) break;
#pragma unroll
                    for (int rr = 0; rr < 4; ++rr) { const int r = r4 + rr; const unsigned idx = (unsigned)(r * 64 + ((r & 1) ? laneO : laneE));
                        const bool gt_ = v[r] > binhi, eq = (v[r] - binlo) <= binspan;
                        const unsigned long long mg = __builtin_amdgcn_ballot_w64(gt_), me = __builtin_amdgcn_ballot_w64(eq);
                        int pg = base + mbcnt64(mg), cp = m + mbcnt64(me);
                        asm("" : "+v"(pg), "+v"(cp));
                        lst[gt_ ? pg : 256 + lane] = (unsigned short)idx;
                        cand[(eq && cp < 128) ? cp : 128 + lane] = ((v[r] & 511u) << 11) | idx;
                        base += __popcll(mg); m += __popcll(me); }
                }
                if (m <= 128) {
                    const int need = 256 - above;
                    const unsigned c0 = lane < m ? cand[lane] : 0u, c1 = 64 + lane < m ? cand[64 + lane] : 0u;
                    const unsigned a0 = lane < m ? (c0 >> 11) + 1u : 0u, a1 = 64 + lane < m ? (c1 >> 11) + 1u : 0u;
                    unsigned lo = 0u;
                    for (int bit = 9; bit >= 0; --bit) { const unsigned cd = lo | (1u << bit); const int c = __popcll(__builtin_amdgcn_ballot_w64(a0 >= cd)) + __popcll(__builtin_amdgcn_ballot_w64(a1 >= cd)); if (c >= need) lo = cd; }
                    const unsigned long long g0 = __builtin_amdgcn_ballot_w64(a0 > lo), g1 = __builtin_amdgcn_ballot_w64(a1 > lo), e0 = __builtin_amdgcn_ballot_w64(a0 == lo), e1 = __builtin_amdgcn_ballot_w64(a1 == lo);
                    const int ties = need - (__popcll(g0) + __popcll(g1));
                    int k0 = mbcnt64(e0), k1 = __popcll(e0) + mbcnt64(e1); asm("" : "+v"(k0), "+v"(k1));
                    const bool s0 = a0 > lo || (a0 == lo && k0 < ties), s1 = a1 > lo || (a1 == lo && k1 < ties);
                    const unsigned long long m0 = __builtin_amdgcn_ballot_w64(s0), m1 = __builtin_amdgcn_ballot_w64(s1);
                    if (s0) lst[base + mbcnt64(m0)] = (unsigned short)(c0 & 2047u);
                    if (s1) lst[base + __popcll(m0) + mbcnt64(m1)] = (unsigned short)(c1 & 2047u);
                } else {
#pragma unroll
                    for (int r = 0; r < 32; ++r) v[r] = ((r * 64 + ((r & 1) ? laneO : laneE)) < nvalid) ? v[r] : 0u;
                    unsigned lo = 0u;
                    for (int bit = 15; bit >= 0; --bit) { const unsigned cd = lo | (1u << bit); int cnt = 0;
#pragma unroll
                        for (int r = 0; r < 32; ++r) cnt += __popcll(__builtin_amdgcn_ballot_w64(v[r] >= cd));
                        if (cnt >= 256) lo = cd; }
                    int cgt = 0;
#pragma unroll
                    for (int r = 0; r < 32; ++r) cgt += __popcll(__builtin_amdgcn_ballot_w64(v[r] > lo));
                    const int need = 256 - cgt; int bs = 0, eqb = 0;
#pragma unroll
                    for (int r = 0; r < 32; ++r) {
                        const bool gt_ = v[r] > lo, eq = v[r] == lo;
                        const unsigned long long me = __builtin_amdgcn_ballot_w64(eq);
                        const bool sel = gt_ || (eq && eqb + mbcnt64(me) < need);
                        const unsigned long long ms = __builtin_amdgcn_ballot_w64(sel);
                        if (sel) lst[bs + mbcnt64(ms)] = (unsigned short)(r * 64 + ((r & 1) ? laneO : laneE));
                        bs += __popcll(ms); eqb += __popcll(me);
                    }
                }
            }
            *(u32x2*)(IDX + (size_t)tok * 256 + lane * 4) = *(LAS u32x2*)(lst + lane * 4);
        }
        __syncthreads();
    }
}

#undef SEL_UNIT
#undef SEL_LOADQK
__device__ __forceinline__ void p3_memattn(const Frame& F) {
    constexpr int KS = 272, VS = 528, VOFF = 256 * KS;
    const bf16_t* KM = WSP(bf16_t, WS_KM); const bf16_t* VMT = WSP(bf16_t, WS_VMT); const bf16_t* QM = DOP(bf16_t, DO_Y3) + 512; unsigned char* YM8 = DOP(unsigned char, DO_YM8);
    const int lane = F.lane, n = lane & 31, hf = lane >> 5;
    for (int u = F.c; u < 256; u += F.G) {
        const int half = u & 1, bh = u >> 1, b = bh >> 2, h = bh & 3;
#pragma unroll
        for (int i = 0; i < 8; ++i) { const int id = F.tid + 512 * i;
            { const int row = id >> 4, seg = id & 15; *(LAS u32x4*)(F.lds + row * KS + seg * 16) = *(const u32x4*)(KM + ((size_t)bh * 256 + row) * 128 + seg * 8); }
            { const int row = id >> 5, seg = id & 31; *(LAS u32x4*)(F.lds + VOFF + row * VS + seg * 16) = *(const u32x4*)(VMT + ((size_t)bh * 128 + row) * 256 + seg * 8); } }
        __syncthreads();
#pragma unroll 1
        for (int qi = 0; qi < 4; ++qi) {
            const int tok = b * 2048 + half * 1024 + F.wave * 128 + qi * 32 + n;
            const bf16_t* qp = QM + (size_t)tok * Y3LD + h * 128;
            bf16x8 bq[8];
#pragma unroll
            for (int ks = 0; ks < 8; ++ks) bq[ks] = *(const bf16x8*)(qp + ks * 16 + hf * 8);
            float qss = 0.f;
#pragma unroll
            for (int ks = 0; ks < 8; ++ks)
#pragma unroll
                for (int e = 0; e < 8; ++e) { const float f = bf2f((unsigned short)bq[ks][e]); qss += f * f; }
            qss += __shfl_xor(qss, 32);
            const float qc = rsqrtf(qss * (1.0f / 128.0f) + 1e-6f) * (0.08838834764831845f * 1.4426950408889634f);
            f32x16 o[4];
#pragma unroll
            for (int dt = 0; dt < 4; ++dt)
#pragma unroll
                for (int r = 0; r < 16; ++r) o[dt][r] = 0.f;
            float mrun = -3.0e38f, lrun = 0.f;
#pragma unroll 1
            for (int kh = 0; kh < 2; ++kh) {
                f32x16 s[4];
#pragma unroll
                for (int k4 = 0; k4 < 4; ++k4) { const int kt = kh * 4 + k4;
#pragma unroll
                    for (int r = 0; r < 16; ++r) s[k4][r] = 0.f;
#pragma unroll
                    for (int ks = 0; ks < 8; ++ks) { const bf16x8 a = *(const LAS bf16x8*)(F.lds + (kt * 32 + n) * KS + (ks * 16 + hf * 8) * 2);
                        s[k4] = __builtin_amdgcn_mfma_f32_32x32x16_bf16(a, bq[ks], s[k4], 0, 0, 0); } }
                float mx = mrun;
#pragma unroll
                for (int k4 = 0; k4 < 4; ++k4)
#pragma unroll
                    for (int r = 0; r < 16; ++r) mx = fmaxf(mx, s[k4][r]);
                mx = fmaxf(mx, __shfl_xor(mx, 32));
                const float resc = __builtin_amdgcn_exp2f((mrun - mx) * qc);
                float sum = 0.f;
#pragma unroll
                for (int k4 = 0; k4 < 4; ++k4)
#pragma unroll
                    for (int r = 0; r < 16; ++r) { const float p = __builtin_amdgcn_exp2f((s[k4][r] - mx) * qc); s[k4][r] = p; sum += p; }
                sum += __shfl_xor(sum, 32);
                lrun = lrun * resc + sum; mrun = mx;
#pragma unroll
                for (int dt = 0; dt < 4; ++dt)
#pragma unroll
                    for (int r = 0; r < 16; ++r) o[dt][r] *= resc;
#pragma unroll
                for (int k4 = 0; k4 < 4; ++k4)
#pragma unroll
                    for (int st = 0; st < 2; ++st) { const int kt = kh * 4 + k4;
                        union { u32x4 u; bf16x8 v; } pb;
                        pb.u.x = cvt_pk_bf16(s[k4][8 * st + 0], s[k4][8 * st + 1]); pb.u.y = cvt_pk_bf16(s[k4][8 * st + 2], s[k4][8 * st + 3]);
                        pb.u.z = cvt_pk_bf16(s[k4][8 * st + 4], s[k4][8 * st + 5]); pb.u.w = cvt_pk_bf16(s[k4][8 * st + 6], s[k4][8 * st + 7]);
#pragma unroll
                        for (int dt = 0; dt < 4; ++dt) { const bf16x8 a = *(const LAS bf16x8*)(F.lds + VOFF + (dt * 32 + n) * VS + (kt * 32 + 16 * st + 8 * hf) * 2);
                            o[dt] = __builtin_amdgcn_mfma_f32_32x32x16_bf16(a, pb.v, o[dt], 0, 0, 0); }
                    }
            }
            const float inv = 16.0f / lrun;
#pragma unroll
            for (int dt = 0; dt < 4; ++dt)
#pragma unroll
                for (int g4 = 0; g4 < 4; ++g4)
                    *(unsigned*)(YM8 + (size_t)tok * 512 + h * 128 + dt * 32 + 8 * g4 + 4 * hf) = pack_fp8x4(o[dt][g4 * 4] * inv, o[dt][g4 * 4 + 1] * inv, o[dt][g4 * 4 + 2] * inv, o[dt][g4 * 4 + 3] * inv);
        }
        __syncthreads();
    }
}

__device__ __forceinline__ void p4_attend(const Frame& F, const Args& a) {
    constexpr int WB = 2 * 8192 + 1024;
    LAS unsigned char* wb = F.lds + F.wave * WB;
    LAS unsigned short* lst = (LAS unsigned short*)(wb + 16384);
    const unsigned short* IDX = WSP(unsigned short, WS_IDX); const unsigned char* KVP8 = WSP(unsigned char, WS_KVP); const bf16_t* Q = DOP(bf16_t, DO_Y3); unsigned char* YD8 = DOP(unsigned char, DO_YD8);
    const int lane = F.lane, n = lane & 15, g = lane >> 4, gw = F.c * 8 + F.wave, nw = F.G * 8;
    const int ntk = (T - gw + nw - 1) / nw;
    float gkm = fabsf(INP(I_GK)[lane]);
    gkm = fmaxf(gkm, __shfl_xor(gkm, 32)); gkm = fmaxf(gkm, __shfl_xor(gkm, 16)); gkm = fmaxf(gkm, __shfl_xor(gkm, 8)); gkm = fmaxf(gkm, __shfl_xor(gkm, 4)); gkm = fmaxf(gkm, __shfl_xor(gkm, 2)); gkm = fmaxf(gkm, __shfl_xor(gkm, 1));
    const float kmax = 8.0f * gkm * 1.07f;
    int koff[4][2];
#pragma unroll
    for (int blk = 0; blk < 4; ++blk)
#pragma unroll
        for (int ks = 0; ks < 2; ++ks) { const int row = blk * 16 + n, pc = ks * 2 + (g >> 1); koff[blk][ks] = row * 128 + ((pc ^ (row & 7)) << 4) + 8 * (g & 1); }
    const int q8 = n >> 1, p8 = n & 1;
    int toff[2][4];
#pragma unroll
    for (int kb2 = 0; kb2 < 2; ++kb2)
#pragma unroll
        for (int d = 0; d < 4; ++d) { const int row = (kb2 * 2 + (q8 >> 2)) * 16 + g * 4 + (q8 & 3), pc = 4 + d; toff[kb2][d] = row * 128 + ((pc ^ (row & 7)) << 4) + 8 * p8; }
    const int grow = lane >> 3, gpc = lane & 7;
    const unsigned wbase = (unsigned)(uintptr_t)wb;
#define AT_KEYS(NK, LB, CH) do { _Pragma("unroll") for (int _i = 0; _i < 8; ++_i) NK[_i] = lst[(LB) * 256 + (CH) * 64 + 8 * _i + grow]; } while (0)
#define AT_ISSUE_K(NK, TOK, BUF) do { const char* _kb = (const char*)(KVP8 + (size_t)((TOK) >> 11) * 2048 * 128); \
        _Pragma("unroll") for (int _i = 0; _i < 8; ++_i) { const int _row = 8 * _i + grow; \
            __builtin_amdgcn_global_load_lds((const unsigned*)(_kb + (size_t)NK[_i] * 128 + ((gpc ^ (_row & 7)) << 4)), (LAS unsigned*)(wb + (BUF) * 8192 + _i * 1024), 16, 0, 0); } } while (0)
#define AT_ISSUE(TOK, LB, CH, BUF) do { int _nk[8]; AT_KEYS(_nk, LB, CH); AT_ISSUE_K(_nk, TOK, BUF); } while (0)
    if (ntk <= 0) return;
    { const u32x2 l0 = *(const u32x2*)(IDX + (size_t)gw * 256 + lane * 4); *(LAS u32x2*)(lst + lane * 4) = l0; }
    float gq1[8], gq2[8];
#pragma unroll
    for (int e = 0; e < 8; ++e) { gq1[e] = INP(I_GQ)[g * 8 + e]; gq2[e] = INP(I_GQ)[32 + g * 8 + e]; }
    const f32x4* CS = WSP(f32x4, WS_CS);
    bf16x8 nbq[2]; f32x4 ncs[4];
#pragma unroll
    for (int e = 0; e < 4; ++e) ncs[e] = CS[(size_t)gw * 16 + g * 4 + e];
#pragma unroll
    for (int ks = 0; ks < 2; ++ks) { if (n < 8) nbq[ks] = *(const bf16x8*)(Q + (size_t)gw * Y3LD + n * 64 + ks * 32 + g * 8); else nbq[ks] = (bf16x8){0, 0, 0, 0, 0, 0, 0, 0}; }
    AT_ISSUE(gw, 0, 0, 0); AT_ISSUE(gw, 0, 1, 1);
#pragma unroll 1
    for (int k = 0; k < ntk; ++k) {
        const int tok = gw + k * nw, ntok = tok + nw, lb = k & 1; const bool hasn = (k + 1 < ntk);
        const int tq = tok & 2047, cnt = tq + 1 < 256 ? tq + 1 : 256;
        long bq[2]; float qs = 0.f;
        { float x1[8], x2[8], ss = 0.f;
#pragma unroll
            for (int e = 0; e < 8; ++e) { x1[e] = bf2f((unsigned short)nbq[0][e]); x2[e] = bf2f((unsigned short)nbq[1][e]); ss += x1[e] * x1[e] + x2[e] * x2[e]; }
            ss += __shfl_xor(ss, 16); ss += __shfl_xor(ss, 32);
            const float rs = rsqrtf(ss * (1.0f / 64.0f) + 1e-6f) * (0.125f * 1.4426950408889634f); float o1[8], o2[8];
#pragma unroll
            for (int e = 0; e < 8; ++e) { const float cs = ncs[e >> 1][(e & 1) * 2], sn = ncs[e >> 1][(e & 1) * 2 + 1], y1 = x1[e] * rs * gq1[e], y2 = x2[e] * rs * gq2[e];
                o1[e] = y1 * cs - y2 * sn; o2[e] = y2 * cs + y1 * sn; qs += o1[e] * o1[e] + o2[e] * o2[e]; }
            const unsigned a0 = pack_fp8x4(o1[0], o1[1], o1[2], o1[3]), a1 = pack_fp8x4(o1[4], o1[5], o1[6], o1[7]), b0 = pack_fp8x4(o2[0], o2[1], o2[2], o2[3]), b1 = pack_fp8x4(o2[4], o2[5], o2[6], o2[7]);
            bq[0] = (long)(((unsigned long long)a1 << 32) | a0); bq[1] = (long)(((unsigned long long)b1 << 32) | b0); }
        qs += __shfl_xor(qs, 16); qs += __shfl_xor(qs, 32);
        const float shift = __builtin_amdgcn_sqrtf(qs) * 1.07f * kmax - 7.0f;
        const f32x4 nsh = (f32x4){-shift, -shift, -shift, -shift};
        u32x2 nl = (u32x2){0u, 0u};
        if (hasn) { nl = *(const u32x2*)(IDX + (size_t)ntok * 256 + lane * 4);
#pragma unroll
            for (int e = 0; e < 4; ++e) ncs[e] = CS[(size_t)ntok * 16 + g * 4 + e];
#pragma unroll
            for (int ks = 0; ks < 2; ++ks) if (n < 8) nbq[ks] = *(const bf16x8*)(Q + (size_t)ntok * Y3LD + n * 64 + ks * 32 + g * 8); }
        f32x4 o[4];
#pragma unroll
        for (int d = 0; d < 4; ++d) o[d] = (f32x4){0.f, 0.f, 0.f, 0.f};
        float lsum = 0.f;
#pragma unroll
        for (int ch = 0; ch < 4; ++ch) {
            const int buf = ch & 1;
            if (ch == 3 && !hasn) asm volatile("s_waitcnt vmcnt(0)" ::: "memory"); else asm volatile("s_waitcnt vmcnt(8)" ::: "memory");
            LAS const unsigned char* bb = wb + buf * 8192;
            int nk[8];
            if (ch < 2) AT_KEYS(nk, lb, ch + 2); else if (hasn) AT_KEYS(nk, lb ^ 1, ch - 2);
            f32x4 s[4];
#pragma unroll
            for (int blk = 0; blk < 4; ++blk) {
                const long k0 = *(LAS const long*)(bb + koff[blk][0]), k1 = *(LAS const long*)(bb + koff[blk][1]);
                s[blk] = __builtin_amdgcn_mfma_f32_16x16x32_fp8_fp8(k0, bq[0], nsh, 0, 0, 0);
                s[blk] = __builtin_amdgcn_mfma_f32_16x16x32_fp8_fp8(k1, bq[1], s[blk], 0, 0, 0);
            }
            u32x2 tr[2][4];
#pragma unroll
            for (int kb2 = 0; kb2 < 2; ++kb2)
#pragma unroll
                for (int d = 0; d < 4; ++d) asm volatile("ds_read_b64_tr_b8 %0, %1 offset:%2" : "=&v"(tr[kb2][d]) : "v"(wbase + (unsigned)toff[kb2][d]), "i"(buf * 8192) : "memory");
            float e[2][4];
#pragma unroll
            for (int b2 = 0; b2 < 2; ++b2)
#pragma unroll
                for (int j = 0; j < 4; ++j) e[b2][j] = __int_as_float(__builtin_amdgcn_update_dpp(__float_as_int(s[b2][j]), __float_as_int(s[b2 + 2][j]), 0x118, 0xf, 0xc, false));
            if (cnt >= (ch + 1) * 64) {
#pragma unroll
                for (int b2 = 0; b2 < 2; ++b2)
#pragma unroll
                    for (int j = 0; j < 4; ++j) { const float x = __builtin_amdgcn_exp2f(e[b2][j]); e[b2][j] = x; lsum += x; }
            } else {
                asm volatile("" ::: "memory");
#pragma unroll
                for (int b2 = 0; b2 < 2; ++b2)
#pragma unroll
                    for (int j = 0; j < 4; ++j) { const int p = ch * 64 + (b2 + (n >> 3) * 2) * 16 + g * 4 + j; const float x = p < cnt ? __builtin_amdgcn_exp2f(e[b2][j]) : 0.f; e[b2][j] = x; lsum += x; }
            }
            const unsigned w0 = pack_fp8x4_nc(e[0][0], e[0][1], e[0][2], e[0][3]), w1 = pack_fp8x4_nc(e[1][0], e[1][1], e[1][2], e[1][3]);
#pragma unroll
            for (int kb2 = 0; kb2 < 2; ++kb2) {
                const unsigned plo = kb2 == 0 ? w0 : (unsigned)__builtin_amdgcn_update_dpp(0, (int)w0, 0x108, 0xf, 0xf, true), phi = kb2 == 0 ? w1 : (unsigned)__builtin_amdgcn_update_dpp(0, (int)w1, 0x108, 0xf, 0xf, true);
                const long pb = (long)(((unsigned long long)phi << 32) | plo);
                if (kb2 == 0) asm volatile("s_waitcnt lgkmcnt(0)" : "+v"(tr[0][0]), "+v"(tr[0][1]), "+v"(tr[0][2]), "+v"(tr[0][3]), "+v"(tr[1][0]), "+v"(tr[1][1]), "+v"(tr[1][2]), "+v"(tr[1][3]) :: "memory");
#pragma unroll
                for (int d = 0; d < 4; ++d) { const long av = (long)(((unsigned long long)tr[kb2][d].y << 32) | tr[kb2][d].x);
                    o[d] = __builtin_amdgcn_mfma_f32_16x16x32_fp8_fp8(av, pb, o[d], 0, 0, 0); }
            }
            __builtin_amdgcn_sched_barrier(0);
            if (ch == 1 && hasn) *(LAS u32x2*)(lst + (lb ^ 1) * 256 + lane * 4) = nl;
            if (ch < 2) AT_ISSUE_K(nk, tok, buf);
            else if (hasn) AT_ISSUE_K(nk, ntok, buf);
            __builtin_amdgcn_sched_barrier(0);
        }
        lsum += __int_as_float(__builtin_amdgcn_update_dpp(0, __float_as_int(lsum), 0x108, 0xf, 0xf, true));
        lsum += __shfl_xor(lsum, 16); lsum += __shfl_xor(lsum, 32);
        const float inv = 16.0f / lsum;
        if (n < 8) {
#pragma unroll
            for (int d = 0; d < 4; ++d) *(unsigned*)(YD8 + (size_t)tok * 512 + n * 64 + d * 16 + g * 4) = pack_fp8x4(o[d][0] * inv, o[d][1] * inv, o[d][2] * inv, o[d][3] * inv);
        }
    }
#undef AT_ISSUE
#undef AT_ISSUE_K
#undef AT_KEYS
}

__device__ __forceinline__ void p8_router(const Frame& F, const Args& a, bool commit) {
    const bf16_t* X1B = WSP(bf16_t, WS_X1B); const bf16_t* WR = WSP(bf16_t, WS_WR);
    int* TOK = WSP(int, WS_TOK); float2* RW = WSP(float2, WS_RW); int* TOK2 = WSP(int, WS_TOK2); unsigned* gcnt = (unsigned*)(F.ws + WS_CTL + CTL_GCNT);
    constexpr int WRS = 2064, RT_LG = 48 * WRS, RT_RS = RT_LG + 8 * 16 * 48 * 4, RT_LC = RT_RS + 8 * 16 * 4;
    LAS float* lg = (LAS float*)(F.lds + RT_LG) + F.wave * (16 * 48);
    LAS float* rsb = (LAS float*)(F.lds + RT_RS) + F.wave * 16;
    LAS int* lc = (LAS int*)(F.lds + RT_LC); LAS int* lbase = lc + 144;
    const int lane = F.lane, n = lane & 15, q = lane >> 4;
    for (int i = F.tid; i < 48 * 128; i += NTHR) { const int r = i >> 7, c = i & 127; *(LAS u32x4*)(F.lds + r * WRS + c * 16) = *(const u32x4*)(WR + (size_t)r * 1024 + c * 8); }
    __syncthreads();
    for (int it = F.c; it < T / 128; it += F.G) {
        const int tw = it * 128 + F.wave * 16;
        if (F.tid < 144) lc[F.tid] = 0;
        const bf16_t* xp = X1B + (size_t)(tw + n) * 1024 + q * 8;
        f32x4 acc[3] = {(f32x4){0.f, 0.f, 0.f, 0.f}, (f32x4){0.f, 0.f, 0.f, 0.f}, (f32x4){0.f, 0.f, 0.f, 0.f}};
        float ss = 0.f;
#pragma unroll
        for (int hb = 0; hb < 2; ++hb) {
            bf16x8 av[16];
#pragma unroll
            for (int k2 = 0; k2 < 16; ++k2) av[k2] = *(const bf16x8*)(xp + (hb * 16 + k2) * 32);
#pragma unroll
            for (int k2 = 0; k2 < 16; ++k2) { const int ks = hb * 16 + k2;
#pragma unroll
                for (int j = 0; j < 8; ++j) { const float f = bf2f((unsigned short)av[k2][j]); ss += f * f; }
#pragma unroll
                for (int bl = 0; bl < 3; ++bl) { const bf16x8 bb = *(const LAS bf16x8*)(F.lds + (bl * 16 + n) * WRS + (ks * 32 + q * 8) * 2);
                    acc[bl] = __builtin_amdgcn_mfma_f32_16x16x32_bf16(av[k2], bb, acc[bl], 0, 0, 0); } }
        }
        ss += __shfl_xor(ss, 16); ss += __shfl_xor(ss, 32);
        const float rs = rsqrtf(ss * (1.0f / 1024.0f) + 1e-6f);
        if (q == 0) rsb[n] = rs;
#pragma unroll
        for (int bl = 0; bl < 3; ++bl)
#pragma unroll
            for (int j = 0; j < 4; ++j) lg[(q * 4 + j) * 48 + bl * 16 + n] = acc[bl][j] * rsb[q * 4 + j];
        __syncthreads();
        int l1 = 0, l2 = 0, lp = 0, r1 = 0, r2 = 0, rp = 0, s1 = 0; float wa = 0.f, wb = 0.f, myrs = 0.f;
        if (lane < 16) {
            LAS const float* l = lg + lane * 48; myrs = rsb[lane];
            float g0 = l[0] + INP(I_BGROUP)[0]; int gi = 0; float gm = g0, gl[4]; gl[0] = g0;
#pragma unroll
            for (int j = 1; j < 4; ++j) { gl[j] = l[j] + INP(I_BGROUP)[j]; if (gl[j] > gm) { gm = gl[j]; gi = j; } }
            float gs = 0.f;
#pragma unroll
            for (int j = 0; j < 4; ++j) gs += __expf(gl[j] - gm);
            const float ggate = 1.0f / gs;
            float e1 = -3.0e38f, e2 = -3.0e38f; int i1 = 0, i2 = 0;
            for (int e = 0; e < 8; ++e) { const float v = l[4 + gi * 8 + e] + INP(I_BEXP)[gi * 8 + e];
                if (v > e1) { e2 = e1; i2 = i1; e1 = v; i1 = e; } else if (v > e2) { e2 = v; i2 = e; } }
            const float pa = 1.0f / (1.0f + __expf(e2 - e1));
            wa = ggate * pa; wb = ggate - wa;
            s1 = i1 < i2 ? 0 : 1;
            const int elo = i1 < i2 ? i1 : i2, ehi = i1 < i2 ? i2 : i1;
            l1 = gi * 8 + i1; l2 = gi * 8 + i2; lp = 32 + gi * 28 + (elo * (15 - elo)) / 2 + (ehi - elo - 1);
            r1 = atomicAdd((int*)(lc + l1), 1); r2 = atomicAdd((int*)(lc + l2), 1); rp = atomicAdd((int*)(lc + lp), 1);
        }
        __syncthreads();
        if (F.tid < 144) { const int cn = lc[F.tid]; lbase[F.tid] = (cn > 0 && commit) ? (int)atomicAdd(gcnt + F.tid * 64, (unsigned)cn) : 0; }
        __syncthreads();
        if (lane < 16 && commit) { const int t = tw + lane;
            const size_t p1 = (size_t)l1 * 65536 + lbase[l1] + r1, p2 = (size_t)l2 * 65536 + lbase[l2] + r2;
            TOK[p1] = t | (s1 << 31); RW[p1] = make_float2(myrs, wa); TOK[p2] = t | ((s1 ^ 1) << 31); RW[p2] = make_float2(myrs, wb);
            TOK2[(size_t)(lp - 32) * 65536 + lbase[lp] + rp] = t; }
        __syncthreads();
    }
}

__device__ __forceinline__ int moe_table(const Frame& F, int first, int count) {
    LAS int* misc = (LAS int*)(F.lds + MISC_OFF); const unsigned* gcnt = (const unsigned*)(F.ws + WS_CTL + CTL_GCNT);
    __syncthreads();
    if (F.tid < count) misc[MI_CNT + F.tid] = (int)__hip_atomic_load(gcnt + (first + F.tid) * 64, __ATOMIC_RELAXED, __HIP_MEMORY_SCOPE_AGENT);
    if (F.tid >= 256 && F.tid < 256 + 28) { const int pi = F.tid - 256; int elo = 0; while (elo < 6 && ((elo + 1) * (15 - (elo + 1))) / 2 <= pi) ++elo;
        misc[MI_PT + pi] = elo | ((pi - (elo * (15 - elo)) / 2 + elo + 1) << 4); }
    __syncthreads();
    if (F.tid == 0) { int run = 0; for (int l = 0; l < count; ++l) { misc[MI_PRE + l] = run; run += (misc[MI_CNT + l] + 255) >> 8; } misc[MI_PRE + count] = run; }
    __syncthreads();
    const int nt = misc[MI_PRE + count];
    for (int idx = F.tid; idx < nt && idx < 640; idx += NTHR) { int l = 0; while (l < count - 1 && misc[MI_PRE + l + 1] <= idx) ++l; misc[MI_TILE + idx] = l | ((idx - misc[MI_PRE + l]) << 8); }
    __syncthreads();
    return nt < 640 ? nt : 640;
}

__global__ void __launch_bounds__(NTHR, 2) fwd(Args a) {
    extern __shared__ __attribute__((aligned(16))) unsigned char lds_raw[];
    Frame F;
    F.lds = (LAS unsigned char*)lds_raw; F.tid = threadIdx.x; F.lane = F.tid & 63; F.wave = __builtin_amdgcn_readfirstlane(F.tid >> 6); F.G = gridDim.x; F.c = blockIdx.x;
    F.ws = a.ws; F.dout = (unsigned char*)a.out;
    LAS unsigned* misc = (LAS unsigned*)(F.lds + MISC_OFF);
    for (int i = F.tid; i < 1024; i += NTHR) misc[i] = 0u;
    __syncthreads();
    XcdBarrier bar; bar.bar = (unsigned*)(F.ws + WS_CTL); bar.x = 0; bar.st = (volatile LAS unsigned*)misc;
    const int lo = a.ph_lo, hi = a.ph_hi;
    if (hi - lo > 1) bar = xcd_barrier_post((unsigned*)(F.ws + WS_CTL), (volatile LAS unsigned*)misc);
#ifndef PH_MASK
#define PH_MASK 0xFFF
#endif
#define IN(k) (((PH_MASK >> (k)) & 1) && lo <= (k) && (k) < hi)
#ifndef REP_MASK
#define REP_MASK 0
#endif
#define NREP(k) (1 + ((REP_MASK >> (k)) & 1))
#define SEAM(k) do { if (IN(k) && IN((k) + 1)) xcd_barrier(bar); } while (0)
    bf16_t* HB = WSP(bf16_t, WS_HB); bf16_t* UA = WSP(bf16_t, WS_UA); unsigned char* SG = WSP(unsigned char, WS_SG);
    bf16_t* Y3 = DOP(bf16_t, DO_Y3); bf16_t* YG = WSP(bf16_t, WS_YG);
    LAS const int* imisc = (LAS const int*)(F.lds + MISC_OFF);

    if (IN(0)) for (int rep = 0; rep < NREP(0); ++rep) { p0_prep(F, a); __syncthreads(); }
    SEAM(0);
    if (IN(0) && IN(1)) {
        if (F.tid == 0) { unsigned* bw = (unsigned*)(F.ws + WS_CTL); bool bal = (F.G % 8) == 0;
            for (int j = 0; j < 16; ++j) { const unsigned cj = xb_ld(&bw[XB_XCNT(j)]); bal = bal && (cj == (j < 8 ? (unsigned)F.G / 8u : 0u)); }
            misc[3] = bal ? (misc[2] * 8u + bar.x) : (unsigned)blockIdx.x; }
        __syncthreads();
        F.c = (int)misc[3];
    }
    if (IN(1)) {
        { pg8::Gemm g{512, 512, 512, 0x7f, 0x7a};
          pg8::SchedGrid S{(const char*)WSP(unsigned char, WS_HB8), (const char*)WSP(unsigned char, WS_WG8), 0, 0, (size_t)256 * 1024, (size_t)256 * 1024, 256, 18, 1, F.G, F.c, NREP(1)};
          EpiInProj E{UA, Y3, SG};
          pg8::gemm_phase<EpiInProj, pg8::SchedGrid, false, PG8_SP2, true>(F.lds, g, S, E); }
        { pg8::Gemm g{1024, 1024, 1024}; pg8::SchedGrid S{(const char*)HB, (const char*)WSP(bf16_t, WS_WIN), 0, 0, (size_t)256 * 1024 * 2, (size_t)256 * 1024 * 2, 256, 2, 1, F.G, F.c, NREP(1)};
          EpiInProjB E{WSP(bf16_t, WS_KVX), WSP(bf16_t, WS_QI)};
          pg8::gemm_phase<EpiInProjB, pg8::SchedGrid, false>(F.lds, g, S, E); }
        { pg8::Gemm g{512, 512, 512, 0x7f, 0x7a};
          pg8::SchedGrid S{(const char*)WSP(unsigned char, WS_MEMN), (const char*)WSP(unsigned char, WS_WMEM), 0, 0, (size_t)256 * 1024, (size_t)256 * 1024, 32, 4, 1, F.G, F.c, NREP(1)};
          EpiBf16 E{WSP(bf16_t, WS_KMVM), 1024};
          pg8::gemm_phase<EpiBf16, pg8::SchedGrid, false, PG8_SP2, true>(F.lds, g, S, E); }
        if (F.G > 128) { if (F.c >= 128) p1_tables(F, a, F.c - 128, F.G - 128); } else p1_tables(F, a, F.c, F.G);
    }
    SEAM(1);
    if (IN(2)) {
        { pg8::Gemm g{640, 512, 512}; pg8::SchedGrid S{(const char*)UA, (const char*)WSP(bf16_t, WS_SIN), (size_t)2048 * 640 * 2, (size_t)256 * 512 * 2, (size_t)256 * 640 * 2, (size_t)256 * 512 * 2, 8, 1, 32, F.G, F.c, NREP(2)};
          EpiSc E{WSP(float, WS_SC)};
          pg8::gemm_phase<EpiSc, pg8::SchedGrid, false>(F.lds, g, S, E); }
        for (int rep = 0; rep < NREP(15); ++rep) p2_post(F, a, rep < NREP(15) - 1);
    }
    SEAM(2);
#ifndef P3_SUB
#define P3_SUB 7
#endif
    if (IN(3)) { for (int rep = 0; rep < NREP(13); ++rep) { if (P3_SUB & 1) p3_scan(F); } for (int rep = 0; rep < NREP(3); ++rep) { if (P3_SUB & 2) p3_select(F, rep == 0 || (REP_MASK & 0x10000)); } for (int rep = 0; rep < NREP(12); ++rep) if (P3_SUB & 4) p3_memattn(F); }
    SEAM(3);
    if (IN(4)) {
        { pg8::Gemm g{640, 640, 640}; pg8::SchedGrid S{(const char*)UA, (const char*)WSP(bf16_t, WS_TW), (size_t)2048 * 640 * 2, (size_t)512 * 640 * 2, (size_t)256 * 640 * 2, (size_t)256 * 640 * 2, 8, 2, 32, F.G, F.c, NREP(4)};
          EpiGelu E{YG};
          pg8::gemm_phase<EpiGelu, pg8::SchedGrid, false>(F.lds, g, S, E); }
        for (int rep = 0; rep < NREP(14); ++rep) p4_attend(F, a);
    }
    SEAM(4);
    if (IN(5)) {
        pg8::Gemm g{512, 512, 512}; pg8::SchedGrid S{(const char*)YG, (const char*)WSP(bf16_t, WS_WGLU), 0, 0, (size_t)256 * 512 * 2, (size_t)256 * 512 * 2, 256, 2, 1, F.G, F.c, NREP(5)};
        EpiGlu E{YG, DOP(unsigned char, DO_YS8)};
        pg8::gemm_phase<EpiGlu, pg8::SchedGrid, false>(F.lds, g, S, E);
    }
    SEAM(5);
    if (IN(6)) {
        pg8::Gemm g{256, 768, 768, 0x7b, 0x7a};
        SchedMerge3 S{(const char*)DOP(unsigned char, DO_Y8), (const char*)WSP(unsigned char, WS_WUP), F.G, F.c, NREP(6)};
        EpiMerge E{SG, (unsigned char*)HB};
        pg8::gemm_phase<EpiMerge, SchedMerge3, false, PG8_SP2, true>(F.lds, g, S, E);
    }
    SEAM(6);
    if (IN(7)) {
        pg8::Gemm g{512, 512, 512, 0x7c, 0x7a};
        pg8::SchedGrid S{(const char*)HB, (const char*)WSP(unsigned char, WS_WOUT), 0, 0, (size_t)256 * 1024, (size_t)256 * 1024, 256, 4, 1, F.G, F.c, NREP(7)};
        EpiOut E{INP(I_X), WSP(bf16_t, WS_X1B), WSP(unsigned char, WS_X1B8)};
        pg8::gemm_phase<EpiOut, pg8::SchedGrid, false, PG8_SP2, true>(F.lds, g, S, E);
    }
    SEAM(7);
    if (IN(8)) for (int rep = 0; rep < NREP(8); ++rep) p8_router(F, a, rep == NREP(8) - 1);
    SEAM(8);
    if (IN(9)) {
        const int nt = moe_table(F, 0, 32);
        pg8::Gemm g{512, 512, 512, 0x7f, 0x7a};
        SchedMoE1 S{(const char*)WSP(unsigned char, WS_X1B8), (const char*)WSP(unsigned char, WS_WGU), imisc, WSP(int, WS_TOK), nt * 4, F.G, F.c, NREP(9)};
        EpiMoe1 E{imisc, WSP(int, WS_TOK), WSP(float2, WS_RW), WSP(unsigned char, WS_HID)};
        pg8::gemm_phase<EpiMoe1, SchedMoE1, true, PG8_SP2, true>(F.lds, g, S, E);
    }
    SEAM(9);
    if (IN(10)) {
        const int nt = moe_table(F, 32, 112);
        pg8::Gemm g{512, 256, 512, 0x7b, 0x7a};
        SchedMoE2 S{(const char*)WSP(unsigned char, WS_HID), (const char*)WSP(unsigned char, WS_WD), imisc, WSP(int, WS_TOK2), nt * 4, F.G, F.c, NREP(10)};
        EpiMoe2 E{imisc, WSP(int, WS_TOK2), WSP(bf16_t, WS_X1B), a.out};
        pg8::gemm_phase<EpiMoe2, SchedMoE2, true, PG8_SP2, true>(F.lds, g, S, E);
    }
#undef IN
#undef SEAM
}

extern "C" void kernel_launch(void* const* d_in, const int* in_sizes, int n_in, void* d_out, int out_size, void* d_ws, size_t ws_size, hipStream_t stream) {
    static int grid = 0;
    if (grid == 0) {
        if (n_in != 32 || out_size != T * D || ws_size < WS_END) { fprintf(stderr, "kernel_launch: unexpected shapes: n_in %d out %d ws %zu (need %zu)\n", n_in, out_size, ws_size, (size_t)WS_END); grid = -1; return; }
        int dev = 0, cus = 0;
        if (hipGetDevice(&dev) != hipSuccess || hipDeviceGetAttribute(&cus, hipDeviceAttributeMultiprocessorCount, dev) != hipSuccess) { grid = -1; return; }
        if (hipFuncSetAttribute((const void*)fwd, hipFuncAttributeMaxDynamicSharedMemorySize, LDS_BYTES) != hipSuccess) { fprintf(stderr, "kernel_launch: hipFuncSetAttribute failed\n"); grid = -1; return; }
        int per_cu = 0;
        if (hipOccupancyMaxActiveBlocksPerMultiprocessor(&per_cu, (const void*)fwd, NTHR, LDS_BYTES) != hipSuccess || per_cu < 1) fprintf(stderr, "kernel_launch: occupancy query reports %d\n", per_cu);
        (void)hipGetLastError();
        grid = cus;
    }
    if (grid < 0) return;
    (void)hipMemsetAsync((char*)d_ws + WS_CTL, 0, CTL_BYTES, stream);
    Args a{};
    for (int i = 0; i < 32; ++i) a.in[i] = d_in[i];
    a.out = (float*)d_out; a.ws = (unsigned char*)d_ws;
#if MK_PER_PHASE
    for (int ph = 0; ph < NPHASE; ++ph) { a.ph_lo = ph; a.ph_hi = ph + 1; hipLaunchKernelGGL(fwd, dim3(grid), dim3(NTHR), LDS_BYTES, stream, a); }
#else
    a.ph_lo = 0; a.ph_hi = NPHASE; hipLaunchKernelGGL(fwd, dim3(grid), dim3(NTHR), LDS_BYTES, stream, a);
#endif
}
```

```cpp
#include <hip/hip_runtime.h>
#include <stdio.h>
#include <stdint.h>

#ifndef MK_PER_PHASE
#define MK_PER_PHASE 0
#endif

#define LAS __attribute__((address_space(3)))
typedef unsigned short bf16_t;
typedef short bf16x8 __attribute__((ext_vector_type(8)));
typedef float f32x4 __attribute__((ext_vector_type(4)));
typedef float f32x16 __attribute__((ext_vector_type(16)));
typedef unsigned u32x4 __attribute__((ext_vector_type(4)));
typedef unsigned u32x2 __attribute__((ext_vector_type(2)));

constexpr int T = 65536, NB = 32, SEQ = 2048, D = 1024;
constexpr int NTHR = 512;
constexpr int LDS_BYTES = 147456, MISC_OFF = LDS_BYTES - 4096;
constexpr int NPHASE = 11;

constexpr size_t WS_CTL = 0, CTL_BYTES = 65536;
constexpr size_t CTL_GCNT = 16384;
constexpr size_t WS_WIN = WS_CTL + CTL_BYTES;
constexpr size_t WS_WMEM = WS_WIN + (size_t)5120 * 1024 * 2;
constexpr size_t WS_WGLU = WS_WMEM + (size_t)1024 * 1024 * 2;
constexpr size_t WS_WUP = WS_WGLU + (size_t)512 * 512 * 2;
constexpr size_t WS_WOUT = WS_WUP + (size_t)3 * 1024 * 512 * 2;
constexpr size_t WS_WGU = WS_WOUT + (size_t)1024 * 1024 * 2;
constexpr size_t WS_WD = WS_WGU + (size_t)32 * 1024 * 1024 * 2;
constexpr size_t WS_TW = WS_WD + (size_t)32 * 1024 * 512 * 2;
constexpr size_t WS_SIN = WS_TW + (size_t)32 * 512 * 640 * 2;
constexpr size_t WS_LAM32 = WS_SIN + (size_t)32 * 256 * 512 * 2;
constexpr size_t WS_WR = WS_LAM32 + 16384;
constexpr size_t WS_HB = WS_WR + 98304;
constexpr size_t WS_UA = WS_HB + (size_t)T * 1024 * 2;
constexpr size_t WS_KVX = WS_UA + (size_t)32 * 2048 * 640 * 2;
constexpr size_t WS_KVP = WS_KVX + (size_t)T * 256 * 2;
constexpr size_t WS_KIP = WS_KVP + (size_t)T * 128 * 2;
constexpr size_t WS_WIF = WS_KIP + (size_t)T * 64 * 2;
constexpr size_t WS_QI = WS_WIF + (size_t)T * 4 * 4;
constexpr size_t WS_SG = WS_QI + (size_t)T * 256 * 2;
constexpr size_t WS_X1B = WS_SG;
constexpr size_t WS_HID = WS_SG + (size_t)T * 3072;
constexpr size_t WS_X1B8 = WS_HID + (size_t)T * 1024;
constexpr size_t WS_SC = WS_HID + (size_t)T * 1024 * 2;
constexpr size_t WS_IDX = WS_SC + (size_t)32 * 2048 * 128 * 4;
constexpr size_t WS_MEMN = WS_IDX + (size_t)T * 256 * 2;
constexpr size_t WS_KMVM = WS_MEMN + (size_t)8192 * 1024 * 2;
constexpr size_t WS_KM = WS_KMVM + (size_t)8192 * 1024 * 2;
constexpr size_t WS_VMT = WS_KM + (size_t)128 * 256 * 128 * 2;
constexpr size_t WS_TOK = WS_VMT + (size_t)128 * 128 * 256 * 2;
constexpr size_t WS_RW = WS_TOK + (size_t)32 * 65536 * 4;
constexpr size_t WS_TOK2 = WS_RW + (size_t)32 * 65536 * 8;
constexpr size_t WS_LP = WS_TOK2 + (size_t)112 * 65536 * 4;
constexpr size_t WS_BB = WS_LP + (size_t)32 * 64 * 33 * 8;
constexpr size_t WS_HB8 = WS_BB + (size_t)32 * 64 * 16 * 8;
constexpr size_t WS_WG8 = WS_HB8 + (size_t)T * 1024;
constexpr size_t WS_CS = WS_WG8 + (size_t)5120 * 1024;
constexpr size_t WS_END = WS_CS + (size_t)T * 32 * 8;
constexpr size_t DO_Y3 = 0, DO_Y8 = (size_t)T * 1024 * 2, DO_YS8 = DO_Y8, DO_YD8 = DO_Y8 + (size_t)T * 512, DO_YM8 = DO_Y8 + (size_t)2 * T * 512;
constexpr int Y3LD = 1024;
constexpr size_t WS_YG = WS_HID;

__device__ __forceinline__ float bf2f(unsigned b) { return __uint_as_float(b << 16); }
__device__ __forceinline__ unsigned cvt_pk_bf16(float lo, float hi) { unsigned r; asm("v_cvt_pk_bf16_f32 %0, %1, %2" : "=v"(r) : "v"(lo), "v"(hi)); return r; }
__device__ __forceinline__ bf16_t f2bf(float f) { return (bf16_t)(cvt_pk_bf16(f, 0.f) & 0xffffu); }
__device__ __forceinline__ float wave_sum(float v) { v += __shfl_xor(v, 32); v += __shfl_xor(v, 16); v += __shfl_xor(v, 8); v += __shfl_xor(v, 4); v += __shfl_xor(v, 2); v += __shfl_xor(v, 1); return v; }
__device__ __forceinline__ float sum32(float v) { v += __shfl_xor(v, 16); v += __shfl_xor(v, 8); v += __shfl_xor(v, 4); v += __shfl_xor(v, 2); v += __shfl_xor(v, 1); return v; }
__device__ __forceinline__ float sigm(float x) { return __builtin_amdgcn_rcpf(1.0f + __expf(-x)); }
__device__ __forceinline__ float gelu_tanh(float x) { const float u = 1.5957691216057308f * (x + 0.044715f * x * x * x); return x * sigm(u); }
__device__ __forceinline__ u32x4 pack8(const f32x4 a, const f32x4 b) { u32x4 w; w.x = cvt_pk_bf16(a[0], a[1]); w.y = cvt_pk_bf16(a[2], a[3]); w.z = cvt_pk_bf16(b[0], b[1]); w.w = cvt_pk_bf16(b[2], b[3]); return w; }
__device__ __forceinline__ void unpack8(const u32x4 w, f32x4& a, f32x4& b) {
    a[0] = bf2f(w.x & 0xffffu); a[1] = bf2f(w.x >> 16); a[2] = bf2f(w.y & 0xffffu); a[3] = bf2f(w.y >> 16);
    b[0] = bf2f(w.z & 0xffffu); b[1] = bf2f(w.z >> 16); b[2] = bf2f(w.w & 0xffffu); b[3] = bf2f(w.w >> 16); }

__device__ __forceinline__ unsigned pack_fp8x4(float a, float b, float c, float d) {
    a = __builtin_amdgcn_fmed3f(a, -448.f, 448.f); b = __builtin_amdgcn_fmed3f(b, -448.f, 448.f); c = __builtin_amdgcn_fmed3f(c, -448.f, 448.f); d = __builtin_amdgcn_fmed3f(d, -448.f, 448.f);
    int p = __builtin_amdgcn_cvt_pk_fp8_f32(a, b, 0, false); p = __builtin_amdgcn_cvt_pk_fp8_f32(c, d, p, true); return (unsigned)p; }

__device__ __forceinline__ unsigned pack_fp8x4_nc(float a, float b, float c, float d) {
    int p = __builtin_amdgcn_cvt_pk_fp8_f32(a, b, 0, false); p = __builtin_amdgcn_cvt_pk_fp8_f32(c, d, p, true); return (unsigned)p; }

#define XB_TMO      128
#define XB_XCNT(j)  (256  + 64 * (j))
#define XB_XSUB(j)  (1280 + 64 * (j))
#define XB_XGEN(j)  (2304 + 64 * (j))
#define XB_TOP      3328
#define XB_TOPGEN   3392
#define XCD_BAR_WORDS 3456
#define XB_SPIN_CAP (1u << 18)
__device__ __forceinline__ unsigned xb_ld(unsigned* p)              { return __hip_atomic_load(p, __ATOMIC_RELAXED, __HIP_MEMORY_SCOPE_AGENT); }
__device__ __forceinline__ unsigned xb_add(unsigned* p, unsigned v) { return __hip_atomic_fetch_add(p, v, __ATOMIC_RELAXED, __HIP_MEMORY_SCOPE_AGENT); }
__device__ __forceinline__ unsigned xb_xcc_id() { return (unsigned)__builtin_amdgcn_s_getreg((3 << 11) | 20) & 0xFu; }
#define XB_SPIN(cond, bar) do { unsigned _sp = 0; while (cond) { __builtin_amdgcn_s_sleep(1); \
    if ((++_sp & 255u) == 0u) { if (xb_ld(&(bar)[XB_TMO])) break; if (_sp > XB_SPIN_CAP) { atomicAdd(&(bar)[XB_TMO], 1u); break; } } } } while (0)
struct XcdBarrier { unsigned* bar; unsigned x; volatile LAS unsigned* st; };
__device__ __forceinline__ XcdBarrier xcd_barrier_post(unsigned* bar, volatile LAS unsigned* st) {
    XcdBarrier b; b.bar = bar; b.x = xb_xcc_id(); b.st = st;
    if (threadIdx.x == 0) st[2] = xb_add(&bar[XB_XCNT(b.x)], 1u);
    return b;
}
__device__ __forceinline__ void xcd_barrier_complete(unsigned* bar, unsigned x, unsigned& nloc, unsigned& nx) {
    const unsigned G = gridDim.x * gridDim.y * gridDim.z;
    unsigned sum, cnt, mine, sp = 0u;
    for (;;) {
        sum = 0u; cnt = 0u; mine = 0u;
#pragma unroll
        for (unsigned j = 0; j < 16; ++j) { const unsigned c = xb_ld(&bar[XB_XCNT(j)]); sum += c; cnt += (c > 0u) ? 1u : 0u; mine = (j == x) ? c : mine; }
        if (sum == G) break;
        __builtin_amdgcn_s_sleep(1);
        if ((++sp & 255u) == 0u) { if (xb_ld(&bar[XB_TMO])) break; if (sp > XB_SPIN_CAP) { atomicAdd(&bar[XB_TMO], 1u); break; } }
    }
    nloc = mine > 0u ? mine : 1u; nx = cnt > 0u ? cnt : 1u;
}
__device__ __forceinline__ void xcd_barrier(const XcdBarrier& b) {
    asm volatile("s_waitcnt vmcnt(0)" ::: "memory");
    __syncthreads();
    if (threadIdx.x == 0) {
        unsigned* bar = b.bar;
        __builtin_amdgcn_s_waitcnt(0);
        unsigned nloc = b.st[0], nx = b.st[1];
        if (nloc == 0u) { xcd_barrier_complete(bar, b.x, nloc, nx); b.st[0] = nloc; b.st[1] = nx; }
        const unsigned old = xb_add(&bar[XB_XSUB(b.x)], 1u);
        const unsigned gen = old / nloc;
        if (old + 1u == (gen + 1u) * nloc) {
            __builtin_amdgcn_fence(__ATOMIC_RELEASE, "agent");
            asm volatile("s_waitcnt vmcnt(0)" ::: "memory");
            const unsigned og = xb_add(&bar[XB_TOP], 1u);
            const unsigned tg = og / nx;
            if (og + 1u == (tg + 1u) * nx) xb_add(&bar[XB_TOPGEN], 1u);
            else XB_SPIN(xb_ld(&bar[XB_TOPGEN]) == tg, bar);
            __builtin_amdgcn_fence(__ATOMIC_ACQUIRE, "agent");
            xb_add(&bar[XB_XGEN(b.x)], 1u);
            asm volatile("s_waitcnt vmcnt(0)" ::: "memory");
        } else {
            XB_SPIN(xb_ld(&bar[XB_XGEN(b.x)]) == gen, bar);
            __builtin_amdgcn_fence(__ATOMIC_ACQUIRE, "agent");
            asm volatile("s_waitcnt vmcnt(0)" ::: "memory");
        }
    }
    __syncthreads();
}

namespace pg8 {
constexpr int BM = 256, BK = 64, HALF = 128, HTB = HALF * BK * 2, STAGE_BYTES = 8 * HTB;
__device__ __forceinline__ int lds_byte(int r, int c) { const int st = (r >> 4) * 2 + (c >> 5), rr = r & 15, cc = c & 31, ob = rr * 64 + cc * 2; return st * 1024 + (ob ^ (((ob >> 9) & 1) << 5)); }
__device__ __forceinline__ void stage_rc(int b, int& R, int& C) { const int st = b / 1024, sb = b % 1024, swz = sb ^ (((sb >> 9) & 1) << 5); R = (st >> 1) * 16 + swz / 64; C = (st & 1) * 32 + (swz % 64) / 2; }
__device__ __forceinline__ int perm32(int rho) { const int n = rho >> 4, i = rho & 15; return 8 * (i >> 2) + 4 * n + (i & 3); }
struct Unit { int pm, pn, z; };
struct Gemm { int lda, ldb, K; int sa = 0x7f, sb = 0x7f; };
typedef int v8i32 __attribute__((ext_vector_type(8)));
typedef int v4i32 __attribute__((ext_vector_type(4)));

#ifndef PG8_SP2
#define PG8_SP2 true
#endif
template <class Epi, class Sched, bool GATHER, bool SP2 = PG8_SP2, bool F8 = false>
__device__ __forceinline__ void gemm_phase(LAS unsigned char* lds, const Gemm g, const Sched& S, const Epi& E) {
    const int tid = threadIdx.x, wid = __builtin_amdgcn_readfirstlane(tid >> 6), lane = tid & 63, wr = wid >> 2, wc = wid & 3, fr = lane & 15, fq = lane >> 4;
    const int K = g.K, nt = K / BK;
    unsigned voffA[2], voffB[2]; int Rr[2], Cc[2];
#pragma unroll
    for (int i = 0; i < 2; ++i) { int R, C; stage_rc(tid * 16 + i * 8192, R, C); const int Rb = Epi::PERM ? ((R & ~31) + perm32(R & 31)) : R;
        Rr[i] = R; Cc[i] = C; voffA[i] = (unsigned)(R * g.lda + C) * 2u; voffB[i] = (unsigned)(Rb * g.ldb + C) * 2u; }
    const size_t hstepA = (size_t)HALF * g.lda * 2, hstepB = (size_t)HALF * g.ldb * 2;
    const unsigned ldsw = (unsigned)wid * 1024u;
    const int aoff = lds_byte(wr * 64 + fr, fq * 8), boff = lds_byte(wc * 32 + fr, fq * 8);
#define PG8_SA(b, h) (((b) * 2 + (h)) * HTB)
#define PG8_SB(b, h) ((4 + (b) * 2 + (h)) * HTB)
#define PG8_GLDS(gp, lo) __builtin_amdgcn_global_load_lds((const unsigned*)(gp), (LAS unsigned*)(lds + (lo)), 16, 0, 0)
#define PG8_STAGE_B(bufoff, gbase, h) do { const char* _b = (const char*)(gbase) + (h) * hstepB; PG8_GLDS(_b + voffB[0], (bufoff) + ldsw); PG8_GLDS(_b + voffB[1], (bufoff) + ldsw + 8192); } while (0)
#define PG8_STAGE_A(bufoff, gbase, h, OFF) do { if constexpr (GATHER) { PG8_GLDS((const char*)(gbase) + OFF##h##0, (bufoff) + ldsw); PG8_GLDS((const char*)(gbase) + OFF##h##1, (bufoff) + ldsw + 8192); } \
        else { const char* _a = (const char*)(gbase) + (h) * hstepA; PG8_GLDS(_a + voffA[0], (bufoff) + ldsw); PG8_GLDS(_a + voffA[1], (bufoff) + ldsw + 8192); } } while (0)
#define PG8_LDA(dst, b, h) do { if constexpr (F8) { _Pragma("unroll") for (int m = 0; m < 4; ++m) { const v4i32 _lo = *(const LAS v4i32*)(lds + PG8_SA(b, h) + aoff + m * 2048), _hi = *(const LAS v4i32*)(lds + PG8_SA(b, h) + aoff + m * 2048 + 1024); \
            dst##8[m] = __builtin_shufflevector(_lo, _hi, 0, 1, 2, 3, 4, 5, 6, 7); } } \
        else { _Pragma("unroll") for (int m = 0; m < 4; ++m) _Pragma("unroll") for (int k = 0; k < 2; ++k) dst[m][k] = *(const LAS bf16x8*)(lds + PG8_SA(b, h) + aoff + m * 2048 + k * 1024); } } while (0)
#define PG8_LDB(dst, b, h) do { if constexpr (F8) { _Pragma("unroll") for (int n = 0; n < 2; ++n) { const v4i32 _lo = *(const LAS v4i32*)(lds + PG8_SB(b, h) + boff + n * 2048), _hi = *(const LAS v4i32*)(lds + PG8_SB(b, h) + boff + n * 2048 + 1024); \
            dst##8[n] = __builtin_shufflevector(_lo, _hi, 0, 1, 2, 3, 4, 5, 6, 7); } } \
        else { _Pragma("unroll") for (int n = 0; n < 2; ++n) _Pragma("unroll") for (int k = 0; k < 2; ++k) dst[n][k] = *(const LAS bf16x8*)(lds + PG8_SB(b, h) + boff + n * 2048 + k * 1024); } } while (0)
#define PG8_MMA(ai, bj, At, Bt) do { __builtin_amdgcn_s_setprio(1); \
        if constexpr (F8) { _Pragma("unroll") for (int m = 0; m < 4; ++m) _Pragma("unroll") for (int n = 0; n < 2; ++n) \
            asm volatile("v_mfma_scale_f32_16x16x128_f8f6f4 %0, %1, %2, %0, %3, %4 op_sel_hi:[0,0,0]" : "+v"(acc[ai][bj][m][n]) : "v"(Bt##8[n]), "v"(At##8[m]), "v"(f8sb), "v"(f8sa)); } \
        else { _Pragma("unroll") for (int m = 0; m < 4; ++m) _Pragma("unroll") for (int n = 0; n < 2; ++n) _Pragma("unroll") for (int k = 0; k < 2; ++k) \
            acc[ai][bj][m][n] = __builtin_amdgcn_mfma_f32_16x16x32_bf16(Bt[n][k], At[m][k], acc[ai][bj][m][n], 0, 0, 0); } \
        __builtin_amdgcn_s_setprio(0); } while (0)
#define PG8_WAIT_V(n) asm volatile("s_waitcnt vmcnt(" #n ")" ::: "memory")
#define PG8_WAIT_L(n) asm volatile("s_waitcnt lgkmcnt(" #n ")" ::: "memory")
#define PG8_BAR __builtin_amdgcn_s_barrier()
#define PG8_SCHED __builtin_amdgcn_sched_barrier(0)
    Unit cur, nxt; int ui = 0;
    if (!S.next(0, cur)) return;
    f32x4 acc[2][2][4][2];
#pragma unroll
    for (int a = 0; a < 2; ++a)
#pragma unroll
        for (int b = 0; b < 2; ++b)
#pragma unroll
            for (int m = 0; m < 4; ++m)
#pragma unroll
                for (int n = 0; n < 2; ++n) acc[a][b][m][n] = (f32x4){0.f, 0.f, 0.f, 0.f};
    bf16x8 At[4][2], B0[2][2], B1[2][2]; v8i32 At8[4], B08[2], B18[2];
    const int f8sa = g.sa, f8sb = g.sb;
    unsigned coff00 = 0u, coff01 = 0u, coff10 = 0u, coff11 = 0u, noff00 = 0u, noff01 = 0u, noff10 = 0u, noff11 = 0u;
    if constexpr (GATHER) {
        coff00 = S.a_off(cur, Rr[0]) + (unsigned)Cc[0] * 2u; coff01 = S.a_off(cur, Rr[1]) + (unsigned)Cc[1] * 2u;
        coff10 = S.a_off(cur, HALF + Rr[0]) + (unsigned)Cc[0] * 2u; coff11 = S.a_off(cur, HALF + Rr[1]) + (unsigned)Cc[1] * 2u;
    }
    { const char* cA = S.a_ptr(cur, 0); const char* cB = S.b_ptr(cur, 0); const char* cA1 = S.a_ptr(cur, 1); const char* cB1 = S.b_ptr(cur, 1);
    if constexpr (SP2) {
    PG8_STAGE_B(PG8_SB(0, 0), cB, 0); PG8_STAGE_B(PG8_SB(0, 1), cB, 1); PG8_STAGE_A(PG8_SA(0, 0), cA, 0, coff); PG8_STAGE_A(PG8_SA(0, 1), cA, 1, coff);
    if (wr == 1) PG8_BAR;
    PG8_WAIT_V(2); PG8_BAR;
    PG8_STAGE_B(PG8_SB(1, 0), cB1, 0); PG8_STAGE_A(PG8_SA(1, 0), cA1, 0, coff); PG8_STAGE_B(PG8_SB(1, 1), cB1, 1);
    PG8_WAIT_V(6); PG8_BAR;
    } else {
    PG8_STAGE_B(PG8_SB(0, 0), cB, 0); PG8_STAGE_A(PG8_SA(0, 0), cA, 0, coff); PG8_STAGE_B(PG8_SB(0, 1), cB, 1); PG8_STAGE_A(PG8_SA(0, 1), cA, 1, coff);
    if (wr == 1) PG8_BAR;
    PG8_WAIT_V(4); PG8_BAR;
    PG8_STAGE_B(PG8_SB(1, 0), cB1, 0); PG8_STAGE_A(PG8_SA(1, 0), cA1, 0, coff); PG8_STAGE_B(PG8_SB(1, 1), cB1, 1);
    PG8_WAIT_V(6); PG8_BAR; } }
    for (;;) {
        const bool has_next = S.next(ui + 1, nxt);
        Unit un; un.pm = has_next ? nxt.pm : cur.pm; un.pn = has_next ? nxt.pn : cur.pn; un.z = has_next ? nxt.z : cur.z;
        if constexpr (GATHER) {
            noff00 = has_next ? (S.a_off(nxt, Rr[0]) + (unsigned)Cc[0] * 2u) : coff00; noff01 = has_next ? (S.a_off(nxt, Rr[1]) + (unsigned)Cc[1] * 2u) : coff01;
            noff10 = has_next ? (S.a_off(nxt, HALF + Rr[0]) + (unsigned)Cc[0] * 2u) : coff10; noff11 = has_next ? (S.a_off(nxt, HALF + Rr[1]) + (unsigned)Cc[1] * 2u) : coff11;
        }
        for (int t = 0; t < nt; t += 2) {
            const bool last = (t == nt - 2);
            if constexpr (Epi::HOOK) { if (t == Epi::H1 || t == Epi::H2) { if constexpr (F8) asm volatile("s_nop 15\n\ts_nop 15\n\ts_nop 7" ::: "memory"); if (wr == 0) PG8_BAR; E.hook(acc, cur, t, wr, wc, fr, fq); if (wr == 1) PG8_BAR; } }
            const char* a1 = S.a_ptr(cur, t + 1);
            const char* a2 = last ? S.a_ptr(un, 0) : S.a_ptr(cur, t + 2); const char* b2 = last ? S.b_ptr(un, 0) : S.b_ptr(cur, t + 2);
            const char* a3 = last ? S.a_ptr(un, 1) : S.a_ptr(cur, t + 3); const char* b3 = last ? S.b_ptr(un, 1) : S.b_ptr(cur, t + 3);
            const unsigned o200 = last ? noff00 : coff00, o201 = last ? noff01 : coff01, o210 = last ? noff10 : coff10, o211 = last ? noff11 : coff11;
            if constexpr (SP2) {
            PG8_LDB(B0, 0, 0); PG8_LDB(B1, 0, 1); PG8_SCHED; PG8_LDA(At, 0, 0); PG8_STAGE_A(PG8_SA(1, 1), a1, 1, coff);
            PG8_WAIT_V(8); PG8_WAIT_L(0); PG8_BAR; PG8_MMA(0, 0, At, B0); PG8_MMA(0, 1, At, B1); PG8_BAR; PG8_SCHED;
            PG8_LDA(At, 0, 1); PG8_STAGE_B(PG8_SB(0, 0), b2, 0); PG8_STAGE_B(PG8_SB(0, 1), b2, 1); PG8_STAGE_A(PG8_SA(0, 0), a2, 0, o2);
            PG8_WAIT_V(8); PG8_WAIT_L(0); PG8_BAR; PG8_MMA(1, 0, At, B0); PG8_MMA(1, 1, At, B1); PG8_BAR; PG8_SCHED;
            PG8_LDB(B0, 1, 0); PG8_LDB(B1, 1, 1); PG8_SCHED; PG8_LDA(At, 1, 0); PG8_STAGE_A(PG8_SA(0, 1), a2, 1, o2);
            PG8_WAIT_V(8); PG8_WAIT_L(0); PG8_BAR; PG8_MMA(0, 0, At, B0); PG8_MMA(0, 1, At, B1); PG8_BAR; PG8_SCHED;
            PG8_LDA(At, 1, 1); PG8_STAGE_B(PG8_SB(1, 0), b3, 0); PG8_STAGE_B(PG8_SB(1, 1), b3, 1); PG8_STAGE_A(PG8_SA(1, 0), a3, 0, o2);
            PG8_WAIT_V(8); PG8_WAIT_L(0); PG8_BAR; PG8_MMA(1, 0, At, B0); PG8_MMA(1, 1, At, B1); PG8_BAR; PG8_SCHED;
            } else {
            PG8_LDB(B0, 0, 0); PG8_SCHED; PG8_LDA(At, 0, 0); PG8_STAGE_A(PG8_SA(1, 1), a1, 1, coff);
            PG8_WAIT_L(8); PG8_BAR; PG8_WAIT_L(0); PG8_MMA(0, 0, At, B0); PG8_BAR; PG8_SCHED;
            PG8_LDB(B1, 0, 1); PG8_STAGE_B(PG8_SB(0, 0), b2, 0);
            PG8_BAR; PG8_WAIT_L(0); PG8_MMA(0, 1, At, B1); PG8_BAR;
            PG8_LDA(At, 0, 1); PG8_STAGE_A(PG8_SA(0, 0), a2, 0, o2);
            PG8_BAR; PG8_WAIT_L(0); PG8_MMA(1, 0, At, B0); PG8_BAR; PG8_SCHED;
            PG8_STAGE_B(PG8_SB(0, 1), b2, 1);
            PG8_WAIT_V(6); PG8_BAR; PG8_MMA(1, 1, At, B1); PG8_BAR;
            PG8_LDB(B0, 1, 0); PG8_SCHED; PG8_LDA(At, 1, 0); PG8_STAGE_A(PG8_SA(0, 1), a2, 1, o2);
            PG8_WAIT_L(8); PG8_BAR; PG8_WAIT_L(0); PG8_MMA(0, 0, At, B0); PG8_BAR; PG8_SCHED;
            PG8_LDB(B1, 1, 1); PG8_STAGE_B(PG8_SB(1, 0), b3, 0);
            PG8_BAR; PG8_WAIT_L(0); PG8_MMA(0, 1, At, B1); PG8_BAR;
            PG8_LDA(At, 1, 1); PG8_STAGE_A(PG8_SA(1, 0), a3, 0, o2);
            PG8_BAR; PG8_WAIT_L(0); PG8_MMA(1, 0, At, B0); PG8_BAR; PG8_SCHED;
            PG8_STAGE_B(PG8_SB(1, 1), b3, 1);
            PG8_WAIT_V(6); PG8_BAR; PG8_MMA(1, 1, At, B1); PG8_BAR;
            }
        }
        if constexpr (F8) asm volatile("s_nop 15\n\ts_nop 15\n\ts_nop 7" ::: "memory");
        if (wr == 0) PG8_BAR;
        E(acc, cur, wr, wc, fr, fq);
        if (!has_next) break;
#pragma unroll
        for (int a = 0; a < 2; ++a)
#pragma unroll
            for (int b = 0; b < 2; ++b)
#pragma unroll
                for (int m = 0; m < 4; ++m)
#pragma unroll
                    for (int n = 0; n < 2; ++n) acc[a][b][m][n] = (f32x4){0.f, 0.f, 0.f, 0.f};
        cur = nxt; ++ui;
        if constexpr (GATHER) { coff00 = noff00; coff01 = noff01; coff10 = noff10; coff11 = noff11; }
        if (wr == 1) PG8_BAR;
    }
    PG8_WAIT_V(0);
    PG8_BAR;
#undef PG8_SA
#undef PG8_SB
#undef PG8_GLDS
#undef PG8_STAGE_A
#undef PG8_STAGE_B
#undef PG8_LDA
#undef PG8_LDB
#undef PG8_MMA
#undef PG8_WAIT_V
#undef PG8_WAIT_L
#undef PG8_BAR
#undef PG8_SCHED
}

struct SchedGrid {
    const char* A; const char* B; size_t zA, zB, tA, tB; int nM, nN, nz, G, c, rep;
    __device__ __forceinline__ bool next(int i, Unit& u) const {
        const int nwg = nz * nM * nN; const long L = (long)i * G + c; if (L >= (long)nwg * rep) return false;
        int w = (int)(L % nwg); { const int q = nwg / 8, r = nwg % 8, x = w % 8, off = w / 8; w = (x < r ? x * (q + 1) : r * (q + 1) + (x - r) * q) + off; }
        const int per = nM * nN; u.z = w / per; w -= u.z * per;
#ifdef PROBE_NOEPI
        if (L >= nwg) u.z |= 0x4000;
#endif
        const int nig = 8 * nN, gid = w / nig, fm = gid * 8, gsz = (nM - fm) < 8 ? (nM - fm) : 8;
        u.pm = fm + ((w % nig) % gsz); u.pn = (w % nig) / gsz; return true; }
    __device__ __forceinline__ const char* a_ptr(const Unit& u, int t) const { return A + (size_t)u.z * zA + (size_t)u.pm * tA + (size_t)t * 128; }
    __device__ __forceinline__ const char* b_ptr(const Unit& u, int t) const { return B + (size_t)u.z * zB + (size_t)u.pn * tB + (size_t)t * 128; }
    __device__ __forceinline__ unsigned a_off(const Unit&, int) const { return 0u; }
};
}

struct Args { const void* in[32]; float* out; unsigned char* ws; int ph_lo, ph_hi; };
struct Frame {
    LAS unsigned char* lds; int tid, lane, wave, G, c;
    unsigned char* ws; unsigned char* dout;
};
enum { I_X = 0, I_MEM, I_POS, I_GMIX, I_GMEM, I_WIN, I_LRE, I_LIM, I_LDT, I_BRE, I_BIM, I_CRE, I_CIM, I_DSKIP, I_WGLU, I_GQ, I_GK, I_GQM, I_GKM, I_WMEMKV,
       I_WUPS, I_WUPD, I_WUPM, I_WOUT, I_GFFN, I_WGROUP, I_BGROUP, I_WEXP, I_BEXP, I_WGATE, I_WUP, I_WDOWN };
#define INP(i) ((const float*)a.in[i])
#define WSP(T_, off) ((T_*)(F.ws + (off)))
#define DOP(T_, off) ((T_*)(F.dout + (off)))

using pg8::Unit;
__device__ __forceinline__ unsigned gpack4(const f32x4 v) {
    unsigned w = 0u;
#pragma unroll
    for (int j = 0; j < 4; ++j) { const float sg255 = __builtin_amdgcn_rcpf(__builtin_fmaf(__builtin_amdgcn_exp2f(v[j]), 1.0f / 255.0f, 1.0f / 255.0f)); w = __builtin_amdgcn_cvt_pk_u8_f32(sg255, j, w); }
    return w; }
__device__ __forceinline__ void gdecode(const u32x2 w, float (&g)[8]) {
#pragma unroll
    for (int j = 0; j < 4; ++j) { g[j] = fmaxf((float)((w.x >> (8 * j)) & 255u), 0.5f); g[4 + j] = fmaxf((float)((w.y >> (8 * j)) & 255u), 0.5f); } }
struct EpiInProj {
    static constexpr bool PERM = true, HOOK = false;
    bf16_t *UA, *Y3; unsigned char* SG;
    __device__ __forceinline__ void operator()(const f32x4 (&acc)[2][2][4][2], const Unit& u, int wr, int wc, int fr, int fq) const {
        const int pn = u.pn, row0 = u.pm * 256 + wr * 64 + fr, cw = wc * 32 + 8 * fq;
#pragma unroll
        for (int ai = 0; ai < 2; ++ai)
#pragma unroll
            for (int m = 0; m < 4; ++m) {
                const int r = row0 + ai * 128 + m * 16;
#pragma unroll
                for (int bj = 0; bj < 2; ++bj) {
                    const int c = bj * 128 + cw;
                    if (pn >= 6) {
                        u32x2 w; w.x = gpack4(acc[ai][bj][m][0]); w.y = gpack4(acc[ai][bj][m][1]);
                        *(u32x2*)(SG + (size_t)r * 3072 + (pn - 6) * 256 + c) = w;
                    } else {
                        bf16_t* p;
                        if (pn < 2) { const int cc = pn * 256 + c, gI = cc >> 4, h0 = cc & 15, b = r >> 11, s = r & 2047;
                            p = UA + ((size_t)(gI * 2048 + b * 64 + (s >> 5)) * 640 + (s & 31) * 16 + h0); }
                        else p = Y3 + (size_t)r * Y3LD + (pn - 2) * 256 + c;
                        *(u32x4*)p = pack8(acc[ai][bj][m][0], acc[ai][bj][m][1]);
                    }
                }
            }
    }
};
struct EpiInProjB {
    static constexpr bool PERM = true, HOOK = false;
    bf16_t *KVX, *QI;
    __device__ __forceinline__ void operator()(const f32x4 (&acc)[2][2][4][2], const Unit& u, int wr, int wc, int fr, int fq) const {
        const int row0 = u.pm * 256 + wr * 64 + fr, cw = wc * 32 + 8 * fq; bf16_t* base = u.pn == 0 ? KVX : QI;
#pragma unroll
        for (int ai = 0; ai < 2; ++ai)
#pragma unroll
            for (int m = 0; m < 4; ++m)
#pragma unroll
                for (int bj = 0; bj < 2; ++bj)
                    *(u32x4*)(base + (size_t)(row0 + ai * 128 + m * 16) * 256 + bj * 128 + cw) = pack8(acc[ai][bj][m][0], acc[ai][bj][m][1]);
    }
};
struct EpiBf16 {
    static constexpr bool PERM = true, HOOK = false;
    bf16_t* O; int ld;
    __device__ __forceinline__ void operator()(const f32x4 (&acc)[2][2][4][2], const Unit& u, int wr, int wc, int fr, int fq) const {
        const int row0 = u.pm * 256 + wr * 64 + fr, col0 = u.pn * 256 + wc * 32 + 8 * fq;
#pragma unroll
        for (int ai = 0; ai < 2; ++ai)
#pragma unroll
            for (int m = 0; m < 4; ++m)
#pragma unroll
                for (int bj = 0; bj < 2; ++bj)
                    *(u32x4*)(O + (size_t)(row0 + ai * 128 + m * 16) * ld + col0 + bj * 128) = pack8(acc[ai][bj][m][0], acc[ai][bj][m][1]);
    }
};
struct EpiSc {
    static constexpr bool PERM = false, HOOK = false;
    float* SC;
    __device__ __forceinline__ void operator()(const f32x4 (&acc)[2][2][4][2], const Unit& u, int wr, int wc, int fr, int fq) const {
        const int row0 = u.pm * 256 + wr * 64 + fr, col0 = wc * 32 + 4 * fq;
#pragma unroll
        for (int ai = 0; ai < 2; ++ai)
#pragma unroll
            for (int m = 0; m < 4; ++m)
#pragma unroll
                for (int n = 0; n < 2; ++n)
                    *(f32x4*)(SC + ((size_t)u.z * 2048 + row0 + ai * 128 + m * 16) * 128 + col0 + n * 16) = acc[ai][0][m][n];
    }
};
struct EpiGelu {
    static constexpr bool PERM = true, HOOK = false;
    bf16_t* YG;
    __device__ __forceinline__ void operator()(const f32x4 (&acc)[2][2][4][2], const Unit& u, int wr, int wc, int fr, int fq) const {
        const int row0 = u.pm * 256 + wr * 64 + fr, col0 = u.pn * 256 + wc * 32 + 8 * fq;
#pragma unroll
        for (int ai = 0; ai < 2; ++ai)
#pragma unroll
            for (int m = 0; m < 4; ++m) {
                const int row = row0 + ai * 128 + m * 16;
#pragma unroll
                for (int bj = 0; bj < 2; ++bj) {
                    const int n8 = col0 + bj * 128, i = n8 >> 4, ho = n8 & 15;
                    f32x4 v0 = acc[ai][bj][m][0], v1 = acc[ai][bj][m][1];
#pragma unroll
                    for (int j = 0; j < 4; ++j) { v0[j] = gelu_tanh(v0[j]); v1[j] = gelu_tanh(v1[j]); }
                    *(u32x4*)(YG + ((size_t)row * 32 + i) * 512 + u.z * 16 + ho) = pack8(v0, v1);
                }
            }
    }
};
struct EpiGlu {
    static constexpr bool PERM = true, HOOK = false;
    const bf16_t* YG; unsigned char* YS8;
    __device__ __forceinline__ void operator()(const f32x4 (&acc)[2][2][4][2], const Unit& u, int wr, int wc, int fr, int fq) const {
        const int row0 = u.pm * 256 + wr * 64 + fr, col0 = u.pn * 256 + wc * 32 + 8 * fq;
        u32x4 yv[2][4][2];
#pragma unroll
        for (int ai = 0; ai < 2; ++ai)
#pragma unroll
            for (int m = 0; m < 4; ++m)
#pragma unroll
                for (int bj = 0; bj < 2; ++bj) yv[ai][m][bj] = *(const u32x4*)(YG + (size_t)(row0 + ai * 128 + m * 16) * 512 + col0 + bj * 128);
#pragma unroll
        for (int ai = 0; ai < 2; ++ai)
#pragma unroll
            for (int m = 0; m < 4; ++m)
#pragma unroll
                for (int bj = 0; bj < 2; ++bj) {
                    const int r = row0 + ai * 128 + m * 16, c = col0 + bj * 128;
                    f32x4 y0, y1; unpack8(yv[ai][m][bj], y0, y1);
                    f32x4 v0 = acc[ai][bj][m][0], v1 = acc[ai][bj][m][1];
#pragma unroll
                    for (int j = 0; j < 4; ++j) { v0[j] = y0[j] * sigm(v0[j]) * 16.0f; v1[j] = y1[j] * sigm(v1[j]) * 16.0f; }
                    u32x2 w8; w8.x = pack_fp8x4(v0[0], v0[1], v0[2], v0[3]); w8.y = pack_fp8x4(v1[0], v1[1], v1[2], v1[3]);
                    *(u32x2*)(YS8 + (size_t)r * 512 + c) = w8;
                }
    }
};
struct EpiMerge {
    static constexpr bool PERM = true, HOOK = true; static constexpr int H1 = 4, H2 = 8;
    const unsigned char* SG; unsigned char* MG;
    __device__ __forceinline__ void hook(f32x4 (&acc)[2][2][4][2], const Unit& u, int t, int wr, int wc, int fr, int fq) const {
        int row0 = u.pm * 256 + wr * 64 + fr, col0 = u.pn * 256 + wc * 32 + 8 * fq; const int br = (t >> 2) - 1;
        asm volatile("" : "+v"(row0), "+v"(col0));
        u32x2 wa[2][4][2], wb[2][4][2];
#pragma unroll
        for (int ai = 0; ai < 2; ++ai)
#pragma unroll
            for (int m = 0; m < 4; ++m)
#pragma unroll
                for (int bj = 0; bj < 2; ++bj) { const unsigned char* gp = SG + (size_t)(row0 + ai * 128 + m * 16) * 3072 + br * 1024 + col0 + bj * 128;
                    wa[ai][m][bj] = *(const u32x2*)gp; wb[ai][m][bj] = *(const u32x2*)(gp + 1024); }
#pragma unroll
        for (int ai = 0; ai < 2; ++ai)
#pragma unroll
            for (int m = 0; m < 4; ++m)
#pragma unroll
                for (int bj = 0; bj < 2; ++bj) {
                    float ga[8], gb[8]; gdecode(wa[ai][m][bj], ga); gdecode(wb[ai][m][bj], gb);
#pragma unroll
                    for (int j = 0; j < 4; ++j) { acc[ai][bj][m][0][j] *= ga[j] * __builtin_amdgcn_rcpf(gb[j]); acc[ai][bj][m][1][j] *= ga[4 + j] * __builtin_amdgcn_rcpf(gb[4 + j]); }
                }
    }
    __device__ __forceinline__ void operator()(const f32x4 (&acc)[2][2][4][2], const Unit& u, int wr, int wc, int fr, int fq) const {
        const int row0 = u.pm * 256 + wr * 64 + fr, col0 = u.pn * 256 + wc * 32 + 8 * fq;
        u32x2 wg[2][4][2];
#pragma unroll
        for (int ai = 0; ai < 2; ++ai)
#pragma unroll
            for (int m = 0; m < 4; ++m)
#pragma unroll
                for (int bj = 0; bj < 2; ++bj) wg[ai][m][bj] = *(const u32x2*)(SG + (size_t)(row0 + ai * 128 + m * 16) * 3072 + 2048 + col0 + bj * 128);
#pragma unroll
        for (int ai = 0; ai < 2; ++ai)
#pragma unroll
            for (int m = 0; m < 4; ++m)
#pragma unroll
                for (int bj = 0; bj < 2; ++bj) {
                    const int r = row0 + ai * 128 + m * 16, c = col0 + bj * 128;
                    float g2[8]; gdecode(wg[ai][m][bj], g2);
                    f32x4 v0 = acc[ai][bj][m][0], v1 = acc[ai][bj][m][1];
#pragma unroll
                    for (int j = 0; j < 4; ++j) { v0[j] *= g2[j] * (8.0f / 255.0f); v1[j] *= g2[4 + j] * (8.0f / 255.0f); }
                    u32x2 w8; w8.x = pack_fp8x4(v0[0], v0[1], v0[2], v0[3]); w8.y = pack_fp8x4(v1[0], v1[1], v1[2], v1[3]);
                    *(u32x2*)(MG + (size_t)r * 1024 + c) = w8;
                }
    }
};
struct EpiOut {
    static constexpr bool PERM = true, HOOK = false;
    const float* X; bf16_t* X1B; unsigned char* X1B8;
    __device__ __forceinline__ void operator()(const f32x4 (&acc)[2][2][4][2], const Unit& u, int wr, int wc, int fr, int fq) const {
        const int row0 = u.pm * 256 + wr * 64 + fr, col0 = u.pn * 256 + wc * 32 + 8 * fq;
#pragma unroll
        for (int ai = 0; ai < 2; ++ai) {
            f32x4 xv[4][2][2];
#pragma unroll
            for (int m = 0; m < 4; ++m)
#pragma unroll
                for (int bj = 0; bj < 2; ++bj) { const float* xp = X + (size_t)(row0 + ai * 128 + m * 16) * 1024 + col0 + bj * 128; xv[m][bj][0] = __builtin_nontemporal_load((const f32x4*)xp); xv[m][bj][1] = __builtin_nontemporal_load((const f32x4*)(xp + 4)); }
#pragma unroll
            for (int m = 0; m < 4; ++m)
#pragma unroll
                for (int bj = 0; bj < 2; ++bj)
                { const f32x4 v0 = xv[m][bj][0] + acc[ai][bj][m][0], v1 = xv[m][bj][1] + acc[ai][bj][m][1]; const size_t o = (size_t)(row0 + ai * 128 + m * 16) * 1024 + col0 + bj * 128;
                    *(u32x4*)(X1B + o) = pack8(v0, v1);
                    u32x2 w8; w8.x = pack_fp8x4(v0[0], v0[1], v0[2], v0[3]); w8.y = pack_fp8x4(v1[0], v1[1], v1[2], v1[3]); *(u32x2*)(X1B8 + o) = w8; }
        }
    }
};

constexpr int MI_CNT = 16, MI_PRE = 160, MI_TILE = 320, MI_PT = 960;
struct SchedMoE1 {
    const char* A; const char* W; LAS const int* misc; const int* tok; int ntile4, G, c, rep;
    __device__ __forceinline__ bool next(int i, Unit& u) const {
        long L = (long)i * G + c; if (L >= (long)ntile4 * rep) return false; L %= ntile4;
        const int e = misc[MI_TILE + (int)(L >> 2)]; u.z = e & 255; u.pm = e >> 8; u.pn = (int)(L & 3); return true; }
    __device__ __forceinline__ const char* a_ptr(const Unit&, int t) const { return A + (size_t)t * 128; }
    __device__ __forceinline__ const char* b_ptr(const Unit& u, int t) const { return W + (size_t)u.z * (1024 * 1024) + (size_t)u.pn * (256 * 1024) + (size_t)t * 128; }
    __device__ __forceinline__ unsigned a_off(const Unit& u, int r) const {
        int pos = u.pm * 256 + r; const int n = misc[MI_CNT + u.z]; pos = pos < n ? pos : 0;
        return (unsigned)(tok[(size_t)u.z * 65536 + pos] & 0x7fffffff) * 1024u; }
};
struct EpiMoe1 {
    static constexpr bool PERM = true, HOOK = false;
    LAS const int* misc; const int* tok; const float2* rw; unsigned char* HID;
    __device__ __forceinline__ void operator()(const f32x4 (&acc)[2][2][4][2], const Unit& u, int wr, int wc, int fr, int fq) const {
        const int l = u.z, n = misc[MI_CNT + l], col = u.pn * 128 + wc * 32 + 8 * fq;
        unsigned tk[2][4]; float2 qv[2][4];
#pragma unroll
        for (int ai = 0; ai < 2; ++ai)
#pragma unroll
            for (int m = 0; m < 4; ++m) { int pos = u.pm * 256 + ai * 128 + wr * 64 + m * 16 + fr; pos = pos < n ? pos : 0;
                tk[ai][m] = (unsigned)tok[(size_t)l * 65536 + pos]; qv[ai][m] = rw[(size_t)l * 65536 + pos]; }
#pragma unroll
        for (int ai = 0; ai < 2; ++ai)
#pragma unroll
            for (int m = 0; m < 4; ++m) {
                const int pos = u.pm * 256 + ai * 128 + wr * 64 + m * 16 + fr;
                if (pos < n) {
                    const float2 q = qv[ai][m];
                    f32x4 v0, v1;
#pragma unroll
                    for (int j = 0; j < 4; ++j) {
                        const float g0 = acc[ai][0][m][0][j] * q.x, u0 = acc[ai][1][m][0][j] * q.x, g1 = acc[ai][0][m][1][j] * q.x, u1 = acc[ai][1][m][1][j] * q.x;
                        v0[j] = g0 * sigm(g0) * u0 * (q.y * 16.0f); v1[j] = g1 * sigm(g1) * u1 * (q.y * 16.0f); }
                    u32x2 w8; w8.x = pack_fp8x4(v0[0], v0[1], v0[2], v0[3]); w8.y = pack_fp8x4(v1[0], v1[1], v1[2], v1[3]);
                    *(u32x2*)(HID + ((size_t)(tk[ai][m] & 0x7fffffffu) * 2 + (tk[ai][m] >> 31)) * 512 + col) = w8;
                }
            }
    }
};
struct SchedMoE2 {
    const char* A; const char* W; LAS const int* misc; const int* tok; int ntile4, G, c, rep;
    __device__ __forceinline__ bool next(int i, Unit& u) const {
        long L = (long)i * G + c; if (L >= (long)ntile4 * rep) return false; L %= ntile4;
        const int e = misc[MI_TILE + (int)(L >> 2)], l = e & 255, gi = l / 28, pt = misc[MI_PT + (l - gi * 28)];
        u.z = l | ((gi * 8 + (pt & 15)) << 8) | ((gi * 8 + (pt >> 4)) << 16); u.pm = e >> 8; u.pn = (int)(L & 3); return true; }
    __device__ __forceinline__ const char* a_ptr(const Unit&, int t) const { return A + (size_t)t * 128; }
    __device__ __forceinline__ const char* b_ptr(const Unit& u, int t) const {
        const int e = t < 4 ? ((u.z >> 8) & 255) : (u.z >> 16), tt = t < 4 ? t : t - 4;
        return W + (size_t)e * (1024 * 512) + (size_t)u.pn * (256 * 512) + (size_t)tt * 128; }
    __device__ __forceinline__ unsigned a_off(const Unit& u, int r) const {
        const int l = u.z & 255; int pos = u.pm * 256 + r; const int n = misc[MI_CNT + l]; pos = pos < n ? pos : 0;
        return (unsigned)tok[(size_t)l * 65536 + pos] * 1024u; }
};
struct EpiMoe2 {
    static constexpr bool PERM = false, HOOK = false;
    LAS const int* misc; const int* tok; const bf16_t* X1B; float* O;
    __device__ __forceinline__ void operator()(const f32x4 (&acc)[2][2][4][2], const Unit& u, int wr, int wc, int fr, int fq) const {
        const int l = u.z & 255, n = misc[MI_CNT + l], col0 = u.pn * 256 + wc * 32 + 4 * fq;
        int tk[2][4];
#pragma unroll
        for (int ai = 0; ai < 2; ++ai)
#pragma unroll
            for (int m = 0; m < 4; ++m) { int pos = u.pm * 256 + ai * 128 + wr * 64 + m * 16 + fr; pos = pos < n ? pos : 0; tk[ai][m] = tok[(size_t)l * 65536 + pos]; }
#pragma unroll
        for (int ai = 0; ai < 2; ++ai) {
            u32x2 xb[4][2][2];
#pragma unroll
            for (int m = 0; m < 4; ++m)
#pragma unroll
                for (int bj = 0; bj < 2; ++bj)
#pragma unroll
                    for (int nn = 0; nn < 2; ++nn) xb[m][bj][nn] = *(const u32x2*)(X1B + (size_t)tk[ai][m] * 1024 + col0 + bj * 128 + nn * 16);
#pragma unroll
            for (int m = 0; m < 4; ++m) {
                const int pos = u.pm * 256 + ai * 128 + wr * 64 + m * 16 + fr;
                if (pos < n) {
#pragma unroll
                    for (int bj = 0; bj < 2; ++bj)
#pragma unroll
                        for (int nn = 0; nn < 2; ++nn) { const u32x2 x = xb[m][bj][nn];
                            const f32x4 xv = (f32x4){bf2f(x.x & 0xffffu), bf2f(x.x >> 16), bf2f(x.y & 0xffffu), bf2f(x.y >> 16)};
                            __builtin_nontemporal_store(xv + acc[ai][bj][m][nn], (f32x4*)(O + (size_t)tk[ai][m] * 1024 + col0 + bj * 128 + nn * 16)); }
                }
            }
        }
    }
};
struct SchedMerge3 {
    const char* Y; const char* W; int G, c, rep;
    __device__ __forceinline__ bool next(int i, Unit& u) const {
        const int nwg = 1024; const long L = (long)i * G + c; if (L >= (long)nwg * rep) return false;
        int w = (int)(L % nwg); { const int q = nwg / 8, x = w % 8, off = w / 8; w = x * q + off; }
        const int nig = 8 * 4, gid = w / nig, fm = gid * 8;
        u.pm = fm + ((w % nig) % 8); u.pn = (w % nig) / 8; u.z = 0; return true; }
    __device__ __forceinline__ const char* a_ptr(const Unit& u, int t) const { return Y + (size_t)(t >> 2) * ((size_t)T * 512) + (size_t)u.pm * (256 * 512) + (size_t)(t & 3) * 128; }
    __device__ __forceinline__ const char* b_ptr(const Unit& u, int t) const { return W + (size_t)u.pn * (256 * 1536) + (size_t)t * 128; }
    __device__ __forceinline__ unsigned a_off(const Unit&, int) const { return 0u; }
};

__device__ __forceinline__ void rms_rows_bf16(const float* x, const float* g, bf16_t* out, unsigned char* out8, int nrows, int gw, int nw, int lane) {
    float4 gg[4];
#pragma unroll
    for (int i = 0; i < 4; ++i) gg[i] = ((const float4*)g)[lane + 64 * i];
#pragma unroll 1
    for (int r0 = gw; r0 < nrows; r0 += 2 * nw) {
        const int r1 = r0 + nw < nrows ? r0 + nw : r0;
        const float4* xa = (const float4*)(x + (size_t)r0 * 1024); const float4* xb = (const float4*)(x + (size_t)r1 * 1024);
        float4 va[4], vb[4]; float sa = 0.f, sb = 0.f;
#pragma unroll
        for (int i = 0; i < 4; ++i) { const f32x4 ta = __builtin_nontemporal_load((const f32x4*)xa + lane + 64 * i), tb = __builtin_nontemporal_load((const f32x4*)xb + lane + 64 * i);
            va[i] = make_float4(ta[0], ta[1], ta[2], ta[3]); vb[i] = make_float4(tb[0], tb[1], tb[2], tb[3]); }
#pragma unroll
        for (int i = 0; i < 4; ++i) { sa += va[i].x * va[i].x + va[i].y * va[i].y + va[i].z * va[i].z + va[i].w * va[i].w; sb += vb[i].x * vb[i].x + vb[i].y * vb[i].y + vb[i].z * vb[i].z + vb[i].w * vb[i].w; }
        sa = wave_sum(sa); sb = wave_sum(sb);
        const float ra = rsqrtf(sa * (1.0f / 1024.0f) + 1e-6f), rb = rsqrtf(sb * (1.0f / 1024.0f) + 1e-6f);
#pragma unroll
        for (int i = 0; i < 4; ++i) {
            u32x2 w; w.x = cvt_pk_bf16(va[i].x * ra * gg[i].x, va[i].y * ra * gg[i].y); w.y = cvt_pk_bf16(va[i].z * ra * gg[i].z, va[i].w * ra * gg[i].w);
            if (out) *(u32x2*)(out + (size_t)r0 * 1024 + (lane + 64 * i) * 4) = w;
            if (out8) *(unsigned*)(out8 + (size_t)r0 * 1024 + (lane + 64 * i) * 4) = pack_fp8x4(va[i].x * ra * gg[i].x, va[i].y * ra * gg[i].y, va[i].z * ra * gg[i].z, va[i].w * ra * gg[i].w);
            if (r1 != r0) { u32x2 z; z.x = cvt_pk_bf16(vb[i].x * rb * gg[i].x, vb[i].y * rb * gg[i].y); z.y = cvt_pk_bf16(vb[i].z * rb * gg[i].z, vb[i].w * rb * gg[i].w);
                if (out) *(u32x2*)(out + (size_t)r1 * 1024 + (lane + 64 * i) * 4) = z;
                if (out8) *(unsigned*)(out8 + (size_t)r1 * 1024 + (lane + 64 * i) * 4) = pack_fp8x4(vb[i].x * rb * gg[i].x, vb[i].y * rb * gg[i].y, vb[i].z * rb * gg[i].z, vb[i].w * rb * gg[i].w); }
        }
    }
}
__device__ __forceinline__ void tr_tile(LAS float* tl, const float* src, int ldsrc, int nvalid, const float* ks, float tsc, bf16_t* dst, unsigned char* dst8, int ldd, int lane) {
    const int r = lane >> 4, c4 = (lane & 15) * 4;
    float4 v[16];
#pragma unroll
    for (int p = 0; p < 16; ++p) { const int k = r + 4 * p; v[p] = make_float4(0.f, 0.f, 0.f, 0.f); if (c4 < nvalid) { const f32x4 tv = __builtin_nontemporal_load((const f32x4*)(src + (size_t)k * ldsrc + c4)); v[p] = make_float4(tv[0], tv[1], tv[2], tv[3]); } }
#pragma unroll
    for (int p = 0; p < 16; ++p) { const int k = r + 4 * p; float4 w = v[p];
        { const float sc = ks ? ks[k] * tsc : tsc; w.x *= sc; w.y *= sc; w.z *= sc; w.w *= sc; }
        tl[k * 65 + c4] = w.x; tl[k * 65 + c4 + 1] = w.y; tl[k * 65 + c4 + 2] = w.z; tl[k * 65 + c4 + 3] = w.w; }
    const int kq = lane & 7;
#pragma unroll
    for (int p = 0; p < 8; ++p) { const int n = (lane >> 3) + 8 * p; float f[8];
#pragma unroll
        for (int j = 0; j < 8; ++j) f[j] = tl[(kq * 8 + j) * 65 + n];
        if (dst8) { u32x2 w8; w8.x = pack_fp8x4(f[0], f[1], f[2], f[3]); w8.y = pack_fp8x4(f[4], f[5], f[6], f[7]); *(u32x2*)(dst8 + (size_t)n * ldd + kq * 8) = w8; }
        else { u32x4 w; w.x = cvt_pk_bf16(f[0], f[1]); w.y = cvt_pk_bf16(f[2], f[3]); w.z = cvt_pk_bf16(f[4], f[5]); w.w = cvt_pk_bf16(f[6], f[7]);
            *(u32x4*)(dst + (size_t)n * ldd + kq * 8) = w; } }
}
struct cf { float re, im; };
__device__ __forceinline__ cf cmul(cf a, cf b) { return cf{a.re * b.re - a.im * b.im, a.re * b.im + a.im * b.re}; }
__device__ __forceinline__ cf lam_pow(const Args& a, int g, int p, float e) {
    const float lre = INP(I_LRE)[g * 64 + p], lim = INP(I_LIM)[g * 64 + p], dt = __expf(INP(I_LDT)[g]);
    const float mag = __expf(lre * dt * e);
    const double rev = (double)lim * (double)dt * (double)e * 0.15915494309189535; const float fr = (float)(rev - rint(rev));
    return cf{mag * __builtin_amdgcn_cosf(fr), mag * __builtin_amdgcn_sinf(fr)};
}
__device__ __forceinline__ cf bbar_of(const Args& a, int g, int p, int h) {
    const float lre = INP(I_LRE)[g * 64 + p], lim = INP(I_LIM)[g * 64 + p];
    const cf lb = lam_pow(a, g, p, 1.0f); const cf num = cf{lb.re - 1.0f, lb.im};
    const float inv = 1.0f / (lre * lre + lim * lim);
    const cf q = cf{(num.re * lre + num.im * lim) * inv, (num.im * lre - num.re * lim) * inv};
    return cmul(q, cf{INP(I_BRE)[(g * 64 + p) * 16 + h], INP(I_BIM)[(g * 64 + p) * 16 + h]});
}
__device__ __forceinline__ void p0_prep(const Frame& F, const Args& a) {
    const int gw = F.c * 8 + F.wave, nw = F.G * 8;
    rms_rows_bf16(INP(I_X), INP(I_GMIX), WSP(bf16_t, WS_HB), WSP(unsigned char, WS_HB8), T, gw, nw, F.lane);
    rms_rows_bf16(INP(I_MEM), INP(I_GMEM), nullptr, WSP(unsigned char, WS_MEMN), 8192, gw, nw, F.lane);
    LAS float* tl = (LAS float*)F.lds + F.wave * (64 * 65);
    constexpr int NT_WIN = 80 * 16, NT_WMEM = 256, NT_WGLU = 64, NT_WUP = 384, NT_WOUT = 256, NT_E = 4096;
    constexpr int O1 = NT_WIN, O2 = O1 + NT_WMEM, O3 = O2 + NT_WGLU, O4 = O3 + NT_WUP, O5 = O4 + NT_WOUT, O6 = O5 + NT_E, O7 = O6 + NT_E, O8 = O7 + NT_E;
    for (int ti = gw; ti < O8; ti += nw) {
        const float* src; int ldsrc, nvalid = 64, ldd; const float* ks = nullptr; bf16_t* dst = nullptr; unsigned char* dst8 = nullptr; float tsc = 1.0f;
        if (ti < O1) { const int nt = ti / 16, kt = ti % 16, n0 = nt * 64; int sc;
            if (n0 < 1152) sc = n0;
            else if (n0 == 1152) sc = 1408;
            else if (n0 == 1216) { sc = 1472; nvalid = 4; }
            else if (n0 < 1280) { sc = 0; nvalid = 0; }
            else if (n0 < 1536) sc = 1152 + (n0 - 1280);
            else if (n0 < 2048) sc = 1476 + (n0 - 1536);
            else { sc = 1988 + (n0 - 2048); tsc = -1.4426950408889634f; }
            src = INP(I_WIN) + (size_t)kt * 64 * 5060 + sc; ldsrc = 5060; ldd = 1024;
            if (n0 >= 1024 && n0 < 1536) dst = WSP(bf16_t, WS_WIN) + (size_t)(n0 - 1024) * 1024 + kt * 64;
            else { const int r8 = n0 < 1024 ? n0 : (n0 < 2048 ? n0 - 512 : n0 - 512); dst8 = WSP(unsigned char, WS_WG8) + (size_t)r8 * 1024 + kt * 64; tsc *= 32.0f; } }
        else if (ti < O2) { const int t = ti - O1, nt = t / 16, kt = t % 16; src = INP(I_WMEMKV) + (size_t)kt * 64 * 1024 + nt * 64; ldsrc = 1024; tsc = 32.0f; dst8 = WSP(unsigned char, WS_WMEM) + (size_t)nt * 64 * 1024 + kt * 64; ldd = 1024; }
        else if (ti < O3) { const int t = ti - O2, nt = t / 8, kt = t % 8; src = INP(I_WGLU) + (size_t)kt * 64 * 512 + nt * 64; ldsrc = 512; dst = WSP(bf16_t, WS_WGLU) + (size_t)nt * 64 * 512 + kt * 64; ldd = 512; }
        else if (ti < O4) { const int t = ti - O3, br = t / 128, tt = t % 128, nt = tt / 8, kt = tt % 8; const float* w = br == 0 ? INP(I_WUPS) : (br == 1 ? INP(I_WUPD) : INP(I_WUPM));
            src = w + (size_t)kt * 64 * 1024 + nt * 64; ldsrc = 1024; tsc = 32.0f; dst8 = WSP(unsigned char, WS_WUP) + (size_t)nt * 64 * 1536 + br * 512 + kt * 64; ldd = 1536; }
        else if (ti < O5) { const int t = ti - O4, nt = t / 16, kt = t % 16; src = INP(I_WOUT) + (size_t)kt * 64 * 1024 + nt * 64; ldsrc = 1024; tsc = 32.0f; dst8 = WSP(unsigned char, WS_WOUT) + (size_t)nt * 64 * 1024 + kt * 64; ldd = 1024; }
        else if (ti < O7) { const int up = ti >= O6, t = ti - (up ? O6 : O5), e = t / 128, tt = t % 128, nt = tt / 16, kt = tt % 16, j0 = nt * 64;
            src = (up ? INP(I_WUP) : INP(I_WGATE)) + (size_t)e * 1024 * 512 + (size_t)kt * 64 * 512 + j0; ldsrc = 512; ks = INP(I_GFFN) + kt * 64; tsc = 32.0f;
            dst8 = WSP(unsigned char, WS_WGU) + (size_t)e * 1024 * 1024 + (size_t)((j0 >> 7) * 256 + up * 128 + (j0 & 127)) * 1024 + kt * 64; ldd = 1024; }
        else { const int t = ti - O7, e = t / 128, tt = t % 128, nt = tt / 8, kt = tt % 8;
            src = INP(I_WDOWN) + (size_t)e * 512 * 1024 + (size_t)kt * 64 * 1024 + nt * 64; ldsrc = 1024; tsc = 32.0f;
            dst8 = WSP(unsigned char, WS_WD) + (size_t)e * 1024 * 512 + (size_t)nt * 64 * 512 + kt * 64; ldd = 512; }
        tr_tile(tl, src, ldsrc, nvalid, ks, tsc, dst, dst8, ldd, F.lane);
    }
    const int gt = F.c * NTHR + F.tid, NTT = F.G * NTHR;
    for (int id = gt; id < 2048 * 33; id += NTT) { const int gp = id / 33, e = id - gp * 33; const cf z = lam_pow(a, gp >> 6, gp & 63, (float)e); WSP(float2, WS_LP)[id] = make_float2(z.re, z.im);
        if (e == 32) { WSP(float, WS_LAM32)[gp * 2] = z.re; WSP(float, WS_LAM32)[gp * 2 + 1] = z.im; } }
    for (int id = gt; id < 2048 * 16; id += NTT) { const int gp = id >> 4, h = id & 15; const cf z = bbar_of(a, gp >> 6, gp & 63, h); WSP(float2, WS_BB)[id] = make_float2(z.re, z.im); }
    for (int id = gt; id < 48 * 1024; id += NTT) { const int n = id >> 10, k = id & 1023;
        const float v = n < 4 ? INP(I_WGROUP)[k * 4 + n] : (n < 36 ? INP(I_WEXP)[k * 32 + (n - 4)] : 0.f);
        WSP(bf16_t, WS_WR)[id] = f2bf(v * INP(I_GFFN)[k]); }
}

__device__ __forceinline__ void p1_tables(const Frame& F, const Args& a, int wgi, int wgn) {
    const int gt = wgi * NTHR + F.tid, NTT = wgn * NTHR;
    bf16_t* TW = WSP(bf16_t, WS_TW); bf16_t* SIN = WSP(bf16_t, WS_SIN); const float2* LP = WSP(float2, WS_LP); const float2* BB = WSP(float2, WS_BB);
    for (int id = gt; id < 32 * 32 * 256; id += NTT) {
        const int hi = id & 15, ho = (id >> 4) & 15, d = (id >> 8) & 31, g = id >> 13;
        float val = 0.f;
        for (int p = 0; p < 64; ++p) { const float2 ez = LP[(g * 64 + p) * 33 + d], bb = BB[(g * 64 + p) * 16 + hi];
            const float cr = INP(I_CRE)[(g * 16 + ho) * 64 + p], ci = INP(I_CIM)[(g * 16 + ho) * 64 + p];
            const float tr = cr * ez.x - ci * ez.y, ti = cr * ez.y + ci * ez.x; val += tr * bb.x - ti * bb.y; }
        if (d == 0 && ho == hi) val += INP(I_DSKIP)[g * 16 + ho];
        const bf16_t bv = f2bf(val); bf16_t* tg = TW + (size_t)g * 512 * 640;
        for (int i = d; i < 32; ++i) { tg[(size_t)(i * 16 + ho) * 640 + (i - d) * 16 + hi] = bv; if (d > 0) tg[(size_t)((i - d) * 16 + ho) * 640 + i * 16 + hi] = 0; }
    }
    for (int id = gt; id < 32 * 32 * 16 * 64; id += NTT) {
        const int p = id & 63, ho = (id >> 6) & 15, i = (id >> 10) & 31, g = id >> 15;
        const float2 ez = LP[(g * 64 + p) * 33 + i + 1]; const float cr = INP(I_CRE)[(g * 16 + ho) * 64 + p], ci = INP(I_CIM)[(g * 16 + ho) * 64 + p];
        bf16_t* row = TW + (size_t)g * 512 * 640 + (size_t)(i * 16 + ho) * 640 + 512; row[p] = f2bf(cr * ez.x - ci * ez.y); row[64 + p] = f2bf(-(cr * ez.y + ci * ez.x));
    }
    for (int id = gt; id < 32 * 64 * 32 * 16; id += NTT) {
        const int h = id & 15, j = (id >> 4) & 31, p = (id >> 9) & 63, g = id >> 15;
        const float2 ez = LP[(g * 64 + p) * 33 + 31 - j], bb = BB[(g * 64 + p) * 16 + h];
        bf16_t* sg = SIN + (size_t)g * 256 * 512; sg[(size_t)p * 512 + j * 16 + h] = f2bf(ez.x * bb.x - ez.y * bb.y); sg[(size_t)(64 + p) * 512 + j * 16 + h] = f2bf(ez.x * bb.y + ez.y * bb.x);
    }
    for (int id = gt; id < 32 * 128 * 64; id += NTT) {
        const int q = id & 63, r = (id >> 6) & 127, g = id >> 13;
        *(u32x4*)(SIN + (size_t)g * 256 * 512 + (size_t)(128 + r) * 512 + q * 8) = (u32x4){0u, 0u, 0u, 0u};
    }
}

__device__ __forceinline__ void p2_post(const Frame& F, const Args& a, bool dry) {
    const int gw = F.c * 8 + F.wave, nw = F.G * 8, lane = F.lane, j = lane & 3, hs = lane >> 5, lr = lane & 31;
    const bf16_t* KVX = WSP(bf16_t, WS_KVX); unsigned char* KVP8 = WSP(unsigned char, WS_KVP); bf16_t* KIP = WSP(bf16_t, WS_KIP); bf16_t* QI = WSP(bf16_t, WS_QI);
    const bool rqi = lr < 16, rk = lr >= 16 && lr < 20, rki = lr >= 20 && lr < 24;
    const float scl = rqi ? 0.125f : 1.0f;
    float g1[8], g2[8];
#pragma unroll
    for (int e = 0; e < 8; ++e) { g1[e] = rk ? INP(I_GK)[8 * j + e] : 1.0f; g2[e] = rk ? INP(I_GK)[32 + 8 * j + e] : 1.0f; }
    constexpr int TB = 4;
    typedef float f32x2e __attribute__((ext_vector_type(2)));
    LAS f32x2e* cst = (LAS f32x2e*)F.lds + F.wave * (TB * 64);
    const float invf1 = __expf(-(float)lr * (9.210340371976184f / 32.0f));
    u32x4 nlo[TB], nhi[TB]; int npos[TB]; unsigned short nwraw[TB];
#define POST_LOAD(TBASE) do { _Pragma("unroll") for (int u = 0; u < TB; ++u) { \
            const int tt = (TBASE) + (u * 2 + hs) * nw, t = tt < T ? tt : T - 1; \
            const bf16_t* src; \
            if (rqi) src = QI + (size_t)t * 256 + (lr >> 2) * 64; \
            else if (rk) src = KVX + (size_t)t * 256; \
            else if (rki) src = KVX + (size_t)t * 256 + 128; \
            else src = KVX + (size_t)t * 256 + 64 + (lr - 24) * 8 - 8 * j;         \
            nlo[u] = *(const u32x4*)(src + 8 * j); nhi[u] = (lr < 24) ? *(const u32x4*)(src + 32 + 8 * j) : nlo[u]; \
            npos[u] = ((const int*)a.in[I_POS])[t]; \
            nwraw[u] = KVX[(size_t)t * 256 + 192 + (lane & 3)]; } } while (0)
    if (gw < T) POST_LOAD(gw);
#pragma unroll 1
    for (int tb = gw; tb < T; tb += nw * TB * 2) {
        u32x4 lo[TB], hi[TB]; float posf[TB]; unsigned short wraw[TB];
#pragma unroll
        for (int u = 0; u < TB; ++u) { lo[u] = nlo[u]; hi[u] = nhi[u]; posf[u] = (float)npos[u]; wraw[u] = nwraw[u]; }
        if (tb + nw * TB * 2 < T) POST_LOAD(tb + nw * TB * 2);
#pragma unroll
        for (int u = 0; u < TB; ++u) {
            const int tt = tb + (u * 2 + hs) * nw, t = tt < T ? tt : T - 1;
            { const float ang = posf[u] * invf1; const double rev = (double)ang * 0.15915494309189535; const float fr = (float)(rev - rint(rev));
              const f32x2e cs2 = (f32x2e){__builtin_amdgcn_cosf(fr), __builtin_amdgcn_sinf(fr)}; cst[(u * 2 + hs) * 32 + lr] = cs2;
              if (tt < T) WSP(f32x2e, WS_CS)[(size_t)t * 32 + lr] = cs2; }
        }
#pragma unroll
        for (int u = 0; u < TB; ++u) {
            const int t = tb + (u * 2 + hs) * nw;
            const bool live = t < T;
            if (lr < 24) {
                bf16_t* dst;
                if (rqi) dst = dry ? WSP(bf16_t, WS_RW) + (size_t)(live ? t : 0) * 256 + (lr >> 2) * 64 : QI + (size_t)(live ? t : 0) * 256 + (lr >> 2) * 64;
                else if (rk) dst = nullptr;
                else dst = KIP + (size_t)(live ? t : 0) * 64;
                f32x4 a0, a1, b0, b1; unpack8(lo[u], a0, a1); unpack8(hi[u], b0, b1);
                float x1[8] = {a0[0], a0[1], a0[2], a0[3], a1[0], a1[1], a1[2], a1[3]}, x2[8] = {b0[0], b0[1], b0[2], b0[3], b1[0], b1[1], b1[2], b1[3]};
                float ss = 0.f;
#pragma unroll
                for (int e = 0; e < 8; ++e) ss += x1[e] * x1[e] + x2[e] * x2[e];
                ss += __shfl_xor(ss, 1); ss += __shfl_xor(ss, 2);
                const float rs = rk ? rsqrtf(ss * (1.0f / 64.0f) + 1e-6f) : 1.0f;
                float o1[8], o2[8];
#pragma unroll
                for (int e = 0; e < 8; ++e) {
                    const f32x2e csn = cst[(u * 2 + hs) * 32 + 8 * j + e]; const float cs = csn.x, sn = csn.y;
                    const float y1 = x1[e] * rs * g1[e], y2 = x2[e] * rs * g2[e];
                    o1[e] = (y1 * cs - y2 * sn) * scl; o2[e] = (y2 * cs + y1 * sn) * scl; }
                if (live) {
                    if (rk) {
                        u32x2 w0, w1; w0.x = pack_fp8x4(o1[0], o1[1], o1[2], o1[3]); w0.y = pack_fp8x4(o1[4], o1[5], o1[6], o1[7]); w1.x = pack_fp8x4(o2[0], o2[1], o2[2], o2[3]); w1.y = pack_fp8x4(o2[4], o2[5], o2[6], o2[7]);
                        *(u32x2*)(KVP8 + (size_t)t * 128 + 8 * j) = w0; *(u32x2*)(KVP8 + (size_t)t * 128 + 32 + 8 * j) = w1;
                    } else {
                        *(u32x4*)(dst + 8 * j) = pack8((f32x4){o1[0], o1[1], o1[2], o1[3]}, (f32x4){o1[4], o1[5], o1[6], o1[7]});
                        *(u32x4*)(dst + 32 + 8 * j) = pack8((f32x4){o2[0], o2[1], o2[2], o2[3]}, (f32x4){o2[4], o2[5], o2[6], o2[7]}); } }
            } else if (live) {
                f32x4 a0, a1; unpack8(lo[u], a0, a1); u32x2 w; w.x = pack_fp8x4(a0[0], a0[1], a0[2], a0[3]); w.y = pack_fp8x4(a1[0], a1[1], a1[2], a1[3]);
                *(u32x2*)(KVP8 + (size_t)t * 128 + 64 + (lr - 24) * 8) = w;
            }
            if (lr < 4 && live) WSP(float, WS_WIF)[t * 4 + lr] = bf2f(wraw[u]) * 0.5f;
        }
    }
#undef POST_LOAD
    const bf16_t* KMVM = WSP(bf16_t, WS_KMVM); bf16_t* KM = WSP(bf16_t, WS_KM); bf16_t* VMT = WSP(bf16_t, WS_VMT);
    { float gk8[8];
#pragma unroll
        for (int e = 0; e < 8; ++e) gk8[e] = INP(I_GKM)[(lane & 15) * 8 + e] * INP(I_GQM)[(lane & 15) * 8 + e];
        for (int r = gw; r < 8192; r += nw) {
            const int h = lane >> 4, b = r >> 8, m = r & 255;
            f32x4 a0, a1; unpack8(*(const u32x4*)(KMVM + (size_t)r * 1024 + h * 128 + (lane & 15) * 8), a0, a1);
            float ss = a0[0] * a0[0] + a0[1] * a0[1] + a0[2] * a0[2] + a0[3] * a0[3] + a1[0] * a1[0] + a1[1] * a1[1] + a1[2] * a1[2] + a1[3] * a1[3];
            ss += __shfl_xor(ss, 1); ss += __shfl_xor(ss, 2); ss += __shfl_xor(ss, 4); ss += __shfl_xor(ss, 8);
            const float rs = rsqrtf(ss * (1.0f / 128.0f) + 1e-6f);
            *(u32x4*)(KM + ((size_t)(b * 4 + h) * 256 + m) * 128 + (lane & 15) * 8) = pack8((f32x4){a0[0] * rs * gk8[0], a0[1] * rs * gk8[1], a0[2] * rs * gk8[2], a0[3] * rs * gk8[3]}, (f32x4){a1[0] * rs * gk8[4], a1[1] * rs * gk8[5], a1[2] * rs * gk8[6], a1[3] * rs * gk8[7]}); } }
    const int gt = F.c * NTHR + F.tid, NTT = F.G * NTHR;
    for (int id = gt; id < 32 * 4 * 32 * 128; id += NTT) { const int d = id & 127, pg = (id >> 7) & 31, h = (id >> 12) & 3, b = id >> 14;
        unsigned short v[8];
#pragma unroll
        for (int j = 0; j < 8; ++j) { const int pp = pg * 8 + j, q = pp & 15, key = (pp & ~15) + 8 * ((q & 7) >> 2) + 4 * (q >> 3) + (q & 3);
            v[j] = KMVM[(size_t)(b * 256 + key) * 1024 + 512 + h * 128 + d]; }
        u32x4 w; w.x = v[0] | ((unsigned)v[1] << 16); w.y = v[2] | ((unsigned)v[3] << 16); w.z = v[4] | ((unsigned)v[5] << 16); w.w = v[6] | ((unsigned)v[7] << 16);
        *(u32x4*)(VMT + ((size_t)(b * 4 + h) * 128 + d) * 256 + pg * 8) = w; }
}

__device__ __forceinline__ void p3_scan(const Frame& F) {
    const int gt = F.c * NTHR + F.tid, NTT = F.G * NTHR;
    const float* SC = WSP(float, WS_SC); bf16_t* UA = WSP(bf16_t, WS_UA);
    for (int id = gt; id < 65536; id += NTT) { const int p = id & 63, b = (id >> 6) & 31, g = id >> 11;
        const float lr = WSP(float, WS_LAM32)[(g * 64 + p) * 2], li = WSP(float, WS_LAM32)[(g * 64 + p) * 2 + 1];
        float sr = 0.f, si = 0.f;
        for (int c = 0; c < 64; ++c) { const size_t row = (size_t)g * 2048 + b * 64 + c;
            UA[row * 640 + 512 + p] = f2bf(sr); UA[row * 640 + 576 + p] = f2bf(si);
            const float cr = SC[row * 128 + p], ci = SC[row * 128 + 64 + p];
            const float nr = lr * sr - li * si + cr, ni = lr * si + li * sr + ci; sr = nr; si = ni; }
    }
}

constexpr int SEL_SC = 0, SEL_HIST = 131072, SEL_END = SEL_HIST + 128 * 17 * 4;
__device__ __forceinline__ int suffix_sum64(int x, int rm1, int rm2, int rm3, int& tot) {
    int p = x;
    p += __builtin_amdgcn_update_dpp(0, p, 0x111, 0xf, 0xf, false);
    p += __builtin_amdgcn_update_dpp(0, p, 0x112, 0xf, 0xf, false);
    p += __builtin_amdgcn_update_dpp(0, p, 0x114, 0xf, 0xf, false);
    p += __builtin_amdgcn_update_dpp(0, p, 0x118, 0xf, 0xf, false);
    const int t0 = __builtin_amdgcn_readlane(p, 15), t1 = __builtin_amdgcn_readlane(p, 31), t2 = __builtin_amdgcn_readlane(p, 47), t3 = __builtin_amdgcn_readlane(p, 63);
    p += (t0 & rm1) + (t1 & rm2) + (t2 & rm3);
    tot = t0 + t1 + t2 + t3;
    return tot - p + x;
}
__device__ __forceinline__ int mbcnt64(unsigned long long m) { return (int)__builtin_amdgcn_mbcnt_hi((unsigned)(m >> 32), __builtin_amdgcn_mbcnt_lo((unsigned)m, 0u)); }
__device__ __forceinline__ void p3_select(const Frame& F, bool doB) {
    LAS unsigned short* sc = (LAS unsigned short*)(F.lds + SEL_SC);
    LAS unsigned* hist = (LAS unsigned*)(F.lds + SEL_HIST);
    const bf16_t* QI = WSP(bf16_t, WS_QI); const bf16_t* KIP = WSP(bf16_t, WS_KIP); const float* WIF = WSP(float, WS_WIF);
    unsigned short* IDX = WSP(unsigned short, WS_IDX);
    const int lane = F.lane, n = lane & 31, hf = lane >> 5, wv = F.wave;
    const int rm1 = (lane >> 4) >= 1 ? -1 : 0, rm2 = (lane >> 4) >= 2 ? -1 : 0, rm3 = (lane >> 4) >= 3 ? -1 : 0;
#define SEL_UNIT(L_, QT, B_) int QT = 63 - ((L_) >> 5); const int B_ = (L_) & 31; \
        if (F.G == 256) { const int k_ = F.c >> 5, i_ = (L_) >> 8, pr_ = i_ >> 1;     \
            QT = (i_ & 1) ? (48 - 16 * pr_ + k_) : (63 - 16 * pr_ - k_); }
#define SEL_LOADQK(QT, B_) do { const int tk_ = (B_) * 2048 + (QT) * 32 + n; \
        _Pragma("unroll") for (int h = 0; h < 4; ++h) { wq[h] = WIF[tk_ * 4 + h]; \
            _Pragma("unroll") for (int ks = 0; ks < 4; ++ks) bq[h][ks] = *(const bf16x8*)(QI + (size_t)tk_ * 256 + h * 64 + ks * 16 + hf * 8); } \
        { const int k0 = wv < (QT) + 1 ? wv : 0; const bf16_t* kp = KIP + (size_t)((B_) * 2048 + k0 * 32 + n) * 64 + hf * 8; \
            _Pragma("unroll") for (int ks = 0; ks < 4; ++ks) ka[ks] = *(const bf16x8*)(kp + ks * 16); } } while (0)
    bf16x8 bq[4][4]; float wq[4]; bf16x8 ka[4];
    if (F.c < 2048) { SEL_UNIT(F.c, qt0, b0); SEL_LOADQK(qt0, b0); }
    for (int L = F.c; L < 2048; L += F.G) {
        SEL_UNIT(L, qt, b);
        const int t0 = qt * 32, nkt = qt + 1, tok0 = b * 2048 + t0;
        for (int i = F.tid; i < 128 * 17; i += NTHR) hist[i] = 0u;
        { const int nz = ((nkt * 8 + 63) & ~63) - nkt * 8;
            for (int i = F.tid; i < nz * 32; i += NTHR) { const int nn = i & 31, ch = nkt * 8 + (i >> 5); *(LAS u32x2*)(sc + nn * 2048 + ((ch ^ nn) << 2)) = (u32x2){0u, 0u}; } }
        __syncthreads();
        const unsigned hinc = 1u << (16 * (n & 1));
        for (int kt = wv; kt < nkt; kt += 8) {
            f32x16 acc[4];
#pragma unroll
            for (int h = 0; h < 4; ++h)
#pragma unroll
                for (int r = 0; r < 16; ++r) acc[h][r] = 0.f;
#pragma unroll
            for (int ks = 0; ks < 4; ++ks)
#pragma unroll
                for (int h = 0; h < 4; ++h) acc[h] = __builtin_amdgcn_mfma_f32_32x32x16_bf16(ka[ks], bq[h][ks], acc[h], 0, 0, 0);
            { const int k1 = kt + 8 < nkt ? kt + 8 : kt; const bf16_t* kp = KIP + (size_t)(b * 2048 + k1 * 32 + n) * 64 + hf * 8;
#pragma unroll
                for (int ks = 0; ks < 4; ++ks) ka[ks] = *(const bf16x8*)(kp + ks * 16); }
            unsigned key[16];
#pragma unroll
            for (int r = 0; r < 16; ++r) {
                const int i0 = __float_as_int(acc[0][r]), i1 = __float_as_int(acc[1][r]), i2 = __float_as_int(acc[2][r]), i3 = __float_as_int(acc[3][r]);
                const float isc = wq[0] * __int_as_float(i0 > 0 ? i0 : 0) + wq[1] * __int_as_float(i1 > 0 ? i1 : 0) + wq[2] * __int_as_float(i2 > 0 ? i2 : 0) + wq[3] * __int_as_float(i3 > 0 ? i3 : 0);
                const float y = isc * __builtin_amdgcn_rcpf(1.0f + 0.25f * fabsf(isc));
                key[r] = (unsigned)(y * 8191.75f + 32768.0f);
            }
            if (kt < qt) {
#pragma unroll
                for (int g4 = 0; g4 < 4; ++g4) {
#pragma unroll
                    for (int j = 0; j < 4; ++j) (void)__hip_atomic_fetch_add(hist + (key[g4 * 4 + j] >> 9) * 17 + (n >> 1), hinc, __ATOMIC_RELAXED, __HIP_MEMORY_SCOPE_WORKGROUP);
                    u32x2 w; w.x = key[g4 * 4] | (key[g4 * 4 + 1] << 16); w.y = key[g4 * 4 + 2] | (key[g4 * 4 + 3] << 16);
                    const int chunk = (kt * 32 + 8 * g4 + 4 * hf) >> 2;
                    *(LAS u32x2*)(sc + n * 2048 + ((chunk ^ n) << 2)) = w;
                }
            } else {
                asm volatile("" ::: "memory");
#pragma unroll
                for (int g4 = 0; g4 < 4; ++g4) {
                    unsigned kk[4];
#pragma unroll
                    for (int j = 0; j < 4; ++j) { const int s = kt * 32 + j + 8 * g4 + 4 * hf; const bool valid = s <= t0 + n;
                        kk[j] = valid ? key[g4 * 4 + j] : 0u;
                        (void)__hip_atomic_fetch_add(hist + (kk[j] >> 9) * 17 + (n >> 1), valid ? hinc : 0u, __ATOMIC_RELAXED, __HIP_MEMORY_SCOPE_WORKGROUP); }
                    u32x2 w; w.x = kk[0] | (kk[1] << 16); w.y = kk[2] | (kk[3] << 16);
                    const int chunk = (kt * 32 + 8 * g4 + 4 * hf) >> 2;
                    *(LAS u32x2*)(sc + n * 2048 + ((chunk ^ n) << 2)) = w;
                }
            }
        }
        __syncthreads();
        if (L + F.G < 2048) { SEL_UNIT(L + F.G, qtn, bn); SEL_LOADQK(qtn, bn); }
        for (int qq = 0; qq < (doB ? 4 : 0); ++qq) {
            const int nq = wv * 4 + qq, tq = t0 + nq, nvalid = tq + 1, tok = tok0 + nq;
            LAS unsigned short* lst = sc + nq * 2048; LAS unsigned* cand = (LAS unsigned*)(sc + nq * 2048 + 512);
            if (nvalid <= 256) {
#pragma unroll
                for (int e = 0; e < 4; ++e) { const int p = lane * 4 + e; lst[p] = (unsigned short)(p < nvalid ? p : 0); }
            } else {
                unsigned v[32];
                LAS const unsigned short* rowp = sc + nq * 2048 + ((((lane >> 2) ^ (nq & 15)) << 2) | (lane & 3));
#pragma unroll
                for (int r = 0; r < 32; ++r) v[r] = rowp[r * 64];
                const int sh = 16 * (nq & 1);
                const int hhi = (int)((hist[(64 + lane) * 17 + (nq >> 1)] >> sh) & 0xffffu), hlo = (int)((hist[lane * 17 + (nq >> 1)] >> sh) & 0xffffu);
                int tothi; const int shi = suffix_sum64(hhi, rm1, rm2, rm3, tothi);
                int b1, above;
                if (tothi >= 256) { const unsigned long long mk = __builtin_amdgcn_ballot_w64(shi >= 256); const int lb = 63 - __clzll(mk); b1 = 64 + lb; above = __builtin_amdgcn_readlane(shi - hhi, lb); }
                else { int totlo; const int slo = tothi + suffix_sum64(hlo, rm1, rm2, rm3, totlo); const unsigned long long mk = __builtin_amdgcn_ballot_w64(slo >= 256); const int lb = 63 - __clzll(mk); b1 = lb; above = __builtin_amdgcn_readlane(slo - hlo, lb); }
                const int sw64 = (nq >> 4) << 6, laneE = lane + sw64, laneO = lane - sw64;
                int base = 0, m = 0;
                const unsigned binhi = (unsigned)b1 * 512u + 511u, binlo = b1 ? (unsigned)b1 * 512u : 1u, binspan = binhi - binlo;
#pragma unroll
                for (int r4 = 0; r4 < 32; r4 += 4) {
                    if (r4 * 64 >= nvalid) break;
#pragma unroll
                    for (int rr = 0; rr < 4; ++rr) { const int r = r4 + rr; const unsigned idx = (unsigned)(r * 64 + ((r & 1) ? laneO : laneE));
                        const bool gt_ = v[r] > binhi, eq = (v[r] - binlo) <= binspan;
                        const unsigned long long mg = __builtin_amdgcn_ballot_w64(gt_), me = __builtin_amdgcn_ballot_w64(eq);
                        int pg = base + mbcnt64(mg), cp = m + mbcnt64(me);
                        asm("" : "+v"(pg), "+v"(cp));
                        lst[gt_ ? pg : 256 + lane] = (unsigned short)idx;
                        cand[(eq && cp < 128) ? cp : 128 + lane] = ((v[r] & 511u) << 11) | idx;
                        base += __popcll(mg); m += __popcll(me); }
                }
                if (m <= 128) {
                    const int need = 256 - above;
                    const unsigned c0 = lane < m ? cand[lane] : 0u, c1 = 64 + lane < m ? cand[64 + lane] : 0u;
                    const unsigned a0 = lane < m ? (c0 >> 11) + 1u : 0u, a1 = 64 + lane < m ? (c1 >> 11) + 1u : 0u;
                    unsigned lo = 0u;
                    for (int bit = 9; bit >= 0; --bit) { const unsigned cd = lo | (1u << bit); const int c = __popcll(__builtin_amdgcn_ballot_w64(a0 >= cd)) + __popcll(__builtin_amdgcn_ballot_w64(a1 >= cd)); if (c >= need) lo = cd; }
                    const unsigned long long g0 = __builtin_amdgcn_ballot_w64(a0 > lo), g1 = __builtin_amdgcn_ballot_w64(a1 > lo), e0 = __builtin_amdgcn_ballot_w64(a0 == lo), e1 = __builtin_amdgcn_ballot_w64(a1 == lo);
                    const int ties = need - (__popcll(g0) + __popcll(g1));
                    int k0 = mbcnt64(e0), k1 = __popcll(e0) + mbcnt64(e1); asm("" : "+v"(k0), "+v"(k1));
                    const bool s0 = a0 > lo || (a0 == lo && k0 < ties), s1 = a1 > lo || (a1 == lo && k1 < ties);
                    const unsigned long long m0 = __builtin_amdgcn_ballot_w64(s0), m1 = __builtin_amdgcn_ballot_w64(s1);
                    if (s0) lst[base + mbcnt64(m0)] = (unsigned short)(c0 & 2047u);
                    if (s1) lst[base + __popcll(m0) + mbcnt64(m1)] = (unsigned short)(c1 & 2047u);
                } else {
#pragma unroll
                    for (int r = 0; r < 32; ++r) v[r] = ((r * 64 + ((r & 1) ? laneO : laneE)) < nvalid) ? v[r] : 0u;
                    unsigned lo = 0u;
                    for (int bit = 15; bit >= 0; --bit) { const unsigned cd = lo | (1u << bit); int cnt = 0;
#pragma unroll
                        for (int r = 0; r < 32; ++r) cnt += __popcll(__builtin_amdgcn_ballot_w64(v[r] >= cd));
                        if (cnt >= 256) lo = cd; }
                    int cgt = 0;
#pragma unroll
                    for (int r = 0; r < 32; ++r) cgt += __popcll(__builtin_amdgcn_ballot_w64(v[r] > lo));
                    const int need = 256 - cgt; int bs = 0, eqb = 0;
#pragma unroll
                    for (int r = 0; r < 32; ++r) {
                        const bool gt_ = v[r] > lo, eq = v[r] == lo;
                        const unsigned long long me = __builtin_amdgcn_ballot_w64(eq);
                        const bool sel = gt_ || (eq && eqb + mbcnt64(me) < need);
                        const unsigned long long ms = __builtin_amdgcn_ballot_w64(sel);
                        if (sel) lst[bs + mbcnt64(ms)] = (unsigned short)(r * 64 + ((r & 1) ? laneO : laneE));
                        bs += __popcll(ms); eqb += __popcll(me);
                    }
                }
            }
            *(u32x2*)(IDX + (size_t)tok * 256 + lane * 4) = *(LAS u32x2*)(lst + lane * 4);
        }
        __syncthreads();
    }
}

#undef SEL_UNIT
#undef SEL_LOADQK
__device__ __forceinline__ void p3_memattn(const Frame& F) {
    constexpr int KS = 272, VS = 528, VOFF = 256 * KS;
    const bf16_t* KM = WSP(bf16_t, WS_KM); const bf16_t* VMT = WSP(bf16_t, WS_VMT); const bf16_t* QM = DOP(bf16_t, DO_Y3) + 512; unsigned char* YM8 = DOP(unsigned char, DO_YM8);
    const int lane = F.lane, n = lane & 31, hf = lane >> 5;
    for (int u = F.c; u < 256; u += F.G) {
        const int half = u & 1, bh = u >> 1, b = bh >> 2, h = bh & 3;
#pragma unroll
        for (int i = 0; i < 8; ++i) { const int id = F.tid + 512 * i;
            { const int row = id >> 4, seg = id & 15; *(LAS u32x4*)(F.lds + row * KS + seg * 16) = *(const u32x4*)(KM + ((size_t)bh * 256 + row) * 128 + seg * 8); }
            { const int row = id >> 5, seg = id & 31; *(LAS u32x4*)(F.lds + VOFF + row * VS + seg * 16) = *(const u32x4*)(VMT + ((size_t)bh * 128 + row) * 256 + seg * 8); } }
        __syncthreads();
#pragma unroll 1
        for (int qi = 0; qi < 4; ++qi) {
            const int tok = b * 2048 + half * 1024 + F.wave * 128 + qi * 32 + n;
            const bf16_t* qp = QM + (size_t)tok * Y3LD + h * 128;
            bf16x8 bq[8];
#pragma unroll
            for (int ks = 0; ks < 8; ++ks) bq[ks] = *(const bf16x8*)(qp + ks * 16 + hf * 8);
            float qss = 0.f;
#pragma unroll
            for (int ks = 0; ks < 8; ++ks)
#pragma unroll
                for (int e = 0; e < 8; ++e) { const float f = bf2f((unsigned short)bq[ks][e]); qss += f * f; }
            qss += __shfl_xor(qss, 32);
            const float qc = rsqrtf(qss * (1.0f / 128.0f) + 1e-6f) * (0.08838834764831845f * 1.4426950408889634f);
            f32x16 o[4];
#pragma unroll
            for (int dt = 0; dt < 4; ++dt)
#pragma unroll
                for (int r = 0; r < 16; ++r) o[dt][r] = 0.f;
            float mrun = -3.0e38f, lrun = 0.f;
#pragma unroll 1
            for (int kh = 0; kh < 2; ++kh) {
                f32x16 s[4];
#pragma unroll
                for (int k4 = 0; k4 < 4; ++k4) { const int kt = kh * 4 + k4;
#pragma unroll
                    for (int r = 0; r < 16; ++r) s[k4][r] = 0.f;
#pragma unroll
                    for (int ks = 0; ks < 8; ++ks) { const bf16x8 a = *(const LAS bf16x8*)(F.lds + (kt * 32 + n) * KS + (ks * 16 + hf * 8) * 2);
                        s[k4] = __builtin_amdgcn_mfma_f32_32x32x16_bf16(a, bq[ks], s[k4], 0, 0, 0); } }
                float mx = mrun;
#pragma unroll
                for (int k4 = 0; k4 < 4; ++k4)
#pragma unroll
                    for (int r = 0; r < 16; ++r) mx = fmaxf(mx, s[k4][r]);
                mx = fmaxf(mx, __shfl_xor(mx, 32));
                const float resc = __builtin_amdgcn_exp2f((mrun - mx) * qc), nmq = -mx * qc;
                float sum = 0.f;
#pragma unroll
                for (int k4 = 0; k4 < 4; ++k4)
#pragma unroll
                    for (int r = 0; r < 16; ++r) { const float p = __builtin_amdgcn_exp2f(__builtin_fmaf(s[k4][r], qc, nmq)); s[k4][r] = p; sum += p; }
                sum += __shfl_xor(sum, 32);
                lrun = lrun * resc + sum; mrun = mx;
#pragma unroll
                for (int dt = 0; dt < 4; ++dt)
#pragma unroll
                    for (int r = 0; r < 16; ++r) o[dt][r] *= resc;
#pragma unroll
                for (int k4 = 0; k4 < 4; ++k4)
#pragma unroll
                    for (int st = 0; st < 2; ++st) { const int kt = kh * 4 + k4;
                        union { u32x4 u; bf16x8 v; } pb;
                        pb.u.x = cvt_pk_bf16(s[k4][8 * st + 0], s[k4][8 * st + 1]); pb.u.y = cvt_pk_bf16(s[k4][8 * st + 2], s[k4][8 * st + 3]);
                        pb.u.z = cvt_pk_bf16(s[k4][8 * st + 4], s[k4][8 * st + 5]); pb.u.w = cvt_pk_bf16(s[k4][8 * st + 6], s[k4][8 * st + 7]);
#pragma unroll
                        for (int dt = 0; dt < 4; ++dt) { const bf16x8 a = *(const LAS bf16x8*)(F.lds + VOFF + (dt * 32 + n) * VS + (kt * 32 + 16 * st + 8 * hf) * 2);
                            o[dt] = __builtin_amdgcn_mfma_f32_32x32x16_bf16(a, pb.v, o[dt], 0, 0, 0); }
                    }
            }
            const float inv = 16.0f * __builtin_amdgcn_rcpf(lrun);
#pragma unroll
            for (int dt = 0; dt < 4; ++dt)
#pragma unroll
                for (int g4 = 0; g4 < 4; ++g4)
                    *(unsigned*)(YM8 + (size_t)tok * 512 + h * 128 + dt * 32 + 8 * g4 + 4 * hf) = pack_fp8x4(o[dt][g4 * 4] * inv, o[dt][g4 * 4 + 1] * inv, o[dt][g4 * 4 + 2] * inv, o[dt][g4 * 4 + 3] * inv);
        }
        __syncthreads();
    }
}

__device__ __forceinline__ void p4_attend(const Frame& F, const Args& a) {
    constexpr int WB = 2 * 8192 + 1024;
    LAS unsigned char* wb = F.lds + F.wave * WB;
    LAS unsigned short* lst = (LAS unsigned short*)(wb + 16384);
    const unsigned short* IDX = WSP(unsigned short, WS_IDX); const unsigned char* KVP8 = WSP(unsigned char, WS_KVP); const bf16_t* Q = DOP(bf16_t, DO_Y3); unsigned char* YD8 = DOP(unsigned char, DO_YD8);
    const int lane = F.lane, n = lane & 15, g = lane >> 4, gw = F.c * 8 + F.wave, nw = F.G * 8;
    const int ntk = (T - gw + nw - 1) / nw;
    float gkm = fabsf(INP(I_GK)[lane]);
    gkm = fmaxf(gkm, __shfl_xor(gkm, 32)); gkm = fmaxf(gkm, __shfl_xor(gkm, 16)); gkm = fmaxf(gkm, __shfl_xor(gkm, 8)); gkm = fmaxf(gkm, __shfl_xor(gkm, 4)); gkm = fmaxf(gkm, __shfl_xor(gkm, 2)); gkm = fmaxf(gkm, __shfl_xor(gkm, 1));
    const float kmax = 8.0f * gkm * 1.07f;
    int koff[4][2];
#pragma unroll
    for (int blk = 0; blk < 4; ++blk)
#pragma unroll
        for (int ks = 0; ks < 2; ++ks) { const int row = blk * 16 + n, pc = ks * 2 + (g >> 1); koff[blk][ks] = row * 128 + ((pc ^ (row & 7)) << 4) + 8 * (g & 1); }
    const int q8 = n >> 1, p8 = n & 1;
    int toff[2][4];
#pragma unroll
    for (int kb2 = 0; kb2 < 2; ++kb2)
#pragma unroll
        for (int d = 0; d < 4; ++d) { const int row = (kb2 * 2 + (q8 >> 2)) * 16 + g * 4 + (q8 & 3), pc = 4 + d; toff[kb2][d] = row * 128 + ((pc ^ (row & 7)) << 4) + 8 * p8; }
    const int grow = lane >> 3, gpc = lane & 7;
    const unsigned wbase = (unsigned)(uintptr_t)wb;
#define AT_KEYS(NK, LB, CH) do { _Pragma("unroll") for (int _i = 0; _i < 8; ++_i) NK[_i] = lst[(LB) * 256 + (CH) * 64 + 8 * _i + grow]; } while (0)
#define AT_ISSUE_K(NK, TOK, BUF) do { const char* _kb = (const char*)(KVP8 + (size_t)((TOK) >> 11) * 2048 * 128); \
        _Pragma("unroll") for (int _i = 0; _i < 8; ++_i) { const int _row = 8 * _i + grow; \
            __builtin_amdgcn_global_load_lds((const unsigned*)(_kb + (size_t)NK[_i] * 128 + ((gpc ^ (_row & 7)) << 4)), (LAS unsigned*)(wb + (BUF) * 8192 + _i * 1024), 16, 0, 0); } } while (0)
#define AT_ISSUE(TOK, LB, CH, BUF) do { int _nk[8]; AT_KEYS(_nk, LB, CH); AT_ISSUE_K(_nk, TOK, BUF); } while (0)
    if (ntk <= 0) return;
    { const u32x2 l0 = *(const u32x2*)(IDX + (size_t)gw * 256 + lane * 4); *(LAS u32x2*)(lst + lane * 4) = l0; }
    float gq1[8], gq2[8];
#pragma unroll
    for (int e = 0; e < 8; ++e) { gq1[e] = INP(I_GQ)[g * 8 + e]; gq2[e] = INP(I_GQ)[32 + g * 8 + e]; }
    const f32x4* CS = WSP(f32x4, WS_CS);
    bf16x8 nbq[2]; f32x4 ncs[4];
#pragma unroll
    for (int e = 0; e < 4; ++e) ncs[e] = CS[(size_t)gw * 16 + g * 4 + e];
#pragma unroll
    for (int ks = 0; ks < 2; ++ks) { if (n < 8) nbq[ks] = *(const bf16x8*)(Q + (size_t)gw * Y3LD + n * 64 + ks * 32 + g * 8); else nbq[ks] = (bf16x8){0, 0, 0, 0, 0, 0, 0, 0}; }
    AT_ISSUE(gw, 0, 0, 0); AT_ISSUE(gw, 0, 1, 1);
#pragma unroll 1
    for (int k = 0; k < ntk; ++k) {
        const int tok = gw + k * nw, ntok = tok + nw, lb = k & 1; const bool hasn = (k + 1 < ntk);
        const int tq = tok & 2047, cnt = tq + 1 < 256 ? tq + 1 : 256;
        long bq[2]; float qs = 0.f;
        { float x1[8], x2[8], ss = 0.f;
#pragma unroll
            for (int e = 0; e < 8; ++e) { x1[e] = bf2f((unsigned short)nbq[0][e]); x2[e] = bf2f((unsigned short)nbq[1][e]); ss += x1[e] * x1[e] + x2[e] * x2[e]; }
            ss += __shfl_xor(ss, 16); ss += __shfl_xor(ss, 32);
            const float rs = rsqrtf(ss * (1.0f / 64.0f) + 1e-6f) * (0.125f * 1.4426950408889634f); float o1[8], o2[8];
#pragma unroll
            for (int e = 0; e < 8; ++e) { const float cs = ncs[e >> 1][(e & 1) * 2], sn = ncs[e >> 1][(e & 1) * 2 + 1], y1 = x1[e] * rs * gq1[e], y2 = x2[e] * rs * gq2[e];
                o1[e] = y1 * cs - y2 * sn; o2[e] = y2 * cs + y1 * sn; qs += o1[e] * o1[e] + o2[e] * o2[e]; }
            const unsigned a0 = pack_fp8x4(o1[0], o1[1], o1[2], o1[3]), a1 = pack_fp8x4(o1[4], o1[5], o1[6], o1[7]), b0 = pack_fp8x4(o2[0], o2[1], o2[2], o2[3]), b1 = pack_fp8x4(o2[4], o2[5], o2[6], o2[7]);
            bq[0] = (long)(((unsigned long long)a1 << 32) | a0); bq[1] = (long)(((unsigned long long)b1 << 32) | b0); }
        qs += __shfl_xor(qs, 16); qs += __shfl_xor(qs, 32);
        const float shift = __builtin_amdgcn_sqrtf(qs) * 1.07f * kmax - 7.0f;
        const f32x4 nsh = (f32x4){-shift, -shift, -shift, -shift};
        u32x2 nl = (u32x2){0u, 0u};
        if (hasn) { nl = *(const u32x2*)(IDX + (size_t)ntok * 256 + lane * 4);
#pragma unroll
            for (int e = 0; e < 4; ++e) ncs[e] = CS[(size_t)ntok * 16 + g * 4 + e];
#pragma unroll
            for (int ks = 0; ks < 2; ++ks) if (n < 8) nbq[ks] = *(const bf16x8*)(Q + (size_t)ntok * Y3LD + n * 64 + ks * 32 + g * 8); }
        f32x4 o[4];
#pragma unroll
        for (int d = 0; d < 4; ++d) o[d] = (f32x4){0.f, 0.f, 0.f, 0.f};
        float lsum = 0.f;
#pragma unroll
        for (int ch = 0; ch < 4; ++ch) {
            const int buf = ch & 1;
            if (ch == 3 && !hasn) asm volatile("s_waitcnt vmcnt(0)" ::: "memory"); else asm volatile("s_waitcnt vmcnt(8)" ::: "memory");
            LAS const unsigned char* bb = wb + buf * 8192;
            int nk[8];
            if (ch < 2) AT_KEYS(nk, lb, ch + 2); else if (hasn) AT_KEYS(nk, lb ^ 1, ch - 2);
            f32x4 s[4];
#pragma unroll
            for (int blk = 0; blk < 4; ++blk) {
                const long k0 = *(LAS const long*)(bb + koff[blk][0]), k1 = *(LAS const long*)(bb + koff[blk][1]);
                s[blk] = __builtin_amdgcn_mfma_f32_16x16x32_fp8_fp8(k0, bq[0], nsh, 0, 0, 0);
                s[blk] = __builtin_amdgcn_mfma_f32_16x16x32_fp8_fp8(k1, bq[1], s[blk], 0, 0, 0);
            }
            u32x2 tr[2][4];
#pragma unroll
            for (int kb2 = 0; kb2 < 2; ++kb2)
#pragma unroll
                for (int d = 0; d < 4; ++d) asm volatile("ds_read_b64_tr_b8 %0, %1 offset:%2" : "=&v"(tr[kb2][d]) : "v"(wbase + (unsigned)toff[kb2][d]), "i"(buf * 8192) : "memory");
            float e[2][4];
#pragma unroll
            for (int b2 = 0; b2 < 2; ++b2)
#pragma unroll
                for (int j = 0; j < 4; ++j) e[b2][j] = __int_as_float(__builtin_amdgcn_update_dpp(__float_as_int(s[b2][j]), __float_as_int(s[b2 + 2][j]), 0x118, 0xf, 0xc, false));
            if (cnt >= (ch + 1) * 64) {
#pragma unroll
                for (int b2 = 0; b2 < 2; ++b2)
#pragma unroll
                    for (int j = 0; j < 4; ++j) { const float x = __builtin_amdgcn_exp2f(e[b2][j]); e[b2][j] = x; lsum += x; }
            } else {
                asm volatile("" ::: "memory");
#pragma unroll
                for (int b2 = 0; b2 < 2; ++b2)
#pragma unroll
                    for (int j = 0; j < 4; ++j) { const int p = ch * 64 + (b2 + (n >> 3) * 2) * 16 + g * 4 + j; const float x = p < cnt ? __builtin_amdgcn_exp2f(e[b2][j]) : 0.f; e[b2][j] = x; lsum += x; }
            }
            const unsigned w0 = pack_fp8x4_nc(e[0][0], e[0][1], e[0][2], e[0][3]), w1 = pack_fp8x4_nc(e[1][0], e[1][1], e[1][2], e[1][3]);
#pragma unroll
            for (int kb2 = 0; kb2 < 2; ++kb2) {
                const unsigned plo = kb2 == 0 ? w0 : (unsigned)__builtin_amdgcn_update_dpp(0, (int)w0, 0x108, 0xf, 0xf, true), phi = kb2 == 0 ? w1 : (unsigned)__builtin_amdgcn_update_dpp(0, (int)w1, 0x108, 0xf, 0xf, true);
                const long pb = (long)(((unsigned long long)phi << 32) | plo);
                if (kb2 == 0) asm volatile("s_waitcnt lgkmcnt(0)" : "+v"(tr[0][0]), "+v"(tr[0][1]), "+v"(tr[0][2]), "+v"(tr[0][3]), "+v"(tr[1][0]), "+v"(tr[1][1]), "+v"(tr[1][2]), "+v"(tr[1][3]) :: "memory");
#pragma unroll
                for (int d = 0; d < 4; ++d) { const long av = (long)(((unsigned long long)tr[kb2][d].y << 32) | tr[kb2][d].x);
                    o[d] = __builtin_amdgcn_mfma_f32_16x16x32_fp8_fp8(av, pb, o[d], 0, 0, 0); }
            }
            __builtin_amdgcn_sched_barrier(0);
            if (ch == 1 && hasn) *(LAS u32x2*)(lst + (lb ^ 1) * 256 + lane * 4) = nl;
            if (ch < 2) AT_ISSUE_K(nk, tok, buf);
            else if (hasn) AT_ISSUE_K(nk, ntok, buf);
            __builtin_amdgcn_sched_barrier(0);
        }
        lsum += __int_as_float(__builtin_amdgcn_update_dpp(0, __float_as_int(lsum), 0x108, 0xf, 0xf, true));
        lsum += __shfl_xor(lsum, 16); lsum += __shfl_xor(lsum, 32);
        const float inv = 16.0f * __builtin_amdgcn_rcpf(lsum);
        if (n < 8) {
#pragma unroll
            for (int d = 0; d < 4; ++d) *(unsigned*)(YD8 + (size_t)tok * 512 + n * 64 + d * 16 + g * 4) = pack_fp8x4(o[d][0] * inv, o[d][1] * inv, o[d][2] * inv, o[d][3] * inv);
        }
    }
#undef AT_ISSUE
#undef AT_ISSUE_K
#undef AT_KEYS
}

__device__ __forceinline__ void p8_router(const Frame& F, const Args& a, bool commit) {
    const bf16_t* X1B = WSP(bf16_t, WS_X1B); const bf16_t* WR = WSP(bf16_t, WS_WR);
    int* TOK = WSP(int, WS_TOK); float2* RW = WSP(float2, WS_RW); int* TOK2 = WSP(int, WS_TOK2); unsigned* gcnt = (unsigned*)(F.ws + WS_CTL + CTL_GCNT);
    constexpr int WRS = 2064, RT_LG = 48 * WRS, RT_RS = RT_LG + 8 * 16 * 48 * 4, RT_LC = RT_RS + 8 * 16 * 4;
    LAS float* lg = (LAS float*)(F.lds + RT_LG) + F.wave * (16 * 48);
    LAS float* rsb = (LAS float*)(F.lds + RT_RS) + F.wave * 16;
    LAS int* lc = (LAS int*)(F.lds + RT_LC); LAS int* lbase = lc + 144;
    const int lane = F.lane, n = lane & 15, q = lane >> 4;
    for (int i = F.tid; i < 48 * 128; i += NTHR) { const int r = i >> 7, c = i & 127; *(LAS u32x4*)(F.lds + r * WRS + c * 16) = *(const u32x4*)(WR + (size_t)r * 1024 + c * 8); }
    __syncthreads();
    for (int it = F.c; it < T / 128; it += F.G) {
        const int tw = it * 128 + F.wave * 16;
        if (F.tid < 144) lc[F.tid] = 0;
        const bf16_t* xp = X1B + (size_t)(tw + n) * 1024 + q * 8;
        f32x4 acc[3] = {(f32x4){0.f, 0.f, 0.f, 0.f}, (f32x4){0.f, 0.f, 0.f, 0.f}, (f32x4){0.f, 0.f, 0.f, 0.f}};
        float ss = 0.f;
#pragma unroll
        for (int hb = 0; hb < 2; ++hb) {
            bf16x8 av[16];
#pragma unroll
            for (int k2 = 0; k2 < 16; ++k2) av[k2] = *(const bf16x8*)(xp + (hb * 16 + k2) * 32);
#pragma unroll
            for (int k2 = 0; k2 < 16; ++k2) { const int ks = hb * 16 + k2;
#pragma unroll
                for (int j = 0; j < 8; ++j) { const float f = bf2f((unsigned short)av[k2][j]); ss += f * f; }
#pragma unroll
                for (int bl = 0; bl < 3; ++bl) { const bf16x8 bb = *(const LAS bf16x8*)(F.lds + (bl * 16 + n) * WRS + (ks * 32 + q * 8) * 2);
                    acc[bl] = __builtin_amdgcn_mfma_f32_16x16x32_bf16(av[k2], bb, acc[bl], 0, 0, 0); } }
        }
        ss += __shfl_xor(ss, 16); ss += __shfl_xor(ss, 32);
        const float rs = rsqrtf(ss * (1.0f / 1024.0f) + 1e-6f);
        if (q == 0) rsb[n] = rs;
#pragma unroll
        for (int bl = 0; bl < 3; ++bl)
#pragma unroll
            for (int j = 0; j < 4; ++j) lg[(q * 4 + j) * 48 + bl * 16 + n] = acc[bl][j] * rsb[q * 4 + j];
        __syncthreads();
        int l1 = 0, l2 = 0, lp = 0, r1 = 0, r2 = 0, rp = 0, s1 = 0; float wa = 0.f, wb = 0.f, myrs = 0.f;
        if (lane < 16) {
            LAS const float* l = lg + lane * 48; myrs = rsb[lane];
            float g0 = l[0] + INP(I_BGROUP)[0]; int gi = 0; float gm = g0, gl[4]; gl[0] = g0;
#pragma unroll
            for (int j = 1; j < 4; ++j) { gl[j] = l[j] + INP(I_BGROUP)[j]; if (gl[j] > gm) { gm = gl[j]; gi = j; } }
            float gs = 0.f;
#pragma unroll
            for (int j = 0; j < 4; ++j) gs += __expf(gl[j] - gm);
            const float ggate = 1.0f / gs;
            float e1 = -3.0e38f, e2 = -3.0e38f; int i1 = 0, i2 = 0;
            for (int e = 0; e < 8; ++e) { const float v = l[4 + gi * 8 + e] + INP(I_BEXP)[gi * 8 + e];
                if (v > e1) { e2 = e1; i2 = i1; e1 = v; i1 = e; } else if (v > e2) { e2 = v; i2 = e; } }
            const float pa = 1.0f / (1.0f + __expf(e2 - e1));
            wa = ggate * pa; wb = ggate - wa;
            s1 = i1 < i2 ? 0 : 1;
            const int elo = i1 < i2 ? i1 : i2, ehi = i1 < i2 ? i2 : i1;
            l1 = gi * 8 + i1; l2 = gi * 8 + i2; lp = 32 + gi * 28 + (elo * (15 - elo)) / 2 + (ehi - elo - 1);
            r1 = atomicAdd((int*)(lc + l1), 1); r2 = atomicAdd((int*)(lc + l2), 1); rp = atomicAdd((int*)(lc + lp), 1);
        }
        __syncthreads();
        if (F.tid < 144) { const int cn = lc[F.tid]; lbase[F.tid] = (cn > 0 && commit) ? (int)atomicAdd(gcnt + F.tid * 64, (unsigned)cn) : 0; }
        __syncthreads();
        if (lane < 16 && commit) { const int t = tw + lane;
            const size_t p1 = (size_t)l1 * 65536 + lbase[l1] + r1, p2 = (size_t)l2 * 65536 + lbase[l2] + r2;
            TOK[p1] = t | (s1 << 31); RW[p1] = make_float2(myrs, wa); TOK[p2] = t | ((s1 ^ 1) << 31); RW[p2] = make_float2(myrs, wb);
            TOK2[(size_t)(lp - 32) * 65536 + lbase[lp] + rp] = t; }
        __syncthreads();
    }
}

__device__ __forceinline__ int moe_table(const Frame& F, int first, int count) {
    LAS int* misc = (LAS int*)(F.lds + MISC_OFF); const unsigned* gcnt = (const unsigned*)(F.ws + WS_CTL + CTL_GCNT);
    __syncthreads();
    if (F.tid < count) misc[MI_CNT + F.tid] = (int)__hip_atomic_load(gcnt + (first + F.tid) * 64, __ATOMIC_RELAXED, __HIP_MEMORY_SCOPE_AGENT);
    if (F.tid >= 256 && F.tid < 256 + 28) { const int pi = F.tid - 256; int elo = 0; while (elo < 6 && ((elo + 1) * (15 - (elo + 1))) / 2 <= pi) ++elo;
        misc[MI_PT + pi] = elo | ((pi - (elo * (15 - elo)) / 2 + elo + 1) << 4); }
    __syncthreads();
    if (F.tid == 0) { int run = 0; for (int l = 0; l < count; ++l) { misc[MI_PRE + l] = run; run += (misc[MI_CNT + l] + 255) >> 8; } misc[MI_PRE + count] = run; }
    __syncthreads();
    const int nt = misc[MI_PRE + count];
    for (int idx = F.tid; idx < nt && idx < 640; idx += NTHR) { int l = 0; while (l < count - 1 && misc[MI_PRE + l + 1] <= idx) ++l; misc[MI_TILE + idx] = l | ((idx - misc[MI_PRE + l]) << 8); }
    __syncthreads();
    return nt < 640 ? nt : 640;
}

__global__ void __launch_bounds__(NTHR, 2) fwd(Args a) {
    extern __shared__ __attribute__((aligned(16))) unsigned char lds_raw[];
    Frame F;
    F.lds = (LAS unsigned char*)lds_raw; F.tid = threadIdx.x; F.lane = F.tid & 63; F.wave = __builtin_amdgcn_readfirstlane(F.tid >> 6); F.G = gridDim.x; F.c = blockIdx.x;
    F.ws = a.ws; F.dout = (unsigned char*)a.out;
    LAS unsigned* misc = (LAS unsigned*)(F.lds + MISC_OFF);
    for (int i = F.tid; i < 1024; i += NTHR) misc[i] = 0u;
    __syncthreads();
    XcdBarrier bar; bar.bar = (unsigned*)(F.ws + WS_CTL); bar.x = 0; bar.st = (volatile LAS unsigned*)misc;
    const int lo = a.ph_lo, hi = a.ph_hi;
    if (hi - lo > 1) bar = xcd_barrier_post((unsigned*)(F.ws + WS_CTL), (volatile LAS unsigned*)misc);
#ifndef PH_MASK
#define PH_MASK 0xFFF
#endif
#define IN(k) (((PH_MASK >> (k)) & 1) && lo <= (k) && (k) < hi)
#ifndef REP_MASK
#define REP_MASK 0
#endif
#define NREP(k) (1 + ((REP_MASK >> (k)) & 1))
#define SEAM(k) do { if (IN(k) && IN((k) + 1)) xcd_barrier(bar); } while (0)
    bf16_t* HB = WSP(bf16_t, WS_HB); bf16_t* UA = WSP(bf16_t, WS_UA); unsigned char* SG = WSP(unsigned char, WS_SG);
    bf16_t* Y3 = DOP(bf16_t, DO_Y3); bf16_t* YG = WSP(bf16_t, WS_YG);
    LAS const int* imisc = (LAS const int*)(F.lds + MISC_OFF);

    if (IN(0)) for (int rep = 0; rep < NREP(0); ++rep) { p0_prep(F, a); __syncthreads(); }
    SEAM(0);
    if (IN(0) && IN(1)) {
        if (F.tid == 0) { unsigned* bw = (unsigned*)(F.ws + WS_CTL); bool bal = (F.G % 8) == 0;
            for (int j = 0; j < 16; ++j) { const unsigned cj = xb_ld(&bw[XB_XCNT(j)]); bal = bal && (cj == (j < 8 ? (unsigned)F.G / 8u : 0u)); }
            misc[3] = bal ? (misc[2] * 8u + bar.x) : (unsigned)blockIdx.x; }
        __syncthreads();
        F.c = (int)misc[3];
    }
    if (IN(1)) {
        { pg8::Gemm g{512, 512, 512, 0x7f, 0x7a};
          pg8::SchedGrid S{(const char*)WSP(unsigned char, WS_HB8), (const char*)WSP(unsigned char, WS_WG8), 0, 0, (size_t)256 * 1024, (size_t)256 * 1024, 256, 18, 1, F.G, F.c, NREP(1)};
          EpiInProj E{UA, Y3, SG};
          pg8::gemm_phase<EpiInProj, pg8::SchedGrid, false, PG8_SP2, true>(F.lds, g, S, E); }
        { pg8::Gemm g{1024, 1024, 1024}; pg8::SchedGrid S{(const char*)HB, (const char*)WSP(bf16_t, WS_WIN), 0, 0, (size_t)256 * 1024 * 2, (size_t)256 * 1024 * 2, 256, 2, 1, F.G, F.c, NREP(1)};
          EpiInProjB E{WSP(bf16_t, WS_KVX), WSP(bf16_t, WS_QI)};
          pg8::gemm_phase<EpiInProjB, pg8::SchedGrid, false>(F.lds, g, S, E); }
        { pg8::Gemm g{512, 512, 512, 0x7f, 0x7a};
          pg8::SchedGrid S{(const char*)WSP(unsigned char, WS_MEMN), (const char*)WSP(unsigned char, WS_WMEM), 0, 0, (size_t)256 * 1024, (size_t)256 * 1024, 32, 4, 1, F.G, F.c, NREP(1)};
          EpiBf16 E{WSP(bf16_t, WS_KMVM), 1024};
          pg8::gemm_phase<EpiBf16, pg8::SchedGrid, false, PG8_SP2, true>(F.lds, g, S, E); }
        if (F.G > 128) { if (F.c >= 128) p1_tables(F, a, F.c - 128, F.G - 128); } else p1_tables(F, a, F.c, F.G);
    }
    SEAM(1);
    if (IN(2)) {
        { pg8::Gemm g{640, 512, 512}; pg8::SchedGrid S{(const char*)UA, (const char*)WSP(bf16_t, WS_SIN), (size_t)2048 * 640 * 2, (size_t)256 * 512 * 2, (size_t)256 * 640 * 2, (size_t)256 * 512 * 2, 8, 1, 32, F.G, F.c, NREP(2)};
          EpiSc E{WSP(float, WS_SC)};
          pg8::gemm_phase<EpiSc, pg8::SchedGrid, false>(F.lds, g, S, E); }
        for (int rep = 0; rep < NREP(15); ++rep) p2_post(F, a, rep < NREP(15) - 1);
    }
    SEAM(2);
#ifndef P3_SUB
#define P3_SUB 7
#endif
    if (IN(3)) { for (int rep = 0; rep < NREP(13); ++rep) { if (P3_SUB & 1) p3_scan(F); } for (int rep = 0; rep < NREP(3); ++rep) { if (P3_SUB & 2) p3_select(F, rep == 0 || (REP_MASK & 0x10000)); } for (int rep = 0; rep < NREP(12); ++rep) if (P3_SUB & 4) p3_memattn(F); }
    SEAM(3);
    if (IN(4)) {
        { pg8::Gemm g{640, 640, 640}; pg8::SchedGrid S{(const char*)UA, (const char*)WSP(bf16_t, WS_TW), (size_t)2048 * 640 * 2, (size_t)512 * 640 * 2, (size_t)256 * 640 * 2, (size_t)256 * 640 * 2, 8, 2, 32, F.G, F.c, NREP(4)};
          EpiGelu E{YG};
          pg8::gemm_phase<EpiGelu, pg8::SchedGrid, false>(F.lds, g, S, E); }
        for (int rep = 0; rep < NREP(14); ++rep) p4_attend(F, a);
    }
    SEAM(4);
    if (IN(5)) {
        pg8::Gemm g{512, 512, 512}; pg8::SchedGrid S{(const char*)YG, (const char*)WSP(bf16_t, WS_WGLU), 0, 0, (size_t)256 * 512 * 2, (size_t)256 * 512 * 2, 256, 2, 1, F.G, F.c, NREP(5)};
        EpiGlu E{YG, DOP(unsigned char, DO_YS8)};
        pg8::gemm_phase<EpiGlu, pg8::SchedGrid, false>(F.lds, g, S, E);
    }
    SEAM(5);
    if (IN(6)) {
        pg8::Gemm g{256, 768, 768, 0x7b, 0x7a};
        SchedMerge3 S{(const char*)DOP(unsigned char, DO_Y8), (const char*)WSP(unsigned char, WS_WUP), F.G, F.c, NREP(6)};
        EpiMerge E{SG, (unsigned char*)HB};
        pg8::gemm_phase<EpiMerge, SchedMerge3, false, PG8_SP2, true>(F.lds, g, S, E);
    }
    SEAM(6);
    if (IN(7)) {
        pg8::Gemm g{512, 512, 512, 0x7c, 0x7a};
        pg8::SchedGrid S{(const char*)HB, (const char*)WSP(unsigned char, WS_WOUT), 0, 0, (size_t)256 * 1024, (size_t)256 * 1024, 256, 4, 1, F.G, F.c, NREP(7)};
        EpiOut E{INP(I_X), WSP(bf16_t, WS_X1B), WSP(unsigned char, WS_X1B8)};
        pg8::gemm_phase<EpiOut, pg8::SchedGrid, false, PG8_SP2, true>(F.lds, g, S, E);
    }
    SEAM(7);
    if (IN(8)) for (int rep = 0; rep < NREP(8); ++rep) p8_router(F, a, rep == NREP(8) - 1);
    SEAM(8);
    if (IN(9)) {
        const int nt = moe_table(F, 0, 32);
        pg8::Gemm g{512, 512, 512, 0x7f, 0x7a};
        SchedMoE1 S{(const char*)WSP(unsigned char, WS_X1B8), (const char*)WSP(unsigned char, WS_WGU), imisc, WSP(int, WS_TOK), nt * 4, F.G, F.c, NREP(9)};
        EpiMoe1 E{imisc, WSP(int, WS_TOK), WSP(float2, WS_RW), WSP(unsigned char, WS_HID)};
        pg8::gemm_phase<EpiMoe1, SchedMoE1, true, PG8_SP2, true>(F.lds, g, S, E);
    }
    SEAM(9);
    if (IN(10)) {
        const int nt = moe_table(F, 32, 112);
        pg8::Gemm g{512, 256, 512, 0x7b, 0x7a};
        SchedMoE2 S{(const char*)WSP(unsigned char, WS_HID), (const char*)WSP(unsigned char, WS_WD), imisc, WSP(int, WS_TOK2), nt * 4, F.G, F.c, NREP(10)};
        EpiMoe2 E{imisc, WSP(int, WS_TOK2), WSP(bf16_t, WS_X1B), a.out};
        pg8::gemm_phase<EpiMoe2, SchedMoE2, true, PG8_SP2, true>(F.lds, g, S, E);
    }
#undef IN
#undef SEAM
}

extern "C" void kernel_launch(void* const* d_in, const int* in_sizes, int n_in, void* d_out, int out_size, void* d_ws, size_t ws_size, hipStream_t stream) {
    static int grid = 0;
    if (grid == 0) {
        if (n_in != 32 || out_size != T * D || ws_size < WS_END) { fprintf(stderr, "kernel_launch: unexpected shapes: n_in %d out %d ws %zu (need %zu)\n", n_in, out_size, ws_size, (size_t)WS_END); grid = -1; return; }
        int dev = 0, cus = 0;
        if (hipGetDevice(&dev) != hipSuccess || hipDeviceGetAttribute(&cus, hipDeviceAttributeMultiprocessorCount, dev) != hipSuccess) { grid = -1; return; }
        if (hipFuncSetAttribute((const void*)fwd, hipFuncAttributeMaxDynamicSharedMemorySize, LDS_BYTES) != hipSuccess) { fprintf(stderr, "kernel_launch: hipFuncSetAttribute failed\n"); grid = -1; return; }
        int per_cu = 0;
        if (hipOccupancyMaxActiveBlocksPerMultiprocessor(&per_cu, (const void*)fwd, NTHR, LDS_BYTES) != hipSuccess || per_cu < 1) fprintf(stderr, "kernel_launch: occupancy query reports %d\n", per_cu);
        (void)hipGetLastError();
        grid = cus;
    }
    if (grid < 0) return;
    (void)hipMemsetAsync((char*)d_ws + WS_CTL, 0, CTL_BYTES, stream);
    Args a{};
    for (int i = 0; i < 32; ++i) a.in[i] = d_in[i];
    a.out = (float*)d_out; a.ws = (unsigned char*)d_ws;
#if MK_PER_PHASE
    for (int ph = 0; ph < NPHASE; ++ph) { a.ph_lo = ph; a.ph_hi = ph + 1; hipLaunchKernelGGL(fwd, dim3(grid), dim3(NTHR), LDS_BYTES, stream, a); }
#else
    a.ph_lo = 0; a.ph_hi = NPHASE; hipLaunchKernelGGL(fwd, dim3(grid), dim3(NTHR), LDS_BYTES, stream, a);
#endif
}
```

```cpp
#include <hip/hip_runtime.h>
#include <stdio.h>
#include <stdint.h>

#ifndef MK_PER_PHASE
#define MK_PER_PHASE 0
#endif

#define LAS __attribute__((address_space(3)))
typedef unsigned short bf16_t;
typedef short bf16x8 __attribute__((ext_vector_type(8)));
typedef float f32x4 __attribute__((ext_vector_type(4)));
typedef float f32x16 __attribute__((ext_vector_type(16)));
typedef unsigned u32x4 __attribute__((ext_vector_type(4)));
typedef unsigned u32x2 __attribute__((ext_vector_type(2)));

constexpr int T = 65536, NB = 32, SEQ = 2048, D = 1024;
constexpr int NTHR = 512;
constexpr int LDS_BYTES = 147456, MISC_OFF = LDS_BYTES - 4096;
constexpr int NPHASE = 11;

constexpr size_t WS_CTL = 0, CTL_BYTES = 65536;
constexpr size_t CTL_GCNT = 16384;
constexpr size_t WS_WIN = WS_CTL + CTL_BYTES;
constexpr size_t WS_WMEM = WS_WIN + (size_t)5120 * 1024 * 2;
constexpr size_t WS_WGLU = WS_WMEM + (size_t)1024 * 1024 * 2;
constexpr size_t WS_WUP = WS_WGLU + (size_t)512 * 512 * 2;
constexpr size_t WS_WOUT = WS_WUP + (size_t)3 * 1024 * 512 * 2;
constexpr size_t WS_WGU = WS_WOUT + (size_t)1024 * 1024 * 2;
constexpr size_t WS_WD = WS_WGU + (size_t)32 * 1024 * 1024 * 2;
constexpr size_t WS_TW = WS_WD + (size_t)32 * 1024 * 512 * 2;
constexpr size_t WS_SIN = WS_TW + (size_t)32 * 512 * 640 * 2;
constexpr size_t WS_LAM32 = WS_SIN + (size_t)32 * 256 * 512 * 2;
constexpr size_t WS_WR = WS_LAM32 + 16384;
constexpr size_t WS_HB = WS_WR + 98304;
constexpr size_t WS_UA = WS_HB + (size_t)T * 1024 * 2;
constexpr size_t WS_KVX = WS_UA + (size_t)32 * 2048 * 640 * 2;
constexpr size_t WS_KVP = WS_KVX + (size_t)T * 256 * 2;
constexpr size_t WS_KIP = WS_KVP + (size_t)T * 128 * 2;
constexpr size_t WS_WIF = WS_KIP + (size_t)T * 64 * 2;
constexpr size_t WS_QI = WS_WIF + (size_t)T * 4 * 4;
constexpr size_t WS_SG = WS_QI + (size_t)T * 256 * 2;
constexpr size_t WS_X1B = WS_SG;
constexpr size_t WS_HID = WS_SG + (size_t)T * 3072;
constexpr size_t WS_X1B8 = WS_HID + (size_t)T * 1024;
constexpr size_t WS_SC = WS_HID + (size_t)T * 1024 * 2;
constexpr size_t WS_IDX = WS_SC + (size_t)32 * 2048 * 128 * 4;
constexpr size_t WS_MEMN = WS_IDX + (size_t)T * 256 * 2;
constexpr size_t WS_KMVM = WS_MEMN + (size_t)8192 * 1024 * 2;
constexpr size_t WS_KM = WS_KMVM + (size_t)8192 * 1024 * 2;
constexpr size_t WS_VMT = WS_KM + (size_t)128 * 256 * 128 * 2;
constexpr size_t WS_TOK = WS_VMT + (size_t)128 * 128 * 256 * 2;
constexpr size_t WS_RW = WS_TOK + (size_t)32 * 65536 * 4;
constexpr size_t WS_TOK2 = WS_RW + (size_t)32 * 65536 * 8;
constexpr size_t WS_LP = WS_TOK2 + (size_t)112 * 65536 * 4;
constexpr size_t WS_BB = WS_LP + (size_t)32 * 64 * 33 * 8;
constexpr size_t WS_HB8 = WS_BB + (size_t)32 * 64 * 16 * 8;
constexpr size_t WS_WG8 = WS_HB8 + (size_t)T * 1024;
constexpr size_t WS_CS = WS_WG8 + (size_t)5120 * 1024;
constexpr size_t WS_END = WS_CS + (size_t)T * 32 * 8;
constexpr size_t DO_Y3 = 0, DO_Y8 = (size_t)T * 1024 * 2, DO_YS8 = DO_Y8, DO_YD8 = DO_Y8 + (size_t)T * 512, DO_YM8 = DO_Y8 + (size_t)2 * T * 512;
constexpr int Y3LD = 1024;
constexpr size_t WS_YG = WS_HID;

__device__ __forceinline__ float bf2f(unsigned b) { return __uint_as_float(b << 16); }
__device__ __forceinline__ unsigned cvt_pk_bf16(float lo, float hi) { unsigned r; asm("v_cvt_pk_bf16_f32 %0, %1, %2" : "=v"(r) : "v"(lo), "v"(hi)); return r; }
__device__ __forceinline__ bf16_t f2bf(float f) { return (bf16_t)(cvt_pk_bf16(f, 0.f) & 0xffffu); }
__device__ __forceinline__ float wave_sum(float v) { v += __shfl_xor(v, 32); v += __shfl_xor(v, 16); v += __shfl_xor(v, 8); v += __shfl_xor(v, 4); v += __shfl_xor(v, 2); v += __shfl_xor(v, 1); return v; }
__device__ __forceinline__ float sum32(float v) { v += __shfl_xor(v, 16); v += __shfl_xor(v, 8); v += __shfl_xor(v, 4); v += __shfl_xor(v, 2); v += __shfl_xor(v, 1); return v; }
__device__ __forceinline__ float sigm(float x) { return __builtin_amdgcn_rcpf(1.0f + __expf(-x)); }
__device__ __forceinline__ float gelu_tanh(float x) { const float u = 1.5957691216057308f * (x + 0.044715f * x * x * x); return x * sigm(u); }
__device__ __forceinline__ u32x4 pack8(const f32x4 a, const f32x4 b) { u32x4 w; w.x = cvt_pk_bf16(a[0], a[1]); w.y = cvt_pk_bf16(a[2], a[3]); w.z = cvt_pk_bf16(b[0], b[1]); w.w = cvt_pk_bf16(b[2], b[3]); return w; }
__device__ __forceinline__ void unpack8(const u32x4 w, f32x4& a, f32x4& b) {
    a[0] = bf2f(w.x & 0xffffu); a[1] = bf2f(w.x >> 16); a[2] = bf2f(w.y & 0xffffu); a[3] = bf2f(w.y >> 16);
    b[0] = bf2f(w.z & 0xffffu); b[1] = bf2f(w.z >> 16); b[2] = bf2f(w.w & 0xffffu); b[3] = bf2f(w.w >> 16); }

__device__ __forceinline__ unsigned pack_fp8x4(float a, float b, float c, float d) {
    a = __builtin_amdgcn_fmed3f(a, -448.f, 448.f); b = __builtin_amdgcn_fmed3f(b, -448.f, 448.f); c = __builtin_amdgcn_fmed3f(c, -448.f, 448.f); d = __builtin_amdgcn_fmed3f(d, -448.f, 448.f);
    int p = __builtin_amdgcn_cvt_pk_fp8_f32(a, b, 0, false); p = __builtin_amdgcn_cvt_pk_fp8_f32(c, d, p, true); return (unsigned)p; }

__device__ __forceinline__ unsigned pack_fp8x4_nc(float a, float b, float c, float d) {
    int p = __builtin_amdgcn_cvt_pk_fp8_f32(a, b, 0, false); p = __builtin_amdgcn_cvt_pk_fp8_f32(c, d, p, true); return (unsigned)p; }

#define XB_TMO      128
#define XB_XCNT(j)  (256  + 64 * (j))
#define XB_XSUB(j)  (1280 + 64 * (j))
#define XB_XGEN(j)  (2304 + 64 * (j))
#define XB_TOP      3328
#define XB_TOPGEN   3392
#define XCD_BAR_WORDS 3456
#define XB_SPIN_CAP (1u << 18)
__device__ __forceinline__ unsigned xb_ld(unsigned* p)              { return __hip_atomic_load(p, __ATOMIC_RELAXED, __HIP_MEMORY_SCOPE_AGENT); }
__device__ __forceinline__ unsigned xb_add(unsigned* p, unsigned v) { return __hip_atomic_fetch_add(p, v, __ATOMIC_RELAXED, __HIP_MEMORY_SCOPE_AGENT); }
__device__ __forceinline__ unsigned xb_xcc_id() { return (unsigned)__builtin_amdgcn_s_getreg((3 << 11) | 20) & 0xFu; }
#define XB_SPIN(cond, bar) do { unsigned _sp = 0; while (cond) { __builtin_amdgcn_s_sleep(1); \
    if ((++_sp & 255u) == 0u) { if (xb_ld(&(bar)[XB_TMO])) break; if (_sp > XB_SPIN_CAP) { atomicAdd(&(bar)[XB_TMO], 1u); break; } } } } while (0)
struct XcdBarrier { unsigned* bar; unsigned x; volatile LAS unsigned* st; };
__device__ __forceinline__ XcdBarrier xcd_barrier_post(unsigned* bar, volatile LAS unsigned* st) {
    XcdBarrier b; b.bar = bar; b.x = xb_xcc_id(); b.st = st;
    if (threadIdx.x == 0) st[2] = xb_add(&bar[XB_XCNT(b.x)], 1u);
    return b;
}
__device__ __forceinline__ void xcd_barrier_complete(unsigned* bar, unsigned x, unsigned& nloc, unsigned& nx) {
    const unsigned G = gridDim.x * gridDim.y * gridDim.z;
    unsigned sum, cnt, mine, sp = 0u;
    for (;;) {
        sum = 0u; cnt = 0u; mine = 0u;
#pragma unroll
        for (unsigned j = 0; j < 16; ++j) { const unsigned c = xb_ld(&bar[XB_XCNT(j)]); sum += c; cnt += (c > 0u) ? 1u : 0u; mine = (j == x) ? c : mine; }
        if (sum == G) break;
        __builtin_amdgcn_s_sleep(1);
        if ((++sp & 255u) == 0u) { if (xb_ld(&bar[XB_TMO])) break; if (sp > XB_SPIN_CAP) { atomicAdd(&bar[XB_TMO], 1u); break; } }
    }
    nloc = mine > 0u ? mine : 1u; nx = cnt > 0u ? cnt : 1u;
}
__device__ __forceinline__ void xcd_barrier(const XcdBarrier& b) {
    asm volatile("s_waitcnt vmcnt(0)" ::: "memory");
    __syncthreads();
    if (threadIdx.x == 0) {
        unsigned* bar = b.bar;
        __builtin_amdgcn_s_waitcnt(0);
        unsigned nloc = b.st[0], nx = b.st[1];
        if (nloc == 0u) { xcd_barrier_complete(bar, b.x, nloc, nx); b.st[0] = nloc; b.st[1] = nx; }
        const unsigned old = xb_add(&bar[XB_XSUB(b.x)], 1u);
        const unsigned gen = old / nloc;
        if (old + 1u == (gen + 1u) * nloc) {
            __builtin_amdgcn_fence(__ATOMIC_RELEASE, "agent");
            asm volatile("s_waitcnt vmcnt(0)" ::: "memory");
            const unsigned og = xb_add(&bar[XB_TOP], 1u);
            const unsigned tg = og / nx;
            if (og + 1u == (tg + 1u) * nx) xb_add(&bar[XB_TOPGEN], 1u);
            else XB_SPIN(xb_ld(&bar[XB_TOPGEN]) == tg, bar);
            __builtin_amdgcn_fence(__ATOMIC_ACQUIRE, "agent");
            xb_add(&bar[XB_XGEN(b.x)], 1u);
            asm volatile("s_waitcnt vmcnt(0)" ::: "memory");
        } else {
            XB_SPIN(xb_ld(&bar[XB_XGEN(b.x)]) == gen, bar);
            __builtin_amdgcn_fence(__ATOMIC_ACQUIRE, "agent");
            asm volatile("s_waitcnt vmcnt(0)" ::: "memory");
        }
    }
    __syncthreads();
}

namespace pg8 {
constexpr int BM = 256, BK = 64, HALF = 128, HTB = HALF * BK * 2, STAGE_BYTES = 8 * HTB;
__device__ __forceinline__ int lds_byte(int r, int c) { const int st = (r >> 4) * 2 + (c >> 5), rr = r & 15, cc = c & 31, ob = rr * 64 + cc * 2; return st * 1024 + (ob ^ (((ob >> 9) & 1) << 5)); }
__device__ __forceinline__ void stage_rc(int b, int& R, int& C) { const int st = b / 1024, sb = b % 1024, swz = sb ^ (((sb >> 9) & 1) << 5); R = (st >> 1) * 16 + swz / 64; C = (st & 1) * 32 + (swz % 64) / 2; }
__device__ __forceinline__ int perm32(int rho) { const int n = rho >> 4, i = rho & 15; return 8 * (i >> 2) + 4 * n + (i & 3); }
struct Unit { int pm, pn, z; };
struct Gemm { int lda, ldb, K; int sa = 0x7f, sb = 0x7f; };
typedef int v8i32 __attribute__((ext_vector_type(8)));
typedef int v4i32 __attribute__((ext_vector_type(4)));

#ifndef PG8_SP2
#define PG8_SP2 true
#endif
template <class Epi, class Sched, bool GATHER, bool SP2 = PG8_SP2, bool F8 = false>
__device__ __forceinline__ void gemm_phase(LAS unsigned char* lds, const Gemm g, const Sched& S, const Epi& E) {
    const int tid = threadIdx.x, wid = __builtin_amdgcn_readfirstlane(tid >> 6), lane = tid & 63, wr = wid >> 2, wc = wid & 3, fr = lane & 15, fq = lane >> 4;
    const int K = g.K, nt = K / BK;
    unsigned voffA[2], voffB[2]; int Rr[2], Cc[2];
#pragma unroll
    for (int i = 0; i < 2; ++i) { int R, C; stage_rc(tid * 16 + i * 8192, R, C); const int Rb = Epi::PERM ? ((R & ~31) + perm32(R & 31)) : R;
        Rr[i] = R; Cc[i] = C; voffA[i] = (unsigned)(R * g.lda + C) * 2u; voffB[i] = (unsigned)(Rb * g.ldb + C) * 2u; }
    const size_t hstepA = (size_t)HALF * g.lda * 2, hstepB = (size_t)HALF * g.ldb * 2;
    const unsigned ldsw = (unsigned)wid * 1024u;
    const int aoff = lds_byte(wr * 64 + fr, fq * 8), boff = lds_byte(wc * 32 + fr, fq * 8);
#define PG8_SA(b, h) (((b) * 2 + (h)) * HTB)
#define PG8_SB(b, h) ((4 + (b) * 2 + (h)) * HTB)
#define PG8_GLDS(gp, lo) __builtin_amdgcn_global_load_lds((const unsigned*)(gp), (LAS unsigned*)(lds + (lo)), 16, 0, 0)
#define PG8_STAGE_B(bufoff, gbase, h) do { const char* _b = (const char*)(gbase) + (h) * hstepB; PG8_GLDS(_b + voffB[0], (bufoff) + ldsw); PG8_GLDS(_b + voffB[1], (bufoff) + ldsw + 8192); } while (0)
#define PG8_STAGE_A(bufoff, gbase, h, OFF) do { if constexpr (GATHER) { PG8_GLDS((const char*)(gbase) + OFF##h##0, (bufoff) + ldsw); PG8_GLDS((const char*)(gbase) + OFF##h##1, (bufoff) + ldsw + 8192); } \
        else { const char* _a = (const char*)(gbase) + (h) * hstepA; PG8_GLDS(_a + voffA[0], (bufoff) + ldsw); PG8_GLDS(_a + voffA[1], (bufoff) + ldsw + 8192); } } while (0)
#define PG8_LDA(dst, b, h) do { if constexpr (F8) { _Pragma("unroll") for (int m = 0; m < 4; ++m) { const v4i32 _lo = *(const LAS v4i32*)(lds + PG8_SA(b, h) + aoff + m * 2048), _hi = *(const LAS v4i32*)(lds + PG8_SA(b, h) + aoff + m * 2048 + 1024); \
            dst##8[m] = __builtin_shufflevector(_lo, _hi, 0, 1, 2, 3, 4, 5, 6, 7); } } \
        else { _Pragma("unroll") for (int m = 0; m < 4; ++m) _Pragma("unroll") for (int k = 0; k < 2; ++k) dst[m][k] = *(const LAS bf16x8*)(lds + PG8_SA(b, h) + aoff + m * 2048 + k * 1024); } } while (0)
#define PG8_LDB(dst, b, h) do { if constexpr (F8) { _Pragma("unroll") for (int n = 0; n < 2; ++n) { const v4i32 _lo = *(const LAS v4i32*)(lds + PG8_SB(b, h) + boff + n * 2048), _hi = *(const LAS v4i32*)(lds + PG8_SB(b, h) + boff + n * 2048 + 1024); \
            dst##8[n] = __builtin_shufflevector(_lo, _hi, 0, 1, 2, 3, 4, 5, 6, 7); } } \
        else { _Pragma("unroll") for (int n = 0; n < 2; ++n) _Pragma("unroll") for (int k = 0; k < 2; ++k) dst[n][k] = *(const LAS bf16x8*)(lds + PG8_SB(b, h) + boff + n * 2048 + k * 1024); } } while (0)
#define PG8_MMA(ai, bj, At, Bt) do { __builtin_amdgcn_s_setprio(1); \
        if constexpr (F8) { _Pragma("unroll") for (int m = 0; m < 4; ++m) _Pragma("unroll") for (int n = 0; n < 2; ++n) \
            asm volatile("v_mfma_scale_f32_16x16x128_f8f6f4 %0, %1, %2, %0, %3, %4 op_sel_hi:[0,0,0]" : "+v"(acc[ai][bj][m][n]) : "v"(Bt##8[n]), "v"(At##8[m]), "v"(f8sb), "v"(f8sa)); } \
        else { _Pragma("unroll") for (int m = 0; m < 4; ++m) _Pragma("unroll") for (int n = 0; n < 2; ++n) _Pragma("unroll") for (int k = 0; k < 2; ++k) \
            acc[ai][bj][m][n] = __builtin_amdgcn_mfma_f32_16x16x32_bf16(Bt[n][k], At[m][k], acc[ai][bj][m][n], 0, 0, 0); } \
        __builtin_amdgcn_s_setprio(0); } while (0)
#define PG8_WAIT_V(n) asm volatile("s_waitcnt vmcnt(" #n ")" ::: "memory")
#define PG8_WAIT_L(n) asm volatile("s_waitcnt lgkmcnt(" #n ")" ::: "memory")
#define PG8_BAR __builtin_amdgcn_s_barrier()
#define PG8_SCHED __builtin_amdgcn_sched_barrier(0)
    Unit cur, nxt; int ui = 0;
    if (!S.next(0, cur)) return;
    f32x4 acc[2][2][4][2];
#pragma unroll
    for (int a = 0; a < 2; ++a)
#pragma unroll
        for (int b = 0; b < 2; ++b)
#pragma unroll
            for (int m = 0; m < 4; ++m)
#pragma unroll
                for (int n = 0; n < 2; ++n) acc[a][b][m][n] = (f32x4){0.f, 0.f, 0.f, 0.f};
    bf16x8 At[4][2], B0[2][2], B1[2][2]; v8i32 At8[4], B08[2], B18[2];
    const int f8sa = g.sa, f8sb = g.sb;
    unsigned coff00 = 0u, coff01 = 0u, coff10 = 0u, coff11 = 0u, noff00 = 0u, noff01 = 0u, noff10 = 0u, noff11 = 0u;
    if constexpr (GATHER) {
        coff00 = S.a_off(cur, Rr[0]) + (unsigned)Cc[0] * 2u; coff01 = S.a_off(cur, Rr[1]) + (unsigned)Cc[1] * 2u;
        coff10 = S.a_off(cur, HALF + Rr[0]) + (unsigned)Cc[0] * 2u; coff11 = S.a_off(cur, HALF + Rr[1]) + (unsigned)Cc[1] * 2u;
    }
    { const char* cA = S.a_ptr(cur, 0); const char* cB = S.b_ptr(cur, 0); const char* cA1 = S.a_ptr(cur, 1); const char* cB1 = S.b_ptr(cur, 1);
    if constexpr (SP2) {
    PG8_STAGE_B(PG8_SB(0, 0), cB, 0); PG8_STAGE_B(PG8_SB(0, 1), cB, 1); PG8_STAGE_A(PG8_SA(0, 0), cA, 0, coff); PG8_STAGE_A(PG8_SA(0, 1), cA, 1, coff);
    if (wr == 1) PG8_BAR;
    PG8_WAIT_V(2); PG8_BAR;
    PG8_STAGE_B(PG8_SB(1, 0), cB1, 0); PG8_STAGE_A(PG8_SA(1, 0), cA1, 0, coff); PG8_STAGE_B(PG8_SB(1, 1), cB1, 1);
    PG8_WAIT_V(6); PG8_BAR;
    } else {
    PG8_STAGE_B(PG8_SB(0, 0), cB, 0); PG8_STAGE_A(PG8_SA(0, 0), cA, 0, coff); PG8_STAGE_B(PG8_SB(0, 1), cB, 1); PG8_STAGE_A(PG8_SA(0, 1), cA, 1, coff);
    if (wr == 1) PG8_BAR;
    PG8_WAIT_V(4); PG8_BAR;
    PG8_STAGE_B(PG8_SB(1, 0), cB1, 0); PG8_STAGE_A(PG8_SA(1, 0), cA1, 0, coff); PG8_STAGE_B(PG8_SB(1, 1), cB1, 1);
    PG8_WAIT_V(6); PG8_BAR; } }
    for (;;) {
        const bool has_next = S.next(ui + 1, nxt);
        Unit un; un.pm = has_next ? nxt.pm : cur.pm; un.pn = has_next ? nxt.pn : cur.pn; un.z = has_next ? nxt.z : cur.z;
        if constexpr (GATHER) {
            noff00 = has_next ? (S.a_off(nxt, Rr[0]) + (unsigned)Cc[0] * 2u) : coff00; noff01 = has_next ? (S.a_off(nxt, Rr[1]) + (unsigned)Cc[1] * 2u) : coff01;
            noff10 = has_next ? (S.a_off(nxt, HALF + Rr[0]) + (unsigned)Cc[0] * 2u) : coff10; noff11 = has_next ? (S.a_off(nxt, HALF + Rr[1]) + (unsigned)Cc[1] * 2u) : coff11;
        }
        for (int t = 0; t < nt; t += 2) {
            const bool last = (t == nt - 2);
            if constexpr (Epi::HOOK) { if (t == Epi::H1 || t == Epi::H2) { if constexpr (F8) asm volatile("s_nop 15\n\ts_nop 15\n\ts_nop 7" ::: "memory"); if (wr == 0) PG8_BAR; E.hook(acc, cur, t, wr, wc, fr, fq); if (wr == 1) PG8_BAR; } }
            const char* a1 = S.a_ptr(cur, t + 1);
            const char* a2 = last ? S.a_ptr(un, 0) : S.a_ptr(cur, t + 2); const char* b2 = last ? S.b_ptr(un, 0) : S.b_ptr(cur, t + 2);
            const char* a3 = last ? S.a_ptr(un, 1) : S.a_ptr(cur, t + 3); const char* b3 = last ? S.b_ptr(un, 1) : S.b_ptr(cur, t + 3);
            const unsigned o200 = last ? noff00 : coff00, o201 = last ? noff01 : coff01, o210 = last ? noff10 : coff10, o211 = last ? noff11 : coff11;
            if constexpr (SP2) {
            PG8_LDB(B0, 0, 0); PG8_LDB(B1, 0, 1); PG8_SCHED; PG8_LDA(At, 0, 0); PG8_STAGE_A(PG8_SA(1, 1), a1, 1, coff);
            PG8_WAIT_V(8); PG8_WAIT_L(0); PG8_BAR; PG8_MMA(0, 0, At, B0); PG8_MMA(0, 1, At, B1); PG8_BAR; PG8_SCHED;
            PG8_LDA(At, 0, 1); PG8_STAGE_B(PG8_SB(0, 0), b2, 0); PG8_STAGE_B(PG8_SB(0, 1), b2, 1); PG8_STAGE_A(PG8_SA(0, 0), a2, 0, o2);
            PG8_WAIT_V(8); PG8_WAIT_L(0); PG8_BAR; PG8_MMA(1, 0, At, B0); PG8_MMA(1, 1, At, B1); PG8_BAR; PG8_SCHED;
            PG8_LDB(B0, 1, 0); PG8_LDB(B1, 1, 1); PG8_SCHED; PG8_LDA(At, 1, 0); PG8_STAGE_A(PG8_SA(0, 1), a2, 1, o2);
            PG8_WAIT_V(8); PG8_WAIT_L(0); PG8_BAR; PG8_MMA(0, 0, At, B0); PG8_MMA(0, 1, At, B1); PG8_BAR; PG8_SCHED;
            PG8_LDA(At, 1, 1); PG8_STAGE_B(PG8_SB(1, 0), b3, 0); PG8_STAGE_B(PG8_SB(1, 1), b3, 1); PG8_STAGE_A(PG8_SA(1, 0), a3, 0, o2);
            PG8_WAIT_V(8); PG8_WAIT_L(0); PG8_BAR; PG8_MMA(1, 0, At, B0); PG8_MMA(1, 1, At, B1); PG8_BAR; PG8_SCHED;
            } else {
            PG8_LDB(B0, 0, 0); PG8_SCHED; PG8_LDA(At, 0, 0); PG8_STAGE_A(PG8_SA(1, 1), a1, 1, coff);
            PG8_WAIT_L(8); PG8_BAR; PG8_WAIT_L(0); PG8_MMA(0, 0, At, B0); PG8_BAR; PG8_SCHED;
            PG8_LDB(B1, 0, 1); PG8_STAGE_B(PG8_SB(0, 0), b2, 0);
            PG8_BAR; PG8_WAIT_L(0); PG8_MMA(0, 1, At, B1); PG8_BAR;
            PG8_LDA(At, 0, 1); PG8_STAGE_A(PG8_SA(0, 0), a2, 0, o2);
            PG8_BAR; PG8_WAIT_L(0); PG8_MMA(1, 0, At, B0); PG8_BAR; PG8_SCHED;
            PG8_STAGE_B(PG8_SB(0, 1), b2, 1);
            PG8_WAIT_V(6); PG8_BAR; PG8_MMA(1, 1, At, B1); PG8_BAR;
            PG8_LDB(B0, 1, 0); PG8_SCHED; PG8_LDA(At, 1, 0); PG8_STAGE_A(PG8_SA(0, 1), a2, 1, o2);
            PG8_WAIT_L(8); PG8_BAR; PG8_WAIT_L(0); PG8_MMA(0, 0, At, B0); PG8_BAR; PG8_SCHED;
            PG8_LDB(B1, 1, 1); PG8_STAGE_B(PG8_SB(1, 0), b3, 0);
            PG8_BAR; PG8_WAIT_L(0); PG8_MMA(0, 1, At, B1); PG8_BAR;
            PG8_LDA(At, 1, 1); PG8_STAGE_A(PG8_SA(1, 0), a3, 0, o2);
            PG8_BAR; PG8_WAIT_L(0); PG8_MMA(1, 0, At, B0); PG8_BAR; PG8_SCHED;
            PG8_STAGE_B(PG8_SB(1, 1), b3, 1);
            PG8_WAIT_V(6); PG8_BAR; PG8_MMA(1, 1, At, B1); PG8_BAR;
            }
        }
        if constexpr (F8) asm volatile("s_nop 15\n\ts_nop 15\n\ts_nop 7" ::: "memory");
        if (wr == 0) PG8_BAR;
        E(acc, cur, wr, wc, fr, fq);
        if (!has_next) break;
#pragma unroll
        for (int a = 0; a < 2; ++a)
#pragma unroll
            for (int b = 0; b < 2; ++b)
#pragma unroll
                for (int m = 0; m < 4; ++m)
#pragma unroll
                    for (int n = 0; n < 2; ++n) acc[a][b][m][n] = (f32x4){0.f, 0.f, 0.f, 0.f};
        cur = nxt; ++ui;
        if constexpr (GATHER) { coff00 = noff00; coff01 = noff01; coff10 = noff10; coff11 = noff11; }
        if (wr == 1) PG8_BAR;
    }
    PG8_WAIT_V(0);
    PG8_BAR;
#undef PG8_SA
#undef PG8_SB
#undef PG8_GLDS
#undef PG8_STAGE_A
#undef PG8_STAGE_B
#undef PG8_LDA
#undef PG8_LDB
#undef PG8_MMA
#undef PG8_WAIT_V
#undef PG8_WAIT_L
#undef PG8_BAR
#undef PG8_SCHED
}

struct SchedGrid {
    const char* A; const char* B; size_t zA, zB, tA, tB; int nM, nN, nz, G, c, rep;
    __device__ __forceinline__ bool next(int i, Unit& u) const {
        const int nwg = nz * nM * nN; const long L = (long)i * G + c; if (L >= (long)nwg * rep) return false;
        int w = (int)(L % nwg); { const int q = nwg / 8, r = nwg % 8, x = w % 8, off = w / 8; w = (x < r ? x * (q + 1) : r * (q + 1) + (x - r) * q) + off; }
        const int per = nM * nN; u.z = w / per; w -= u.z * per;
#ifdef PROBE_NOEPI
        if (L >= nwg) u.z |= 0x4000;
#endif
        const int nig = 8 * nN, gid = w / nig, fm = gid * 8, gsz = (nM - fm) < 8 ? (nM - fm) : 8;
        u.pm = fm + ((w % nig) % gsz); u.pn = (w % nig) / gsz; return true; }
    __device__ __forceinline__ const char* a_ptr(const Unit& u, int t) const { return A + (size_t)u.z * zA + (size_t)u.pm * tA + (size_t)t * 128; }
    __device__ __forceinline__ const char* b_ptr(const Unit& u, int t) const { return B + (size_t)u.z * zB + (size_t)u.pn * tB + (size_t)t * 128; }
    __device__ __forceinline__ unsigned a_off(const Unit&, int) const { return 0u; }
};
}

struct Args { const void* in[32]; float* out; unsigned char* ws; int ph_lo, ph_hi; };
struct Frame {
    LAS unsigned char* lds; int tid, lane, wave, G, c;
    unsigned char* ws; unsigned char* dout;
};
enum { I_X = 0, I_MEM, I_POS, I_GMIX, I_GMEM, I_WIN, I_LRE, I_LIM, I_LDT, I_BRE, I_BIM, I_CRE, I_CIM, I_DSKIP, I_WGLU, I_GQ, I_GK, I_GQM, I_GKM, I_WMEMKV,
       I_WUPS, I_WUPD, I_WUPM, I_WOUT, I_GFFN, I_WGROUP, I_BGROUP, I_WEXP, I_BEXP, I_WGATE, I_WUP, I_WDOWN };
#define INP(i) ((const float*)a.in[i])
#define WSP(T_, off) ((T_*)(F.ws + (off)))
#define DOP(T_, off) ((T_*)(F.dout + (off)))

using pg8::Unit;
__device__ __forceinline__ unsigned gpack4(const f32x4 v) {
    unsigned w = 0u;
#pragma unroll
    for (int j = 0; j < 4; ++j) { const float sg255 = __builtin_amdgcn_rcpf(__builtin_fmaf(__builtin_amdgcn_exp2f(v[j]), 1.0f / 255.0f, 1.0f / 255.0f)); w = __builtin_amdgcn_cvt_pk_u8_f32(sg255, j, w); }
    return w; }
__device__ __forceinline__ void gdecode(const u32x2 w, float (&g)[8]) {
#pragma unroll
    for (int j = 0; j < 4; ++j) { g[j] = fmaxf((float)((w.x >> (8 * j)) & 255u), 0.5f); g[4 + j] = fmaxf((float)((w.y >> (8 * j)) & 255u), 0.5f); } }
struct EpiInProj {
    static constexpr bool PERM = true, HOOK = false;
    bf16_t *UA, *Y3; unsigned char* SG;
    __device__ __forceinline__ void operator()(const f32x4 (&acc)[2][2][4][2], const Unit& u, int wr, int wc, int fr, int fq) const {
        const int pn = u.pn, row0 = u.pm * 256 + wr * 64 + fr, cw = wc * 32 + 8 * fq;
#pragma unroll
        for (int ai = 0; ai < 2; ++ai)
#pragma unroll
            for (int m = 0; m < 4; ++m) {
                const int r = row0 + ai * 128 + m * 16;
#pragma unroll
                for (int bj = 0; bj < 2; ++bj) {
                    const int c = bj * 128 + cw;
                    if (pn >= 6) {
                        u32x2 w; w.x = gpack4(acc[ai][bj][m][0]); w.y = gpack4(acc[ai][bj][m][1]);
                        *(u32x2*)(SG + (size_t)r * 3072 + (pn - 6) * 256 + c) = w;
                    } else {
                        bf16_t* p;
                        if (pn < 2) { const int cc = pn * 256 + c, gI = cc >> 4, h0 = cc & 15, b = r >> 11, s = r & 2047;
                            p = UA + ((size_t)(gI * 2048 + b * 64 + (s >> 5)) * 640 + (s & 31) * 16 + h0); }
                        else p = Y3 + (size_t)r * Y3LD + (pn - 2) * 256 + c;
                        *(u32x4*)p = pack8(acc[ai][bj][m][0], acc[ai][bj][m][1]);
                    }
                }
            }
    }
};
struct EpiInProjB {
    static constexpr bool PERM = true, HOOK = false;
    bf16_t *KVX, *QI;
    __device__ __forceinline__ void operator()(const f32x4 (&acc)[2][2][4][2], const Unit& u, int wr, int wc, int fr, int fq) const {
        const int row0 = u.pm * 256 + wr * 64 + fr, cw = wc * 32 + 8 * fq; bf16_t* base = u.pn == 0 ? KVX : QI;
#pragma unroll
        for (int ai = 0; ai < 2; ++ai)
#pragma unroll
            for (int m = 0; m < 4; ++m)
#pragma unroll
                for (int bj = 0; bj < 2; ++bj)
                    *(u32x4*)(base + (size_t)(row0 + ai * 128 + m * 16) * 256 + bj * 128 + cw) = pack8(acc[ai][bj][m][0], acc[ai][bj][m][1]);
    }
};
struct EpiBf16 {
    static constexpr bool PERM = true, HOOK = false;
    bf16_t* O; int ld;
    __device__ __forceinline__ void operator()(const f32x4 (&acc)[2][2][4][2], const Unit& u, int wr, int wc, int fr, int fq) const {
        const int row0 = u.pm * 256 + wr * 64 + fr, col0 = u.pn * 256 + wc * 32 + 8 * fq;
#pragma unroll
        for (int ai = 0; ai < 2; ++ai)
#pragma unroll
            for (int m = 0; m < 4; ++m)
#pragma unroll
                for (int bj = 0; bj < 2; ++bj)
                    *(u32x4*)(O + (size_t)(row0 + ai * 128 + m * 16) * ld + col0 + bj * 128) = pack8(acc[ai][bj][m][0], acc[ai][bj][m][1]);
    }
};
struct EpiSc {
    static constexpr bool PERM = false, HOOK = false;
    float* SC;
    __device__ __forceinline__ void operator()(const f32x4 (&acc)[2][2][4][2], const Unit& u, int wr, int wc, int fr, int fq) const {
        const int row0 = u.pm * 256 + wr * 64 + fr, col0 = wc * 32 + 4 * fq;
#pragma unroll
        for (int ai = 0; ai < 2; ++ai)
#pragma unroll
            for (int m = 0; m < 4; ++m)
#pragma unroll
                for (int n = 0; n < 2; ++n)
                    *(f32x4*)(SC + ((size_t)u.z * 2048 + row0 + ai * 128 + m * 16) * 128 + col0 + n * 16) = acc[ai][0][m][n];
    }
};
struct EpiGelu {
    static constexpr bool PERM = true, HOOK = false;
    bf16_t* YG;
    __device__ __forceinline__ void operator()(const f32x4 (&acc)[2][2][4][2], const Unit& u, int wr, int wc, int fr, int fq) const {
        const int row0 = u.pm * 256 + wr * 64 + fr, col0 = u.pn * 256 + wc * 32 + 8 * fq;
#pragma unroll
        for (int ai = 0; ai < 2; ++ai)
#pragma unroll
            for (int m = 0; m < 4; ++m) {
                const int row = row0 + ai * 128 + m * 16;
#pragma unroll
                for (int bj = 0; bj < 2; ++bj) {
                    const int n8 = col0 + bj * 128, i = n8 >> 4, ho = n8 & 15;
                    f32x4 v0 = acc[ai][bj][m][0], v1 = acc[ai][bj][m][1];
#pragma unroll
                    for (int j = 0; j < 4; ++j) { v0[j] = gelu_tanh(v0[j]); v1[j] = gelu_tanh(v1[j]); }
                    *(u32x4*)(YG + ((size_t)row * 32 + i) * 512 + u.z * 16 + ho) = pack8(v0, v1);
                }
            }
    }
};
struct EpiGlu {
    static constexpr bool PERM = true, HOOK = false;
    const bf16_t* YG; unsigned char* YS8;
    __device__ __forceinline__ void operator()(const f32x4 (&acc)[2][2][4][2], const Unit& u, int wr, int wc, int fr, int fq) const {
        const int row0 = u.pm * 256 + wr * 64 + fr, col0 = u.pn * 256 + wc * 32 + 8 * fq;
        u32x4 yv[2][4][2];
#pragma unroll
        for (int ai = 0; ai < 2; ++ai)
#pragma unroll
            for (int m = 0; m < 4; ++m)
#pragma unroll
                for (int bj = 0; bj < 2; ++bj) yv[ai][m][bj] = *(const u32x4*)(YG + (size_t)(row0 + ai * 128 + m * 16) * 512 + col0 + bj * 128);
#pragma unroll
        for (int ai = 0; ai < 2; ++ai)
#pragma unroll
            for (int m = 0; m < 4; ++m)
#pragma unroll
                for (int bj = 0; bj < 2; ++bj) {
                    const int r = row0 + ai * 128 + m * 16, c = col0 + bj * 128;
                    f32x4 y0, y1; unpack8(yv[ai][m][bj], y0, y1);
                    f32x4 v0 = acc[ai][bj][m][0], v1 = acc[ai][bj][m][1];
#pragma unroll
                    for (int j = 0; j < 4; ++j) { v0[j] = y0[j] * sigm(v0[j]) * 16.0f; v1[j] = y1[j] * sigm(v1[j]) * 16.0f; }
                    u32x2 w8; w8.x = pack_fp8x4(v0[0], v0[1], v0[2], v0[3]); w8.y = pack_fp8x4(v1[0], v1[1], v1[2], v1[3]);
                    *(u32x2*)(YS8 + (size_t)r * 512 + c) = w8;
                }
    }
};
struct EpiMerge {
    static constexpr bool PERM = true, HOOK = true; static constexpr int H1 = 4, H2 = 8;
    const unsigned char* SG; unsigned char* MG;
    __device__ __forceinline__ void hook(f32x4 (&acc)[2][2][4][2], const Unit& u, int t, int wr, int wc, int fr, int fq) const {
        int row0 = u.pm * 256 + wr * 64 + fr, col0 = u.pn * 256 + wc * 32 + 8 * fq; const int br = (t >> 2) - 1;
        asm volatile("" : "+v"(row0), "+v"(col0));
        u32x2 wa[2][4][2], wb[2][4][2];
#pragma unroll
        for (int ai = 0; ai < 2; ++ai)
#pragma unroll
            for (int m = 0; m < 4; ++m)
#pragma unroll
                for (int bj = 0; bj < 2; ++bj) { const unsigned char* gp = SG + (size_t)(row0 + ai * 128 + m * 16) * 3072 + br * 1024 + col0 + bj * 128;
                    wa[ai][m][bj] = *(const u32x2*)gp; wb[ai][m][bj] = *(const u32x2*)(gp + 1024); }
#pragma unroll
        for (int ai = 0; ai < 2; ++ai)
#pragma unroll
            for (int m = 0; m < 4; ++m)
#pragma unroll
                for (int bj = 0; bj < 2; ++bj) {
                    float ga[8], gb[8]; gdecode(wa[ai][m][bj], ga); gdecode(wb[ai][m][bj], gb);
#pragma unroll
                    for (int j = 0; j < 4; ++j) { acc[ai][bj][m][0][j] *= ga[j] * __builtin_amdgcn_rcpf(gb[j]); acc[ai][bj][m][1][j] *= ga[4 + j] * __builtin_amdgcn_rcpf(gb[4 + j]); }
                }
    }
    __device__ __forceinline__ void operator()(const f32x4 (&acc)[2][2][4][2], const Unit& u, int wr, int wc, int fr, int fq) const {
        const int row0 = u.pm * 256 + wr * 64 + fr, col0 = u.pn * 256 + wc * 32 + 8 * fq;
        u32x2 wg[2][4][2];
#pragma unroll
        for (int ai = 0; ai < 2; ++ai)
#pragma unroll
            for (int m = 0; m < 4; ++m)
#pragma unroll
                for (int bj = 0; bj < 2; ++bj) wg[ai][m][bj] = *(const u32x2*)(SG + (size_t)(row0 + ai * 128 + m * 16) * 3072 + 2048 + col0 + bj * 128);
#pragma unroll
        for (int ai = 0; ai < 2; ++ai)
#pragma unroll
            for (int m = 0; m < 4; ++m)
#pragma unroll
                for (int bj = 0; bj < 2; ++bj) {
                    const int r = row0 + ai * 128 + m * 16, c = col0 + bj * 128;
                    float g2[8]; gdecode(wg[ai][m][bj], g2);
                    f32x4 v0 = acc[ai][bj][m][0], v1 = acc[ai][bj][m][1];
#pragma unroll
                    for (int j = 0; j < 4; ++j) { v0[j] *= g2[j] * (8.0f / 255.0f); v1[j] *= g2[4 + j] * (8.0f / 255.0f); }
                    u32x2 w8; w8.x = pack_fp8x4(v0[0], v0[1], v0[2], v0[3]); w8.y = pack_fp8x4(v1[0], v1[1], v1[2], v1[3]);
                    *(u32x2*)(MG + (size_t)r * 1024 + c) = w8;
                }
    }
};
struct EpiOut {
    static constexpr bool PERM = true, HOOK = false;
    const float* X; bf16_t* X1B; unsigned char* X1B8;
    __device__ __forceinline__ void operator()(const f32x4 (&acc)[2][2][4][2], const Unit& u, int wr, int wc, int fr, int fq) const {
        const int row0 = u.pm * 256 + wr * 64 + fr, col0 = u.pn * 256 + wc * 32 + 8 * fq;
#pragma unroll
        for (int ai = 0; ai < 2; ++ai) {
            f32x4 xv[4][2][2];
#pragma unroll
            for (int m = 0; m < 4; ++m)
#pragma unroll
                for (int bj = 0; bj < 2; ++bj) { const float* xp = X + (size_t)(row0 + ai * 128 + m * 16) * 1024 + col0 + bj * 128; xv[m][bj][0] = __builtin_nontemporal_load((const f32x4*)xp); xv[m][bj][1] = __builtin_nontemporal_load((const f32x4*)(xp + 4)); }
#pragma unroll
            for (int m = 0; m < 4; ++m)
#pragma unroll
                for (int bj = 0; bj < 2; ++bj)
                { const f32x4 v0 = xv[m][bj][0] + acc[ai][bj][m][0], v1 = xv[m][bj][1] + acc[ai][bj][m][1]; const size_t o = (size_t)(row0 + ai * 128 + m * 16) * 1024 + col0 + bj * 128;
                    *(u32x4*)(X1B + o) = pack8(v0, v1);
                    u32x2 w8; w8.x = pack_fp8x4(v0[0], v0[1], v0[2], v0[3]); w8.y = pack_fp8x4(v1[0], v1[1], v1[2], v1[3]); *(u32x2*)(X1B8 + o) = w8; }
        }
    }
};

constexpr int MI_CNT = 16, MI_PRE = 160, MI_TILE = 320, MI_PT = 960;
struct SchedMoE1 {
    const char* A; const char* W; LAS const int* misc; const int* tok; int ntile4, G, c, rep;
    __device__ __forceinline__ bool next(int i, Unit& u) const {
        long L = (long)i * G + c; if (L >= (long)ntile4 * rep) return false; L %= ntile4;
        const int e = misc[MI_TILE + (int)(L >> 2)]; u.z = e & 255; u.pm = e >> 8; u.pn = (int)(L & 3); return true; }
    __device__ __forceinline__ const char* a_ptr(const Unit&, int t) const { return A + (size_t)t * 128; }
    __device__ __forceinline__ const char* b_ptr(const Unit& u, int t) const { return W + (size_t)u.z * (1024 * 1024) + (size_t)u.pn * (256 * 1024) + (size_t)t * 128; }
    __device__ __forceinline__ unsigned a_off(const Unit& u, int r) const {
        int pos = u.pm * 256 + r; const int n = misc[MI_CNT + u.z]; pos = pos < n ? pos : 0;
        return (unsigned)(tok[(size_t)u.z * 65536 + pos] & 0x7fffffff) * 1024u; }
};
struct EpiMoe1 {
    static constexpr bool PERM = true, HOOK = false;
    LAS const int* misc; const int* tok; const float2* rw; unsigned char* HID;
    __device__ __forceinline__ void operator()(const f32x4 (&acc)[2][2][4][2], const Unit& u, int wr, int wc, int fr, int fq) const {
        const int l = u.z, n = misc[MI_CNT + l], col = u.pn * 128 + wc * 32 + 8 * fq;
        unsigned tk[2][4]; float2 qv[2][4];
#pragma unroll
        for (int ai = 0; ai < 2; ++ai)
#pragma unroll
            for (int m = 0; m < 4; ++m) { int pos = u.pm * 256 + ai * 128 + wr * 64 + m * 16 + fr; pos = pos < n ? pos : 0;
                tk[ai][m] = (unsigned)tok[(size_t)l * 65536 + pos]; qv[ai][m] = rw[(size_t)l * 65536 + pos]; }
#pragma unroll
        for (int ai = 0; ai < 2; ++ai)
#pragma unroll
            for (int m = 0; m < 4; ++m) {
                const int pos = u.pm * 256 + ai * 128 + wr * 64 + m * 16 + fr;
                if (pos < n) {
                    const float2 q = qv[ai][m];
                    f32x4 v0, v1;
#pragma unroll
                    for (int j = 0; j < 4; ++j) {
                        const float g0 = acc[ai][0][m][0][j] * q.x, u0 = acc[ai][1][m][0][j] * q.x, g1 = acc[ai][0][m][1][j] * q.x, u1 = acc[ai][1][m][1][j] * q.x;
                        v0[j] = g0 * sigm(g0) * u0 * (q.y * 16.0f); v1[j] = g1 * sigm(g1) * u1 * (q.y * 16.0f); }
                    u32x2 w8; w8.x = pack_fp8x4(v0[0], v0[1], v0[2], v0[3]); w8.y = pack_fp8x4(v1[0], v1[1], v1[2], v1[3]);
                    *(u32x2*)(HID + ((size_t)(tk[ai][m] & 0x7fffffffu) * 2 + (tk[ai][m] >> 31)) * 512 + col) = w8;
                }
            }
    }
};
struct SchedMoE2 {
    const char* A; const char* W; LAS const int* misc; const int* tok; int ntile4, G, c, rep;
    __device__ __forceinline__ bool next(int i, Unit& u) const {
        long L = (long)i * G + c; if (L >= (long)ntile4 * rep) return false; L %= ntile4;
        const int e = misc[MI_TILE + (int)(L >> 2)], l = e & 255, gi = l / 28, pt = misc[MI_PT + (l - gi * 28)];
        u.z = l | ((gi * 8 + (pt & 15)) << 8) | ((gi * 8 + (pt >> 4)) << 16); u.pm = e >> 8; u.pn = (int)(L & 3); return true; }
    __device__ __forceinline__ const char* a_ptr(const Unit&, int t) const { return A + (size_t)t * 128; }
    __device__ __forceinline__ const char* b_ptr(const Unit& u, int t) const {
        const int e = t < 4 ? ((u.z >> 8) & 255) : (u.z >> 16), tt = t < 4 ? t : t - 4;
        return W + (size_t)e * (1024 * 512) + (size_t)u.pn * (256 * 512) + (size_t)tt * 128; }
    __device__ __forceinline__ unsigned a_off(const Unit& u, int r) const {
        const int l = u.z & 255; int pos = u.pm * 256 + r; const int n = misc[MI_CNT + l]; pos = pos < n ? pos : 0;
        return (unsigned)tok[(size_t)l * 65536 + pos] * 1024u; }
};
struct EpiMoe2 {
    static constexpr bool PERM = false, HOOK = false;
    LAS const int* misc; const int* tok; const bf16_t* X1B; float* O;
    __device__ __forceinline__ void operator()(const f32x4 (&acc)[2][2][4][2], const Unit& u, int wr, int wc, int fr, int fq) const {
        const int l = u.z & 255, n = misc[MI_CNT + l], col0 = u.pn * 256 + wc * 32 + 4 * fq;
        int tk[2][4];
#pragma unroll
        for (int ai = 0; ai < 2; ++ai)
#pragma unroll
            for (int m = 0; m < 4; ++m) { int pos = u.pm * 256 + ai * 128 + wr * 64 + m * 16 + fr; pos = pos < n ? pos : 0; tk[ai][m] = tok[(size_t)l * 65536 + pos]; }
#pragma unroll
        for (int ai = 0; ai < 2; ++ai) {
            u32x2 xb[4][2][2];
#pragma unroll
            for (int m = 0; m < 4; ++m)
#pragma unroll
                for (int bj = 0; bj < 2; ++bj)
#pragma unroll
                    for (int nn = 0; nn < 2; ++nn) xb[m][bj][nn] = *(const u32x2*)(X1B + (size_t)tk[ai][m] * 1024 + col0 + bj * 128 + nn * 16);
#pragma unroll
            for (int m = 0; m < 4; ++m) {
                const int pos = u.pm * 256 + ai * 128 + wr * 64 + m * 16 + fr;
                if (pos < n) {
#pragma unroll
                    for (int bj = 0; bj < 2; ++bj)
#pragma unroll
                        for (int nn = 0; nn < 2; ++nn) { const u32x2 x = xb[m][bj][nn];
                            const f32x4 xv = (f32x4){bf2f(x.x & 0xffffu), bf2f(x.x >> 16), bf2f(x.y & 0xffffu), bf2f(x.y >> 16)};
                            __builtin_nontemporal_store(xv + acc[ai][bj][m][nn], (f32x4*)(O + (size_t)tk[ai][m] * 1024 + col0 + bj * 128 + nn * 16)); }
                }
            }
        }
    }
};
struct SchedMerge3 {
    const char* Y; const char* W; int G, c, rep;
    __device__ __forceinline__ bool next(int i, Unit& u) const {
        const int nwg = 1024; const long L = (long)i * G + c; if (L >= (long)nwg * rep) return false;
        int w = (int)(L % nwg); { const int q = nwg / 8, x = w % 8, off = w / 8; w = x * q + off; }
        const int nig = 8 * 4, gid = w / nig, fm = gid * 8;
        u.pm = fm + ((w % nig) % 8); u.pn = (w % nig) / 8; u.z = 0; return true; }
    __device__ __forceinline__ const char* a_ptr(const Unit& u, int t) const { return Y + (size_t)(t >> 2) * ((size_t)T * 512) + (size_t)u.pm * (256 * 512) + (size_t)(t & 3) * 128; }
    __device__ __forceinline__ const char* b_ptr(const Unit& u, int t) const { return W + (size_t)u.pn * (256 * 1536) + (size_t)t * 128; }
    __device__ __forceinline__ unsigned a_off(const Unit&, int) const { return 0u; }
};

__device__ __forceinline__ void rms_rows_bf16(const float* x, const float* g, bf16_t* out, unsigned char* out8, int nrows, int gw, int nw, int lane) {
    float4 gg[4];
#pragma unroll
    for (int i = 0; i < 4; ++i) gg[i] = ((const float4*)g)[lane + 64 * i];
#pragma unroll 1
    for (int r0 = gw; r0 < nrows; r0 += 2 * nw) {
        const int r1 = r0 + nw < nrows ? r0 + nw : r0;
        const float4* xa = (const float4*)(x + (size_t)r0 * 1024); const float4* xb = (const float4*)(x + (size_t)r1 * 1024);
        float4 va[4], vb[4]; float sa = 0.f, sb = 0.f;
#pragma unroll
        for (int i = 0; i < 4; ++i) { const f32x4 ta = __builtin_nontemporal_load((const f32x4*)xa + lane + 64 * i), tb = __builtin_nontemporal_load((const f32x4*)xb + lane + 64 * i);
            va[i] = make_float4(ta[0], ta[1], ta[2], ta[3]); vb[i] = make_float4(tb[0], tb[1], tb[2], tb[3]); }
#pragma unroll
        for (int i = 0; i < 4; ++i) { sa += va[i].x * va[i].x + va[i].y * va[i].y + va[i].z * va[i].z + va[i].w * va[i].w; sb += vb[i].x * vb[i].x + vb[i].y * vb[i].y + vb[i].z * vb[i].z + vb[i].w * vb[i].w; }
        sa = wave_sum(sa); sb = wave_sum(sb);
        const float ra = rsqrtf(sa * (1.0f / 1024.0f) + 1e-6f), rb = rsqrtf(sb * (1.0f / 1024.0f) + 1e-6f);
#pragma unroll
        for (int i = 0; i < 4; ++i) {
            u32x2 w; w.x = cvt_pk_bf16(va[i].x * ra * gg[i].x, va[i].y * ra * gg[i].y); w.y = cvt_pk_bf16(va[i].z * ra * gg[i].z, va[i].w * ra * gg[i].w);
            if (out) *(u32x2*)(out + (size_t)r0 * 1024 + (lane + 64 * i) * 4) = w;
            if (out8) *(unsigned*)(out8 + (size_t)r0 * 1024 + (lane + 64 * i) * 4) = pack_fp8x4(va[i].x * ra * gg[i].x, va[i].y * ra * gg[i].y, va[i].z * ra * gg[i].z, va[i].w * ra * gg[i].w);
            if (r1 != r0) { u32x2 z; z.x = cvt_pk_bf16(vb[i].x * rb * gg[i].x, vb[i].y * rb * gg[i].y); z.y = cvt_pk_bf16(vb[i].z * rb * gg[i].z, vb[i].w * rb * gg[i].w);
                if (out) *(u32x2*)(out + (size_t)r1 * 1024 + (lane + 64 * i) * 4) = z;
                if (out8) *(unsigned*)(out8 + (size_t)r1 * 1024 + (lane + 64 * i) * 4) = pack_fp8x4(vb[i].x * rb * gg[i].x, vb[i].y * rb * gg[i].y, vb[i].z * rb * gg[i].z, vb[i].w * rb * gg[i].w); }
        }
    }
}
__device__ __forceinline__ void tr_tile(LAS float* tl, const float* src, int ldsrc, int nvalid, const float* ks, float tsc, bf16_t* dst, unsigned char* dst8, int ldd, int lane) {
    const int r = lane >> 4, c4 = (lane & 15) * 4;
    float4 v[16];
#pragma unroll
    for (int p = 0; p < 16; ++p) { const int k = r + 4 * p; v[p] = make_float4(0.f, 0.f, 0.f, 0.f); if (c4 < nvalid) { const f32x4 tv = __builtin_nontemporal_load((const f32x4*)(src + (size_t)k * ldsrc + c4)); v[p] = make_float4(tv[0], tv[1], tv[2], tv[3]); } }
#pragma unroll
    for (int p = 0; p < 16; ++p) { const int k = r + 4 * p; float4 w = v[p];
        { const float sc = ks ? ks[k] * tsc : tsc; w.x *= sc; w.y *= sc; w.z *= sc; w.w *= sc; }
        tl[k * 65 + c4] = w.x; tl[k * 65 + c4 + 1] = w.y; tl[k * 65 + c4 + 2] = w.z; tl[k * 65 + c4 + 3] = w.w; }
    const int kq = lane & 7;
#pragma unroll
    for (int p = 0; p < 8; ++p) { const int n = (lane >> 3) + 8 * p; float f[8];
#pragma unroll
        for (int j = 0; j < 8; ++j) f[j] = tl[(kq * 8 + j) * 65 + n];
        if (dst8) { u32x2 w8; w8.x = pack_fp8x4(f[0], f[1], f[2], f[3]); w8.y = pack_fp8x4(f[4], f[5], f[6], f[7]); *(u32x2*)(dst8 + (size_t)n * ldd + kq * 8) = w8; }
        else { u32x4 w; w.x = cvt_pk_bf16(f[0], f[1]); w.y = cvt_pk_bf16(f[2], f[3]); w.z = cvt_pk_bf16(f[4], f[5]); w.w = cvt_pk_bf16(f[6], f[7]);
            *(u32x4*)(dst + (size_t)n * ldd + kq * 8) = w; } }
}
struct cf { float re, im; };
__device__ __forceinline__ cf cmul(cf a, cf b) { return cf{a.re * b.re - a.im * b.im, a.re * b.im + a.im * b.re}; }
__device__ __forceinline__ cf lam_pow(const Args& a, int g, int p, float e) {
    const float lre = INP(I_LRE)[g * 64 + p], lim = INP(I_LIM)[g * 64 + p], dt = __expf(INP(I_LDT)[g]);
    const float mag = __expf(lre * dt * e);
    const double rev = (double)lim * (double)dt * (double)e * 0.15915494309189535; const float fr = (float)(rev - rint(rev));
    return cf{mag * __builtin_amdgcn_cosf(fr), mag * __builtin_amdgcn_sinf(fr)};
}
__device__ __forceinline__ cf bbar_of(const Args& a, int g, int p, int h) {
    const float lre = INP(I_LRE)[g * 64 + p], lim = INP(I_LIM)[g * 64 + p];
    const cf lb = lam_pow(a, g, p, 1.0f); const cf num = cf{lb.re - 1.0f, lb.im};
    const float inv = 1.0f / (lre * lre + lim * lim);
    const cf q = cf{(num.re * lre + num.im * lim) * inv, (num.im * lre - num.re * lim) * inv};
    return cmul(q, cf{INP(I_BRE)[(g * 64 + p) * 16 + h], INP(I_BIM)[(g * 64 + p) * 16 + h]});
}
__device__ __forceinline__ void p0_prep(const Frame& F, const Args& a) {
    const int gw = F.c * 8 + F.wave, nw = F.G * 8;
    rms_rows_bf16(INP(I_X), INP(I_GMIX), WSP(bf16_t, WS_HB), WSP(unsigned char, WS_HB8), T, gw, nw, F.lane);
    rms_rows_bf16(INP(I_MEM), INP(I_GMEM), nullptr, WSP(unsigned char, WS_MEMN), 8192, gw, nw, F.lane);
    LAS float* tl = (LAS float*)F.lds + F.wave * (64 * 65);
    constexpr int NT_WIN = 80 * 16, NT_WMEM = 256, NT_WGLU = 64, NT_WUP = 384, NT_WOUT = 256, NT_E = 4096;
    constexpr int O1 = NT_WIN, O2 = O1 + NT_WMEM, O3 = O2 + NT_WGLU, O4 = O3 + NT_WUP, O5 = O4 + NT_WOUT, O6 = O5 + NT_E, O7 = O6 + NT_E, O8 = O7 + NT_E;
    for (int ti = gw; ti < O8; ti += nw) {
        const float* src; int ldsrc, nvalid = 64, ldd; const float* ks = nullptr; bf16_t* dst = nullptr; unsigned char* dst8 = nullptr; float tsc = 1.0f;
        if (ti < O1) { const int nt = ti / 16, kt = ti % 16, n0 = nt * 64; int sc;
            if (n0 < 1152) sc = n0;
            else if (n0 == 1152) sc = 1408;
            else if (n0 == 1216) { sc = 1472; nvalid = 4; }
            else if (n0 < 1280) { sc = 0; nvalid = 0; }
            else if (n0 < 1536) sc = 1152 + (n0 - 1280);
            else if (n0 < 2048) sc = 1476 + (n0 - 1536);
            else { sc = 1988 + (n0 - 2048); tsc = -1.4426950408889634f; }
            src = INP(I_WIN) + (size_t)kt * 64 * 5060 + sc; ldsrc = 5060; ldd = 1024;
            if (n0 >= 1024 && n0 < 1536) dst = WSP(bf16_t, WS_WIN) + (size_t)(n0 - 1024) * 1024 + kt * 64;
            else { const int r8 = n0 < 1024 ? n0 : (n0 < 2048 ? n0 - 512 : n0 - 512); dst8 = WSP(unsigned char, WS_WG8) + (size_t)r8 * 1024 + kt * 64; tsc *= 32.0f; } }
        else if (ti < O2) { const int t = ti - O1, nt = t / 16, kt = t % 16; src = INP(I_WMEMKV) + (size_t)kt * 64 * 1024 + nt * 64; ldsrc = 1024; tsc = 32.0f; dst8 = WSP(unsigned char, WS_WMEM) + (size_t)nt * 64 * 1024 + kt * 64; ldd = 1024; }
        else if (ti < O3) { const int t = ti - O2, nt = t / 8, kt = t % 8; src = INP(I_WGLU) + (size_t)kt * 64 * 512 + nt * 64; ldsrc = 512; dst = WSP(bf16_t, WS_WGLU) + (size_t)nt * 64 * 512 + kt * 64; ldd = 512; }
        else if (ti < O4) { const int t = ti - O3, br = t / 128, tt = t % 128, nt = tt / 8, kt = tt % 8; const float* w = br == 0 ? INP(I_WUPS) : (br == 1 ? INP(I_WUPD) : INP(I_WUPM));
            src = w + (size_t)kt * 64 * 1024 + nt * 64; ldsrc = 1024; tsc = 32.0f; dst8 = WSP(unsigned char, WS_WUP) + (size_t)nt * 64 * 1536 + br * 512 + kt * 64; ldd = 1536; }
        else if (ti < O5) { const int t = ti - O4, nt = t / 16, kt = t % 16; src = INP(I_WOUT) + (size_t)kt * 64 * 1024 + nt * 64; ldsrc = 1024; tsc = 32.0f; dst8 = WSP(unsigned char, WS_WOUT) + (size_t)nt * 64 * 1024 + kt * 64; ldd = 1024; }
        else if (ti < O7) { const int up = ti >= O6, t = ti - (up ? O6 : O5), e = t / 128, tt = t % 128, nt = tt / 16, kt = tt % 16, j0 = nt * 64;
            src = (up ? INP(I_WUP) : INP(I_WGATE)) + (size_t)e * 1024 * 512 + (size_t)kt * 64 * 512 + j0; ldsrc = 512; ks = INP(I_GFFN) + kt * 64; tsc = 32.0f;
            dst8 = WSP(unsigned char, WS_WGU) + (size_t)e * 1024 * 1024 + (size_t)((j0 >> 7) * 256 + up * 128 + (j0 & 127)) * 1024 + kt * 64; ldd = 1024; }
        else { const int t = ti - O7, e = t / 128, tt = t % 128, nt = tt / 8, kt = tt % 8;
            src = INP(I_WDOWN) + (size_t)e * 512 * 1024 + (size_t)kt * 64 * 1024 + nt * 64; ldsrc = 1024; tsc = 32.0f;
            dst8 = WSP(unsigned char, WS_WD) + (size_t)e * 1024 * 512 + (size_t)nt * 64 * 512 + kt * 64; ldd = 512; }
        tr_tile(tl, src, ldsrc, nvalid, ks, tsc, dst, dst8, ldd, F.lane);
    }
    const int gt = F.c * NTHR + F.tid, NTT = F.G * NTHR;
    for (int id = gt; id < 2048 * 33; id += NTT) { const int gp = id / 33, e = id - gp * 33; const cf z = lam_pow(a, gp >> 6, gp & 63, (float)e); WSP(float2, WS_LP)[id] = make_float2(z.re, z.im);
        if (e == 32) { WSP(float, WS_LAM32)[gp * 2] = z.re; WSP(float, WS_LAM32)[gp * 2 + 1] = z.im; } }
    for (int id = gt; id < 2048 * 16; id += NTT) { const int gp = id >> 4, h = id & 15; const cf z = bbar_of(a, gp >> 6, gp & 63, h); WSP(float2, WS_BB)[id] = make_float2(z.re, z.im); }
    for (int id = gt; id < 48 * 1024; id += NTT) { const int n = id >> 10, k = id & 1023;
        const float v = n < 4 ? INP(I_WGROUP)[k * 4 + n] : (n < 36 ? INP(I_WEXP)[k * 32 + (n - 4)] : 0.f);
        WSP(bf16_t, WS_WR)[id] = f2bf(v * INP(I_GFFN)[k]); }
}

__device__ __forceinline__ void p1_tables(const Frame& F, const Args& a, int wgi, int wgn) {
    const int gt = wgi * NTHR + F.tid, NTT = wgn * NTHR;
    bf16_t* TW = WSP(bf16_t, WS_TW); bf16_t* SIN = WSP(bf16_t, WS_SIN); const float2* LP = WSP(float2, WS_LP); const float2* BB = WSP(float2, WS_BB);
    for (int id = gt; id < 32 * 32 * 256; id += NTT) {
        const int hi = id & 15, ho = (id >> 4) & 15, d = (id >> 8) & 31, g = id >> 13;
        float val = 0.f;
        for (int p = 0; p < 64; ++p) { const float2 ez = LP[(g * 64 + p) * 33 + d], bb = BB[(g * 64 + p) * 16 + hi];
            const float cr = INP(I_CRE)[(g * 16 + ho) * 64 + p], ci = INP(I_CIM)[(g * 16 + ho) * 64 + p];
            const float tr = cr * ez.x - ci * ez.y, ti = cr * ez.y + ci * ez.x; val += tr * bb.x - ti * bb.y; }
        if (d == 0 && ho == hi) val += INP(I_DSKIP)[g * 16 + ho];
        const bf16_t bv = f2bf(val); bf16_t* tg = TW + (size_t)g * 512 * 640;
        for (int i = d; i < 32; ++i) { tg[(size_t)(i * 16 + ho) * 640 + (i - d) * 16 + hi] = bv; if (d > 0) tg[(size_t)((i - d) * 16 + ho) * 640 + i * 16 + hi] = 0; }
    }
    for (int id = gt; id < 32 * 32 * 16 * 64; id += NTT) {
        const int p = id & 63, ho = (id >> 6) & 15, i = (id >> 10) & 31, g = id >> 15;
        const float2 ez = LP[(g * 64 + p) * 33 + i + 1]; const float cr = INP(I_CRE)[(g * 16 + ho) * 64 + p], ci = INP(I_CIM)[(g * 16 + ho) * 64 + p];
        bf16_t* row = TW + (size_t)g * 512 * 640 + (size_t)(i * 16 + ho) * 640 + 512; row[p] = f2bf(cr * ez.x - ci * ez.y); row[64 + p] = f2bf(-(cr * ez.y + ci * ez.x));
    }
    for (int id = gt; id < 32 * 64 * 32 * 16; id += NTT) {
        const int h = id & 15, j = (id >> 4) & 31, p = (id >> 9) & 63, g = id >> 15;
        const float2 ez = LP[(g * 64 + p) * 33 + 31 - j], bb = BB[(g * 64 + p) * 16 + h];
        bf16_t* sg = SIN + (size_t)g * 256 * 512; sg[(size_t)p * 512 + j * 16 + h] = f2bf(ez.x * bb.x - ez.y * bb.y); sg[(size_t)(64 + p) * 512 + j * 16 + h] = f2bf(ez.x * bb.y + ez.y * bb.x);
    }
    for (int id = gt; id < 32 * 128 * 64; id += NTT) {
        const int q = id & 63, r = (id >> 6) & 127, g = id >> 13;
        *(u32x4*)(SIN + (size_t)g * 256 * 512 + (size_t)(128 + r) * 512 + q * 8) = (u32x4){0u, 0u, 0u, 0u};
    }
}

__device__ __forceinline__ void p2_post(const Frame& F, const Args& a, bool dry) {
    const int gw = F.c * 8 + F.wave, nw = F.G * 8, lane = F.lane, j = lane & 3, hs = lane >> 5, lr = lane & 31;
    const bf16_t* KVX = WSP(bf16_t, WS_KVX); unsigned char* KVP8 = WSP(unsigned char, WS_KVP); bf16_t* KIP = WSP(bf16_t, WS_KIP); bf16_t* QI = WSP(bf16_t, WS_QI);
    const bool rqi = lr < 16, rk = lr >= 16 && lr < 20, rki = lr >= 20 && lr < 24;
    const float scl = rqi ? 0.125f : 1.0f;
    float g1[8], g2[8];
#pragma unroll
    for (int e = 0; e < 8; ++e) { g1[e] = rk ? INP(I_GK)[8 * j + e] : 1.0f; g2[e] = rk ? INP(I_GK)[32 + 8 * j + e] : 1.0f; }
    constexpr int TB = 4;
    typedef float f32x2e __attribute__((ext_vector_type(2)));
    LAS f32x2e* cst = (LAS f32x2e*)F.lds + F.wave * (TB * 64);
    const float invf1 = __expf(-(float)lr * (9.210340371976184f / 32.0f));
    u32x4 nlo[TB], nhi[TB]; int npos[TB]; unsigned short nwraw[TB];
#define POST_LOAD(TBASE) do { _Pragma("unroll") for (int u = 0; u < TB; ++u) { \
            const int tt = (TBASE) + (u * 2 + hs) * nw, t = tt < T ? tt : T - 1; \
            const bf16_t* src; \
            if (rqi) src = QI + (size_t)t * 256 + (lr >> 2) * 64; \
            else if (rk) src = KVX + (size_t)t * 256; \
            else if (rki) src = KVX + (size_t)t * 256 + 128; \
            else src = KVX + (size_t)t * 256 + 64 + (lr - 24) * 8 - 8 * j;         \
            nlo[u] = *(const u32x4*)(src + 8 * j); nhi[u] = (lr < 24) ? *(const u32x4*)(src + 32 + 8 * j) : nlo[u]; \
            npos[u] = ((const int*)a.in[I_POS])[t]; \
            nwraw[u] = KVX[(size_t)t * 256 + 192 + (lane & 3)]; } } while (0)
    if (gw < T) POST_LOAD(gw);
#pragma unroll 1
    for (int tb = gw; tb < T; tb += nw * TB * 2) {
        u32x4 lo[TB], hi[TB]; float posf[TB]; unsigned short wraw[TB];
#pragma unroll
        for (int u = 0; u < TB; ++u) { lo[u] = nlo[u]; hi[u] = nhi[u]; posf[u] = (float)npos[u]; wraw[u] = nwraw[u]; }
        if (tb + nw * TB * 2 < T) POST_LOAD(tb + nw * TB * 2);
#pragma unroll
        for (int u = 0; u < TB; ++u) {
            const int tt = tb + (u * 2 + hs) * nw, t = tt < T ? tt : T - 1;
            { const float ang = posf[u] * invf1; const double rev = (double)ang * 0.15915494309189535; const float fr = (float)(rev - rint(rev));
              const f32x2e cs2 = (f32x2e){__builtin_amdgcn_cosf(fr), __builtin_amdgcn_sinf(fr)}; cst[(u * 2 + hs) * 32 + lr] = cs2;
              if (tt < T) WSP(f32x2e, WS_CS)[(size_t)t * 32 + lr] = cs2; }
        }
#pragma unroll
        for (int u = 0; u < TB; ++u) {
            const int t = tb + (u * 2 + hs) * nw;
            const bool live = t < T;
            if (lr < 24) {
                bf16_t* dst;
                if (rqi) dst = dry ? WSP(bf16_t, WS_RW) + (size_t)(live ? t : 0) * 256 + (lr >> 2) * 64 : QI + (size_t)(live ? t : 0) * 256 + (lr >> 2) * 64;
                else if (rk) dst = nullptr;
                else dst = KIP + (size_t)(live ? t : 0) * 64;
                f32x4 a0, a1, b0, b1; unpack8(lo[u], a0, a1); unpack8(hi[u], b0, b1);
                float x1[8] = {a0[0], a0[1], a0[2], a0[3], a1[0], a1[1], a1[2], a1[3]}, x2[8] = {b0[0], b0[1], b0[2], b0[3], b1[0], b1[1], b1[2], b1[3]};
                float ss = 0.f;
#pragma unroll
                for (int e = 0; e < 8; ++e) ss += x1[e] * x1[e] + x2[e] * x2[e];
                ss += __shfl_xor(ss, 1); ss += __shfl_xor(ss, 2);
                const float rs = rk ? rsqrtf(ss * (1.0f / 64.0f) + 1e-6f) : 1.0f;
                float o1[8], o2[8];
#pragma unroll
                for (int e = 0; e < 8; ++e) {
                    const f32x2e csn = cst[(u * 2 + hs) * 32 + 8 * j + e]; const float cs = csn.x, sn = csn.y;
                    const float y1 = x1[e] * rs * g1[e], y2 = x2[e] * rs * g2[e];
                    o1[e] = (y1 * cs - y2 * sn) * scl; o2[e] = (y2 * cs + y1 * sn) * scl; }
                if (live) {
                    if (rk) {
                        u32x2 w0, w1; w0.x = pack_fp8x4(o1[0], o1[1], o1[2], o1[3]); w0.y = pack_fp8x4(o1[4], o1[5], o1[6], o1[7]); w1.x = pack_fp8x4(o2[0], o2[1], o2[2], o2[3]); w1.y = pack_fp8x4(o2[4], o2[5], o2[6], o2[7]);
                        *(u32x2*)(KVP8 + (size_t)t * 128 + 8 * j) = w0; *(u32x2*)(KVP8 + (size_t)t * 128 + 32 + 8 * j) = w1;
                    } else {
                        *(u32x4*)(dst + 8 * j) = pack8((f32x4){o1[0], o1[1], o1[2], o1[3]}, (f32x4){o1[4], o1[5], o1[6], o1[7]});
                        *(u32x4*)(dst + 32 + 8 * j) = pack8((f32x4){o2[0], o2[1], o2[2], o2[3]}, (f32x4){o2[4], o2[5], o2[6], o2[7]}); } }
            } else if (live) {
                f32x4 a0, a1; unpack8(lo[u], a0, a1); u32x2 w; w.x = pack_fp8x4(a0[0], a0[1], a0[2], a0[3]); w.y = pack_fp8x4(a1[0], a1[1], a1[2], a1[3]);
                *(u32x2*)(KVP8 + (size_t)t * 128 + 64 + (lr - 24) * 8) = w;
            }
            if (lr < 4 && live) WSP(float, WS_WIF)[t * 4 + lr] = bf2f(wraw[u]) * 0.5f;
        }
    }
#undef POST_LOAD
    const bf16_t* KMVM = WSP(bf16_t, WS_KMVM); bf16_t* KM = WSP(bf16_t, WS_KM); bf16_t* VMT = WSP(bf16_t, WS_VMT);
    { float gk8[8];
#pragma unroll
        for (int e = 0; e < 8; ++e) gk8[e] = INP(I_GKM)[(lane & 15) * 8 + e] * INP(I_GQM)[(lane & 15) * 8 + e];
        for (int r = gw; r < 8192; r += nw) {
            const int h = lane >> 4, b = r >> 8, m = r & 255;
            f32x4 a0, a1; unpack8(*(const u32x4*)(KMVM + (size_t)r * 1024 + h * 128 + (lane & 15) * 8), a0, a1);
            float ss = a0[0] * a0[0] + a0[1] * a0[1] + a0[2] * a0[2] + a0[3] * a0[3] + a1[0] * a1[0] + a1[1] * a1[1] + a1[2] * a1[2] + a1[3] * a1[3];
            ss += __shfl_xor(ss, 1); ss += __shfl_xor(ss, 2); ss += __shfl_xor(ss, 4); ss += __shfl_xor(ss, 8);
            const float rs = rsqrtf(ss * (1.0f / 128.0f) + 1e-6f);
            *(u32x4*)(KM + ((size_t)(b * 4 + h) * 256 + m) * 128 + (lane & 15) * 8) = pack8((f32x4){a0[0] * rs * gk8[0], a0[1] * rs * gk8[1], a0[2] * rs * gk8[2], a0[3] * rs * gk8[3]}, (f32x4){a1[0] * rs * gk8[4], a1[1] * rs * gk8[5], a1[2] * rs * gk8[6], a1[3] * rs * gk8[7]}); } }
    const int gt = F.c * NTHR + F.tid, NTT = F.G * NTHR;
    for (int id = gt; id < 32 * 4 * 32 * 128; id += NTT) { const int d = id & 127, pg = (id >> 7) & 31, h = (id >> 12) & 3, b = id >> 14;
        unsigned short v[8];
#pragma unroll
        for (int j = 0; j < 8; ++j) { const int pp = pg * 8 + j, q = pp & 15, key = (pp & ~15) + 8 * ((q & 7) >> 2) + 4 * (q >> 3) + (q & 3);
            v[j] = KMVM[(size_t)(b * 256 + key) * 1024 + 512 + h * 128 + d]; }
        u32x4 w; w.x = v[0] | ((unsigned)v[1] << 16); w.y = v[2] | ((unsigned)v[3] << 16); w.z = v[4] | ((unsigned)v[5] << 16); w.w = v[6] | ((unsigned)v[7] << 16);
        *(u32x4*)(VMT + ((size_t)(b * 4 + h) * 128 + d) * 256 + pg * 8) = w; }
}

__device__ __forceinline__ void p3_scan(const Frame& F) {
    const int gt = F.c * NTHR + F.tid, NTT = F.G * NTHR;
    const float* SC = WSP(float, WS_SC); bf16_t* UA = WSP(bf16_t, WS_UA);
    for (int id = gt; id < 65536; id += NTT) { const int p = id & 63, b = (id >> 6) & 31, g = id >> 11;
        const float lr = WSP(float, WS_LAM32)[(g * 64 + p) * 2], li = WSP(float, WS_LAM32)[(g * 64 + p) * 2 + 1];
        float sr = 0.f, si = 0.f;
        for (int c = 0; c < 64; ++c) { const size_t row = (size_t)g * 2048 + b * 64 + c;
            UA[row * 640 + 512 + p] = f2bf(sr); UA[row * 640 + 576 + p] = f2bf(si);
            const float cr = SC[row * 128 + p], ci = SC[row * 128 + 64 + p];
            const float nr = lr * sr - li * si + cr, ni = lr * si + li * sr + ci; sr = nr; si = ni; }
    }
}

constexpr int SEL_SC = 0, SEL_HIST = 131072, SEL_END = SEL_HIST + 128 * 17 * 4;
__device__ __forceinline__ int suffix_sum64(int x, int rm1, int rm2, int rm3, int& tot) {
    int p = x;
    p += __builtin_amdgcn_update_dpp(0, p, 0x111, 0xf, 0xf, false);
    p += __builtin_amdgcn_update_dpp(0, p, 0x112, 0xf, 0xf, false);
    p += __builtin_amdgcn_update_dpp(0, p, 0x114, 0xf, 0xf, false);
    p += __builtin_amdgcn_update_dpp(0, p, 0x118, 0xf, 0xf, false);
    const int t0 = __builtin_amdgcn_readlane(p, 15), t1 = __builtin_amdgcn_readlane(p, 31), t2 = __builtin_amdgcn_readlane(p, 47), t3 = __builtin_amdgcn_readlane(p, 63);
    p += (t0 & rm1) + (t1 & rm2) + (t2 & rm3);
    tot = t0 + t1 + t2 + t3;
    return tot - p + x;
}
__device__ __forceinline__ int mbcnt64(unsigned long long m) { return (int)__builtin_amdgcn_mbcnt_hi((unsigned)(m >> 32), __builtin_amdgcn_mbcnt_lo((unsigned)m, 0u)); }
__device__ __forceinline__ void p3_select(const Frame& F, bool doB) {
    LAS unsigned short* sc = (LAS unsigned short*)(F.lds + SEL_SC);
    LAS unsigned* hist = (LAS unsigned*)(F.lds + SEL_HIST);
    const bf16_t* QI = WSP(bf16_t, WS_QI); const bf16_t* KIP = WSP(bf16_t, WS_KIP); const float* WIF = WSP(float, WS_WIF);
    unsigned short* IDX = WSP(unsigned short, WS_IDX);
    const int lane = F.lane, n = lane & 31, hf = lane >> 5, wv = F.wave;
    const int rm1 = (lane >> 4) >= 1 ? -1 : 0, rm2 = (lane >> 4) >= 2 ? -1 : 0, rm3 = (lane >> 4) >= 3 ? -1 : 0;
#define SEL_UNIT(L_, QT, B_) int QT = 63 - ((L_) >> 5); const int B_ = (L_) & 31; \
        if (F.G == 256) { const int k_ = F.c >> 5, i_ = (L_) >> 8, pr_ = i_ >> 1;     \
            QT = (i_ & 1) ? (48 - 16 * pr_ + k_) : (63 - 16 * pr_ - k_); }
#define SEL_LOADQK(QT, B_) do { const int tk_ = (B_) * 2048 + (QT) * 32 + n; \
        _Pragma("unroll") for (int h = 0; h < 4; ++h) { wq[h] = WIF[tk_ * 4 + h]; \
            _Pragma("unroll") for (int ks = 0; ks < 4; ++ks) bq[h][ks] = *(const bf16x8*)(QI + (size_t)tk_ * 256 + h * 64 + ks * 16 + hf * 8); } \
        { const int k0 = wv < (QT) + 1 ? wv : 0; const bf16_t* kp = KIP + (size_t)((B_) * 2048 + k0 * 32 + n) * 64 + hf * 8; \
            _Pragma("unroll") for (int ks = 0; ks < 4; ++ks) ka[ks] = *(const bf16x8*)(kp + ks * 16); } } while (0)
    bf16x8 bq[4][4]; float wq[4]; bf16x8 ka[4];
    if (F.c < 2048) { SEL_UNIT(F.c, qt0, b0); SEL_LOADQK(qt0, b0); }
    for (int L = F.c; L < 2048; L += F.G) {
        SEL_UNIT(L, qt, b);
        const int t0 = qt * 32, nkt = qt + 1, tok0 = b * 2048 + t0;
        for (int i = F.tid; i < 128 * 17; i += NTHR) hist[i] = 0u;
        { const int nz = ((nkt * 8 + 63) & ~63) - nkt * 8;
            for (int i = F.tid; i < nz * 32; i += NTHR) { const int nn = i & 31, ch = nkt * 8 + (i >> 5); *(LAS u32x2*)(sc + nn * 2048 + ((ch ^ nn) << 2)) = (u32x2){0u, 0u}; } }
        __syncthreads();
        const unsigned hinc = 1u << (16 * (n & 1));
        for (int kt = wv; kt < nkt; kt += 8) {
            f32x16 acc[4];
#pragma unroll
            for (int h = 0; h < 4; ++h)
#pragma unroll
                for (int r = 0; r < 16; ++r) acc[h][r] = 0.f;
#pragma unroll
            for (int ks = 0; ks < 4; ++ks)
#pragma unroll
                for (int h = 0; h < 4; ++h) acc[h] = __builtin_amdgcn_mfma_f32_32x32x16_bf16(ka[ks], bq[h][ks], acc[h], 0, 0, 0);
            { const int k1 = kt + 8 < nkt ? kt + 8 : kt; const bf16_t* kp = KIP + (size_t)(b * 2048 + k1 * 32 + n) * 64 + hf * 8;
#pragma unroll
                for (int ks = 0; ks < 4; ++ks) ka[ks] = *(const bf16x8*)(kp + ks * 16); }
            unsigned key[16];
#pragma unroll
            for (int r = 0; r < 16; ++r) {
                const int i0 = __float_as_int(acc[0][r]), i1 = __float_as_int(acc[1][r]), i2 = __float_as_int(acc[2][r]), i3 = __float_as_int(acc[3][r]);
                const float isc = wq[0] * __int_as_float(i0 > 0 ? i0 : 0) + wq[1] * __int_as_float(i1 > 0 ? i1 : 0) + wq[2] * __int_as_float(i2 > 0 ? i2 : 0) + wq[3] * __int_as_float(i3 > 0 ? i3 : 0);
                const float y = isc * __builtin_amdgcn_rcpf(1.0f + 0.25f * fabsf(isc));
                key[r] = (unsigned)(y * 8191.75f + 32768.0f);
            }
            if (kt < qt) {
#pragma unroll
                for (int g4 = 0; g4 < 4; ++g4) {
#pragma unroll
                    for (int j = 0; j < 4; ++j) (void)__hip_atomic_fetch_add(hist + (key[g4 * 4 + j] >> 9) * 17 + (n >> 1), hinc, __ATOMIC_RELAXED, __HIP_MEMORY_SCOPE_WORKGROUP);
                    u32x2 w; w.x = key[g4 * 4] | (key[g4 * 4 + 1] << 16); w.y = key[g4 * 4 + 2] | (key[g4 * 4 + 3] << 16);
                    const int chunk = (kt * 32 + 8 * g4 + 4 * hf) >> 2;
                    *(LAS u32x2*)(sc + n * 2048 + ((chunk ^ n) << 2)) = w;
                }
            } else {
                asm volatile("" ::: "memory");
#pragma unroll
                for (int g4 = 0; g4 < 4; ++g4) {
                    unsigned kk[4];
#pragma unroll
                    for (int j = 0; j < 4; ++j) { const int s = kt * 32 + j + 8 * g4 + 4 * hf; const bool valid = s <= t0 + n;
                        kk[j] = valid ? key[g4 * 4 + j] : 0u;
                        (void)__hip_atomic_fetch_add(hist + (kk[j] >> 9) * 17 + (n >> 1), valid ? hinc : 0u, __ATOMIC_RELAXED, __HIP_MEMORY_SCOPE_WORKGROUP); }
                    u32x2 w; w.x = kk[0] | (kk[1] << 16); w.y = kk[2] | (kk[3] << 16);
                    const int chunk = (kt * 32 + 8 * g4 + 4 * hf) >> 2;
                    *(LAS u32x2*)(sc + n * 2048 + ((chunk ^ n) << 2)) = w;
                }
            }
        }
        __syncthreads();
        if (L + F.G < 2048) { SEL_UNIT(L + F.G, qtn, bn); SEL_LOADQK(qtn, bn); }
        for (int qq = 0; qq < (doB ? 4 : 0); ++qq) {
            const int nq = wv * 4 + qq, tq = t0 + nq, nvalid = tq + 1, tok = tok0 + nq;
            LAS unsigned short* lst = sc + nq * 2048; LAS unsigned* cand = (LAS unsigned*)(sc + nq * 2048 + 512);
            if (nvalid <= 256) {
#pragma unroll
                for (int e = 0; e < 4; ++e) { const int p = lane * 4 + e; lst[p] = (unsigned short)(p < nvalid ? p : 0); }
            } else {
                unsigned v[32];
                LAS const unsigned short* rowp = sc + nq * 2048 + ((((lane >> 2) ^ (nq & 15)) << 2) | (lane & 3));
#pragma unroll
                for (int r = 0; r < 32; ++r) v[r] = rowp[r * 64];
                const int sh = 16 * (nq & 1);
                const int hhi = (int)((hist[(64 + lane) * 17 + (nq >> 1)] >> sh) & 0xffffu), hlo = (int)((hist[lane * 17 + (nq >> 1)] >> sh) & 0xffffu);
                int tothi; const int shi = suffix_sum64(hhi, rm1, rm2, rm3, tothi);
                int b1, above;
                if (tothi >= 256) { const unsigned long long mk = __builtin_amdgcn_ballot_w64(shi >= 256); const int lb = 63 - __clzll(mk); b1 = 64 + lb; above = __builtin_amdgcn_readlane(shi - hhi, lb); }
                else { int totlo; const int slo = tothi + suffix_sum64(hlo, rm1, rm2, rm3, totlo); const unsigned long long mk = __builtin_amdgcn_ballot_w64(slo >= 256); const int lb = 63 - __clzll(mk); b1 = lb; above = __builtin_amdgcn_readlane(slo - hlo, lb); }
                const int sw64 = (nq >> 4) << 6, laneE = lane + sw64, laneO = lane - sw64;
                int base = 0, m = 0;
                const unsigned binhi = (unsigned)b1 * 512u + 511u, binlo = b1 ? (unsigned)b1 * 512u : 1u, binspan = binhi - binlo;
#pragma unroll
                for (int r4 = 0; r4 < 32; r4 += 4) {
                    if (r4 * 64 >= nvalid) break;
#pragma unroll
                    for (int rr = 0; rr < 4; ++rr) { const int r = r4 + rr; const unsigned idx = (unsigned)(r * 64 + ((r & 1) ? laneO : laneE));
                        const bool gt_ = v[r] > binhi, eq = (v[r] - binlo) <= binspan;
                        const unsigned long long mg = __builtin_amdgcn_ballot_w64(gt_), me = __builtin_amdgcn_ballot_w64(eq);
                        int pg = base + mbcnt64(mg), cp = m + mbcnt64(me);
                        asm("" : "+v"(pg), "+v"(cp));
                        lst[gt_ ? pg : 256 + lane] = (unsigned short)idx;
                        cand[(eq && cp < 128) ? cp : 128 + lane] = ((v[r] & 511u) << 11) | idx;
                        base += __popcll(mg); m += __popcll(me); }
                }
                if (m <= 128) {
                    const int need = 256 - above;
                    const unsigned c0 = lane < m ? cand[lane] : 0u, c1 = 64 + lane < m ? cand[64 + lane] : 0u;
                    const unsigned a0 = lane < m ? (c0 >> 11) + 1u : 0u, a1 = 64 + lane < m ? (c1 >> 11) + 1u : 0u;
                    unsigned lo = 0u;
                    for (int bit = 9; bit >= 0; --bit) { const unsigned cd = lo | (1u << bit); const int c = __popcll(__builtin_amdgcn_ballot_w64(a0 >= cd)) + __popcll(__builtin_amdgcn_ballot_w64(a1 >= cd)); if (c >= need) lo = cd; }
                    const unsigned long long g0 = __builtin_amdgcn_ballot_w64(a0 > lo), g1 = __builtin_amdgcn_ballot_w64(a1 > lo), e0 = __builtin_amdgcn_ballot_w64(a0 == lo), e1 = __builtin_amdgcn_ballot_w64(a1 == lo);
                    const int ties = need - (__popcll(g0) + __popcll(g1));
                    int k0 = mbcnt64(e0), k1 = __popcll(e0) + mbcnt64(e1); asm("" : "+v"(k0), "+v"(k1));
                    const bool s0 = a0 > lo || (a0 == lo && k0 < ties), s1 = a1 > lo || (a1 == lo && k1 < ties);
                    const unsigned long long m0 = __builtin_amdgcn_ballot_w64(s0), m1 = __builtin_amdgcn_ballot_w64(s1);
                    if (s0) lst[base + mbcnt64(m0)] = (unsigned short)(c0 & 2047u);
                    if (s1) lst[base + __popcll(m0) + mbcnt64(m1)] = (unsigned short)(c1 & 2047u);
                } else {
#pragma unroll
                    for (int r = 0; r < 32; ++r) v[r] = ((r * 64 + ((r & 1) ? laneO : laneE)) < nvalid) ? v[r] : 0u;
                    unsigned lo = 0u;
                    for (int bit = 15; bit >= 0; --bit) { const unsigned cd = lo | (1u << bit); int cnt = 0;
#pragma unroll
                        for (int r = 0; r < 32; ++r) cnt += __popcll(__builtin_amdgcn_ballot_w64(v[r] >= cd));
                        if (cnt >= 256) lo = cd; }
                    int cgt = 0;
#pragma unroll
                    for (int r = 0; r < 32; ++r) cgt += __popcll(__builtin_amdgcn_ballot_w64(v[r] > lo));
                    const int need = 256 - cgt; int bs = 0, eqb = 0;
#pragma unroll
                    for (int r = 0; r < 32; ++r) {
                        const bool gt_ = v[r] > lo, eq = v[r] == lo;
                        const unsigned long long me = __builtin_amdgcn_ballot_w64(eq);
                        const bool sel = gt_ || (eq && eqb + mbcnt64(me) < need);
                        const unsigned long long ms = __builtin_amdgcn_ballot_w64(sel);
                        if (sel) lst[bs + mbcnt64(ms)] = (unsigned short)(r * 64 + ((r & 1) ? laneO : laneE));
                        bs += __popcll(ms); eqb += __popcll(me);
                    }
                }
            }
            *(u32x2*)(IDX + (size_t)tok * 256 + lane * 4) = *(LAS u32x2*)(lst + lane * 4);
        }
        __syncthreads();
    }
}

#undef SEL_UNIT
#undef SEL_LOADQK
__device__ __forceinline__ void p3_memattn(const Frame& F) {
    constexpr int KS = 272, VS = 528, VOFF = 256 * KS;
    const bf16_t* KM = WSP(bf16_t, WS_KM); const bf16_t* VMT = WSP(bf16_t, WS_VMT); const bf16_t* QM = DOP(bf16_t, DO_Y3) + 512; unsigned char* YM8 = DOP(unsigned char, DO_YM8);
    const int lane = F.lane, n = lane & 31, hf = lane >> 5;
    for (int u = F.c; u < 256; u += F.G) {
        const int half = u & 1, bh = u >> 1, b = bh >> 2, h = bh & 3;
#pragma unroll
        for (int i = 0; i < 8; ++i) { const int id = F.tid + 512 * i;
            { const int row = id >> 4, seg = id & 15; *(LAS u32x4*)(F.lds + row * KS + seg * 16) = *(const u32x4*)(KM + ((size_t)bh * 256 + row) * 128 + seg * 8); }
            { const int row = id >> 5, seg = id & 31; *(LAS u32x4*)(F.lds + VOFF + row * VS + seg * 16) = *(const u32x4*)(VMT + ((size_t)bh * 128 + row) * 256 + seg * 8); } }
        __syncthreads();
#pragma unroll 1
        for (int qi = 0; qi < 4; ++qi) {
            const int tok = b * 2048 + half * 1024 + F.wave * 128 + qi * 32 + n;
            const bf16_t* qp = QM + (size_t)tok * Y3LD + h * 128;
            bf16x8 bq[8];
#pragma unroll
            for (int ks = 0; ks < 8; ++ks) bq[ks] = *(const bf16x8*)(qp + ks * 16 + hf * 8);
            float qss = 0.f;
#pragma unroll
            for (int ks = 0; ks < 8; ++ks)
#pragma unroll
                for (int e = 0; e < 8; ++e) { const float f = bf2f((unsigned short)bq[ks][e]); qss += f * f; }
            qss += __shfl_xor(qss, 32);
            const float qc = rsqrtf(qss * (1.0f / 128.0f) + 1e-6f) * (0.08838834764831845f * 1.4426950408889634f);
            f32x16 o[4];
#pragma unroll
            for (int dt = 0; dt < 4; ++dt)
#pragma unroll
                for (int r = 0; r < 16; ++r) o[dt][r] = 0.f;
            float mrun = -3.0e38f, lrun = 0.f;
#pragma unroll 1
            for (int kh = 0; kh < 2; ++kh) {
                f32x16 s[4];
#pragma unroll
                for (int k4 = 0; k4 < 4; ++k4) { const int kt = kh * 4 + k4;
#pragma unroll
                    for (int r = 0; r < 16; ++r) s[k4][r] = 0.f;
#pragma unroll
                    for (int ks = 0; ks < 8; ++ks) { const bf16x8 a = *(const LAS bf16x8*)(F.lds + (kt * 32 + n) * KS + (ks * 16 + hf * 8) * 2);
                        s[k4] = __builtin_amdgcn_mfma_f32_32x32x16_bf16(a, bq[ks], s[k4], 0, 0, 0); } }
                float mx = mrun;
#pragma unroll
                for (int k4 = 0; k4 < 4; ++k4)
#pragma unroll
                    for (int r = 0; r < 16; ++r) mx = fmaxf(mx, s[k4][r]);
                mx = fmaxf(mx, __shfl_xor(mx, 32));
                const float resc = __builtin_amdgcn_exp2f((mrun - mx) * qc), nmq = -mx * qc;
                float sum = 0.f;
#pragma unroll
                for (int k4 = 0; k4 < 4; ++k4)
#pragma unroll
                    for (int r = 0; r < 16; ++r) { const float p = __builtin_amdgcn_exp2f(__builtin_fmaf(s[k4][r], qc, nmq)); s[k4][r] = p; sum += p; }
                sum += __shfl_xor(sum, 32);
                lrun = lrun * resc + sum; mrun = mx;
#pragma unroll
                for (int dt = 0; dt < 4; ++dt)
#pragma unroll
                    for (int r = 0; r < 16; ++r) o[dt][r] *= resc;
#pragma unroll
                for (int k4 = 0; k4 < 4; ++k4)
#pragma unroll
                    for (int st = 0; st < 2; ++st) { const int kt = kh * 4 + k4;
                        union { u32x4 u; bf16x8 v; } pb;
                        pb.u.x = cvt_pk_bf16(s[k4][8 * st + 0], s[k4][8 * st + 1]); pb.u.y = cvt_pk_bf16(s[k4][8 * st + 2], s[k4][8 * st + 3]);
                        pb.u.z = cvt_pk_bf16(s[k4][8 * st + 4], s[k4][8 * st + 5]); pb.u.w = cvt_pk_bf16(s[k4][8 * st + 6], s[k4][8 * st + 7]);
#pragma unroll
                        for (int dt = 0; dt < 4; ++dt) { const bf16x8 a = *(const LAS bf16x8*)(F.lds + VOFF + (dt * 32 + n) * VS + (kt * 32 + 16 * st + 8 * hf) * 2);
                            o[dt] = __builtin_amdgcn_mfma_f32_32x32x16_bf16(a, pb.v, o[dt], 0, 0, 0); }
                    }
            }
            const float inv = 16.0f * __builtin_amdgcn_rcpf(lrun);
#pragma unroll
            for (int dt = 0; dt < 4; ++dt)
#pragma unroll
                for (int g4 = 0; g4 < 4; ++g4)
                    *(unsigned*)(YM8 + (size_t)tok * 512 + h * 128 + dt * 32 + 8 * g4 + 4 * hf) = pack_fp8x4(o[dt][g4 * 4] * inv, o[dt][g4 * 4 + 1] * inv, o[dt][g4 * 4 + 2] * inv, o[dt][g4 * 4 + 3] * inv);
        }
        __syncthreads();
    }
}

__device__ __forceinline__ void p4_attend(const Frame& F, const Args& a) {
    constexpr int WB = 2 * 8192 + 1024;
    LAS unsigned char* wb = F.lds + F.wave * WB;
    LAS unsigned short* lst = (LAS unsigned short*)(wb + 16384);
    const unsigned short* IDX = WSP(unsigned short, WS_IDX); const unsigned char* KVP8 = WSP(unsigned char, WS_KVP); const bf16_t* Q = DOP(bf16_t, DO_Y3); unsigned char* YD8 = DOP(unsigned char, DO_YD8);
    const int lane = F.lane, n = lane & 15, g = lane >> 4, gw = F.c * 8 + F.wave, nw = F.G * 8;
    const int ntk = (T - gw + nw - 1) / nw;
    float gkm = fabsf(INP(I_GK)[lane]);
    gkm = fmaxf(gkm, __shfl_xor(gkm, 32)); gkm = fmaxf(gkm, __shfl_xor(gkm, 16)); gkm = fmaxf(gkm, __shfl_xor(gkm, 8)); gkm = fmaxf(gkm, __shfl_xor(gkm, 4)); gkm = fmaxf(gkm, __shfl_xor(gkm, 2)); gkm = fmaxf(gkm, __shfl_xor(gkm, 1));
    const float kmax = 8.0f * gkm * 1.07f;
    int koff[4][2];
#pragma unroll
    for (int blk = 0; blk < 4; ++blk)
#pragma unroll
        for (int ks = 0; ks < 2; ++ks) { const int row = blk * 16 + n, pc = ks * 2 + (g >> 1); koff[blk][ks] = row * 128 + ((pc ^ (row & 7)) << 4) + 8 * (g & 1); }
    const int q8 = n >> 1, p8 = n & 1;
    int toff[2][4];
#pragma unroll
    for (int kb2 = 0; kb2 < 2; ++kb2)
#pragma unroll
        for (int d = 0; d < 4; ++d) { const int row = (kb2 * 2 + (q8 >> 2)) * 16 + g * 4 + (q8 & 3), pc = 4 + d; toff[kb2][d] = row * 128 + ((pc ^ (row & 7)) << 4) + 8 * p8; }
    const int grow = lane >> 3, gpc = lane & 7;
    const unsigned wbase = (unsigned)(uintptr_t)wb;
#define AT_KEYS(NK, LB, CH) do { _Pragma("unroll") for (int _i = 0; _i < 8; ++_i) NK[_i] = lst[(LB) * 256 + (CH) * 64 + 8 * _i + grow]; } while (0)
#define AT_ISSUE_K(NK, TOK, BUF) do { const char* _kb = (const char*)(KVP8 + (size_t)((TOK) >> 11) * 2048 * 128); \
        _Pragma("unroll") for (int _i = 0; _i < 8; ++_i) { const int _row = 8 * _i + grow; \
            const unsigned _off = (unsigned)NK[_i] * 128u + (unsigned)((gpc ^ (_row & 7)) << 4);        \
            __builtin_amdgcn_global_load_lds((const unsigned*)(_kb + _off), (LAS unsigned*)(wb + (BUF) * 8192 + _i * 1024), 16, 0, 0); } } while (0)
#define AT_ISSUE(TOK, LB, CH, BUF) do { int _nk[8]; AT_KEYS(_nk, LB, CH); AT_ISSUE_K(_nk, TOK, BUF); } while (0)
    if (ntk <= 0) return;
    { const u32x2 l0 = *(const u32x2*)(IDX + (size_t)gw * 256 + lane * 4); *(LAS u32x2*)(lst + lane * 4) = l0; }
    float gq1[8], gq2[8];
#pragma unroll
    for (int e = 0; e < 8; ++e) { gq1[e] = INP(I_GQ)[g * 8 + e]; gq2[e] = INP(I_GQ)[32 + g * 8 + e]; }
    const f32x4* CS = WSP(f32x4, WS_CS);
    bf16x8 nbq[2]; f32x4 ncs[4];
#pragma unroll
    for (int e = 0; e < 4; ++e) ncs[e] = CS[(size_t)gw * 16 + g * 4 + e];
#pragma unroll
    for (int ks = 0; ks < 2; ++ks) { if (n < 8) nbq[ks] = *(const bf16x8*)(Q + (size_t)gw * Y3LD + n * 64 + ks * 32 + g * 8); else nbq[ks] = (bf16x8){0, 0, 0, 0, 0, 0, 0, 0}; }
    AT_ISSUE(gw, 0, 0, 0); AT_ISSUE(gw, 0, 1, 1);
#pragma unroll 1
    for (int k = 0; k < ntk; ++k) {
        const int tok = gw + k * nw, ntok = tok + nw, lb = k & 1; const bool hasn = (k + 1 < ntk);
        const int tq = tok & 2047, cnt = tq + 1 < 256 ? tq + 1 : 256;
        long bq[2]; float qs = 0.f;
        { float x1[8], x2[8], ss = 0.f;
#pragma unroll
            for (int e = 0; e < 8; ++e) { x1[e] = bf2f((unsigned short)nbq[0][e]); x2[e] = bf2f((unsigned short)nbq[1][e]); ss += x1[e] * x1[e] + x2[e] * x2[e]; }
            ss += __shfl_xor(ss, 16); ss += __shfl_xor(ss, 32);
            const float rs = rsqrtf(ss * (1.0f / 64.0f) + 1e-6f) * (0.125f * 1.4426950408889634f); float o1[8], o2[8];
#pragma unroll
            for (int e = 0; e < 8; ++e) { const float cs = ncs[e >> 1][(e & 1) * 2], sn = ncs[e >> 1][(e & 1) * 2 + 1], y1 = x1[e] * rs * gq1[e], y2 = x2[e] * rs * gq2[e];
                o1[e] = y1 * cs - y2 * sn; o2[e] = y2 * cs + y1 * sn; qs += o1[e] * o1[e] + o2[e] * o2[e]; }
            const unsigned a0 = pack_fp8x4(o1[0], o1[1], o1[2], o1[3]), a1 = pack_fp8x4(o1[4], o1[5], o1[6], o1[7]), b0 = pack_fp8x4(o2[0], o2[1], o2[2], o2[3]), b1 = pack_fp8x4(o2[4], o2[5], o2[6], o2[7]);
            bq[0] = (long)(((unsigned long long)a1 << 32) | a0); bq[1] = (long)(((unsigned long long)b1 << 32) | b0); }
        qs += __shfl_xor(qs, 16); qs += __shfl_xor(qs, 32);
        const float shift = __builtin_amdgcn_sqrtf(qs) * 1.07f * kmax - 7.0f;
        const f32x4 nsh = (f32x4){-shift, -shift, -shift, -shift};
        u32x2 nl = (u32x2){0u, 0u};
        if (hasn) { nl = *(const u32x2*)(IDX + (size_t)ntok * 256 + lane * 4);
#pragma unroll
            for (int e = 0; e < 4; ++e) ncs[e] = CS[(size_t)ntok * 16 + g * 4 + e];
#pragma unroll
            for (int ks = 0; ks < 2; ++ks) if (n < 8) nbq[ks] = *(const bf16x8*)(Q + (size_t)ntok * Y3LD + n * 64 + ks * 32 + g * 8); }
        f32x4 o[4];
#pragma unroll
        for (int d = 0; d < 4; ++d) o[d] = (f32x4){0.f, 0.f, 0.f, 0.f};
        float lsum = 0.f;
#pragma unroll
        for (int ch = 0; ch < 4; ++ch) {
            const int buf = ch & 1;
            if (ch == 3 && !hasn) asm volatile("s_waitcnt vmcnt(0)" ::: "memory"); else asm volatile("s_waitcnt vmcnt(8)" ::: "memory");
            LAS const unsigned char* bb = wb + buf * 8192;
            int nk[8];
            if (ch < 2) AT_KEYS(nk, lb, ch + 2); else if (hasn) AT_KEYS(nk, lb ^ 1, ch - 2);
            f32x4 s[4];
#pragma unroll
            for (int blk = 0; blk < 4; ++blk) {
                const long k0 = *(LAS const long*)(bb + koff[blk][0]), k1 = *(LAS const long*)(bb + koff[blk][1]);
                s[blk] = __builtin_amdgcn_mfma_f32_16x16x32_fp8_fp8(k0, bq[0], nsh, 0, 0, 0);
                s[blk] = __builtin_amdgcn_mfma_f32_16x16x32_fp8_fp8(k1, bq[1], s[blk], 0, 0, 0);
            }
            u32x2 tr[2][4];
#pragma unroll
            for (int kb2 = 0; kb2 < 2; ++kb2)
#pragma unroll
                for (int d = 0; d < 4; ++d) asm volatile("ds_read_b64_tr_b8 %0, %1 offset:%2" : "=&v"(tr[kb2][d]) : "v"(wbase + (unsigned)toff[kb2][d]), "i"(buf * 8192) : "memory");
            float e[2][4];
#pragma unroll
            for (int b2 = 0; b2 < 2; ++b2)
#pragma unroll
                for (int j = 0; j < 4; ++j) e[b2][j] = __int_as_float(__builtin_amdgcn_update_dpp(__float_as_int(s[b2][j]), __float_as_int(s[b2 + 2][j]), 0x118, 0xf, 0xc, false));
            if (cnt >= (ch + 1) * 64) {
#pragma unroll
                for (int b2 = 0; b2 < 2; ++b2)
#pragma unroll
                    for (int j = 0; j < 4; ++j) { const float x = __builtin_amdgcn_exp2f(e[b2][j]); e[b2][j] = x; lsum += x; }
            } else {
                asm volatile("" ::: "memory");
#pragma unroll
                for (int b2 = 0; b2 < 2; ++b2)
#pragma unroll
                    for (int j = 0; j < 4; ++j) { const int p = ch * 64 + (b2 + (n >> 3) * 2) * 16 + g * 4 + j; const float x = p < cnt ? __builtin_amdgcn_exp2f(e[b2][j]) : 0.f; e[b2][j] = x; lsum += x; }
            }
            const unsigned w0 = pack_fp8x4_nc(e[0][0], e[0][1], e[0][2], e[0][3]), w1 = pack_fp8x4_nc(e[1][0], e[1][1], e[1][2], e[1][3]);
#pragma unroll
            for (int kb2 = 0; kb2 < 2; ++kb2) {
                const unsigned plo = kb2 == 0 ? w0 : (unsigned)__builtin_amdgcn_update_dpp(0, (int)w0, 0x108, 0xf, 0xf, true), phi = kb2 == 0 ? w1 : (unsigned)__builtin_amdgcn_update_dpp(0, (int)w1, 0x108, 0xf, 0xf, true);
                const long pb = (long)(((unsigned long long)phi << 32) | plo);
                if (kb2 == 0) asm volatile("s_waitcnt lgkmcnt(0)" : "+v"(tr[0][0]), "+v"(tr[0][1]), "+v"(tr[0][2]), "+v"(tr[0][3]), "+v"(tr[1][0]), "+v"(tr[1][1]), "+v"(tr[1][2]), "+v"(tr[1][3]) :: "memory");
#pragma unroll
                for (int d = 0; d < 4; ++d) { const long av = (long)(((unsigned long long)tr[kb2][d].y << 32) | tr[kb2][d].x);
                    o[d] = __builtin_amdgcn_mfma_f32_16x16x32_fp8_fp8(av, pb, o[d], 0, 0, 0); }
            }
            __builtin_amdgcn_sched_barrier(0);
            if (ch == 1 && hasn) *(LAS u32x2*)(lst + (lb ^ 1) * 256 + lane * 4) = nl;
            if (ch < 2) AT_ISSUE_K(nk, tok, buf);
            else if (hasn) AT_ISSUE_K(nk, ntok, buf);
            __builtin_amdgcn_sched_barrier(0);
        }
        lsum += __int_as_float(__builtin_amdgcn_update_dpp(0, __float_as_int(lsum), 0x108, 0xf, 0xf, true));
        lsum += __shfl_xor(lsum, 16); lsum += __shfl_xor(lsum, 32);
        const float inv = 16.0f * __builtin_amdgcn_rcpf(lsum);
        if (n < 8) {
#pragma unroll
            for (int d = 0; d < 4; ++d) *(unsigned*)(YD8 + (size_t)tok * 512 + n * 64 + d * 16 + g * 4) = pack_fp8x4(o[d][0] * inv, o[d][1] * inv, o[d][2] * inv, o[d][3] * inv);
        }
    }
#undef AT_ISSUE
#undef AT_ISSUE_K
#undef AT_KEYS
}

__device__ __forceinline__ void p8_router(const Frame& F, const Args& a, bool commit) {
    const bf16_t* X1B = WSP(bf16_t, WS_X1B); const bf16_t* WR = WSP(bf16_t, WS_WR);
    int* TOK = WSP(int, WS_TOK); float2* RW = WSP(float2, WS_RW); int* TOK2 = WSP(int, WS_TOK2); unsigned* gcnt = (unsigned*)(F.ws + WS_CTL + CTL_GCNT);
    constexpr int WRS = 2064, RT_LG = 48 * WRS, RT_RS = RT_LG + 8 * 16 * 48 * 4, RT_LC = RT_RS + 8 * 16 * 4;
    LAS float* lg = (LAS float*)(F.lds + RT_LG) + F.wave * (16 * 48);
    LAS float* rsb = (LAS float*)(F.lds + RT_RS) + F.wave * 16;
    LAS int* lc = (LAS int*)(F.lds + RT_LC); LAS int* lbase = lc + 144;
    const int lane = F.lane, n = lane & 15, q = lane >> 4;
    for (int i = F.tid; i < 48 * 128; i += NTHR) { const int r = i >> 7, c = i & 127; *(LAS u32x4*)(F.lds + r * WRS + c * 16) = *(const u32x4*)(WR + (size_t)r * 1024 + c * 8); }
    __syncthreads();
    for (int it = F.c; it < T / 128; it += F.G) {
        const int tw = it * 128 + F.wave * 16;
        if (F.tid < 144) lc[F.tid] = 0;
        const bf16_t* xp = X1B + (size_t)(tw + n) * 1024 + q * 8;
        f32x4 acc[3] = {(f32x4){0.f, 0.f, 0.f, 0.f}, (f32x4){0.f, 0.f, 0.f, 0.f}, (f32x4){0.f, 0.f, 0.f, 0.f}};
        float ss = 0.f;
#pragma unroll
        for (int hb = 0; hb < 2; ++hb) {
            bf16x8 av[16];
#pragma unroll
            for (int k2 = 0; k2 < 16; ++k2) av[k2] = *(const bf16x8*)(xp + (hb * 16 + k2) * 32);
#pragma unroll
            for (int k2 = 0; k2 < 16; ++k2) { const int ks = hb * 16 + k2;
#pragma unroll
                for (int j = 0; j < 8; ++j) { const float f = bf2f((unsigned short)av[k2][j]); ss += f * f; }
#pragma unroll
                for (int bl = 0; bl < 3; ++bl) { const bf16x8 bb = *(const LAS bf16x8*)(F.lds + (bl * 16 + n) * WRS + (ks * 32 + q * 8) * 2);
                    acc[bl] = __builtin_amdgcn_mfma_f32_16x16x32_bf16(av[k2], bb, acc[bl], 0, 0, 0); } }
        }
        ss += __shfl_xor(ss, 16); ss += __shfl_xor(ss, 32);
        const float rs = rsqrtf(ss * (1.0f / 1024.0f) + 1e-6f);
        if (q == 0) rsb[n] = rs;
#pragma unroll
        for (int bl = 0; bl < 3; ++bl)
#pragma unroll
            for (int j = 0; j < 4; ++j) lg[(q * 4 + j) * 48 + bl * 16 + n] = acc[bl][j] * rsb[q * 4 + j];
        __syncthreads();
        int l1 = 0, l2 = 0, lp = 0, r1 = 0, r2 = 0, rp = 0, s1 = 0; float wa = 0.f, wb = 0.f, myrs = 0.f;
        if (lane < 16) {
            LAS const float* l = lg + lane * 48; myrs = rsb[lane];
            float g0 = l[0] + INP(I_BGROUP)[0]; int gi = 0; float gm = g0, gl[4]; gl[0] = g0;
#pragma unroll
            for (int j = 1; j < 4; ++j) { gl[j] = l[j] + INP(I_BGROUP)[j]; if (gl[j] > gm) { gm = gl[j]; gi = j; } }
            float gs = 0.f;
#pragma unroll
            for (int j = 0; j < 4; ++j) gs += __expf(gl[j] - gm);
            const float ggate = 1.0f / gs;
            float e1 = -3.0e38f, e2 = -3.0e38f; int i1 = 0, i2 = 0;
            for (int e = 0; e < 8; ++e) { const float v = l[4 + gi * 8 + e] + INP(I_BEXP)[gi * 8 + e];
                if (v > e1) { e2 = e1; i2 = i1; e1 = v; i1 = e; } else if (v > e2) { e2 = v; i2 = e; } }
            const float pa = 1.0f / (1.0f + __expf(e2 - e1));
            wa = ggate * pa; wb = ggate - wa;
            s1 = i1 < i2 ? 0 : 1;
            const int elo = i1 < i2 ? i1 : i2, ehi = i1 < i2 ? i2 : i1;
            l1 = gi * 8 + i1; l2 = gi * 8 + i2; lp = 32 + gi * 28 + (elo * (15 - elo)) / 2 + (ehi - elo - 1);
            r1 = atomicAdd((int*)(lc + l1), 1); r2 = atomicAdd((int*)(lc + l2), 1); rp = atomicAdd((int*)(lc + lp), 1);
        }
        __syncthreads();
        if (F.tid < 144) { const int cn = lc[F.tid]; lbase[F.tid] = (cn > 0 && commit) ? (int)atomicAdd(gcnt + F.tid * 64, (unsigned)cn) : 0; }
        __syncthreads();
        if (lane < 16 && commit) { const int t = tw + lane;
            const size_t p1 = (size_t)l1 * 65536 + lbase[l1] + r1, p2 = (size_t)l2 * 65536 + lbase[l2] + r2;
            TOK[p1] = t | (s1 << 31); RW[p1] = make_float2(myrs, wa); TOK[p2] = t | ((s1 ^ 1) << 31); RW[p2] = make_float2(myrs, wb);
            TOK2[(size_t)(lp - 32) * 65536 + lbase[lp] + rp] = t; }
        __syncthreads();
    }
}

__device__ __forceinline__ int moe_table(const Frame& F, int first, int count) {
    LAS int* misc = (LAS int*)(F.lds + MISC_OFF); const unsigned* gcnt = (const unsigned*)(F.ws + WS_CTL + CTL_GCNT);
    __syncthreads();
    if (F.tid < count) misc[MI_CNT + F.tid] = (int)__hip_atomic_load(gcnt + (first + F.tid) * 64, __ATOMIC_RELAXED, __HIP_MEMORY_SCOPE_AGENT);
    if (F.tid >= 256 && F.tid < 256 + 28) { const int pi = F.tid - 256; int elo = 0; while (elo < 6 && ((elo + 1) * (15 - (elo + 1))) / 2 <= pi) ++elo;
        misc[MI_PT + pi] = elo | ((pi - (elo * (15 - elo)) / 2 + elo + 1) << 4); }
    __syncthreads();
    if (F.tid == 0) { int run = 0; for (int l = 0; l < count; ++l) { misc[MI_PRE + l] = run; run += (misc[MI_CNT + l] + 255) >> 8; } misc[MI_PRE + count] = run; }
    __syncthreads();
    const int nt = misc[MI_PRE + count];
    for (int idx = F.tid; idx < nt && idx < 640; idx += NTHR) { int l = 0; while (l < count - 1 && misc[MI_PRE + l + 1] <= idx) ++l; misc[MI_TILE + idx] = l | ((idx - misc[MI_PRE + l]) << 8); }
    __syncthreads();
    return nt < 640 ? nt : 640;
}

__global__ void __launch_bounds__(NTHR, 2) fwd(Args a) {
    extern __shared__ __attribute__((aligned(16))) unsigned char lds_raw[];
    Frame F;
    F.lds = (LAS unsigned char*)lds_raw; F.tid = threadIdx.x; F.lane = F.tid & 63; F.wave = __builtin_amdgcn_readfirstlane(F.tid >> 6); F.G = gridDim.x; F.c = blockIdx.x;
    F.ws = a.ws; F.dout = (unsigned char*)a.out;
    LAS unsigned* misc = (LAS unsigned*)(F.lds + MISC_OFF);
    for (int i = F.tid; i < 1024; i += NTHR) misc[i] = 0u;
    __syncthreads();
    XcdBarrier bar; bar.bar = (unsigned*)(F.ws + WS_CTL); bar.x = 0; bar.st = (volatile LAS unsigned*)misc;
    const int lo = a.ph_lo, hi = a.ph_hi;
    if (hi - lo > 1) bar = xcd_barrier_post((unsigned*)(F.ws + WS_CTL), (volatile LAS unsigned*)misc);
#ifndef PH_MASK
#define PH_MASK 0xFFF
#endif
#define IN(k) (((PH_MASK >> (k)) & 1) && lo <= (k) && (k) < hi)
#ifndef REP_MASK
#define REP_MASK 0
#endif
#define NREP(k) (1 + ((REP_MASK >> (k)) & 1))
#define SEAM(k) do { if (IN(k) && IN((k) + 1)) xcd_barrier(bar); } while (0)
    bf16_t* HB = WSP(bf16_t, WS_HB); bf16_t* UA = WSP(bf16_t, WS_UA); unsigned char* SG = WSP(unsigned char, WS_SG);
    bf16_t* Y3 = DOP(bf16_t, DO_Y3); bf16_t* YG = WSP(bf16_t, WS_YG);
    LAS const int* imisc = (LAS const int*)(F.lds + MISC_OFF);

    if (IN(0)) for (int rep = 0; rep < NREP(0); ++rep) { p0_prep(F, a); __syncthreads(); }
    SEAM(0);
    if (IN(0) && IN(1)) {
        if (F.tid == 0) { unsigned* bw = (unsigned*)(F.ws + WS_CTL); bool bal = (F.G % 8) == 0;
            for (int j = 0; j < 16; ++j) { const unsigned cj = xb_ld(&bw[XB_XCNT(j)]); bal = bal && (cj == (j < 8 ? (unsigned)F.G / 8u : 0u)); }
            misc[3] = bal ? (misc[2] * 8u + bar.x) : (unsigned)blockIdx.x; }
        __syncthreads();
        F.c = (int)misc[3];
    }
    if (IN(1)) {
        { pg8::Gemm g{512, 512, 512, 0x7f, 0x7a};
          pg8::SchedGrid S{(const char*)WSP(unsigned char, WS_HB8), (const char*)WSP(unsigned char, WS_WG8), 0, 0, (size_t)256 * 1024, (size_t)256 * 1024, 256, 18, 1, F.G, F.c, NREP(1)};
          EpiInProj E{UA, Y3, SG};
          pg8::gemm_phase<EpiInProj, pg8::SchedGrid, false, PG8_SP2, true>(F.lds, g, S, E); }
        { pg8::Gemm g{1024, 1024, 1024}; pg8::SchedGrid S{(const char*)HB, (const char*)WSP(bf16_t, WS_WIN), 0, 0, (size_t)256 * 1024 * 2, (size_t)256 * 1024 * 2, 256, 2, 1, F.G, F.c, NREP(1)};
          EpiInProjB E{WSP(bf16_t, WS_KVX), WSP(bf16_t, WS_QI)};
          pg8::gemm_phase<EpiInProjB, pg8::SchedGrid, false>(F.lds, g, S, E); }
        { pg8::Gemm g{512, 512, 512, 0x7f, 0x7a};
          pg8::SchedGrid S{(const char*)WSP(unsigned char, WS_MEMN), (const char*)WSP(unsigned char, WS_WMEM), 0, 0, (size_t)256 * 1024, (size_t)256 * 1024, 32, 4, 1, F.G, F.c, NREP(1)};
          EpiBf16 E{WSP(bf16_t, WS_KMVM), 1024};
          pg8::gemm_phase<EpiBf16, pg8::SchedGrid, false, PG8_SP2, true>(F.lds, g, S, E); }
        if (F.G > 128) { if (F.c >= 128) p1_tables(F, a, F.c - 128, F.G - 128); } else p1_tables(F, a, F.c, F.G);
    }
    SEAM(1);
    if (IN(2)) {
        { pg8::Gemm g{640, 512, 512}; pg8::SchedGrid S{(const char*)UA, (const char*)WSP(bf16_t, WS_SIN), (size_t)2048 * 640 * 2, (size_t)256 * 512 * 2, (size_t)256 * 640 * 2, (size_t)256 * 512 * 2, 8, 1, 32, F.G, F.c, NREP(2)};
          EpiSc E{WSP(float, WS_SC)};
          pg8::gemm_phase<EpiSc, pg8::SchedGrid, false>(F.lds, g, S, E); }
        for (int rep = 0; rep < NREP(15); ++rep) p2_post(F, a, rep < NREP(15) - 1);
    }
    SEAM(2);
#ifndef P3_SUB
#define P3_SUB 7
#endif
    if (IN(3)) { for (int rep = 0; rep < NREP(13); ++rep) { if (P3_SUB & 1) p3_scan(F); } for (int rep = 0; rep < NREP(3); ++rep) { if (P3_SUB & 2) p3_select(F, rep == 0 || (REP_MASK & 0x10000)); } for (int rep = 0; rep < NREP(12); ++rep) if (P3_SUB & 4) p3_memattn(F); }
    SEAM(3);
    if (IN(4)) {
        { pg8::Gemm g{640, 640, 640}; pg8::SchedGrid S{(const char*)UA, (const char*)WSP(bf16_t, WS_TW), (size_t)2048 * 640 * 2, (size_t)512 * 640 * 2, (size_t)256 * 640 * 2, (size_t)256 * 640 * 2, 8, 2, 32, F.G, F.c, NREP(4)};
          EpiGelu E{YG};
          pg8::gemm_phase<EpiGelu, pg8::SchedGrid, false>(F.lds, g, S, E); }
        for (int rep = 0; rep < NREP(14); ++rep) p4_attend(F, a);
    }
    SEAM(4);
    if (IN(5)) {
        pg8::Gemm g{512, 512, 512}; pg8::SchedGrid S{(const char*)YG, (const char*)WSP(bf16_t, WS_WGLU), 0, 0, (size_t)256 * 512 * 2, (size_t)256 * 512 * 2, 256, 2, 1, F.G, F.c, NREP(5)};
        EpiGlu E{YG, DOP(unsigned char, DO_YS8)};
        pg8::gemm_phase<EpiGlu, pg8::SchedGrid, false>(F.lds, g, S, E);
    }
    SEAM(5);
    if (IN(6)) {
        pg8::Gemm g{256, 768, 768, 0x7b, 0x7a};
        SchedMerge3 S{(const char*)DOP(unsigned char, DO_Y8), (const char*)WSP(unsigned char, WS_WUP), F.G, F.c, NREP(6)};
        EpiMerge E{SG, (unsigned char*)HB};
        pg8::gemm_phase<EpiMerge, SchedMerge3, false, PG8_SP2, true>(F.lds, g, S, E);
    }
    SEAM(6);
    if (IN(7)) {
        pg8::Gemm g{512, 512, 512, 0x7c, 0x7a};
        pg8::SchedGrid S{(const char*)HB, (const char*)WSP(unsigned char, WS_WOUT), 0, 0, (size_t)256 * 1024, (size_t)256 * 1024, 256, 4, 1, F.G, F.c, NREP(7)};
        EpiOut E{INP(I_X), WSP(bf16_t, WS_X1B), WSP(unsigned char, WS_X1B8)};
        pg8::gemm_phase<EpiOut, pg8::SchedGrid, false, PG8_SP2, true>(F.lds, g, S, E);
    }
    SEAM(7);
    if (IN(8)) for (int rep = 0; rep < NREP(8); ++rep) p8_router(F, a, rep == NREP(8) - 1);
    SEAM(8);
    if (IN(9)) {
        const int nt = moe_table(F, 0, 32);
        pg8::Gemm g{512, 512, 512, 0x7f, 0x7a};
        SchedMoE1 S{(const char*)WSP(unsigned char, WS_X1B8), (const char*)WSP(unsigned char, WS_WGU), imisc, WSP(int, WS_TOK), nt * 4, F.G, F.c, NREP(9)};
        EpiMoe1 E{imisc, WSP(int, WS_TOK), WSP(float2, WS_RW), WSP(unsigned char, WS_HID)};
        pg8::gemm_phase<EpiMoe1, SchedMoE1, true, PG8_SP2, true>(F.lds, g, S, E);
    }
    SEAM(9);
    if (IN(10)) {
        const int nt = moe_table(F, 32, 112);
        pg8::Gemm g{512, 256, 512, 0x7b, 0x7a};
        SchedMoE2 S{(const char*)WSP(unsigned char, WS_HID), (const char*)WSP(unsigned char, WS_WD), imisc, WSP(int, WS_TOK2), nt * 4, F.G, F.c, NREP(10)};
        EpiMoe2 E{imisc, WSP(int, WS_TOK2), WSP(bf16_t, WS_X1B), a.out};
        pg8::gemm_phase<EpiMoe2, SchedMoE2, true, PG8_SP2, true>(F.lds, g, S, E);
    }
#undef IN
#undef SEAM
}

extern "C" void kernel_launch(void* const* d_in, const int* in_sizes, int n_in, void* d_out, int out_size, void* d_ws, size_t ws_size, hipStream_t stream) {
    static int grid = 0;
    if (grid == 0) {
        if (n_in != 32 || out_size != T * D || ws_size < WS_END) { fprintf(stderr, "kernel_launch: unexpected shapes: n_in %d out %d ws %zu (need %zu)\n", n_in, out_size, ws_size, (size_t)WS_END); grid = -1; return; }
        int dev = 0, cus = 0;
        if (hipGetDevice(&dev) != hipSuccess || hipDeviceGetAttribute(&cus, hipDeviceAttributeMultiprocessorCount, dev) != hipSuccess) { grid = -1; return; }
        if (hipFuncSetAttribute((const void*)fwd, hipFuncAttributeMaxDynamicSharedMemorySize, LDS_BYTES) != hipSuccess) { fprintf(stderr, "kernel_launch: hipFuncSetAttribute failed\n"); grid = -1; return; }
        int per_cu = 0;
        if (hipOccupancyMaxActiveBlocksPerMultiprocessor(&per_cu, (const void*)fwd, NTHR, LDS_BYTES) != hipSuccess || per_cu < 1) fprintf(stderr, "kernel_launch: occupancy query reports %d\n", per_cu);
        (void)hipGetLastError();
        grid = cus;
    }
    if (grid < 0) return;
    (void)hipMemsetAsync((char*)d_ws + WS_CTL, 0, CTL_BYTES, stream);
    Args a{};
    for (int i = 0; i < 32; ++i) a.in[i] = d_in[i];
    a.out = (float*)d_out; a.ws = (unsigned char*)d_ws;
#if MK_PER_PHASE
    for (int ph = 0; ph < NPHASE; ++ph) { a.ph_lo = ph; a.ph_hi = ph + 1; hipLaunchKernelGGL(fwd, dim3(grid), dim3(NTHR), LDS_BYTES, stream, a); }
#else
    a.ph_lo = 0; a.ph_hi = NPHASE; hipLaunchKernelGGL(fwd, dim3(grid), dim3(NTHR), LDS_BYTES, stream, a);
#endif
}
```

```cpp
#include <hip/hip_runtime.h>
#include <stdio.h>
#include <stdint.h>

#ifndef MK_PER_PHASE
#define MK_PER_PHASE 0
#endif

#define LAS __attribute__((address_space(3)))
typedef unsigned short bf16_t;
typedef short bf16x8 __attribute__((ext_vector_type(8)));
typedef float f32x4 __attribute__((ext_vector_type(4)));
typedef float f32x16 __attribute__((ext_vector_type(16)));
typedef unsigned u32x4 __attribute__((ext_vector_type(4)));
typedef unsigned u32x2 __attribute__((ext_vector_type(2)));

constexpr int T = 65536, NB = 32, SEQ = 2048, D = 1024;
constexpr int NTHR = 512;
constexpr int LDS_BYTES = 159744, MISC_OFF = LDS_BYTES - 4096;
constexpr int NPHASE = 11;

constexpr size_t WS_CTL = 0, CTL_BYTES = 65536;
constexpr size_t CTL_GCNT = 16384;
constexpr size_t WS_WIN = WS_CTL + CTL_BYTES;
constexpr size_t WS_WMEM = WS_WIN + (size_t)5120 * 1024 * 2;
constexpr size_t WS_WGLU = WS_WMEM + (size_t)1024 * 1024 * 2;
constexpr size_t WS_WUP = WS_WGLU + (size_t)512 * 512 * 2;
constexpr size_t WS_WOUT = WS_WUP + (size_t)3 * 1024 * 512 * 2;
constexpr size_t WS_WGU = WS_WOUT + (size_t)1024 * 1024 * 2;
constexpr size_t WS_WD = WS_WGU + (size_t)32 * 1024 * 1024 * 2;
constexpr size_t WS_TW = WS_WD + (size_t)32 * 1024 * 512 * 2;
constexpr size_t WS_SIN = WS_TW + (size_t)32 * 512 * 640 * 2;
constexpr size_t WS_LAM32 = WS_SIN + (size_t)32 * 256 * 512 * 2;
constexpr size_t WS_WR = WS_LAM32 + 16384;
constexpr size_t WS_HB = WS_WR + 98304;
constexpr size_t WS_UA = WS_HB + (size_t)T * 1024 * 2;
constexpr size_t WS_KVX = WS_UA + (size_t)32 * 2048 * 640 * 2;
constexpr size_t WS_KVP = WS_KVX + (size_t)T * 256 * 2;
constexpr size_t WS_KIP = WS_KVP + (size_t)T * 128 * 2;
constexpr size_t WS_WIF = WS_KIP + (size_t)T * 64 * 2;
constexpr size_t WS_QI = WS_WIF + (size_t)T * 4 * 4;
constexpr size_t WS_SG = WS_QI + (size_t)T * 256 * 2;
constexpr size_t WS_X1B = WS_SG;
constexpr size_t WS_HID = WS_SG + (size_t)T * 3072;
constexpr size_t WS_X1B8 = WS_HID + (size_t)T * 1024;
constexpr size_t WS_SC = WS_HID + (size_t)T * 1024 * 2;
constexpr size_t WS_IDX = WS_SC + (size_t)32 * 2048 * 128 * 4;
constexpr size_t WS_MEMN = WS_IDX + (size_t)T * 256 * 2;
constexpr size_t WS_KMVM = WS_MEMN + (size_t)8192 * 1024 * 2;
constexpr size_t WS_KM = WS_KMVM + (size_t)8192 * 1024 * 2;
constexpr size_t WS_VMT = WS_KM + (size_t)128 * 256 * 128 * 2;
constexpr size_t WS_TOK = WS_VMT + (size_t)128 * 128 * 256 * 2;
constexpr size_t WS_RW = WS_TOK + (size_t)32 * 65536 * 4;
constexpr size_t WS_TOK2 = WS_RW + (size_t)32 * 65536 * 8;
constexpr size_t WS_LP = WS_TOK2 + (size_t)112 * 65536 * 4;
constexpr size_t WS_BB = WS_LP + (size_t)32 * 64 * 33 * 8;
constexpr size_t WS_HB8 = WS_BB + (size_t)32 * 64 * 16 * 8;
constexpr size_t WS_WG8 = WS_HB8 + (size_t)T * 1024;
constexpr size_t WS_CS = WS_WG8 + (size_t)5120 * 1024;
constexpr size_t WS_END = WS_CS + (size_t)T * 32 * 8;
constexpr size_t DO_Y3 = 0, DO_Y8 = (size_t)T * 1024 * 2, DO_YS8 = DO_Y8, DO_YD8 = DO_Y8 + (size_t)T * 512, DO_YM8 = DO_Y8 + (size_t)2 * T * 512;
constexpr int Y3LD = 1024;
constexpr size_t WS_YG = WS_HID;

__device__ __forceinline__ float bf2f(unsigned b) { return __uint_as_float(b << 16); }
__device__ __forceinline__ unsigned cvt_pk_bf16(float lo, float hi) { unsigned r; asm("v_cvt_pk_bf16_f32 %0, %1, %2" : "=v"(r) : "v"(lo), "v"(hi)); return r; }
__device__ __forceinline__ bf16_t f2bf(float f) { return (bf16_t)(cvt_pk_bf16(f, 0.f) & 0xffffu); }
__device__ __forceinline__ float wave_sum(float v) { v += __shfl_xor(v, 32); v += __shfl_xor(v, 16); v += __shfl_xor(v, 8); v += __shfl_xor(v, 4); v += __shfl_xor(v, 2); v += __shfl_xor(v, 1); return v; }
__device__ __forceinline__ float sum32(float v) { v += __shfl_xor(v, 16); v += __shfl_xor(v, 8); v += __shfl_xor(v, 4); v += __shfl_xor(v, 2); v += __shfl_xor(v, 1); return v; }
__device__ __forceinline__ float xsum32(float x) { const auto r = __builtin_amdgcn_permlane32_swap(__float_as_uint(x), __float_as_uint(x), false, false); return __uint_as_float(r[0]) + __uint_as_float(r[1]); }
__device__ __forceinline__ float xmax32(float x) { const auto r = __builtin_amdgcn_permlane32_swap(__float_as_uint(x), __float_as_uint(x), false, false); return fmaxf(__uint_as_float(r[0]), __uint_as_float(r[1])); }
__device__ __forceinline__ float xsum16(float x) { const auto r = __builtin_amdgcn_permlane16_swap(__float_as_uint(x), __float_as_uint(x), false, false); return __uint_as_float(r[0]) + __uint_as_float(r[1]); }
__device__ __forceinline__ float sigm(float x) { return __builtin_amdgcn_rcpf(1.0f + __expf(-x)); }
__device__ __forceinline__ float gelu_tanh(float x) { const float u = 1.5957691216057308f * (x + 0.044715f * x * x * x); return x * sigm(u); }
__device__ __forceinline__ u32x4 pack8(const f32x4 a, const f32x4 b) { u32x4 w; w.x = cvt_pk_bf16(a[0], a[1]); w.y = cvt_pk_bf16(a[2], a[3]); w.z = cvt_pk_bf16(b[0], b[1]); w.w = cvt_pk_bf16(b[2], b[3]); return w; }
__device__ __forceinline__ void unpack8(const u32x4 w, f32x4& a, f32x4& b) {
    a[0] = bf2f(w.x & 0xffffu); a[1] = bf2f(w.x >> 16); a[2] = bf2f(w.y & 0xffffu); a[3] = bf2f(w.y >> 16);
    b[0] = bf2f(w.z & 0xffffu); b[1] = bf2f(w.z >> 16); b[2] = bf2f(w.w & 0xffffu); b[3] = bf2f(w.w >> 16); }

__device__ __forceinline__ unsigned pack_fp8x4(float a, float b, float c, float d) {
    a = __builtin_amdgcn_fmed3f(a, -448.f, 448.f); b = __builtin_amdgcn_fmed3f(b, -448.f, 448.f); c = __builtin_amdgcn_fmed3f(c, -448.f, 448.f); d = __builtin_amdgcn_fmed3f(d, -448.f, 448.f);
    int p = __builtin_amdgcn_cvt_pk_fp8_f32(a, b, 0, false); p = __builtin_amdgcn_cvt_pk_fp8_f32(c, d, p, true); return (unsigned)p; }

__device__ __forceinline__ unsigned pack_fp8x4_nc(float a, float b, float c, float d) {
    int p = __builtin_amdgcn_cvt_pk_fp8_f32(a, b, 0, false); p = __builtin_amdgcn_cvt_pk_fp8_f32(c, d, p, true); return (unsigned)p; }

#define XB_TMO      128
#define XB_XCNT(j)  (256  + 64 * (j))
#define XB_XSUB(j)  (1280 + 64 * (j))
#define XB_XGEN(j)  (2304 + 64 * (j))
#define XB_TOP      3328
#define XB_TOPGEN   3392
#define XCD_BAR_WORDS 3456
#define XB_SPIN_CAP (1u << 18)
__device__ __forceinline__ unsigned xb_ld(unsigned* p)              { return __hip_atomic_load(p, __ATOMIC_RELAXED, __HIP_MEMORY_SCOPE_AGENT); }
__device__ __forceinline__ unsigned xb_add(unsigned* p, unsigned v) { return __hip_atomic_fetch_add(p, v, __ATOMIC_RELAXED, __HIP_MEMORY_SCOPE_AGENT); }
__device__ __forceinline__ unsigned xb_xcc_id() { return (unsigned)__builtin_amdgcn_s_getreg((3 << 11) | 20) & 0xFu; }
#define XB_SPIN(cond, bar) do { unsigned _sp = 0; while (cond) { __builtin_amdgcn_s_sleep(1); \
    if ((++_sp & 255u) == 0u) { if (xb_ld(&(bar)[XB_TMO])) break; if (_sp > XB_SPIN_CAP) { atomicAdd(&(bar)[XB_TMO], 1u); break; } } } } while (0)
struct XcdBarrier { unsigned* bar; unsigned x; volatile LAS unsigned* st; };
__device__ __forceinline__ XcdBarrier xcd_barrier_post(unsigned* bar, volatile LAS unsigned* st) {
    XcdBarrier b; b.bar = bar; b.x = xb_xcc_id(); b.st = st;
    if (threadIdx.x == 0) st[2] = xb_add(&bar[XB_XCNT(b.x)], 1u);
    return b;
}
__device__ __forceinline__ void xcd_barrier_complete(unsigned* bar, unsigned x, unsigned& nloc, unsigned& nx) {
    const unsigned G = gridDim.x * gridDim.y * gridDim.z;
    unsigned sum, cnt, mine, sp = 0u;
    for (;;) {
        sum = 0u; cnt = 0u; mine = 0u;
#pragma unroll
        for (unsigned j = 0; j < 16; ++j) { const unsigned c = xb_ld(&bar[XB_XCNT(j)]); sum += c; cnt += (c > 0u) ? 1u : 0u; mine = (j == x) ? c : mine; }
        if (sum == G) break;
        __builtin_amdgcn_s_sleep(1);
        if ((++sp & 255u) == 0u) { if (xb_ld(&bar[XB_TMO])) break; if (sp > XB_SPIN_CAP) { atomicAdd(&bar[XB_TMO], 1u); break; } }
    }
    nloc = mine > 0u ? mine : 1u; nx = cnt > 0u ? cnt : 1u;
}
__device__ __forceinline__ void xcd_barrier(const XcdBarrier& b) {
    asm volatile("s_waitcnt vmcnt(0)" ::: "memory");
    __syncthreads();
    if (threadIdx.x == 0) {
        unsigned* bar = b.bar;
        __builtin_amdgcn_s_waitcnt(0);
        unsigned nloc = b.st[0], nx = b.st[1];
        if (nloc == 0u) { xcd_barrier_complete(bar, b.x, nloc, nx); b.st[0] = nloc; b.st[1] = nx; }
        const unsigned old = xb_add(&bar[XB_XSUB(b.x)], 1u);
        const unsigned gen = old / nloc;
        if (old + 1u == (gen + 1u) * nloc) {
            __builtin_amdgcn_fence(__ATOMIC_RELEASE, "agent");
            asm volatile("s_waitcnt vmcnt(0)" ::: "memory");
            const unsigned og = xb_add(&bar[XB_TOP], 1u);
            const unsigned tg = og / nx;
            if (og + 1u == (tg + 1u) * nx) xb_add(&bar[XB_TOPGEN], 1u);
            else XB_SPIN(xb_ld(&bar[XB_TOPGEN]) == tg, bar);
            __builtin_amdgcn_fence(__ATOMIC_ACQUIRE, "agent");
            xb_add(&bar[XB_XGEN(b.x)], 1u);
            asm volatile("s_waitcnt vmcnt(0)" ::: "memory");
        } else {
            XB_SPIN(xb_ld(&bar[XB_XGEN(b.x)]) == gen, bar);
            __builtin_amdgcn_fence(__ATOMIC_ACQUIRE, "agent");
            asm volatile("s_waitcnt vmcnt(0)" ::: "memory");
        }
    }
    __syncthreads();
}

namespace pg8 {
constexpr int BM = 256, BK = 64, HALF = 128, HTB = HALF * BK * 2, STAGE_BYTES = 8 * HTB;
__device__ __forceinline__ int lds_byte(int r, int c) { const int st = (r >> 4) * 2 + (c >> 5), rr = r & 15, cc = c & 31, ob = rr * 64 + cc * 2; return st * 1024 + (ob ^ (((ob >> 9) & 1) << 5)); }
__device__ __forceinline__ void stage_rc(int b, int& R, int& C) { const int st = b / 1024, sb = b % 1024, swz = sb ^ (((sb >> 9) & 1) << 5); R = (st >> 1) * 16 + swz / 64; C = (st & 1) * 32 + (swz % 64) / 2; }
__device__ __forceinline__ int perm32(int rho) { const int n = rho >> 4, i = rho & 15; return 8 * (i >> 2) + 4 * n + (i & 3); }
__device__ __forceinline__ int perm16(int R) { return ((R >> 5) << 6) + (((R >> 2) & 3) << 4) + (((R >> 4) & 1) << 2) + (R & 3); }
struct Unit { int pm, pn, z; };
struct Gemm { int lda, ldb, K; int sa = 0x7f, sb = 0x7f; };
typedef int v8i32 __attribute__((ext_vector_type(8)));
typedef int v4i32 __attribute__((ext_vector_type(4)));

#ifndef PG8_SP2
#define PG8_SP2 true
#endif
template <class Epi, class Sched, bool GATHER, bool SP2 = PG8_SP2, bool F8 = false>
__device__ __forceinline__ void gemm_phase(LAS unsigned char* lds, const Gemm g, const Sched& S, const Epi& E) {
    const int tid = threadIdx.x, wid = __builtin_amdgcn_readfirstlane(tid >> 6), lane = tid & 63, wr = wid >> 2, wc = wid & 3, fr = lane & 15, fq = lane >> 4;
    const int K = g.K, nt = K / BK;
    unsigned voffA[2], voffB[2]; int Rr[2], Cc[2];
#pragma unroll
    for (int i = 0; i < 2; ++i) { int R, C; stage_rc(tid * 16 + i * 8192, R, C); const int Rb = Epi::PERM16 ? perm16(R) : (Epi::PERM ? ((R & ~31) + perm32(R & 31)) : R);
        Rr[i] = R; Cc[i] = C; voffA[i] = (unsigned)(R * g.lda + C) * 2u; voffB[i] = (unsigned)(Rb * g.ldb + C) * 2u; }
    const size_t hstepA = (size_t)HALF * g.lda * 2, hstepB = (size_t)(Epi::PERM16 ? 8 : HALF) * g.ldb * 2;
    const unsigned ldsw = (unsigned)wid * 1024u;
    const int aoff = lds_byte(wr * 64 + fr, fq * 8), boff = lds_byte(wc * 32 + fr, fq * 8);
#define PG8_SA(b, h) (((b) * 2 + (h)) * HTB)
#define PG8_SB(b, h) ((4 + (b) * 2 + (h)) * HTB)
#define PG8_GLDS(gp, lo) __builtin_amdgcn_global_load_lds((const unsigned*)(gp), (LAS unsigned*)(lds + (lo)), 16, 0, 0)
#define PG8_STAGE_B(bufoff, gbase, h) do { const char* _b = (const char*)(gbase) + (h) * hstepB; PG8_GLDS(_b + voffB[0], (bufoff) + ldsw); PG8_GLDS(_b + voffB[1], (bufoff) + ldsw + 8192); } while (0)
#define PG8_STAGE_A(bufoff, gbase, h, OFF) do { if constexpr (GATHER) { PG8_GLDS((const char*)(gbase) + OFF##h##0, (bufoff) + ldsw); PG8_GLDS((const char*)(gbase) + OFF##h##1, (bufoff) + ldsw + 8192); } \
        else { const char* _a = (const char*)(gbase) + (h) * hstepA; PG8_GLDS(_a + voffA[0], (bufoff) + ldsw); PG8_GLDS(_a + voffA[1], (bufoff) + ldsw + 8192); } } while (0)
#define PG8_LDA(dst, b, h) do { if constexpr (F8) { _Pragma("unroll") for (int m = 0; m < 4; ++m) { const v4i32 _lo = *(const LAS v4i32*)(lds + PG8_SA(b, h) + aoff + m * 2048), _hi = *(const LAS v4i32*)(lds + PG8_SA(b, h) + aoff + m * 2048 + 1024); \
            dst##8[m] = __builtin_shufflevector(_lo, _hi, 0, 1, 2, 3, 4, 5, 6, 7); } } \
        else { _Pragma("unroll") for (int m = 0; m < 4; ++m) _Pragma("unroll") for (int k = 0; k < 2; ++k) dst[m][k] = *(const LAS bf16x8*)(lds + PG8_SA(b, h) + aoff + m * 2048 + k * 1024); } } while (0)
#define PG8_LDB(dst, b, h) do { if constexpr (F8) { _Pragma("unroll") for (int n = 0; n < 2; ++n) { const v4i32 _lo = *(const LAS v4i32*)(lds + PG8_SB(b, h) + boff + n * 2048), _hi = *(const LAS v4i32*)(lds + PG8_SB(b, h) + boff + n * 2048 + 1024); \
            dst##8[n] = __builtin_shufflevector(_lo, _hi, 0, 1, 2, 3, 4, 5, 6, 7); } } \
        else { _Pragma("unroll") for (int n = 0; n < 2; ++n) _Pragma("unroll") for (int k = 0; k < 2; ++k) dst[n][k] = *(const LAS bf16x8*)(lds + PG8_SB(b, h) + boff + n * 2048 + k * 1024); } } while (0)
#define PG8_MMA(ai, bj, At, Bt) do { __builtin_amdgcn_s_setprio(3); \
        if constexpr (F8) { _Pragma("unroll") for (int m = 0; m < 4; ++m) _Pragma("unroll") for (int n = 0; n < 2; ++n) \
            asm volatile("v_mfma_scale_f32_16x16x128_f8f6f4 %0, %1, %2, %0, %3, %4 op_sel_hi:[0,0,0]" : "+v"(acc[ai][bj][m][n]) : "v"(Bt##8[n]), "v"(At##8[m]), "v"(f8sb), "v"(f8sa)); } \
        else { _Pragma("unroll") for (int m = 0; m < 4; ++m) _Pragma("unroll") for (int n = 0; n < 2; ++n) _Pragma("unroll") for (int k = 0; k < 2; ++k) \
            acc[ai][bj][m][n] = __builtin_amdgcn_mfma_f32_16x16x32_bf16(Bt[n][k], At[m][k], acc[ai][bj][m][n], 0, 0, 0); } \
        __builtin_amdgcn_s_setprio(0); } while (0)
#define PG8_WAIT_V(n) asm volatile("s_waitcnt vmcnt(" #n ")" ::: "memory")
#define PG8_WAIT_L(n) asm volatile("s_waitcnt lgkmcnt(" #n ")" ::: "memory")
#define PG8_BAR __builtin_amdgcn_s_barrier()
#define PG8_SCHED __builtin_amdgcn_sched_barrier(0)
    Unit cur, nxt; int ui = 0;
    if (!S.next(0, cur)) return;
    f32x4 acc[2][2][4][2];
#pragma unroll
    for (int a = 0; a < 2; ++a)
#pragma unroll
        for (int b = 0; b < 2; ++b)
#pragma unroll
            for (int m = 0; m < 4; ++m)
#pragma unroll
                for (int n = 0; n < 2; ++n) acc[a][b][m][n] = (f32x4){0.f, 0.f, 0.f, 0.f};
    bf16x8 At[4][2], B0[2][2], B1[2][2]; v8i32 At8[4], B08[2], B18[2];
    const int f8sa = g.sa, f8sb = g.sb;
    unsigned coff00 = 0u, coff01 = 0u, coff10 = 0u, coff11 = 0u, noff00 = 0u, noff01 = 0u, noff10 = 0u, noff11 = 0u;
    if constexpr (GATHER) {
        coff00 = S.a_off(cur, Rr[0]) + (unsigned)Cc[0] * 2u; coff01 = S.a_off(cur, Rr[1]) + (unsigned)Cc[1] * 2u;
        coff10 = S.a_off(cur, HALF + Rr[0]) + (unsigned)Cc[0] * 2u; coff11 = S.a_off(cur, HALF + Rr[1]) + (unsigned)Cc[1] * 2u;
    }
    { const char* cA = S.a_ptr(cur, 0); const char* cB = S.b_ptr(cur, 0); const char* cA1 = S.a_ptr(cur, 1); const char* cB1 = S.b_ptr(cur, 1);
    if constexpr (SP2) {
    PG8_STAGE_B(PG8_SB(0, 0), cB, 0); PG8_STAGE_B(PG8_SB(0, 1), cB, 1); PG8_STAGE_A(PG8_SA(0, 0), cA, 0, coff); PG8_STAGE_A(PG8_SA(0, 1), cA, 1, coff);
    if (wr == 1) PG8_BAR;
    PG8_WAIT_V(2); PG8_BAR;
    PG8_STAGE_B(PG8_SB(1, 0), cB1, 0); PG8_STAGE_A(PG8_SA(1, 0), cA1, 0, coff); PG8_STAGE_B(PG8_SB(1, 1), cB1, 1);
    PG8_WAIT_V(6); PG8_BAR;
    } else {
    PG8_STAGE_B(PG8_SB(0, 0), cB, 0); PG8_STAGE_A(PG8_SA(0, 0), cA, 0, coff); PG8_STAGE_B(PG8_SB(0, 1), cB, 1); PG8_STAGE_A(PG8_SA(0, 1), cA, 1, coff);
    if (wr == 1) PG8_BAR;
    PG8_WAIT_V(4); PG8_BAR;
    PG8_STAGE_B(PG8_SB(1, 0), cB1, 0); PG8_STAGE_A(PG8_SA(1, 0), cA1, 0, coff); PG8_STAGE_B(PG8_SB(1, 1), cB1, 1);
    PG8_WAIT_V(6); PG8_BAR; } }
    for (;;) {
        const bool has_next = S.next(ui + 1, nxt);
        Unit un; un.pm = has_next ? nxt.pm : cur.pm; un.pn = has_next ? nxt.pn : cur.pn; un.z = has_next ? nxt.z : cur.z;
        if constexpr (GATHER) {
            noff00 = has_next ? (S.a_off(nxt, Rr[0]) + (unsigned)Cc[0] * 2u) : coff00; noff01 = has_next ? (S.a_off(nxt, Rr[1]) + (unsigned)Cc[1] * 2u) : coff01;
            noff10 = has_next ? (S.a_off(nxt, HALF + Rr[0]) + (unsigned)Cc[0] * 2u) : coff10; noff11 = has_next ? (S.a_off(nxt, HALF + Rr[1]) + (unsigned)Cc[1] * 2u) : coff11;
        }
        for (int t = 0; t < nt; t += 2) {
            const bool last = (t == nt - 2);
            if constexpr (Epi::HOOK) { if (t == Epi::H1 || t == Epi::H2) { if constexpr (F8) asm volatile("s_nop 15\n\ts_nop 15\n\ts_nop 7" ::: "memory"); if (wr == 0) PG8_BAR; E.hook(acc, cur, t, wr, wc, fr, fq); if (wr == 1) PG8_BAR; } }
            const char* a1 = S.a_ptr(cur, t + 1);
            const char* a2 = last ? S.a_ptr(un, 0) : S.a_ptr(cur, t + 2); const char* b2 = last ? S.b_ptr(un, 0) : S.b_ptr(cur, t + 2);
            const char* a3 = last ? S.a_ptr(un, 1) : S.a_ptr(cur, t + 3); const char* b3 = last ? S.b_ptr(un, 1) : S.b_ptr(cur, t + 3);
            const unsigned o200 = last ? noff00 : coff00, o201 = last ? noff01 : coff01, o210 = last ? noff10 : coff10, o211 = last ? noff11 : coff11;
            if constexpr (SP2) {
            PG8_LDB(B0, 0, 0); PG8_LDB(B1, 0, 1); PG8_SCHED; PG8_LDA(At, 0, 0); PG8_STAGE_A(PG8_SA(1, 1), a1, 1, coff);
            PG8_WAIT_V(8); PG8_WAIT_L(0); PG8_BAR; PG8_MMA(0, 0, At, B0); PG8_MMA(0, 1, At, B1); PG8_BAR; PG8_SCHED;
            PG8_LDA(At, 0, 1); PG8_STAGE_B(PG8_SB(0, 0), b2, 0); PG8_STAGE_B(PG8_SB(0, 1), b2, 1); PG8_STAGE_A(PG8_SA(0, 0), a2, 0, o2);
            PG8_WAIT_V(8); PG8_WAIT_L(0); PG8_BAR; PG8_MMA(1, 0, At, B0); PG8_MMA(1, 1, At, B1); PG8_BAR; PG8_SCHED;
            PG8_LDB(B0, 1, 0); PG8_LDB(B1, 1, 1); PG8_SCHED; PG8_LDA(At, 1, 0); PG8_STAGE_A(PG8_SA(0, 1), a2, 1, o2);
            PG8_WAIT_V(8); PG8_WAIT_L(0); PG8_BAR; PG8_MMA(0, 0, At, B0); PG8_MMA(0, 1, At, B1); PG8_BAR; PG8_SCHED;
            PG8_LDA(At, 1, 1); PG8_STAGE_B(PG8_SB(1, 0), b3, 0); PG8_STAGE_B(PG8_SB(1, 1), b3, 1); PG8_STAGE_A(PG8_SA(1, 0), a3, 0, o2);
            PG8_WAIT_V(8); PG8_WAIT_L(0); PG8_BAR; PG8_MMA(1, 0, At, B0); PG8_MMA(1, 1, At, B1); PG8_BAR; PG8_SCHED;
            } else {
            PG8_LDB(B0, 0, 0); PG8_SCHED; PG8_LDA(At, 0, 0); PG8_STAGE_A(PG8_SA(1, 1), a1, 1, coff);
            PG8_WAIT_L(8); PG8_BAR; PG8_WAIT_L(0); PG8_MMA(0, 0, At, B0); PG8_BAR; PG8_SCHED;
            PG8_LDB(B1, 0, 1); PG8_STAGE_B(PG8_SB(0, 0), b2, 0);
            PG8_BAR; PG8_WAIT_L(0); PG8_MMA(0, 1, At, B1); PG8_BAR;
            PG8_LDA(At, 0, 1); PG8_STAGE_A(PG8_SA(0, 0), a2, 0, o2);
            PG8_BAR; PG8_WAIT_L(0); PG8_MMA(1, 0, At, B0); PG8_BAR; PG8_SCHED;
            PG8_STAGE_B(PG8_SB(0, 1), b2, 1);
            PG8_WAIT_V(6); PG8_BAR; PG8_MMA(1, 1, At, B1); PG8_BAR;
            PG8_LDB(B0, 1, 0); PG8_SCHED; PG8_LDA(At, 1, 0); PG8_STAGE_A(PG8_SA(0, 1), a2, 1, o2);
            PG8_WAIT_L(8); PG8_BAR; PG8_WAIT_L(0); PG8_MMA(0, 0, At, B0); PG8_BAR; PG8_SCHED;
            PG8_LDB(B1, 1, 1); PG8_STAGE_B(PG8_SB(1, 0), b3, 0);
            PG8_BAR; PG8_WAIT_L(0); PG8_MMA(0, 1, At, B1); PG8_BAR;
            PG8_LDA(At, 1, 1); PG8_STAGE_A(PG8_SA(1, 0), a3, 0, o2);
            PG8_BAR; PG8_WAIT_L(0); PG8_MMA(1, 0, At, B0); PG8_BAR; PG8_SCHED;
            PG8_STAGE_B(PG8_SB(1, 1), b3, 1);
            PG8_WAIT_V(6); PG8_BAR; PG8_MMA(1, 1, At, B1); PG8_BAR;
            }
        }
        if constexpr (F8) asm volatile("s_nop 15\n\ts_nop 15\n\ts_nop 7" ::: "memory");
        if (wr == 0) PG8_BAR;
        E(acc, cur, wr, wc, fr, fq);
        if (!has_next) break;
#pragma unroll
        for (int a = 0; a < 2; ++a)
#pragma unroll
            for (int b = 0; b < 2; ++b)
#pragma unroll
                for (int m = 0; m < 4; ++m)
#pragma unroll
                    for (int n = 0; n < 2; ++n) acc[a][b][m][n] = (f32x4){0.f, 0.f, 0.f, 0.f};
        cur = nxt; ++ui;
        if constexpr (GATHER) { coff00 = noff00; coff01 = noff01; coff10 = noff10; coff11 = noff11; }
        if (wr == 1) PG8_BAR;
    }
    PG8_WAIT_V(0);
    PG8_BAR;
#undef PG8_SA
#undef PG8_SB
#undef PG8_GLDS
#undef PG8_STAGE_A
#undef PG8_STAGE_B
#undef PG8_LDA
#undef PG8_LDB
#undef PG8_MMA
#undef PG8_WAIT_V
#undef PG8_WAIT_L
#undef PG8_BAR
#undef PG8_SCHED
}

struct SchedGrid {
    const char* A; const char* B; size_t zA, zB, tA, tB; int nM, nN, nz, G, c, rep;
    __device__ __forceinline__ bool next(int i, Unit& u) const {
        const int nwg = nz * nM * nN; const long L = (long)i * G + c; if (L >= (long)nwg * rep) return false;
        int w = (int)(L % nwg); { const int q = nwg / 8, r = nwg % 8, x = w % 8, off = w / 8; w = (x < r ? x * (q + 1) : r * (q + 1) + (x - r) * q) + off; }
        const int per = nM * nN; u.z = w / per; w -= u.z * per;
#ifdef PROBE_NOEPI
        if (L >= nwg) u.z |= 0x4000;
#endif
        const int nig = 8 * nN, gid = w / nig, fm = gid * 8, gsz = (nM - fm) < 8 ? (nM - fm) : 8;
        u.pm = fm + ((w % nig) % gsz); u.pn = (w % nig) / gsz; return true; }
    __device__ __forceinline__ const char* a_ptr(const Unit& u, int t) const { return A + (size_t)u.z * zA + (size_t)u.pm * tA + (size_t)t * 128; }
    __device__ __forceinline__ const char* b_ptr(const Unit& u, int t) const { return B + (size_t)u.z * zB + (size_t)u.pn * tB + (size_t)t * 128; }
    __device__ __forceinline__ unsigned a_off(const Unit&, int) const { return 0u; }
};
}

struct Args { const void* in[32]; float* out; unsigned char* ws; int ph_lo, ph_hi; };
struct Frame {
    LAS unsigned char* lds; int tid, lane, wave, G, c;
    unsigned char* ws; unsigned char* dout;
};
enum { I_X = 0, I_MEM, I_POS, I_GMIX, I_GMEM, I_WIN, I_LRE, I_LIM, I_LDT, I_BRE, I_BIM, I_CRE, I_CIM, I_DSKIP, I_WGLU, I_GQ, I_GK, I_GQM, I_GKM, I_WMEMKV,
       I_WUPS, I_WUPD, I_WUPM, I_WOUT, I_GFFN, I_WGROUP, I_BGROUP, I_WEXP, I_BEXP, I_WGATE, I_WUP, I_WDOWN };
#define INP(i) ((const float*)a.in[i])
#define WSP(T_, off) ((T_*)(F.ws + (off)))
#define DOP(T_, off) ((T_*)(F.dout + (off)))

using pg8::Unit;
__device__ __forceinline__ unsigned gpack4(const f32x4 v) {
    unsigned w = 0u;
#pragma unroll
    for (int j = 0; j < 4; ++j) { const float sg255 = __builtin_amdgcn_rcpf(__builtin_fmaf(__builtin_amdgcn_exp2f(v[j]), 1.0f / 255.0f, 1.0f / 255.0f)); w = __builtin_amdgcn_cvt_pk_u8_f32(sg255, j, w); }
    return w; }
__device__ __forceinline__ void gdecode(const u32x2 w, float (&g)[8]) {
#pragma unroll
    for (int j = 0; j < 4; ++j) { g[j] = fmaxf((float)((w.x >> (8 * j)) & 255u), 0.5f); g[4 + j] = fmaxf((float)((w.y >> (8 * j)) & 255u), 0.5f); } }
__device__ __forceinline__ size_t sg_off(int pm, int gt, int am, int wave, int lane) { return ((size_t)(pm * 12 + gt) * 64 + am * 8 + wave) * 1024 + lane * 16; }
struct EpiInProj {
    static constexpr bool PERM = true, PERM16 = true, HOOK = false;
    bf16_t *UA, *Y3, *KVX, *QI; unsigned char* SG;
    __device__ __forceinline__ void operator()(const f32x4 (&acc)[2][2][4][2], const Unit& u, int wr, int wc, int fr, int fq) const {
        const int pn = u.pn, row0 = u.pm * 256 + wr * 64 + fr, c0 = wc * 64 + 16 * fq;
        if (pn >= 18) {
            bf16_t* base = (pn == 18 ? KVX : QI) + (size_t)row0 * 256 + c0;
#pragma unroll
            for (int ai = 0; ai < 2; ++ai)
#pragma unroll
                for (int m = 0; m < 4; ++m) { bf16_t* p = base + (size_t)(ai * 128 + m * 16) * 256;
                    *(u32x4*)p = pack8(acc[ai][0][m][0], acc[ai][0][m][1]); *(u32x4*)(p + 8) = pack8(acc[ai][1][m][0], acc[ai][1][m][1]); }
        } else if (pn >= 6) {
            unsigned char* base = SG + sg_off(u.pm, pn - 6, 0, wr * 4 + wc, fq * 16 + fr);
#pragma unroll
            for (int ai = 0; ai < 2; ++ai)
#pragma unroll
                for (int m = 0; m < 4; ++m) { u32x4 w; w.x = gpack4(acc[ai][0][m][0]); w.y = gpack4(acc[ai][0][m][1]); w.z = gpack4(acc[ai][1][m][0]); w.w = gpack4(acc[ai][1][m][1]);
                    *(u32x4*)(base + (ai * 4 + m) * 8192) = w; }
        } else if (pn >= 2) {
            bf16_t* base = Y3 + (size_t)row0 * Y3LD + (pn - 2) * 256 + c0;
#pragma unroll
            for (int ai = 0; ai < 2; ++ai)
#pragma unroll
                for (int m = 0; m < 4; ++m) { bf16_t* p = base + (size_t)(ai * 128 + m * 16) * Y3LD;
                    *(u32x4*)p = pack8(acc[ai][0][m][0], acc[ai][0][m][1]); *(u32x4*)(p + 8) = pack8(acc[ai][1][m][0], acc[ai][1][m][1]); }
        } else {
#pragma unroll
            for (int ai = 0; ai < 2; ++ai)
#pragma unroll
                for (int m = 0; m < 4; ++m) { const int r = row0 + ai * 128 + m * 16, b = r >> 11, s = r & 2047, gI = (pn * 256 + c0) >> 4;
                    bf16_t* p = UA + ((size_t)(gI * 2048 + b * 64 + (s >> 5)) * 640 + (s & 31) * 16);
                    *(u32x4*)p = pack8(acc[ai][0][m][0], acc[ai][0][m][1]); *(u32x4*)(p + 8) = pack8(acc[ai][1][m][0], acc[ai][1][m][1]); }
        }
    }
};
struct EpiInProjB {
    static constexpr bool PERM = true, PERM16 = false, HOOK = false;
    bf16_t *KVX, *QI;
    __device__ __forceinline__ void operator()(const f32x4 (&acc)[2][2][4][2], const Unit& u, int wr, int wc, int fr, int fq) const {
        const int row0 = u.pm * 256 + wr * 64 + fr, cw = wc * 32 + 8 * fq; bf16_t* base = u.pn == 0 ? KVX : QI;
#pragma unroll
        for (int ai = 0; ai < 2; ++ai)
#pragma unroll
            for (int m = 0; m < 4; ++m)
#pragma unroll
                for (int bj = 0; bj < 2; ++bj)
                    *(u32x4*)(base + (size_t)(row0 + ai * 128 + m * 16) * 256 + bj * 128 + cw) = pack8(acc[ai][bj][m][0], acc[ai][bj][m][1]);
    }
};
struct EpiBf16 {
    static constexpr bool PERM = true, PERM16 = false, HOOK = false;
    bf16_t* O; int ld;
    __device__ __forceinline__ void operator()(const f32x4 (&acc)[2][2][4][2], const Unit& u, int wr, int wc, int fr, int fq) const {
        const int row0 = u.pm * 256 + wr * 64 + fr, col0 = u.pn * 256 + wc * 32 + 8 * fq;
#pragma unroll
        for (int ai = 0; ai < 2; ++ai)
#pragma unroll
            for (int m = 0; m < 4; ++m)
#pragma unroll
                for (int bj = 0; bj < 2; ++bj)
                    *(u32x4*)(O + (size_t)(row0 + ai * 128 + m * 16) * ld + col0 + bj * 128) = pack8(acc[ai][bj][m][0], acc[ai][bj][m][1]);
    }
};
struct EpiSc {
    static constexpr bool PERM = false, PERM16 = false, HOOK = false;
    float* SC;
    __device__ __forceinline__ void operator()(const f32x4 (&acc)[2][2][4][2], const Unit& u, int wr, int wc, int fr, int fq) const {
        const int row0 = u.pm * 256 + wr * 64 + fr, col0 = wc * 32 + 4 * fq;
#pragma unroll
        for (int ai = 0; ai < 2; ++ai)
#pragma unroll
            for (int m = 0; m < 4; ++m)
#pragma unroll
                for (int n = 0; n < 2; ++n)
                    *(f32x4*)(SC + ((size_t)u.z * 2048 + row0 + ai * 128 + m * 16) * 128 + col0 + n * 16) = acc[ai][0][m][n];
    }
};
struct EpiGelu {
    static constexpr bool PERM = true, PERM16 = false, HOOK = false;
    bf16_t* YG;
    __device__ __forceinline__ void operator()(const f32x4 (&acc)[2][2][4][2], const Unit& u, int wr, int wc, int fr, int fq) const {
        const int row0 = u.pm * 256 + wr * 64 + fr, col0 = u.pn * 256 + wc * 32 + 8 * fq;
#pragma unroll
        for (int ai = 0; ai < 2; ++ai)
#pragma unroll
            for (int m = 0; m < 4; ++m) {
                const int row = row0 + ai * 128 + m * 16;
#pragma unroll
                for (int bj = 0; bj < 2; ++bj) {
                    const int n8 = col0 + bj * 128, i = n8 >> 4, ho = n8 & 15;
                    f32x4 v0 = acc[ai][bj][m][0], v1 = acc[ai][bj][m][1];
#pragma unroll
                    for (int j = 0; j < 4; ++j) { v0[j] = gelu_tanh(v0[j]); v1[j] = gelu_tanh(v1[j]); }
                    *(u32x4*)(YG + ((size_t)row * 32 + i) * 512 + u.z * 16 + ho) = pack8(v0, v1);
                }
            }
    }
};
struct EpiGlu {
    static constexpr bool PERM = true, PERM16 = false, HOOK = false;
    const bf16_t* YG; unsigned char* YS8;
    __device__ __forceinline__ void operator()(const f32x4 (&acc)[2][2][4][2], const Unit& u, int wr, int wc, int fr, int fq) const {
        const int row0 = u.pm * 256 + wr * 64 + fr, col0 = u.pn * 256 + wc * 32 + 8 * fq;
        u32x4 yv[2][4][2];
#pragma unroll
        for (int ai = 0; ai < 2; ++ai)
#pragma unroll
            for (int m = 0; m < 4; ++m)
#pragma unroll
                for (int bj = 0; bj < 2; ++bj) yv[ai][m][bj] = *(const u32x4*)(YG + (size_t)(row0 + ai * 128 + m * 16) * 512 + col0 + bj * 128);
#pragma unroll
        for (int ai = 0; ai < 2; ++ai)
#pragma unroll
            for (int m = 0; m < 4; ++m)
#pragma unroll
                for (int bj = 0; bj < 2; ++bj) {
                    const int r = row0 + ai * 128 + m * 16, c = col0 + bj * 128;
                    f32x4 y0, y1; unpack8(yv[ai][m][bj], y0, y1);
                    f32x4 v0 = acc[ai][bj][m][0], v1 = acc[ai][bj][m][1];
#pragma unroll
                    for (int j = 0; j < 4; ++j) { v0[j] = y0[j] * sigm(v0[j]) * 16.0f; v1[j] = y1[j] * sigm(v1[j]) * 16.0f; }
                    u32x2 w8; w8.x = pack_fp8x4(v0[0], v0[1], v0[2], v0[3]); w8.y = pack_fp8x4(v1[0], v1[1], v1[2], v1[3]);
                    *(u32x2*)(YS8 + (size_t)r * 512 + c) = w8;
                }
    }
};
struct EpiMerge {
    static constexpr bool PERM = true, PERM16 = true, HOOK = true; static constexpr int H1 = 4, H2 = 8;
    const unsigned char* SG; unsigned char* MG;
    static __device__ __forceinline__ float dec(unsigned w, int j) { return fmaxf((float)((w >> (8 * j)) & 255u), 0.5f); }
    __device__ __forceinline__ void hook(f32x4 (&acc)[2][2][4][2], const Unit& u, int t, int wr, int wc, int fr, int fq) const {
        int row0 = u.pm * 256 + wr * 64 + fr, col0 = u.pn * 256 + wc * 64 + 16 * fq; const int br = (t >> 2) - 1;
        asm volatile("" : "+v"(row0), "+v"(col0));
        u32x4 wa[2][4], wb[2][4];
#pragma unroll
        for (int ai = 0; ai < 2; ++ai)
#pragma unroll
            for (int m = 0; m < 4; ++m) { const unsigned char* gp = SG + sg_off(u.pm, br * 4 + u.pn, ai * 4 + m, wr * 4 + wc, fq * 16 + fr);
                wa[ai][m] = *(const u32x4*)gp; wb[ai][m] = *(const u32x4*)(gp + 4 * 65536); }
#pragma unroll
        for (int ai = 0; ai < 2; ++ai)
#pragma unroll
            for (int m = 0; m < 4; ++m)
#pragma unroll
                for (int bj = 0; bj < 2; ++bj)
#pragma unroll
                    for (int n = 0; n < 2; ++n) { const unsigned ca = wa[ai][m][bj * 2 + n], cb = wb[ai][m][bj * 2 + n];
#pragma unroll
                        for (int j = 0; j < 4; ++j) acc[ai][bj][m][n][j] *= dec(ca, j) * __builtin_amdgcn_rcpf(dec(cb, j)); }
    }
    __device__ __forceinline__ void operator()(const f32x4 (&acc)[2][2][4][2], const Unit& u, int wr, int wc, int fr, int fq) const {
        const int row0 = u.pm * 256 + wr * 64 + fr, col0 = u.pn * 256 + wc * 64 + 16 * fq;
        u32x4 wg[2][4];
#pragma unroll
        for (int ai = 0; ai < 2; ++ai)
#pragma unroll
            for (int m = 0; m < 4; ++m) wg[ai][m] = *(const u32x4*)(SG + sg_off(u.pm, 8 + u.pn, ai * 4 + m, wr * 4 + wc, fq * 16 + fr));
#pragma unroll
        for (int ai = 0; ai < 2; ++ai)
#pragma unroll
            for (int m = 0; m < 4; ++m) {
                u32x4 w8;
#pragma unroll
                for (int bj = 0; bj < 2; ++bj)
#pragma unroll
                    for (int n = 0; n < 2; ++n) { const unsigned cg = wg[ai][m][bj * 2 + n]; f32x4 v = acc[ai][bj][m][n];
#pragma unroll
                        for (int j = 0; j < 4; ++j) v[j] *= dec(cg, j) * (8.0f / 255.0f);
                        w8[bj * 2 + n] = pack_fp8x4(v[0], v[1], v[2], v[3]); }
                *(u32x4*)(MG + (size_t)(row0 + ai * 128 + m * 16) * 1024 + col0) = w8;
            }
    }
};
struct EpiOut {
    static constexpr bool PERM = true, PERM16 = false, HOOK = false;
    const float* X; bf16_t* X1B; unsigned char* X1B8;
    __device__ __forceinline__ void operator()(const f32x4 (&acc)[2][2][4][2], const Unit& u, int wr, int wc, int fr, int fq) const {
        const int row0 = u.pm * 256 + wr * 64 + fr, col0 = u.pn * 256 + wc * 32 + 8 * fq;
#pragma unroll
        for (int ai = 0; ai < 2; ++ai) {
            f32x4 xv[4][2][2];
#pragma unroll
            for (int m = 0; m < 4; ++m)
#pragma unroll
                for (int bj = 0; bj < 2; ++bj) { const float* xp = X + (size_t)(row0 + ai * 128 + m * 16) * 1024 + col0 + bj * 128; xv[m][bj][0] = __builtin_nontemporal_load((const f32x4*)xp); xv[m][bj][1] = __builtin_nontemporal_load((const f32x4*)(xp + 4)); }
#pragma unroll
            for (int m = 0; m < 4; ++m)
#pragma unroll
                for (int bj = 0; bj < 2; ++bj)
                { const f32x4 v0 = xv[m][bj][0] + acc[ai][bj][m][0], v1 = xv[m][bj][1] + acc[ai][bj][m][1]; const size_t o = (size_t)(row0 + ai * 128 + m * 16) * 1024 + col0 + bj * 128;
                    *(u32x4*)(X1B + o) = pack8(v0, v1);
                    u32x2 w8; w8.x = pack_fp8x4(v0[0], v0[1], v0[2], v0[3]); w8.y = pack_fp8x4(v1[0], v1[1], v1[2], v1[3]); *(u32x2*)(X1B8 + o) = w8; }
        }
    }
};

constexpr int MI_CNT = 16, MI_PRE = 160, MI_TILE = 320, MI_PT = 960;
constexpr int LTOK_OFF = 131072, LTOK_UNITS = 12, LRS_OFF = LTOK_OFF + LTOK_UNITS * 1024;
static_assert(LRS_OFF + LTOK_UNITS * 1024 <= MISC_OFF, "MoE LDS tables");
struct SchedMoE1 {
    const char* A; const char* W; LAS const int* misc; LAS const int* ltok; int ntile4, G, c;
    __device__ __forceinline__ bool next(int i, Unit& u) const {
        const long L = (long)i * G + c; if (L >= (long)ntile4 || i >= LTOK_UNITS) return false;
        const int e = misc[MI_TILE + (int)(L >> 2)]; u.z = (e & 255) | (i << 24); u.pm = e >> 8; u.pn = (int)(L & 3); return true; }
    __device__ __forceinline__ const char* a_ptr(const Unit&, int t) const { return A + (size_t)t * 128; }
    __device__ __forceinline__ const char* b_ptr(const Unit& u, int t) const { return W + (size_t)(u.z & 255) * (1024 * 1024) + (size_t)u.pn * (256 * 1024) + (size_t)t * 128; }
    __device__ __forceinline__ unsigned a_off(const Unit& u, int r) const { return (unsigned)(ltok[(u.z >> 24) * 256 + r] & 0xffff) * 1024u; }
};
struct EpiMoe1 {
    static constexpr bool PERM = true, PERM16 = false, HOOK = false;
    LAS const int* misc; LAS const int* ltok; unsigned char* HID;
    __device__ __forceinline__ void operator()(const f32x4 (&acc)[2][2][4][2], const Unit& u, int wr, int wc, int fr, int fq) const {
        const int l = u.z & 255, n = misc[MI_CNT + l], col = u.pn * 128 + wc * 32 + 8 * fq; LAS const int* lt = ltok + (u.z >> 24) * 256;
        LAS const float* lr = (LAS const float*)(lt + (LRS_OFF - LTOK_OFF) / 4);
        unsigned tk[2][4]; float2 qv[2][4];
#pragma unroll
        for (int ai = 0; ai < 2; ++ai)
#pragma unroll
            for (int m = 0; m < 4; ++m) { const int rl = ai * 128 + wr * 64 + m * 16 + fr;
                tk[ai][m] = (unsigned)lt[rl]; qv[ai][m] = make_float2(lr[rl], __uint_as_float((tk[ai][m] & 0x7fff0000u))); }
#pragma unroll
        for (int ai = 0; ai < 2; ++ai)
#pragma unroll
            for (int m = 0; m < 4; ++m) {
                const int pos = u.pm * 256 + ai * 128 + wr * 64 + m * 16 + fr;
                if (pos < n) {
                    const float2 q = qv[ai][m];
                    f32x4 v0, v1;
#pragma unroll
                    for (int j = 0; j < 4; ++j) {
                        const float g0 = acc[ai][0][m][0][j] * q.x, u0 = acc[ai][1][m][0][j] * q.x, g1 = acc[ai][0][m][1][j] * q.x, u1 = acc[ai][1][m][1][j] * q.x;
                        v0[j] = g0 * sigm(g0) * u0 * (q.y * 16.0f); v1[j] = g1 * sigm(g1) * u1 * (q.y * 16.0f); }
                    u32x2 w8; w8.x = pack_fp8x4(v0[0], v0[1], v0[2], v0[3]); w8.y = pack_fp8x4(v1[0], v1[1], v1[2], v1[3]);
                    *(u32x2*)(HID + ((size_t)(tk[ai][m] & 0xffffu) * 2 + (tk[ai][m] >> 31)) * 512 + col) = w8;
                }
            }
    }
};
struct SchedMoE2 {
    const char* A; const char* W; LAS const int* misc; LAS const int* ltok; int ntile4, G, c;
    __device__ __forceinline__ bool next(int i, Unit& u) const {
        const long L = (long)i * G + c; if (L >= (long)ntile4 || i >= LTOK_UNITS) return false;
        const int e = misc[MI_TILE + (int)(L >> 2)], l = e & 255, gi = l / 28, pt = misc[MI_PT + (l - gi * 28)];
        u.z = l | ((gi * 8 + (pt & 15)) << 8) | ((gi * 8 + (pt >> 4)) << 16) | (i << 24); u.pm = e >> 8; u.pn = (int)(L & 3); return true; }
    __device__ __forceinline__ const char* a_ptr(const Unit&, int t) const { return A + (size_t)t * 128; }
    __device__ __forceinline__ const char* b_ptr(const Unit& u, int t) const {
        const int e = t < 4 ? ((u.z >> 8) & 255) : ((u.z >> 16) & 255), tt = t < 4 ? t : t - 4;
        return W + (size_t)e * (1024 * 512) + (size_t)u.pn * (256 * 512) + (size_t)tt * 128; }
    __device__ __forceinline__ unsigned a_off(const Unit& u, int r) const { return (unsigned)ltok[(u.z >> 24) * 256 + r] * 1024u; }
};
struct EpiMoe2 {
    static constexpr bool PERM = true, PERM16 = false, HOOK = false;
    LAS const int* misc; LAS const int* ltok; const bf16_t* X1B; float* O;
    __device__ __forceinline__ void operator()(const f32x4 (&acc)[2][2][4][2], const Unit& u, int wr, int wc, int fr, int fq) const {
        const int l = u.z & 255, n = misc[MI_CNT + l], col0 = u.pn * 256 + wc * 32 + 8 * fq;
        LAS const int* lt = ltok + (u.z >> 24) * 256;
        int tk[2][4];
#pragma unroll
        for (int ai = 0; ai < 2; ++ai)
#pragma unroll
            for (int m = 0; m < 4; ++m) tk[ai][m] = lt[ai * 128 + wr * 64 + m * 16 + fr];
        u32x4 xb[2][4][2];
#pragma unroll
        for (int ai = 0; ai < 2; ++ai)
#pragma unroll
            for (int m = 0; m < 4; ++m)
#pragma unroll
                for (int bj = 0; bj < 2; ++bj) xb[ai][m][bj] = *(const u32x4*)(X1B + (size_t)tk[ai][m] * 1024 + col0 + bj * 128);
#pragma unroll
        for (int ai = 0; ai < 2; ++ai) {
#pragma unroll
            for (int m = 0; m < 4; ++m) {
                const int pos = u.pm * 256 + ai * 128 + wr * 64 + m * 16 + fr;
                if (pos < n) {
#pragma unroll
                    for (int bj = 0; bj < 2; ++bj) { f32x4 x0, x1; unpack8(xb[ai][m][bj], x0, x1);
                        float* op = O + (size_t)tk[ai][m] * 1024 + col0 + bj * 128;
                        __builtin_nontemporal_store(x0 + acc[ai][bj][m][0], (f32x4*)op); __builtin_nontemporal_store(x1 + acc[ai][bj][m][1], (f32x4*)(op + 4)); }
                }
            }
        }
    }
};
template <class Sched>
__device__ __forceinline__ void moe_ltok(const Frame& F, const Sched& S, const int* tok, const float2* rw) {
    LAS int* lt = (LAS int*)(F.lds + LTOK_OFF); LAS float* lr = (LAS float*)(F.lds + LRS_OFF);
    const int t = F.tid & 255;
    for (int i = F.tid >> 8; i < LTOK_UNITS; i += 2) { Unit u; if (!S.next(i, u)) break;
        const int l = u.z & 255, n = S.misc[MI_CNT + l]; int pos = u.pm * 256 + t; pos = pos < n ? pos : 0;
        int e = tok[(size_t)l * 65536 + pos];
        if (rw) { const float2 q = rw[(size_t)l * 65536 + pos]; lr[i * 256 + t] = q.x; e |= (int)(cvt_pk_bf16(q.y, 0.f) & 0x7fffu) << 16; }
        lt[i * 256 + t] = e; }
    __syncthreads();
}
struct SchedMerge3 {
    const char* Y; const char* W; int G, c, rep;
    __device__ __forceinline__ bool next(int i, Unit& u) const {
        const int nwg = 1024; const long L = (long)i * G + c; if (L >= (long)nwg * rep) return false;
        int w = (int)(L % nwg); { const int q = nwg / 8, x = w % 8, off = w / 8; w = x * q + off; }
        const int nig = 8 * 4, gid = w / nig, fm = gid * 8;
        u.pm = fm + ((w % nig) % 8); u.pn = (w % nig) / 8; u.z = 0; return true; }
    __device__ __forceinline__ const char* a_ptr(const Unit& u, int t) const { return Y + (size_t)(t >> 2) * ((size_t)T * 512) + (size_t)u.pm * (256 * 512) + (size_t)(t & 3) * 128; }
    __device__ __forceinline__ const char* b_ptr(const Unit& u, int t) const { return W + (size_t)u.pn * (256 * 1536) + (size_t)t * 128; }
    __device__ __forceinline__ unsigned a_off(const Unit&, int) const { return 0u; }
};

__device__ __forceinline__ void rms_rows_bf16(const float* x, const float* g, bf16_t* out, unsigned char* out8, int nrows, int gw, int nw, int lane) {
    float4 gg[4];
#pragma unroll
    for (int i = 0; i < 4; ++i) gg[i] = ((const float4*)g)[lane + 64 * i];
#pragma unroll 1
    for (int r0 = gw; r0 < nrows; r0 += 2 * nw) {
        const int r1 = r0 + nw < nrows ? r0 + nw : r0;
        const float4* xa = (const float4*)(x + (size_t)r0 * 1024); const float4* xb = (const float4*)(x + (size_t)r1 * 1024);
        float4 va[4], vb[4]; float sa = 0.f, sb = 0.f;
#pragma unroll
        for (int i = 0; i < 4; ++i) { const f32x4 ta = __builtin_nontemporal_load((const f32x4*)xa + lane + 64 * i), tb = __builtin_nontemporal_load((const f32x4*)xb + lane + 64 * i);
            va[i] = make_float4(ta[0], ta[1], ta[2], ta[3]); vb[i] = make_float4(tb[0], tb[1], tb[2], tb[3]); }
#pragma unroll
        for (int i = 0; i < 4; ++i) { sa += va[i].x * va[i].x + va[i].y * va[i].y + va[i].z * va[i].z + va[i].w * va[i].w; sb += vb[i].x * vb[i].x + vb[i].y * vb[i].y + vb[i].z * vb[i].z + vb[i].w * vb[i].w; }
        sa = wave_sum(sa); sb = wave_sum(sb);
        const float ra = rsqrtf(sa * (1.0f / 1024.0f) + 1e-6f), rb = rsqrtf(sb * (1.0f / 1024.0f) + 1e-6f);
#pragma unroll
        for (int i = 0; i < 4; ++i) {
            u32x2 w; w.x = cvt_pk_bf16(va[i].x * ra * gg[i].x, va[i].y * ra * gg[i].y); w.y = cvt_pk_bf16(va[i].z * ra * gg[i].z, va[i].w * ra * gg[i].w);
            if (out) *(u32x2*)(out + (size_t)r0 * 1024 + (lane + 64 * i) * 4) = w;
            if (out8) *(unsigned*)(out8 + (size_t)r0 * 1024 + (lane + 64 * i) * 4) = pack_fp8x4(va[i].x * ra * gg[i].x, va[i].y * ra * gg[i].y, va[i].z * ra * gg[i].z, va[i].w * ra * gg[i].w);
            if (r1 != r0) { u32x2 z; z.x = cvt_pk_bf16(vb[i].x * rb * gg[i].x, vb[i].y * rb * gg[i].y); z.y = cvt_pk_bf16(vb[i].z * rb * gg[i].z, vb[i].w * rb * gg[i].w);
                if (out) *(u32x2*)(out + (size_t)r1 * 1024 + (lane + 64 * i) * 4) = z;
                if (out8) *(unsigned*)(out8 + (size_t)r1 * 1024 + (lane + 64 * i) * 4) = pack_fp8x4(vb[i].x * rb * gg[i].x, vb[i].y * rb * gg[i].y, vb[i].z * rb * gg[i].z, vb[i].w * rb * gg[i].w); }
        }
    }
}
__device__ __forceinline__ void tr_tile(LAS float* tl, const float* src, int ldsrc, int nvalid, const float* ks, float tsc, bf16_t* dst, unsigned char* dst8, int ldd, int lane) {
    const int r = lane >> 4, c4 = (lane & 15) * 4;
    float4 v[16];
#pragma unroll
    for (int p = 0; p < 16; ++p) { const int k = r + 4 * p; v[p] = make_float4(0.f, 0.f, 0.f, 0.f); if (c4 < nvalid) { const f32x4 tv = __builtin_nontemporal_load((const f32x4*)(src + (size_t)k * ldsrc + c4)); v[p] = make_float4(tv[0], tv[1], tv[2], tv[3]); } }
#pragma unroll
    for (int p = 0; p < 16; ++p) { const int k = r + 4 * p; float4 w = v[p];
        { const float sc = ks ? ks[k] * tsc : tsc; w.x *= sc; w.y *= sc; w.z *= sc; w.w *= sc; }
        tl[k * 65 + c4] = w.x; tl[k * 65 + c4 + 1] = w.y; tl[k * 65 + c4 + 2] = w.z; tl[k * 65 + c4 + 3] = w.w; }
    const int kq = lane & 7;
#pragma unroll
    for (int p = 0; p < 8; ++p) { const int n = (lane >> 3) + 8 * p; float f[8];
#pragma unroll
        for (int j = 0; j < 8; ++j) f[j] = tl[(kq * 8 + j) * 65 + n];
        if (dst8) { u32x2 w8; w8.x = pack_fp8x4(f[0], f[1], f[2], f[3]); w8.y = pack_fp8x4(f[4], f[5], f[6], f[7]); *(u32x2*)(dst8 + (size_t)n * ldd + kq * 8) = w8; }
        else { u32x4 w; w.x = cvt_pk_bf16(f[0], f[1]); w.y = cvt_pk_bf16(f[2], f[3]); w.z = cvt_pk_bf16(f[4], f[5]); w.w = cvt_pk_bf16(f[6], f[7]);
            *(u32x4*)(dst + (size_t)n * ldd + kq * 8) = w; } }
}
struct cf { float re, im; };
__device__ __forceinline__ cf cmul(cf a, cf b) { return cf{a.re * b.re - a.im * b.im, a.re * b.im + a.im * b.re}; }
__device__ __forceinline__ cf lam_pow(const Args& a, int g, int p, float e) {
    const float lre = INP(I_LRE)[g * 64 + p], lim = INP(I_LIM)[g * 64 + p], dt = __expf(INP(I_LDT)[g]);
    const float mag = __expf(lre * dt * e);
    const double rev = (double)lim * (double)dt * (double)e * 0.15915494309189535; const float fr = (float)(rev - rint(rev));
    return cf{mag * __builtin_amdgcn_cosf(fr), mag * __builtin_amdgcn_sinf(fr)};
}
__device__ __forceinline__ cf bbar_of(const Args& a, int g, int p, int h) {
    const float lre = INP(I_LRE)[g * 64 + p], lim = INP(I_LIM)[g * 64 + p];
    const cf lb = lam_pow(a, g, p, 1.0f); const cf num = cf{lb.re - 1.0f, lb.im};
    const float inv = 1.0f / (lre * lre + lim * lim);
    const cf q = cf{(num.re * lre + num.im * lim) * inv, (num.im * lre - num.re * lim) * inv};
    return cmul(q, cf{INP(I_BRE)[(g * 64 + p) * 16 + h], INP(I_BIM)[(g * 64 + p) * 16 + h]});
}
__device__ __forceinline__ void p0_prep(const Frame& F, const Args& a) {
    const int gw = F.c * 8 + F.wave, nw = F.G * 8;
    rms_rows_bf16(INP(I_X), INP(I_GMIX), nullptr, WSP(unsigned char, WS_HB8), T, gw, nw, F.lane);
    rms_rows_bf16(INP(I_MEM), INP(I_GMEM), nullptr, WSP(unsigned char, WS_MEMN), 8192, gw, nw, F.lane);
    LAS float* tl = (LAS float*)F.lds + F.wave * (64 * 65);
    constexpr int NT_WIN = 80 * 16, NT_WMEM = 256, NT_WGLU = 64, NT_WUP = 384, NT_WOUT = 256, NT_E = 4096;
    constexpr int O1 = NT_WIN, O2 = O1 + NT_WMEM, O3 = O2 + NT_WGLU, O4 = O3 + NT_WUP, O5 = O4 + NT_WOUT, O6 = O5 + NT_E, O7 = O6 + NT_E, O8 = O7 + NT_E;
    for (int ti = gw; ti < O8; ti += nw) {
        const float* src; int ldsrc, nvalid = 64, ldd; const float* ks = nullptr; bf16_t* dst = nullptr; unsigned char* dst8 = nullptr; float tsc = 1.0f;
        if (ti < O1) { const int nt = ti / 16, kt = ti % 16, n0 = nt * 64; int sc;
            if (n0 < 1152) sc = n0;
            else if (n0 == 1152) sc = 1408;
            else if (n0 == 1216) { sc = 1472; nvalid = 4; }
            else if (n0 < 1280) { sc = 0; nvalid = 0; }
            else if (n0 < 1536) sc = 1152 + (n0 - 1280);
            else if (n0 < 2048) sc = 1476 + (n0 - 1536);
            else { sc = 1988 + (n0 - 2048); tsc = -1.4426950408889634f; }
            src = INP(I_WIN) + (size_t)kt * 64 * 5060 + sc; ldsrc = 5060; ldd = 1024;
            { const int r8 = n0 < 1024 ? n0 : (n0 < 1536 ? 4608 + (n0 - 1024) : n0 - 512); dst8 = WSP(unsigned char, WS_WG8) + (size_t)r8 * 1024 + kt * 64; tsc *= 32.0f; } }
        else if (ti < O2) { const int t = ti - O1, nt = t / 16, kt = t % 16; src = INP(I_WMEMKV) + (size_t)kt * 64 * 1024 + nt * 64; ldsrc = 1024; tsc = 32.0f; dst8 = WSP(unsigned char, WS_WMEM) + (size_t)nt * 64 * 1024 + kt * 64; ldd = 1024; }
        else if (ti < O3) { const int t = ti - O2, nt = t / 8, kt = t % 8; src = INP(I_WGLU) + (size_t)kt * 64 * 512 + nt * 64; ldsrc = 512; dst = WSP(bf16_t, WS_WGLU) + (size_t)nt * 64 * 512 + kt * 64; ldd = 512; }
        else if (ti < O4) { const int t = ti - O3, br = t / 128, tt = t % 128, nt = tt / 8, kt = tt % 8; const float* w = br == 0 ? INP(I_WUPS) : (br == 1 ? INP(I_WUPD) : INP(I_WUPM));
            src = w + (size_t)kt * 64 * 1024 + nt * 64; ldsrc = 1024; tsc = 32.0f; dst8 = WSP(unsigned char, WS_WUP) + (size_t)nt * 64 * 1536 + br * 512 + kt * 64; ldd = 1536; }
        else if (ti < O5) { const int t = ti - O4, nt = t / 16, kt = t % 16; src = INP(I_WOUT) + (size_t)kt * 64 * 1024 + nt * 64; ldsrc = 1024; tsc = 32.0f; dst8 = WSP(unsigned char, WS_WOUT) + (size_t)nt * 64 * 1024 + kt * 64; ldd = 1024; }
        else if (ti < O7) { const int up = ti >= O6, t = ti - (up ? O6 : O5), e = t / 128, tt = t % 128, nt = tt / 16, kt = tt % 16, j0 = nt * 64;
            src = (up ? INP(I_WUP) : INP(I_WGATE)) + (size_t)e * 1024 * 512 + (size_t)kt * 64 * 512 + j0; ldsrc = 512; ks = INP(I_GFFN) + kt * 64; tsc = 32.0f;
            dst8 = WSP(unsigned char, WS_WGU) + (size_t)e * 1024 * 1024 + (size_t)((j0 >> 7) * 256 + up * 128 + (j0 & 127)) * 1024 + kt * 64; ldd = 1024; }
        else { const int t = ti - O7, e = t / 128, tt = t % 128, nt = tt / 8, kt = tt % 8;
            src = INP(I_WDOWN) + (size_t)e * 512 * 1024 + (size_t)kt * 64 * 1024 + nt * 64; ldsrc = 1024; tsc = 32.0f;
            dst8 = WSP(unsigned char, WS_WD) + (size_t)e * 1024 * 512 + (size_t)nt * 64 * 512 + kt * 64; ldd = 512; }
        tr_tile(tl, src, ldsrc, nvalid, ks, tsc, dst, dst8, ldd, F.lane);
    }
    const int gt = F.c * NTHR + F.tid, NTT = F.G * NTHR;
    for (int id = gt; id < 2048 * 33; id += NTT) { const int gp = id / 33, e = id - gp * 33; const cf z = lam_pow(a, gp >> 6, gp & 63, (float)e); WSP(float2, WS_LP)[id] = make_float2(z.re, z.im);
        if (e == 32) { WSP(float, WS_LAM32)[gp * 2] = z.re; WSP(float, WS_LAM32)[gp * 2 + 1] = z.im; } }
    for (int id = gt; id < 2048 * 16; id += NTT) { const int gp = id >> 4, h = id & 15; const cf z = bbar_of(a, gp >> 6, gp & 63, h); WSP(float2, WS_BB)[id] = make_float2(z.re, z.im); }
    for (int id = gt; id < 48 * 1024; id += NTT) { const int n = id >> 10, k = id & 1023;
        const float v = n < 4 ? INP(I_WGROUP)[k * 4 + n] : (n < 36 ? INP(I_WEXP)[k * 32 + (n - 4)] : 0.f);
        WSP(bf16_t, WS_WR)[id] = f2bf(v * INP(I_GFFN)[k]); }
}

__device__ __forceinline__ void p1_tables(const Frame& F, const Args& a, int wgi, int wgn) {
    const int gt = wgi * NTHR + F.tid, NTT = wgn * NTHR;
    bf16_t* TW = WSP(bf16_t, WS_TW); bf16_t* SIN = WSP(bf16_t, WS_SIN); const float2* LP = WSP(float2, WS_LP); const float2* BB = WSP(float2, WS_BB);
    for (int id = gt; id < 32 * 32 * 256; id += NTT) {
        const int hi = id & 15, ho = (id >> 4) & 15, d = (id >> 8) & 31, g = id >> 13;
        float val = 0.f;
        for (int p = 0; p < 64; ++p) { const float2 ez = LP[(g * 64 + p) * 33 + d], bb = BB[(g * 64 + p) * 16 + hi];
            const float cr = INP(I_CRE)[(g * 16 + ho) * 64 + p], ci = INP(I_CIM)[(g * 16 + ho) * 64 + p];
            const float tr = cr * ez.x - ci * ez.y, ti = cr * ez.y + ci * ez.x; val += tr * bb.x - ti * bb.y; }
        if (d == 0 && ho == hi) val += INP(I_DSKIP)[g * 16 + ho];
        const bf16_t bv = f2bf(val); bf16_t* tg = TW + (size_t)g * 512 * 640;
        for (int i = d; i < 32; ++i) { tg[(size_t)(i * 16 + ho) * 640 + (i - d) * 16 + hi] = bv; if (d > 0) tg[(size_t)((i - d) * 16 + ho) * 640 + i * 16 + hi] = 0; }
    }
    for (int id = gt; id < 32 * 32 * 16 * 64; id += NTT) {
        const int p = id & 63, ho = (id >> 6) & 15, i = (id >> 10) & 31, g = id >> 15;
        const float2 ez = LP[(g * 64 + p) * 33 + i + 1]; const float cr = INP(I_CRE)[(g * 16 + ho) * 64 + p], ci = INP(I_CIM)[(g * 16 + ho) * 64 + p];
        bf16_t* row = TW + (size_t)g * 512 * 640 + (size_t)(i * 16 + ho) * 640 + 512; row[p] = f2bf(cr * ez.x - ci * ez.y); row[64 + p] = f2bf(-(cr * ez.y + ci * ez.x));
    }
    for (int id = gt; id < 32 * 64 * 32 * 16; id += NTT) {
        const int h = id & 15, j = (id >> 4) & 31, p = (id >> 9) & 63, g = id >> 15;
        const float2 ez = LP[(g * 64 + p) * 33 + 31 - j], bb = BB[(g * 64 + p) * 16 + h];
        bf16_t* sg = SIN + (size_t)g * 256 * 512; sg[(size_t)p * 512 + j * 16 + h] = f2bf(ez.x * bb.x - ez.y * bb.y); sg[(size_t)(64 + p) * 512 + j * 16 + h] = f2bf(ez.x * bb.y + ez.y * bb.x);
    }
    for (int id = gt; id < 32 * 128 * 64; id += NTT) {
        const int q = id & 63, r = (id >> 6) & 127, g = id >> 13;
        *(u32x4*)(SIN + (size_t)g * 256 * 512 + (size_t)(128 + r) * 512 + q * 8) = (u32x4){0u, 0u, 0u, 0u};
    }
}

__device__ __forceinline__ void p2_post(const Frame& F, const Args& a, bool dry) {
    const int gw = F.c * 8 + F.wave, nw = F.G * 8, lane = F.lane, j = lane & 3, hs = lane >> 5, lr = lane & 31;
    const bf16_t* KVX = WSP(bf16_t, WS_KVX); unsigned char* KVP8 = WSP(unsigned char, WS_KVP); bf16_t* KIP = WSP(bf16_t, WS_KIP); bf16_t* QI = WSP(bf16_t, WS_QI);
    const bool rqi = lr < 16, rk = lr >= 16 && lr < 20, rki = lr >= 20 && lr < 24;
    const float scl = rqi ? 0.125f : 1.0f;
    float g1[8], g2[8];
#pragma unroll
    for (int e = 0; e < 8; ++e) { g1[e] = rk ? INP(I_GK)[8 * j + e] : 1.0f; g2[e] = rk ? INP(I_GK)[32 + 8 * j + e] : 1.0f; }
    constexpr int TB = 4;
    typedef float f32x2e __attribute__((ext_vector_type(2)));
    LAS f32x2e* cst = (LAS f32x2e*)F.lds + F.wave * (TB * 64);
    const float invf1 = __expf(-(float)lr * (9.210340371976184f / 32.0f));
    u32x4 nlo[TB], nhi[TB]; int npos[TB]; unsigned short nwraw[TB];
#define POST_LOAD(TBASE) do { _Pragma("unroll") for (int u = 0; u < TB; ++u) { \
            const int tt = (TBASE) + (u * 2 + hs) * nw, t = tt < T ? tt : T - 1; \
            const bf16_t* src; \
            if (rqi) src = QI + (size_t)t * 256 + (lr >> 2) * 64; \
            else if (rk) src = KVX + (size_t)t * 256; \
            else if (rki) src = KVX + (size_t)t * 256 + 128; \
            else src = KVX + (size_t)t * 256 + 64 + (lr - 24) * 8 - 8 * j;         \
            nlo[u] = *(const u32x4*)(src + 8 * j); nhi[u] = (lr < 24) ? *(const u32x4*)(src + 32 + 8 * j) : nlo[u]; \
            npos[u] = ((const int*)a.in[I_POS])[t]; \
            nwraw[u] = KVX[(size_t)t * 256 + 192 + (lane & 3)]; } } while (0)
    if (gw < T) POST_LOAD(gw);
#pragma unroll 1
    for (int tb = gw; tb < T; tb += nw * TB * 2) {
        u32x4 lo[TB], hi[TB]; float posf[TB]; unsigned short wraw[TB];
#pragma unroll
        for (int u = 0; u < TB; ++u) { lo[u] = nlo[u]; hi[u] = nhi[u]; posf[u] = (float)npos[u]; wraw[u] = nwraw[u]; }
        if (tb + nw * TB * 2 < T) POST_LOAD(tb + nw * TB * 2);
#pragma unroll
        for (int u = 0; u < TB; ++u) {
            const int tt = tb + (u * 2 + hs) * nw, t = tt < T ? tt : T - 1;
            { const float ang = posf[u] * invf1; const double rev = (double)ang * 0.15915494309189535; const float fr = (float)(rev - rint(rev));
              const f32x2e cs2 = (f32x2e){__builtin_amdgcn_cosf(fr), __builtin_amdgcn_sinf(fr)}; cst[(u * 2 + hs) * 32 + lr] = cs2;
              if (tt < T) WSP(f32x2e, WS_CS)[(size_t)t * 32 + lr] = cs2; }
        }
#pragma unroll
        for (int u = 0; u < TB; ++u) {
            const int t = tb + (u * 2 + hs) * nw;
            const bool live = t < T;
            if (lr < 24) {
                bf16_t* dst;
                if (rqi) dst = dry ? WSP(bf16_t, WS_RW) + (size_t)(live ? t : 0) * 256 + (lr >> 2) * 64 : QI + (size_t)(live ? t : 0) * 256 + (lr >> 2) * 64;
                else if (rk) dst = nullptr;
                else { const int tt_ = live ? t : 0; dst = KIP + (size_t)(tt_ >> 5) * 2048 + (j >> 1) * 512 + ((j & 1) * 32 + (tt_ & 31)) * 8 - 8 * j; }
                f32x4 a0, a1, b0, b1; unpack8(lo[u], a0, a1); unpack8(hi[u], b0, b1);
                float x1[8] = {a0[0], a0[1], a0[2], a0[3], a1[0], a1[1], a1[2], a1[3]}, x2[8] = {b0[0], b0[1], b0[2], b0[3], b1[0], b1[1], b1[2], b1[3]};
                float ss = 0.f;
#pragma unroll
                for (int e = 0; e < 8; ++e) ss += x1[e] * x1[e] + x2[e] * x2[e];
                ss += __shfl_xor(ss, 1); ss += __shfl_xor(ss, 2);
                const float rs = rk ? rsqrtf(ss * (1.0f / 64.0f) + 1e-6f) : 1.0f;
                float o1[8], o2[8];
#pragma unroll
                for (int e = 0; e < 8; ++e) {
                    const f32x2e csn = cst[(u * 2 + hs) * 32 + 8 * j + e]; const float cs = csn.x, sn = csn.y;
                    const float y1 = x1[e] * rs * g1[e], y2 = x2[e] * rs * g2[e];
                    o1[e] = (y1 * cs - y2 * sn) * scl; o2[e] = (y2 * cs + y1 * sn) * scl; }
                if (live) {
                    if (rk) {
                        u32x2 w0, w1; w0.x = pack_fp8x4(o1[0], o1[1], o1[2], o1[3]); w0.y = pack_fp8x4(o1[4], o1[5], o1[6], o1[7]); w1.x = pack_fp8x4(o2[0], o2[1], o2[2], o2[3]); w1.y = pack_fp8x4(o2[4], o2[5], o2[6], o2[7]);
                        *(u32x2*)(KVP8 + (size_t)t * 128 + 8 * j) = w0; *(u32x2*)(KVP8 + (size_t)t * 128 + 32 + 8 * j) = w1;
                    } else {
                        *(u32x4*)(dst + 8 * j) = pack8((f32x4){o1[0], o1[1], o1[2], o1[3]}, (f32x4){o1[4], o1[5], o1[6], o1[7]});
                        *(u32x4*)(dst + (rqi ? 32 : 1024) + 8 * j) = pack8((f32x4){o2[0], o2[1], o2[2], o2[3]}, (f32x4){o2[4], o2[5], o2[6], o2[7]}); } }
            } else if (live) {
                f32x4 a0, a1; unpack8(lo[u], a0, a1); u32x2 w; w.x = pack_fp8x4(a0[0], a0[1], a0[2], a0[3]); w.y = pack_fp8x4(a1[0], a1[1], a1[2], a1[3]);
                *(u32x2*)(KVP8 + (size_t)t * 128 + 64 + (lr - 24) * 8) = w;
            }
            if (lr < 4 && live) WSP(float, WS_WIF)[t * 4 + lr] = bf2f(wraw[u]) * 0.5f;
        }
    }
#undef POST_LOAD
    const bf16_t* KMVM = WSP(bf16_t, WS_KMVM); bf16_t* KM = WSP(bf16_t, WS_KM); bf16_t* VMT = WSP(bf16_t, WS_VMT);
    { float gk8[8];
#pragma unroll
        for (int e = 0; e < 8; ++e) gk8[e] = INP(I_GKM)[(lane & 15) * 8 + e] * INP(I_GQM)[(lane & 15) * 8 + e];
        for (int r = gw; r < 8192; r += nw) {
            const int h = lane >> 4, b = r >> 8, m = r & 255;
            f32x4 a0, a1; unpack8(*(const u32x4*)(KMVM + (size_t)r * 1024 + h * 128 + (lane & 15) * 8), a0, a1);
            float ss = a0[0] * a0[0] + a0[1] * a0[1] + a0[2] * a0[2] + a0[3] * a0[3] + a1[0] * a1[0] + a1[1] * a1[1] + a1[2] * a1[2] + a1[3] * a1[3];
            ss += __shfl_xor(ss, 1); ss += __shfl_xor(ss, 2); ss += __shfl_xor(ss, 4); ss += __shfl_xor(ss, 8);
            const float rs = rsqrtf(ss * (1.0f / 128.0f) + 1e-6f);
            *(u32x4*)(KM + ((size_t)(b * 4 + h) * 256 + m) * 128 + (lane & 15) * 8) = pack8((f32x4){a0[0] * rs * gk8[0], a0[1] * rs * gk8[1], a0[2] * rs * gk8[2], a0[3] * rs * gk8[3]}, (f32x4){a1[0] * rs * gk8[4], a1[1] * rs * gk8[5], a1[2] * rs * gk8[6], a1[3] * rs * gk8[7]}); } }
    const int gt = F.c * NTHR + F.tid, NTT = F.G * NTHR;
    for (int id = gt; id < 32 * 4 * 32 * 128; id += NTT) { const int d = id & 127, pg = (id >> 7) & 31, h = (id >> 12) & 3, b = id >> 14;
        unsigned short v[8];
#pragma unroll
        for (int j = 0; j < 8; ++j) { const int pp = pg * 8 + j, q = pp & 15, key = (pp & ~15) + 8 * ((q & 7) >> 2) + 4 * (q >> 3) + (q & 3);
            v[j] = KMVM[(size_t)(b * 256 + key) * 1024 + 512 + h * 128 + d]; }
        u32x4 w; w.x = v[0] | ((unsigned)v[1] << 16); w.y = v[2] | ((unsigned)v[3] << 16); w.z = v[4] | ((unsigned)v[5] << 16); w.w = v[6] | ((unsigned)v[7] << 16);
        *(u32x4*)(VMT + ((size_t)(b * 4 + h) * 128 + d) * 256 + pg * 8) = w; }
}

__device__ __forceinline__ void p3_scan(const Frame& F) {
    const int gt = F.c * NTHR + F.tid, NTT = F.G * NTHR;
    const float* SC = WSP(float, WS_SC); bf16_t* UA = WSP(bf16_t, WS_UA);
    for (int id = gt; id < 65536; id += NTT) { const int p = id & 63, b = (id >> 6) & 31, g = id >> 11;
        const float lr = WSP(float, WS_LAM32)[(g * 64 + p) * 2], li = WSP(float, WS_LAM32)[(g * 64 + p) * 2 + 1];
        float sr = 0.f, si = 0.f;
        for (int c = 0; c < 64; ++c) { const size_t row = (size_t)g * 2048 + b * 64 + c;
            UA[row * 640 + 512 + p] = f2bf(sr); UA[row * 640 + 576 + p] = f2bf(si);
            const float cr = SC[row * 128 + p], ci = SC[row * 128 + 64 + p];
            const float nr = lr * sr - li * si + cr, ni = lr * si + li * sr + ci; sr = nr; si = ni; }
    }
}

constexpr int SEL_SC = 0, SEL_HIST = 131072, SEL_END = SEL_HIST + 128 * 17 * 4;
__device__ __forceinline__ int suffix_sum64(int x, int rm1, int rm2, int rm3, int& tot) {
    int p = x;
    p += __builtin_amdgcn_update_dpp(0, p, 0x111, 0xf, 0xf, false);
    p += __builtin_amdgcn_update_dpp(0, p, 0x112, 0xf, 0xf, false);
    p += __builtin_amdgcn_update_dpp(0, p, 0x114, 0xf, 0xf, false);
    p += __builtin_amdgcn_update_dpp(0, p, 0x118, 0xf, 0xf, false);
    const int t0 = __builtin_amdgcn_readlane(p, 15), t1 = __builtin_amdgcn_readlane(p, 31), t2 = __builtin_amdgcn_readlane(p, 47), t3 = __builtin_amdgcn_readlane(p, 63);
    p += (t0 & rm1) + (t1 & rm2) + (t2 & rm3);
    tot = t0 + t1 + t2 + t3;
    return tot - p + x;
}
__device__ __forceinline__ int mbcnt64(unsigned long long m) { return (int)__builtin_amdgcn_mbcnt_hi((unsigned)(m >> 32), __builtin_amdgcn_mbcnt_lo((unsigned)m, 0u)); }
template <int NR>
__device__ __forceinline__ void sel_level2(LAS const unsigned* cand, LAS unsigned short* lst, int lane, int m, int need, int base) {
    unsigned c8[NR], a8[NR];
#pragma unroll
    for (int k = 0; k < NR; ++k) { c8[k] = cand[k * 64 + lane]; a8[k] = (k * 64 + lane < m) ? (c8[k] >> 11) + 1u : 0u; }
    unsigned lo = 0u;
#pragma unroll 1
    for (int bit = 9; bit >= 0; --bit) { const unsigned cd = lo | (1u << bit); int cn = 0;
#pragma unroll
        for (int k = 0; k < NR; ++k) cn += __popcll(__builtin_amdgcn_ballot_w64(a8[k] >= cd));
        if (cn >= need) lo = cd; }
    int cgt = 0;
#pragma unroll
    for (int k = 0; k < NR; ++k) cgt += __popcll(__builtin_amdgcn_ballot_w64(a8[k] > lo));
    const int ties = need - cgt; int bs = base, eqb = 0;
#pragma unroll
    for (int k = 0; k < NR; ++k) {
        const bool eq = a8[k] == lo;
        const unsigned long long me = __builtin_amdgcn_ballot_w64(eq);
        int rk = eqb + mbcnt64(me); asm("" : "+v"(rk));
        const bool sel = a8[k] > lo || (eq && rk < ties);
        const unsigned long long ms = __builtin_amdgcn_ballot_w64(sel);
        int ps = bs + mbcnt64(ms); asm("" : "+v"(ps));
        if (sel) lst[ps] = (unsigned short)(c8[k] & 2047u);
        bs += __popcll(ms); eqb += __popcll(me);
    }
}
__device__ __forceinline__ void p3_select(const Frame& F, bool doB, int pmode = 0) {
    LAS unsigned short* sc = (LAS unsigned short*)(F.lds + SEL_SC);
    LAS unsigned* hist = (LAS unsigned*)(F.lds + SEL_HIST);
    const bf16_t* QI = WSP(bf16_t, WS_QI); const bf16_t* KIP = WSP(bf16_t, WS_KIP); const float* WIF = WSP(float, WS_WIF);
    unsigned short* IDX = WSP(unsigned short, WS_IDX);
    const int lane = F.lane, n = lane & 31, hf = lane >> 5, wv = F.wave;
    const int rm1 = (lane >> 4) >= 1 ? -1 : 0, rm2 = (lane >> 4) >= 2 ? -1 : 0, rm3 = (lane >> 4) >= 3 ? -1 : 0;
#define SEL_UNIT(L_, QT, B_) int QT = 63 - ((L_) >> 5); const int B_ = (L_) & 31; \
        if (F.G == 256) { const int k_ = F.c >> 5, i_ = (L_) >> 8, pr_ = i_ >> 1;     \
            QT = (i_ & 1) ? (48 - 16 * pr_ + k_) : (63 - 16 * pr_ - k_); }
#define SEL_LOADQK(QT, B_) do { const int tk_ = (B_) * 2048 + (QT) * 32 + n; \
        _Pragma("unroll") for (int h = 0; h < 4; ++h) { wq[h] = WIF[tk_ * 4 + h]; \
            _Pragma("unroll") for (int ks = 0; ks < 4; ++ks) bq[h][ks] = *(const bf16x8*)(QI + (size_t)tk_ * 256 + h * 64 + ks * 16 + hf * 8); } \
        { const int k0 = wv < (QT) + 1 ? wv : 0; const bf16_t* kp = KIP + (size_t)((B_) * 64 + k0) * 2048 + lane * 8; \
            _Pragma("unroll") for (int ks = 0; ks < 4; ++ks) ka[ks] = *(const bf16x8*)(kp + ks * 512); } } while (0)
    bf16x8 bq[4][4]; float wq[4]; bf16x8 ka[4];
    if (F.c < 2048) { SEL_UNIT(F.c, qt0, b0); SEL_LOADQK(qt0, b0); }
    for (int L = F.c; L < 2048; L += F.G) {
        SEL_UNIT(L, qt, b);
        const int t0 = qt * 32, nkt = qt + 1, tok0 = b * 2048 + t0;
        if (qt < 8 && L + F.G >= 2048) {
            if (doB) {
#pragma unroll
                for (int qq = 0; qq < 4; ++qq) { const int nq = wv * 4 + qq, nvalid = t0 + nq + 1; unsigned short pp[4];
#pragma unroll
                    for (int e = 0; e < 4; ++e) { const int p = lane * 4 + e; pp[e] = (unsigned short)(p < nvalid ? p : 0); }
                    u32x2 w; w.x = pp[0] | ((unsigned)pp[1] << 16); w.y = pp[2] | ((unsigned)pp[3] << 16);
                    *(u32x2*)(IDX + (size_t)(tok0 + nq) * 256 + lane * 4) = w; } }
            break;
        }
        for (int i = F.tid; i < 128 * 17; i += NTHR) hist[i] = 0u;
        { const int nz = ((nkt * 8 + 63) & ~63) - nkt * 8;
            for (int i = F.tid; i < nz * 32; i += NTHR) { const int nn = i & 31, ch = nkt * 8 + (i >> 5); *(LAS u32x2*)(sc + nn * 2048 + ((ch ^ nn) << 2)) = (u32x2){0u, 0u}; } }
        __syncthreads();
        const unsigned hinc = 1u << (16 * (n & 1));
        for (int kt = wv; kt < nkt; kt += 8) {
            f32x16 acc[4];
#pragma unroll
            for (int h = 0; h < 4; ++h)
#pragma unroll
                for (int r = 0; r < 16; ++r) acc[h][r] = 0.f;
#pragma unroll
            for (int ks = 0; ks < 4; ++ks)
#pragma unroll
                for (int h = 0; h < 4; ++h) acc[h] = __builtin_amdgcn_mfma_f32_32x32x16_bf16(ka[ks], bq[h][ks], acc[h], 0, 0, 0);
            { const int k1 = kt + 8 < nkt ? kt + 8 : kt; const bf16_t* kp = KIP + (size_t)(b * 64 + k1) * 2048 + lane * 8;
#pragma unroll
                for (int ks = 0; ks < 4; ++ks) ka[ks] = *(const bf16x8*)(kp + ks * 512); }
            unsigned key[16];
#pragma unroll
            for (int r = 0; r < 16; ++r) {
                const int i0 = __float_as_int(acc[0][r]), i1 = __float_as_int(acc[1][r]), i2 = __float_as_int(acc[2][r]), i3 = __float_as_int(acc[3][r]);
                const float isc = wq[0] * __int_as_float(i0 > 0 ? i0 : 0) + wq[1] * __int_as_float(i1 > 0 ? i1 : 0) + wq[2] * __int_as_float(i2 > 0 ? i2 : 0) + wq[3] * __int_as_float(i3 > 0 ? i3 : 0);
                const float y = isc * __builtin_amdgcn_rcpf(1.0f + fabsf(isc));
                key[r] = (unsigned)(y * 32767.0f + 32768.0f);
            }
            if (kt < qt) {
#pragma unroll
                for (int g4 = 0; g4 < 4; ++g4) {
#pragma unroll
                    for (int j = 0; j < 4; ++j) (void)__hip_atomic_fetch_add(hist + (key[g4 * 4 + j] >> 9) * 17 + (n >> 1), hinc, __ATOMIC_RELAXED, __HIP_MEMORY_SCOPE_WORKGROUP);
                    u32x2 w; w.x = key[g4 * 4] | (key[g4 * 4 + 1] << 16); w.y = key[g4 * 4 + 2] | (key[g4 * 4 + 3] << 16);
                    const int chunk = (kt * 32 + 8 * g4 + 4 * hf) >> 2;
                    *(LAS u32x2*)(sc + n * 2048 + ((chunk ^ n) << 2)) = w;
                }
            } else {
                asm volatile("" ::: "memory");
#pragma unroll
                for (int g4 = 0; g4 < 4; ++g4) {
                    unsigned kk[4];
#pragma unroll
                    for (int j = 0; j < 4; ++j) { const int s = kt * 32 + j + 8 * g4 + 4 * hf; const bool valid = s <= t0 + n;
                        kk[j] = valid ? key[g4 * 4 + j] : 0u;
                        (void)__hip_atomic_fetch_add(hist + (kk[j] >> 9) * 17 + (n >> 1), valid ? hinc : 0u, __ATOMIC_RELAXED, __HIP_MEMORY_SCOPE_WORKGROUP); }
                    u32x2 w; w.x = kk[0] | (kk[1] << 16); w.y = kk[2] | (kk[3] << 16);
                    const int chunk = (kt * 32 + 8 * g4 + 4 * hf) >> 2;
                    *(LAS u32x2*)(sc + n * 2048 + ((chunk ^ n) << 2)) = w;
                }
            }
        }
        __syncthreads();
        if (L + F.G < 2048) { SEL_UNIT(L + F.G, qtn, bn); SEL_LOADQK(qtn, bn); }
        for (int qq = 0; qq < (doB ? 4 : 0); ++qq) {
            const int nq = wv * 4 + qq, tq = t0 + nq, nvalid = tq + 1, tok = tok0 + nq;
            LAS unsigned short* lst = sc + nq * 2048; LAS unsigned* cand = (LAS unsigned*)(sc + nq * 2048 + 512);
            if (nvalid <= 256) {
#pragma unroll
                for (int e = 0; e < 4; ++e) { const int p = lane * 4 + e; lst[p] = (unsigned short)(p < nvalid ? p : 0); }
            } else {
                unsigned v[32];
                LAS const unsigned short* rowp = sc + nq * 2048 + ((((lane >> 2) ^ (nq & 15)) << 2) | (lane & 3));
#pragma unroll
                for (int r = 0; r < 32; ++r) v[r] = rowp[r * 64];
                const int sh = 16 * (nq & 1);
                const int hhi = (int)((hist[(64 + lane) * 17 + (nq >> 1)] >> sh) & 0xffffu), hlo = (int)((hist[lane * 17 + (nq >> 1)] >> sh) & 0xffffu);
                int tothi; const int shi = suffix_sum64(hhi, rm1, rm2, rm3, tothi);
                int b1, above;
                if (tothi >= 256) { const unsigned long long mk = __builtin_amdgcn_ballot_w64(shi >= 256); const int lb = 63 - __clzll(mk); b1 = 64 + lb; above = __builtin_amdgcn_readlane(shi - hhi, lb); }
                else { int totlo; const int slo = tothi + suffix_sum64(hlo, rm1, rm2, rm3, totlo); const unsigned long long mk = __builtin_amdgcn_ballot_w64(slo >= 256); const int lb = 63 - __clzll(mk); b1 = lb; above = __builtin_amdgcn_readlane(slo - hlo, lb); }
                const int sw64 = (nq >> 4) << 6, laneE = lane + sw64, laneO = lane - sw64;
                const unsigned binhi = (unsigned)b1 * 512u + 511u, binlo = b1 ? (unsigned)b1 * 512u : 1u, binspan = binhi - binlo;
                unsigned cnt2 = 0u;
#pragma unroll
                for (int r4 = 0; r4 < 32; r4 += 4) {
                    if (r4 * 64 >= nvalid || (pmode & 1)) break;
#pragma unroll
                    for (int rr = 0; rr < 4; ++rr) { const int r = r4 + rr; cnt2 += (v[r] > binhi ? 1u : 0u) + ((v[r] - binlo) <= binspan ? 65536u : 0u); }
                }
                unsigned pfx = cnt2;
                pfx += (unsigned)__builtin_amdgcn_update_dpp(0, (int)pfx, 0x111, 0xf, 0xf, false);
                pfx += (unsigned)__builtin_amdgcn_update_dpp(0, (int)pfx, 0x112, 0xf, 0xf, false);
                pfx += (unsigned)__builtin_amdgcn_update_dpp(0, (int)pfx, 0x114, 0xf, 0xf, false);
                pfx += (unsigned)__builtin_amdgcn_update_dpp(0, (int)pfx, 0x118, 0xf, 0xf, false);
                pfx += (unsigned)__builtin_amdgcn_update_dpp(0, (int)pfx, 0x142, 0xa, 0xf, false);
                pfx += (unsigned)__builtin_amdgcn_update_dpp(0, (int)pfx, 0x143, 0xc, 0xf, false);
                const unsigned tot2 = (unsigned)__builtin_amdgcn_readlane((int)pfx, 63);
                const int base = (int)(tot2 & 0xffffu), m = (int)(tot2 >> 16);
                int pg = (int)((pfx - cnt2) & 0xffffu), pe = (int)((pfx - cnt2) >> 16);
#pragma unroll
                for (int r4 = 0; r4 < 32; r4 += 4) {
                    if (r4 * 64 >= nvalid || (pmode & 1)) break;
#pragma unroll
                    for (int rr = 0; rr < 4; ++rr) { const int r = r4 + rr; const unsigned idx = (unsigned)(r * 64 + ((r & 1) ? laneO : laneE));
                        const bool gt_ = v[r] > binhi, eq = (v[r] - binlo) <= binspan;
                        if (!(pmode & 4)) lst[gt_ ? pg : 256 + lane] = (unsigned short)idx;
                        const int pc = pe < 512 + lane ? pe : 512 + lane;
                        if (!(pmode & 8)) cand[eq ? pc : 512 + lane] = ((v[r] & 511u) << 11) | idx;
                        pg += gt_ ? 1 : 0; pe += eq ? 1 : 0; }
                }
                if (pmode & 2) { }
                else if (m <= 128) sel_level2<2>(cand, lst, lane, m, 256 - above, base);
                else if (m <= 256) sel_level2<4>(cand, lst, lane, m, 256 - above, base);
                else if (m <= 512) sel_level2<8>(cand, lst, lane, m, 256 - above, base);
                else {
#pragma unroll
                    for (int r = 0; r < 32; ++r) v[r] = ((r * 64 + ((r & 1) ? laneO : laneE)) < nvalid) ? v[r] : 0u;
                    unsigned lo = 0u;
                    for (int bit = 15; bit >= 0; --bit) { const unsigned cd = lo | (1u << bit); int cnt = 0;
#pragma unroll
                        for (int r = 0; r < 32; ++r) cnt += __popcll(__builtin_amdgcn_ballot_w64(v[r] >= cd));
                        if (cnt >= 256) lo = cd; }
                    int cgt = 0;
#pragma unroll
                    for (int r = 0; r < 32; ++r) cgt += __popcll(__builtin_amdgcn_ballot_w64(v[r] > lo));
                    const int need = 256 - cgt; int bs = 0, eqb = 0;
#pragma unroll
                    for (int r = 0; r < 32; ++r) {
                        const bool gt_ = v[r] > lo, eq = v[r] == lo;
                        const unsigned long long me = __builtin_amdgcn_ballot_w64(eq);
                        const bool sel = gt_ || (eq && eqb + mbcnt64(me) < need);
                        const unsigned long long ms = __builtin_amdgcn_ballot_w64(sel);
                        if (sel) lst[bs + mbcnt64(ms)] = (unsigned short)(r * 64 + ((r & 1) ? laneO : laneE));
                        bs += __popcll(ms); eqb += __popcll(me);
                    }
                }
            }
            *(u32x2*)(IDX + (size_t)tok * 256 + lane * 4) = *(LAS u32x2*)(lst + lane * 4);
        }
        __syncthreads();
    }
}

#undef SEL_UNIT
#undef SEL_LOADQK
__device__ __forceinline__ void p3_memattn(const Frame& F) {
    constexpr int KS = 272, VS = 528, VOFF = 256 * KS;
    const bf16_t* KM = WSP(bf16_t, WS_KM); const bf16_t* VMT = WSP(bf16_t, WS_VMT); const bf16_t* QM = DOP(bf16_t, DO_Y3) + 512; unsigned char* YM8 = DOP(unsigned char, DO_YM8);
    const int lane = F.lane, n = lane & 31, hf = lane >> 5;
    for (int u = F.c; u < 256; u += F.G) {
        const int half = u & 1, bh = u >> 1, b = bh >> 2, h = bh & 3;
#pragma unroll
        for (int i = 0; i < 8; ++i) { const int id = F.tid + 512 * i;
            { const int row = id >> 4, seg = id & 15; *(LAS u32x4*)(F.lds + row * KS + seg * 16) = *(const u32x4*)(KM + ((size_t)bh * 256 + row) * 128 + seg * 8); }
            { const int row = id >> 5, seg = id & 31; *(LAS u32x4*)(F.lds + VOFF + row * VS + seg * 16) = *(const u32x4*)(VMT + ((size_t)bh * 128 + row) * 256 + seg * 8); } }
        __syncthreads();
#pragma unroll 1
        for (int qi = 0; qi < 4; ++qi) {
            const int tok = b * 2048 + half * 1024 + F.wave * 128 + qi * 32 + n;
            const bf16_t* qp = QM + (size_t)tok * Y3LD + h * 128;
            bf16x8 bq[8];
#pragma unroll
            for (int ks = 0; ks < 8; ++ks) bq[ks] = *(const bf16x8*)(qp + ks * 16 + hf * 8);
            float qss = 0.f;
#pragma unroll
            for (int ks = 0; ks < 8; ++ks)
#pragma unroll
                for (int e = 0; e < 8; ++e) { const float f = bf2f((unsigned short)bq[ks][e]); qss += f * f; }
            qss = xsum32(qss);
            const float qc = rsqrtf(qss * (1.0f / 128.0f) + 1e-6f) * (0.08838834764831845f * 1.4426950408889634f);
            f32x16 o[4];
#pragma unroll
            for (int dt = 0; dt < 4; ++dt)
#pragma unroll
                for (int r = 0; r < 16; ++r) o[dt][r] = 0.f;
            float mrun = -3.0e38f, lrun = 0.f;
#pragma unroll 1
            for (int kh = 0; kh < 2; ++kh) {
                f32x16 s[4];
#pragma unroll
                for (int k4 = 0; k4 < 4; ++k4) { const int kt = kh * 4 + k4;
#pragma unroll
                    for (int r = 0; r < 16; ++r) s[k4][r] = 0.f;
#pragma unroll
                    for (int ks = 0; ks < 8; ++ks) { const bf16x8 a = *(const LAS bf16x8*)(F.lds + (kt * 32 + n) * KS + (ks * 16 + hf * 8) * 2);
                        s[k4] = __builtin_amdgcn_mfma_f32_32x32x16_bf16(a, bq[ks], s[k4], 0, 0, 0); } }
                float mx = mrun;
#pragma unroll
                for (int k4 = 0; k4 < 4; ++k4)
#pragma unroll
                    for (int r = 0; r < 16; ++r) mx = fmaxf(mx, s[k4][r]);
                mx = xmax32(mx);
                const float resc = __builtin_amdgcn_exp2f((mrun - mx) * qc), nmq = -mx * qc;
                float sum = 0.f;
#pragma unroll
                for (int k4 = 0; k4 < 4; ++k4)
#pragma unroll
                    for (int r = 0; r < 16; ++r) { const float p = __builtin_amdgcn_exp2f(__builtin_fmaf(s[k4][r], qc, nmq)); s[k4][r] = p; sum += p; }
                sum = xsum32(sum);
                lrun = lrun * resc + sum; mrun = mx;
#pragma unroll
                for (int dt = 0; dt < 4; ++dt)
#pragma unroll
                    for (int r = 0; r < 16; ++r) o[dt][r] *= resc;
#pragma unroll
                for (int k4 = 0; k4 < 4; ++k4)
#pragma unroll
                    for (int st = 0; st < 2; ++st) { const int kt = kh * 4 + k4;
                        union { u32x4 u; bf16x8 v; } pb;
                        pb.u.x = cvt_pk_bf16(s[k4][8 * st + 0], s[k4][8 * st + 1]); pb.u.y = cvt_pk_bf16(s[k4][8 * st + 2], s[k4][8 * st + 3]);
                        pb.u.z = cvt_pk_bf16(s[k4][8 * st + 4], s[k4][8 * st + 5]); pb.u.w = cvt_pk_bf16(s[k4][8 * st + 6], s[k4][8 * st + 7]);
#pragma unroll
                        for (int dt = 0; dt < 4; ++dt) { const bf16x8 a = *(const LAS bf16x8*)(F.lds + VOFF + (dt * 32 + n) * VS + (kt * 32 + 16 * st + 8 * hf) * 2);
                            o[dt] = __builtin_amdgcn_mfma_f32_32x32x16_bf16(a, pb.v, o[dt], 0, 0, 0); }
                    }
            }
            const float inv = 16.0f * __builtin_amdgcn_rcpf(lrun);
#pragma unroll
            for (int dt = 0; dt < 4; ++dt) {
                unsigned W[4];
#pragma unroll
                for (int g4 = 0; g4 < 4; ++g4) W[g4] = pack_fp8x4(o[dt][g4 * 4] * inv, o[dt][g4 * 4 + 1] * inv, o[dt][g4 * 4 + 2] * inv, o[dt][g4 * 4 + 3] * inv);
                const auto r02 = __builtin_amdgcn_permlane32_swap(W[0], W[2], false, false), r13 = __builtin_amdgcn_permlane32_swap(W[1], W[3], false, false);
                *(u32x4*)(YM8 + (size_t)tok * 512 + h * 128 + dt * 32 + 16 * hf) = (u32x4){r02[0], r02[1], r13[0], r13[1]};
            }
        }
        __syncthreads();
    }
}

__device__ __forceinline__ void p4_attend(const Frame& F, const Args& a) {
    constexpr int WB = 2 * 8192 + 1024;
    LAS unsigned char* wb = F.lds + F.wave * WB;
    LAS unsigned short* lst = (LAS unsigned short*)(wb + 16384);
    const unsigned short* IDX = WSP(unsigned short, WS_IDX); const unsigned char* KVP8 = WSP(unsigned char, WS_KVP); const bf16_t* Q = DOP(bf16_t, DO_Y3); unsigned char* YD8 = DOP(unsigned char, DO_YD8);
    const int lane = F.lane, n = lane & 15, g = lane >> 4, gw = F.c * 8 + F.wave, nw = F.G * 8;
    const int ntk = (T - gw + nw - 1) / nw;
    float gkm = fabsf(INP(I_GK)[lane]);
    gkm = fmaxf(gkm, __shfl_xor(gkm, 32)); gkm = fmaxf(gkm, __shfl_xor(gkm, 16)); gkm = fmaxf(gkm, __shfl_xor(gkm, 8)); gkm = fmaxf(gkm, __shfl_xor(gkm, 4)); gkm = fmaxf(gkm, __shfl_xor(gkm, 2)); gkm = fmaxf(gkm, __shfl_xor(gkm, 1));
    const float kmax = 8.0f * gkm * 1.07f;
    int koff[4][2];
#pragma unroll
    for (int blk = 0; blk < 4; ++blk)
#pragma unroll
        for (int ks = 0; ks < 2; ++ks) { const int row = blk * 16 + n, pc = ks * 2 + (g >> 1); koff[blk][ks] = row * 128 + ((pc ^ (row & 7)) << 4) + 8 * (g & 1); }
    const int q8 = n >> 1, p8 = n & 1;
    int toff[2][4];
#pragma unroll
    for (int kb2 = 0; kb2 < 2; ++kb2)
#pragma unroll
        for (int d = 0; d < 4; ++d) { const int row = (kb2 * 2 + (q8 >> 2)) * 16 + g * 4 + (q8 & 3), pc = 4 + d; toff[kb2][d] = row * 128 + ((pc ^ (row & 7)) << 4) + 8 * p8; }
    const int grow = lane >> 3, gpc = lane & 7;
    const unsigned wbase = (unsigned)(uintptr_t)wb;
#define AT_KEYS(NK, LB, CH) do { _Pragma("unroll") for (int _i = 0; _i < 8; ++_i) NK[_i] = lst[(LB) * 256 + (CH) * 64 + 8 * _i + grow]; } while (0)
#define AT_ISSUE_K(NK, TOK, BUF) do { const char* _kb = (const char*)(KVP8 + (size_t)((TOK) >> 11) * 2048 * 128); \
        _Pragma("unroll") for (int _i = 0; _i < 8; ++_i) { const int _row = 8 * _i + grow; \
            const unsigned _off = (unsigned)NK[_i] * 128u + (unsigned)((gpc ^ (_row & 7)) << 4);        \
            __builtin_amdgcn_global_load_lds((const unsigned*)(_kb + _off), (LAS unsigned*)(wb + (BUF) * 8192 + _i * 1024), 16, 0, 0); } } while (0)
#define AT_ISSUE(TOK, LB, CH, BUF) do { int _nk[8]; AT_KEYS(_nk, LB, CH); AT_ISSUE_K(_nk, TOK, BUF); } while (0)
    if (ntk <= 0) return;
    const bool rot = (nw == SEQ);
#define AT_TOK(K) (rot ? (K) * SEQ + ((gw + 64 * (K)) & (SEQ - 1)) : gw + (K) * nw)
    { const u32x2 l0 = *(const u32x2*)(IDX + (size_t)AT_TOK(0) * 256 + lane * 4); *(LAS u32x2*)(lst + lane * 4) = l0; }
    float gq1[8], gq2[8];
#pragma unroll
    for (int e = 0; e < 8; ++e) { gq1[e] = INP(I_GQ)[g * 8 + e]; gq2[e] = INP(I_GQ)[32 + g * 8 + e]; }
    const f32x4* CS = WSP(f32x4, WS_CS);
    bf16x8 nbq[2]; f32x4 ncs[4];
    { const int pt = (n >= 8 && 1 < ntk) ? AT_TOK(1) : AT_TOK(0);
#pragma unroll
        for (int e = 0; e < 4; ++e) ncs[e] = CS[(size_t)pt * 16 + g * 4 + e];
#pragma unroll
        for (int ks = 0; ks < 2; ++ks) nbq[ks] = *(const bf16x8*)(Q + (size_t)pt * Y3LD + (n & 7) * 64 + ks * 32 + g * 8); }
    long bqp[2] = {0, 0}; float shiftp = 0.f;
    AT_ISSUE(AT_TOK(0), 0, 0, 0); AT_ISSUE(AT_TOK(0), 0, 1, 1);
#pragma unroll 1
    for (int k = 0; k < ntk; ++k) {
        const int tok = AT_TOK(k), ntok = AT_TOK(k + 1), lb = k & 1; const bool hasn = (k + 1 < ntk);
        const int tq = tok & 2047, cnt = tq + 1 < 256 ? tq + 1 : 256;
        long bq[2]; float shift;
        if ((k & 1) == 0) {
            float qs = 0.f;
            { float x1[8], x2[8], ss = 0.f;
#pragma unroll
                for (int e = 0; e < 8; ++e) { x1[e] = bf2f((unsigned short)nbq[0][e]); x2[e] = bf2f((unsigned short)nbq[1][e]); ss += x1[e] * x1[e] + x2[e] * x2[e]; }
                ss = xsum32(xsum16(ss));
                const float rs = rsqrtf(ss * (1.0f / 64.0f) + 1e-6f) * (0.125f * 1.4426950408889634f); float o1[8], o2[8];
#pragma unroll
                for (int e = 0; e < 8; ++e) { const float cs = ncs[e >> 1][(e & 1) * 2], sn = ncs[e >> 1][(e & 1) * 2 + 1], y1 = x1[e] * rs * gq1[e], y2 = x2[e] * rs * gq2[e];
                    o1[e] = y1 * cs - y2 * sn; o2[e] = y2 * cs + y1 * sn; qs += o1[e] * o1[e] + o2[e] * o2[e]; }
                const unsigned a0 = pack_fp8x4(o1[0], o1[1], o1[2], o1[3]), a1 = pack_fp8x4(o1[4], o1[5], o1[6], o1[7]), b0 = pack_fp8x4(o2[0], o2[1], o2[2], o2[3]), b1 = pack_fp8x4(o2[4], o2[5], o2[6], o2[7]);
                bq[0] = (long)(((unsigned long long)a1 << 32) | a0); bq[1] = (long)(((unsigned long long)b1 << 32) | b0); }
            qs = xsum32(xsum16(qs));
            shift = __builtin_amdgcn_sqrtf(qs) * 1.07f * kmax - 7.0f;
            bqp[0] = bq[0]; bqp[1] = bq[1]; shiftp = shift;
            if (k + 2 < ntk) { const int pt = (n >= 8 && k + 3 < ntk) ? AT_TOK(k + 3) : AT_TOK(k + 2);
#pragma unroll
                for (int e = 0; e < 4; ++e) ncs[e] = CS[(size_t)pt * 16 + g * 4 + e];
#pragma unroll
                for (int ks = 0; ks < 2; ++ks) nbq[ks] = *(const bf16x8*)(Q + (size_t)pt * Y3LD + (n & 7) * 64 + ks * 32 + g * 8); }
        } else {
#pragma unroll
            for (int ks = 0; ks < 2; ++ks) { const unsigned lo_ = (unsigned)__builtin_amdgcn_update_dpp(0, (int)(unsigned)bqp[ks], 0x108, 0xf, 0xf, true), hi_ = (unsigned)__builtin_amdgcn_update_dpp(0, (int)(unsigned)((unsigned long long)bqp[ks] >> 32), 0x108, 0xf, 0xf, true);
                bq[ks] = (long)(((unsigned long long)hi_ << 32) | lo_); }
            shift = __int_as_float(__builtin_amdgcn_update_dpp(0, __float_as_int(shiftp), 0x108, 0xf, 0xf, true));
        }
        const f32x4 nsh = (f32x4){-shift, -shift, -shift, -shift};
        u32x2 nl = (u32x2){0u, 0u};
        if (hasn) nl = *(const u32x2*)(IDX + (size_t)ntok * 256 + lane * 4);
        f32x4 o[4];
#pragma unroll
        for (int d = 0; d < 4; ++d) o[d] = (f32x4){0.f, 0.f, 0.f, 0.f};
        float lsum = 0.f;
#pragma unroll
        for (int ch = 0; ch < 4; ++ch) {
            const int buf = ch & 1;
            if (ch == 3 && !hasn) asm volatile("s_waitcnt vmcnt(0)" ::: "memory"); else asm volatile("s_waitcnt vmcnt(8)" ::: "memory");
            LAS const unsigned char* bb = wb + buf * 8192;
            int nk[8];
            if (ch < 2) AT_KEYS(nk, lb, ch + 2); else if (hasn) AT_KEYS(nk, lb ^ 1, ch - 2);
            if (ch * 64 < cnt) {
            f32x4 s[4];
#pragma unroll
            for (int blk = 0; blk < 4; ++blk) {
                const long k0 = *(LAS const long*)(bb + koff[blk][0]), k1 = *(LAS const long*)(bb + koff[blk][1]);
                s[blk] = __builtin_amdgcn_mfma_f32_16x16x32_fp8_fp8(k0, bq[0], nsh, 0, 0, 0);
                s[blk] = __builtin_amdgcn_mfma_f32_16x16x32_fp8_fp8(k1, bq[1], s[blk], 0, 0, 0);
            }
            u32x2 tr[2][4];
#pragma unroll
            for (int kb2 = 0; kb2 < 2; ++kb2)
#pragma unroll
                for (int d = 0; d < 4; ++d) asm volatile("ds_read_b64_tr_b8 %0, %1 offset:%2" : "=&v"(tr[kb2][d]) : "v"(wbase + (unsigned)toff[kb2][d]), "i"(buf * 8192) : "memory");
            float e[2][4];
#pragma unroll
            for (int b2 = 0; b2 < 2; ++b2)
#pragma unroll
                for (int j = 0; j < 4; ++j) e[b2][j] = __int_as_float(__builtin_amdgcn_update_dpp(__float_as_int(s[b2][j]), __float_as_int(s[b2 + 2][j]), 0x118, 0xf, 0xc, false));
            if (cnt >= (ch + 1) * 64) {
#pragma unroll
                for (int b2 = 0; b2 < 2; ++b2)
#pragma unroll
                    for (int j = 0; j < 4; ++j) { const float x = __builtin_amdgcn_exp2f(e[b2][j]); e[b2][j] = x; lsum += x; }
            } else {
                asm volatile("" ::: "memory");
#pragma unroll
                for (int b2 = 0; b2 < 2; ++b2)
#pragma unroll
                    for (int j = 0; j < 4; ++j) { const int p = ch * 64 + (b2 + (n >> 3) * 2) * 16 + g * 4 + j; const float x = p < cnt ? __builtin_amdgcn_exp2f(e[b2][j]) : 0.f; e[b2][j] = x; lsum += x; }
            }
            const unsigned w0 = pack_fp8x4_nc(e[0][0], e[0][1], e[0][2], e[0][3]), w1 = pack_fp8x4_nc(e[1][0], e[1][1], e[1][2], e[1][3]);
#pragma unroll
            for (int kb2 = 0; kb2 < 2; ++kb2) {
                const unsigned plo = kb2 == 0 ? w0 : (unsigned)__builtin_amdgcn_update_dpp(0, (int)w0, 0x108, 0xf, 0xf, true), phi = kb2 == 0 ? w1 : (unsigned)__builtin_amdgcn_update_dpp(0, (int)w1, 0x108, 0xf, 0xf, true);
                const long pb = (long)(((unsigned long long)phi << 32) | plo);
                if (kb2 == 0) asm volatile("s_waitcnt lgkmcnt(0)" : "+v"(tr[0][0]), "+v"(tr[0][1]), "+v"(tr[0][2]), "+v"(tr[0][3]), "+v"(tr[1][0]), "+v"(tr[1][1]), "+v"(tr[1][2]), "+v"(tr[1][3]) :: "memory");
#pragma unroll
                for (int d = 0; d < 4; ++d) { const long av = (long)(((unsigned long long)tr[kb2][d].y << 32) | tr[kb2][d].x);
                    o[d] = __builtin_amdgcn_mfma_f32_16x16x32_fp8_fp8(av, pb, o[d], 0, 0, 0); }
            }
            }
            __builtin_amdgcn_sched_barrier(0);
            if (ch == 1 && hasn) *(LAS u32x2*)(lst + (lb ^ 1) * 256 + lane * 4) = nl;
            if (ch < 2) AT_ISSUE_K(nk, tok, buf);
            else if (hasn) AT_ISSUE_K(nk, ntok, buf);
            __builtin_amdgcn_sched_barrier(0);
        }
        lsum += __int_as_float(__builtin_amdgcn_update_dpp(0, __float_as_int(lsum), 0x108, 0xf, 0xf, true));
        lsum = xsum32(xsum16(lsum));
        const float inv = 16.0f * __builtin_amdgcn_rcpf(lsum);
        if (n < 8) {
#pragma unroll
            for (int d = 0; d < 4; ++d) *(unsigned*)(YD8 + (size_t)tok * 512 + n * 64 + d * 16 + g * 4) = pack_fp8x4(o[d][0] * inv, o[d][1] * inv, o[d][2] * inv, o[d][3] * inv);
        }
    }
#undef AT_ISSUE
#undef AT_TOK
#undef AT_ISSUE_K
#undef AT_KEYS
}

__device__ __forceinline__ void p8_router(const Frame& F, const Args& a, bool commit) {
    const bf16_t* X1B = WSP(bf16_t, WS_X1B); const bf16_t* WR = WSP(bf16_t, WS_WR);
    int* TOK = WSP(int, WS_TOK); float2* RW = WSP(float2, WS_RW); int* TOK2 = WSP(int, WS_TOK2); unsigned* gcnt = (unsigned*)(F.ws + WS_CTL + CTL_GCNT);
    constexpr int WRS = 2064, RT_LG = 48 * WRS, RT_RS = RT_LG + 8 * 16 * 48 * 4, RT_LC = RT_RS + 8 * 16 * 4;
    LAS float* lg = (LAS float*)(F.lds + RT_LG) + F.wave * (16 * 48);
    LAS float* rsb = (LAS float*)(F.lds + RT_RS) + F.wave * 16;
    LAS int* lc = (LAS int*)(F.lds + RT_LC); LAS int* lbase = lc + 144;
    const int lane = F.lane, n = lane & 15, q = lane >> 4;
    for (int i = F.tid; i < 48 * 128; i += NTHR) { const int r = i >> 7, c = i & 127; *(LAS u32x4*)(F.lds + r * WRS + c * 16) = *(const u32x4*)(WR + (size_t)r * 1024 + c * 8); }
    __syncthreads();
    for (int it = F.c; it < T / 128; it += F.G) {
        const int tw = it * 128 + F.wave * 16;
        if (F.tid < 144) lc[F.tid] = 0;
        const bf16_t* xp = X1B + (size_t)(tw + n) * 1024 + q * 8;
        f32x4 acc[3] = {(f32x4){0.f, 0.f, 0.f, 0.f}, (f32x4){0.f, 0.f, 0.f, 0.f}, (f32x4){0.f, 0.f, 0.f, 0.f}};
        float ss = 0.f;
#pragma unroll
        for (int hb = 0; hb < 2; ++hb) {
            bf16x8 av[16];
#pragma unroll
            for (int k2 = 0; k2 < 16; ++k2) av[k2] = *(const bf16x8*)(xp + (hb * 16 + k2) * 32);
#pragma unroll
            for (int k2 = 0; k2 < 16; ++k2) { const int ks = hb * 16 + k2;
#pragma unroll
                for (int j = 0; j < 8; ++j) { const float f = bf2f((unsigned short)av[k2][j]); ss += f * f; }
#pragma unroll
                for (int bl = 0; bl < 3; ++bl) { const bf16x8 bb = *(const LAS bf16x8*)(F.lds + (bl * 16 + n) * WRS + (ks * 32 + q * 8) * 2);
                    acc[bl] = __builtin_amdgcn_mfma_f32_16x16x32_bf16(av[k2], bb, acc[bl], 0, 0, 0); } }
        }
        ss += __shfl_xor(ss, 16); ss += __shfl_xor(ss, 32);
        const float rs = rsqrtf(ss * (1.0f / 1024.0f) + 1e-6f);
        if (q == 0) rsb[n] = rs;
#pragma unroll
        for (int bl = 0; bl < 3; ++bl)
#pragma unroll
            for (int j = 0; j < 4; ++j) lg[(q * 4 + j) * 48 + bl * 16 + n] = acc[bl][j] * rsb[q * 4 + j];
        __syncthreads();
        int l1 = 0, l2 = 0, lp = 0, r1 = 0, r2 = 0, rp = 0, s1 = 0; float wa = 0.f, wb = 0.f, myrs = 0.f;
        if (lane < 16) {
            LAS const float* l = lg + lane * 48; myrs = rsb[lane];
            float g0 = l[0] + INP(I_BGROUP)[0]; int gi = 0; float gm = g0, gl[4]; gl[0] = g0;
#pragma unroll
            for (int j = 1; j < 4; ++j) { gl[j] = l[j] + INP(I_BGROUP)[j]; if (gl[j] > gm) { gm = gl[j]; gi = j; } }
            float gs = 0.f;
#pragma unroll
            for (int j = 0; j < 4; ++j) gs += __expf(gl[j] - gm);
            const float ggate = 1.0f / gs;
            float e1 = -3.0e38f, e2 = -3.0e38f; int i1 = 0, i2 = 0;
            for (int e = 0; e < 8; ++e) { const float v = l[4 + gi * 8 + e] + INP(I_BEXP)[gi * 8 + e];
                if (v > e1) { e2 = e1; i2 = i1; e1 = v; i1 = e; } else if (v > e2) { e2 = v; i2 = e; } }
            const float pa = 1.0f / (1.0f + __expf(e2 - e1));
            wa = ggate * pa; wb = ggate - wa;
            s1 = i1 < i2 ? 0 : 1;
            const int elo = i1 < i2 ? i1 : i2, ehi = i1 < i2 ? i2 : i1;
            l1 = gi * 8 + i1; l2 = gi * 8 + i2; lp = 32 + gi * 28 + (elo * (15 - elo)) / 2 + (ehi - elo - 1);
            r1 = atomicAdd((int*)(lc + l1), 1); r2 = atomicAdd((int*)(lc + l2), 1); rp = atomicAdd((int*)(lc + lp), 1);
        }
        __syncthreads();
        if (F.tid < 144) { const int cn = lc[F.tid]; lbase[F.tid] = (cn > 0 && commit) ? (int)atomicAdd(gcnt + F.tid * 64, (unsigned)cn) : 0; }
        __syncthreads();
        if (lane < 16 && commit) { const int t = tw + lane;
            const size_t p1 = (size_t)l1 * 65536 + lbase[l1] + r1, p2 = (size_t)l2 * 65536 + lbase[l2] + r2;
            TOK[p1] = t | (s1 << 31); RW[p1] = make_float2(myrs, wa); TOK[p2] = t | ((s1 ^ 1) << 31); RW[p2] = make_float2(myrs, wb);
            TOK2[(size_t)(lp - 32) * 65536 + lbase[lp] + rp] = t; }
        __syncthreads();
    }
}

__device__ __forceinline__ int moe_table(const Frame& F, int first, int count) {
    LAS int* misc = (LAS int*)(F.lds + MISC_OFF); const unsigned* gcnt = (const unsigned*)(F.ws + WS_CTL + CTL_GCNT);
    __syncthreads();
    if (F.tid < count) misc[MI_CNT + F.tid] = (int)__hip_atomic_load(gcnt + (first + F.tid) * 64, __ATOMIC_RELAXED, __HIP_MEMORY_SCOPE_AGENT);
    if (F.tid >= 256 && F.tid < 256 + 28) { const int pi = F.tid - 256; int elo = 0; while (elo < 6 && ((elo + 1) * (15 - (elo + 1))) / 2 <= pi) ++elo;
        misc[MI_PT + pi] = elo | ((pi - (elo * (15 - elo)) / 2 + elo + 1) << 4); }
    __syncthreads();
    if (F.tid == 0) { int run = 0; for (int l = 0; l < count; ++l) { misc[MI_PRE + l] = run; run += (misc[MI_CNT + l] + 255) >> 8; } misc[MI_PRE + count] = run; }
    __syncthreads();
    const int nt = misc[MI_PRE + count];
    for (int idx = F.tid; idx < nt && idx < 640; idx += NTHR) { int l = 0; while (l < count - 1 && misc[MI_PRE + l + 1] <= idx) ++l; misc[MI_TILE + idx] = l | ((idx - misc[MI_PRE + l]) << 8); }
    __syncthreads();
    return nt < 640 ? nt : 640;
}

__global__ void __launch_bounds__(NTHR, 2) fwd(Args a) {
    extern __shared__ __attribute__((aligned(16))) unsigned char lds_raw[];
    Frame F;
    F.lds = (LAS unsigned char*)lds_raw; F.tid = threadIdx.x; F.lane = F.tid & 63; F.wave = __builtin_amdgcn_readfirstlane(F.tid >> 6); F.G = gridDim.x; F.c = blockIdx.x;
    F.ws = a.ws; F.dout = (unsigned char*)a.out;
    LAS unsigned* misc = (LAS unsigned*)(F.lds + MISC_OFF);
    for (int i = F.tid; i < 1024; i += NTHR) misc[i] = 0u;
    __syncthreads();
    XcdBarrier bar; bar.bar = (unsigned*)(F.ws + WS_CTL); bar.x = 0; bar.st = (volatile LAS unsigned*)misc;
    const int lo = a.ph_lo, hi = a.ph_hi;
    if (hi - lo > 1) bar = xcd_barrier_post((unsigned*)(F.ws + WS_CTL), (volatile LAS unsigned*)misc);
#ifndef PH_MASK
#define PH_MASK 0xFFF
#endif
#define IN(k) (((PH_MASK >> (k)) & 1) && lo <= (k) && (k) < hi)
#ifndef REP_MASK
#define REP_MASK 0
#endif
#ifndef PROBE_SELB
#define PROBE_SELB 0
#endif
#define NREP(k) (1 + ((REP_MASK >> (k)) & 1))
#define SEAM(k) do { if (IN(k) && IN((k) + 1)) xcd_barrier(bar); } while (0)
    bf16_t* HB = WSP(bf16_t, WS_HB); bf16_t* UA = WSP(bf16_t, WS_UA); unsigned char* SG = WSP(unsigned char, WS_SG);
    bf16_t* Y3 = DOP(bf16_t, DO_Y3); bf16_t* YG = WSP(bf16_t, WS_YG);
    LAS const int* imisc = (LAS const int*)(F.lds + MISC_OFF);

    if (IN(0)) for (int rep = 0; rep < NREP(0); ++rep) { p0_prep(F, a); __syncthreads(); }
    SEAM(0);
    if (IN(0) && IN(1)) {
        if (F.tid == 0) { unsigned* bw = (unsigned*)(F.ws + WS_CTL); bool bal = (F.G % 8) == 0;
            for (int j = 0; j < 16; ++j) { const unsigned cj = xb_ld(&bw[XB_XCNT(j)]); bal = bal && (cj == (j < 8 ? (unsigned)F.G / 8u : 0u)); }
            misc[3] = bal ? (misc[2] * 8u + bar.x) : (unsigned)blockIdx.x; }
        __syncthreads();
        F.c = (int)misc[3];
    }
    if (IN(1)) {
        { pg8::Gemm g{512, 512, 512, 0x7f, 0x7a};
          pg8::SchedGrid S{(const char*)WSP(unsigned char, WS_HB8), (const char*)WSP(unsigned char, WS_WG8), 0, 0, (size_t)256 * 1024, (size_t)256 * 1024, 256, 20, 1, F.G, F.c, NREP(1)};
          EpiInProj E{UA, Y3, WSP(bf16_t, WS_KVX), WSP(bf16_t, WS_QI), SG};
          pg8::gemm_phase<EpiInProj, pg8::SchedGrid, false, PG8_SP2, true>(F.lds, g, S, E); }
        { pg8::Gemm g{512, 512, 512, 0x7f, 0x7a};
          pg8::SchedGrid S{(const char*)WSP(unsigned char, WS_MEMN), (const char*)WSP(unsigned char, WS_WMEM), 0, 0, (size_t)256 * 1024, (size_t)256 * 1024, 32, 4, 1, F.G, F.c, NREP(1)};
          EpiBf16 E{WSP(bf16_t, WS_KMVM), 1024};
          pg8::gemm_phase<EpiBf16, pg8::SchedGrid, false, PG8_SP2, true>(F.lds, g, S, E); }
        if (F.G > 128) { if (F.c >= 128) p1_tables(F, a, F.c - 128, F.G - 128); } else p1_tables(F, a, F.c, F.G);
    }
    SEAM(1);
    if (IN(2)) {
        { pg8::Gemm g{640, 512, 512}; pg8::SchedGrid S{(const char*)UA, (const char*)WSP(bf16_t, WS_SIN), (size_t)2048 * 640 * 2, (size_t)256 * 512 * 2, (size_t)256 * 640 * 2, (size_t)256 * 512 * 2, 8, 1, 32, F.G, F.c, NREP(2)};
          EpiSc E{WSP(float, WS_SC)};
          pg8::gemm_phase<EpiSc, pg8::SchedGrid, false>(F.lds, g, S, E); }
        for (int rep = 0; rep < NREP(15); ++rep) p2_post(F, a, rep < NREP(15) - 1);
    }
    SEAM(2);
#ifndef P3_SUB
#define P3_SUB 7
#endif
    if (IN(3)) { for (int rep = 0; rep < NREP(13); ++rep) { if (P3_SUB & 1) p3_scan(F); } for (int rep = 0; rep < NREP(3); ++rep) { if (P3_SUB & 2) p3_select(F, rep == 0 || (REP_MASK & 0x10000), (NREP(3) > 1 && rep == 0) ? PROBE_SELB : 0); } for (int rep = 0; rep < NREP(12); ++rep) if (P3_SUB & 4) p3_memattn(F); }
    SEAM(3);
    if (IN(4)) {
        { pg8::Gemm g{640, 640, 640}; pg8::SchedGrid S{(const char*)UA, (const char*)WSP(bf16_t, WS_TW), (size_t)2048 * 640 * 2, (size_t)512 * 640 * 2, (size_t)256 * 640 * 2, (size_t)256 * 640 * 2, 8, 2, 32, F.G, F.c, NREP(4)};
          EpiGelu E{YG};
          pg8::gemm_phase<EpiGelu, pg8::SchedGrid, false>(F.lds, g, S, E); }
        for (int rep = 0; rep < NREP(14); ++rep) p4_attend(F, a);
    }
    SEAM(4);
    if (IN(5)) {
        pg8::Gemm g{512, 512, 512}; pg8::SchedGrid S{(const char*)YG, (const char*)WSP(bf16_t, WS_WGLU), 0, 0, (size_t)256 * 512 * 2, (size_t)256 * 512 * 2, 256, 2, 1, F.G, F.c, NREP(5)};
        EpiGlu E{YG, DOP(unsigned char, DO_YS8)};
        pg8::gemm_phase<EpiGlu, pg8::SchedGrid, false>(F.lds, g, S, E);
    }
    SEAM(5);
    if (IN(6)) {
        pg8::Gemm g{256, 768, 768, 0x7b, 0x7a};
        SchedMerge3 S{(const char*)DOP(unsigned char, DO_Y8), (const char*)WSP(unsigned char, WS_WUP), F.G, F.c, NREP(6)};
        EpiMerge E{SG, (unsigned char*)HB};
        pg8::gemm_phase<EpiMerge, SchedMerge3, false, PG8_SP2, true>(F.lds, g, S, E);
    }
    SEAM(6);
    if (IN(7)) {
        pg8::Gemm g{512, 512, 512, 0x7c, 0x7a};
        pg8::SchedGrid S{(const char*)HB, (const char*)WSP(unsigned char, WS_WOUT), 0, 0, (size_t)256 * 1024, (size_t)256 * 1024, 256, 4, 1, F.G, F.c, NREP(7)};
        EpiOut E{INP(I_X), WSP(bf16_t, WS_X1B), WSP(unsigned char, WS_X1B8)};
        pg8::gemm_phase<EpiOut, pg8::SchedGrid, false, PG8_SP2, true>(F.lds, g, S, E);
    }
    SEAM(7);
    if (IN(8)) for (int rep = 0; rep < NREP(8); ++rep) p8_router(F, a, rep == NREP(8) - 1);
    SEAM(8);
    if (IN(9)) {
        const int nt = moe_table(F, 0, 32);
        pg8::Gemm g{512, 512, 512, 0x7f, 0x7a};
        LAS const int* ltok = (LAS const int*)(F.lds + LTOK_OFF);
        const int cx = (F.G % 8 == 0) ? (F.c & 7) * (F.G / 8) + (F.c >> 3) : F.c;
        SchedMoE1 S{(const char*)WSP(unsigned char, WS_X1B8), (const char*)WSP(unsigned char, WS_WGU), imisc, ltok, nt * 4, F.G, cx};
        moe_ltok(F, S, WSP(int, WS_TOK), WSP(float2, WS_RW));
        EpiMoe1 E{imisc, ltok, WSP(unsigned char, WS_HID)};
        pg8::gemm_phase<EpiMoe1, SchedMoE1, true, PG8_SP2, true>(F.lds, g, S, E);
    }
    SEAM(9);
    if (IN(10)) {
        const int nt = moe_table(F, 32, 112);
        pg8::Gemm g{512, 256, 512, 0x7b, 0x7a};
        LAS const int* ltok = (LAS const int*)(F.lds + LTOK_OFF);
        const int cx = (F.G % 8 == 0) ? (F.c & 7) * (F.G / 8) + (F.c >> 3) : F.c;
        SchedMoE2 S{(const char*)WSP(unsigned char, WS_HID), (const char*)WSP(unsigned char, WS_WD), imisc, ltok, nt * 4, F.G, cx};
        moe_ltok(F, S, WSP(int, WS_TOK2), (const float2*)nullptr);
        EpiMoe2 E{imisc, ltok, WSP(bf16_t, WS_X1B), a.out};
        pg8::gemm_phase<EpiMoe2, SchedMoE2, true, PG8_SP2, true>(F.lds, g, S, E);
    }
#undef IN
#undef SEAM
}

extern "C" void kernel_launch(void* const* d_in, const int* in_sizes, int n_in, void* d_out, int out_size, void* d_ws, size_t ws_size, hipStream_t stream) {
    static int grid = 0;
    if (grid == 0) {
        if (n_in != 32 || out_size != T * D || ws_size < WS_END) { fprintf(stderr, "kernel_launch: unexpected shapes: n_in %d out %d ws %zu (need %zu)\n", n_in, out_size, ws_size, (size_t)WS_END); grid = -1; return; }
        int dev = 0, cus = 0;
        if (hipGetDevice(&dev) != hipSuccess || hipDeviceGetAttribute(&cus, hipDeviceAttributeMultiprocessorCount, dev) != hipSuccess) { grid = -1; return; }
        if (hipFuncSetAttribute((const void*)fwd, hipFuncAttributeMaxDynamicSharedMemorySize, LDS_BYTES) != hipSuccess) { fprintf(stderr, "kernel_launch: hipFuncSetAttribute failed\n"); grid = -1; return; }
        int per_cu = 0;
        if (hipOccupancyMaxActiveBlocksPerMultiprocessor(&per_cu, (const void*)fwd, NTHR, LDS_BYTES) != hipSuccess || per_cu < 1) fprintf(stderr, "kernel_launch: occupancy query reports %d\n", per_cu);
        (void)hipGetLastError();
        grid = cus;
    }
    if (grid < 0) return;
    (void)hipMemsetAsync((char*)d_ws + WS_CTL, 0, CTL_BYTES, stream);
    Args a{};
    for (int i = 0; i < 32; ++i) a.in[i] = d_in[i];
    a.out = (float*)d_out; a.ws = (unsigned char*)d_ws;
#if MK_PER_PHASE
    for (int ph = 0; ph < NPHASE; ++ph) { a.ph_lo = ph; a.ph_hi = ph + 1; hipLaunchKernelGGL(fwd, dim3(grid), dim3(NTHR), LDS_BYTES, stream, a); }
#else
    a.ph_lo = 0; a.ph_hi = NPHASE; hipLaunchKernelGGL(fwd, dim3(grid), dim3(NTHR), LDS_BYTES, stream, a);
#endif
}
```
